# Optimizing an MI355X kernel written in HIP

```python
import math
import jax, jax.numpy as jnp
from jax import lax
import numpy as np

D_MODEL = 1024
BATCH = 8
SEQ = 4096
DEPTH = 4

CHUNK = 64
NORM_EPS = 1e-6
POOL_WIDTH = D_MODEL // 4
POOL_WINDOWS = (2, 4, 8, 16)
POOL_GROUPS = len(POOL_WINDOWS)
POOL_GROUP_DIM = POOL_WIDTH // POOL_GROUPS
ATTN_HEAD_DIM = 64
ATTN_HEADS = D_MODEL // 256
ATTN_V_DIM = 2 * ATTN_HEAD_DIM
ATTN_QK_WIDTH = ATTN_HEADS * 2 * ATTN_HEAD_DIM
ATTN_V_WIDTH = ATTN_HEADS * ATTN_V_DIM
ROPE_THETA = 10000.0
Q_BLOCK = 128
SSM_WIDTH = D_MODEL // 4
SSM_GROUP_DIM = 16
SSM_GROUPS = SSM_WIDTH // SSM_GROUP_DIM
SSM_STATE = 64
DT_MIN = 0.001
DT_MAX = 0.1
IN_WIDTH = POOL_WIDTH + 2 * ATTN_QK_WIDTH + ATTN_V_WIDTH + SSM_WIDTH
N_BRANCHES = 3
MOE_GROUPS = 4
EXPERTS_PER_GROUP = 8
N_EXPERTS = MOE_GROUPS * EXPERTS_PER_GROUP
TOP_K_EXPERT = 2
EXPERT_FF = 512
MOE_BLOCK = 128

kernel_name = "hybrid_chunk_causal_pool_diffattn_s5_hmoe"


def rmsnorm(x, g):
    xf = x.astype(jnp.float32)
    y = xf * lax.rsqrt(jnp.mean(xf * xf, axis=-1, keepdims=True) + NORM_EPS)
    return (y * g.astype(jnp.float32)).astype(x.dtype)


def modulate(h, shift, scale):
    return h * (1.0 + scale[:, None, :]) + shift[:, None, :]


def rope_tables(positions):
    inv = ROPE_THETA ** (-jnp.arange(0, ATTN_HEAD_DIM, 2, dtype=jnp.float32) / ATTN_HEAD_DIM)
    ang = positions.astype(jnp.float32)[..., None] * inv
    return jnp.cos(ang)[:, :, None, None, :], jnp.sin(ang)[:, :, None, None, :]


def apply_rope(t, cos, sin):
    t1, t2 = jnp.split(t, 2, axis=-1)
    return jnp.concatenate([t1 * cos - t2 * sin, t2 * cos + t1 * sin], axis=-1)


def pool_mixer(u, pool_w, pool_scale):
    B, S, _ = u.shape
    ug = u.astype(jnp.float32).reshape(B, S, POOL_GROUPS, POOL_GROUP_DIM)
    cs = jnp.cumsum(ug, axis=1)
    t = jnp.arange(1, S + 1, dtype=jnp.float32)
    outs = []
    for g, w in enumerate(POOL_WINDOWS):
        cg = cs[:, :, g]
        prev = jnp.pad(cg, ((0, 0), (w, 0), (0, 0)))[:, :S]
        cnt = jnp.minimum(t, float(w))[None, :, None]
        outs.append((cg - prev) / cnt - ug[:, :, g])
    pooled = jnp.stack(outs, axis=2)
    y = jnp.einsum('bsgc,gcd->bsgd', pooled, pool_w.astype(jnp.float32)).reshape(B, S, POOL_WIDTH)
    return (y * pool_scale.astype(jnp.float32)).astype(u.dtype)


def diff_attention(q, k, v, cos, sin, q_g, k_g, lq1, lk1, lq2, lk2, subln_g, lambda_init):
    B, S, _ = q.shape
    H, dh, E = ATTN_HEADS, ATTN_HEAD_DIM, ATTN_V_DIM
    qf = rmsnorm(q.astype(jnp.float32).reshape(B, S, H, 2, dh), q_g)
    kf = rmsnorm(k.astype(jnp.float32).reshape(B, S, H, 2, dh), k_g)
    vf = v.astype(jnp.float32).reshape(B, S, H, E)
    qf = apply_rope(qf, cos, sin) * (dh ** -0.5)
    kf = apply_rope(kf, cos, sin)
    lam = (jnp.exp(jnp.sum(lq1.astype(jnp.float32) * lk1.astype(jnp.float32)))
           - jnp.exp(jnp.sum(lq2.astype(jnp.float32) * lk2.astype(jnp.float32))) + lambda_init)
    nb = S // Q_BLOCK
    qb = jnp.moveaxis(qf.reshape(B, nb, Q_BLOCK, H, 2, dh), 1, 0)
    k_chunk = jnp.arange(S) // CHUNK

    def block(args):
        qi, i = args
        s = jnp.einsum('bqhmd,bkhmd->bhmqk', qi, kf)
        q_chunk = (i * Q_BLOCK + jnp.arange(Q_BLOCK)) // CHUNK
        mask = k_chunk[None, :] <= q_chunk[:, None]
        p = jax.nn.softmax(jnp.where(mask, s, -1e30), axis=-1)
        a = p[:, :, 0] - lam * p[:, :, 1]
        return jnp.einsum('bhqk,bkhe->bqhe', a, vf)

    o = lax.map(block, (qb, jnp.arange(nb)))
    o = jnp.moveaxis(o, 0, 1).reshape(B, S, H, E)
    o = rmsnorm(o, subln_g) * (1.0 - lambda_init)
    return o.reshape(B, S, H * E).astype(q.dtype)


def ssm_mixer(u, lam_re, lam_im, log_dt, b_re, b_im, c_re, c_im, d_skip, glu_w, glu_b):
    B, S, _ = u.shape
    f32 = jnp.float32
    uf = u.astype(f32)
    ug = uf.reshape(B, S, SSM_GROUPS, SSM_GROUP_DIM)
    lr, li = lam_re.astype(f32), lam_im.astype(f32)
    dt = jnp.exp(log_dt.astype(f32))[:, None]
    mag = jnp.exp(lr * dt)
    ar, ai = mag * jnp.cos(li * dt), mag * jnp.sin(li * dt)
    nr, ni = ar - 1.0, ai
    den = lr * lr + li * li
    kr, ki = (nr * lr + ni * li) / den, (ni * lr - nr * li) / den
    br, bi = b_re.astype(f32), b_im.astype(f32)
    bbr = kr[..., None] * br - ki[..., None] * bi
    bbi = kr[..., None] * bi + ki[..., None] * br
    bur = jnp.einsum('bsgc,gpc->bsgp', ug, bbr)
    bui = jnp.einsum('bsgc,gpc->bsgp', ug, bbi)
    a_r = jnp.broadcast_to(ar, bur.shape)
    a_i = jnp.broadcast_to(ai, bui.shape)

    def combine(e1, e2):
        a1r, a1i, b1r, b1i = e1
        a2r, a2i, b2r, b2i = e2
        return (a2r * a1r - a2i * a1i, a2r * a1i + a2i * a1r,
                a2r * b1r - a2i * b1i + b2r, a2r * b1i + a2i * b1r + b2i)

    _, _, xr, xi = lax.associative_scan(combine, (a_r, a_i, bur, bui), axis=1)
    y = (jnp.einsum('bsgp,gcp->bsgc', xr, c_re.astype(f32))
         - jnp.einsum('bsgp,gcp->bsgc', xi, c_im.astype(f32))).reshape(B, S, SSM_WIDTH)
    y = jax.nn.gelu(y + d_skip.astype(f32) * uf)
    y = y * jax.nn.sigmoid(y @ glu_w.astype(f32) + glu_b.astype(f32))
    return y.astype(u.dtype)


def moe_dispatch(ht, e_idx, e_w, w1, w3, w2):
    T, D = ht.shape
    n_slots = T * TOP_K_EXPERT
    e_flat = e_idx.reshape(-1)
    w_flat = e_w.reshape(-1)
    tok_flat = jnp.repeat(jnp.arange(T, dtype=jnp.int32), TOP_K_EXPERT)
    order = jnp.argsort(e_flat)
    e_s, tok_s, w_s = e_flat[order], tok_flat[order], w_flat[order]
    counts = jnp.zeros((N_EXPERTS,), jnp.int32).at[e_flat].add(1)
    padded = (counts + MOE_BLOCK - 1) // MOE_BLOCK * MOE_BLOCK
    start = jnp.cumsum(counts) - counts
    pend = jnp.cumsum(padded)
    pstart = pend - padded
    dest = pstart[e_s] + (jnp.arange(n_slots, dtype=jnp.int32) - start[e_s])
    L = n_slots + N_EXPERTS * MOE_BLOCK
    nblk = L // MOE_BLOCK
    buf_tok = jnp.zeros((L,), jnp.int32).at[dest].set(tok_s)
    buf_w = jnp.zeros((L,), w_s.dtype).at[dest].set(w_s)
    blk_start = jnp.arange(nblk, dtype=jnp.int32) * MOE_BLOCK
    blk_e = jnp.minimum(jnp.sum(pend[None, :] <= blk_start[:, None], axis=1), N_EXPERTS - 1)
    xb = ht[buf_tok].reshape(nblk, MOE_BLOCK, D)

    def run_block(args):
        xblk, e = args
        return (jax.nn.silu(xblk @ w1[e]) * (xblk @ w3[e])) @ w2[e]

    yb = lax.map(run_block, (xb, blk_e)).reshape(L, D)
    return jnp.zeros((T, D), yb.dtype).at[buf_tok].add(yb * buf_w[:, None].astype(yb.dtype))


def hier_moe(h, rg_w, rg_b, re_w, re_b, w1, w3, w2):
    B, S, D = h.shape
    ht = h.reshape(B * S, D)
    T = B * S
    pg = jax.nn.softmax((ht @ rg_w).astype(jnp.float32) + rg_b.astype(jnp.float32), axis=-1)
    pg_top, g_idx = lax.top_k(pg, 1)
    el = ((ht @ re_w).astype(jnp.float32) + re_b.astype(jnp.float32)).reshape(T, MOE_GROUPS, EXPERTS_PER_GROUP)
    el_sel = jnp.take_along_axis(el, g_idx[:, :, None], axis=1)[:, 0]
    pe = jax.nn.softmax(el_sel, axis=-1)
    pe_top, e_local = lax.top_k(pe, TOP_K_EXPERT)
    w = pg_top * pe_top / jnp.sum(pe_top, axis=-1, keepdims=True)
    e_idx = g_idx * EXPERTS_PER_GROUP + e_local
    return moe_dispatch(ht, e_idx, w, w1, w3, w2).reshape(B, S, D)


def setup_inputs(seed: int = 0) -> dict:
    key = jax.random.key(seed)
    ks = jax.random.split(key, 40)
    f32 = jnp.float32
    L, D = DEPTH, D_MODEL

    def nrm(k, shape, scale):
        return jax.random.normal(k, shape, f32) * scale

    x = nrm(ks[0], (BATCH, SEQ, D), 1.0)
    c = nrm(ks[1], (BATCH, D), 1.0)
    start = jax.random.randint(ks[2], (BATCH, 1), 0, 16384, dtype=jnp.int32)
    positions = start + jnp.arange(SEQ, dtype=jnp.int32)[None, :]
    n = jnp.arange(SSM_STATE, dtype=f32)
    return {
        "x": x,
        "c": c,
        "positions": positions,
        "ada_w": nrm(ks[3], (L, D, 6 * D), 0.5 * D ** -0.5),
        "ada_b": nrm(ks[4], (L, 6 * D), 0.01),
        "norm1_g": 1.0 + nrm(ks[5], (L, D), 0.02),
        "w_in": nrm(ks[6], (L, D, IN_WIDTH), D ** -0.5),
        "pool_w": nrm(ks[7], (L, POOL_GROUPS, POOL_GROUP_DIM, POOL_GROUP_DIM), POOL_GROUP_DIM ** -0.5),
        "pool_scale": 1.0 + nrm(ks[8], (L, POOL_WIDTH), 0.02),
        "q_norm_g": 1.0 + nrm(ks[9], (L, ATTN_HEAD_DIM), 0.02),
        "k_norm_g": 1.0 + nrm(ks[10], (L, ATTN_HEAD_DIM), 0.02),
        "lambda_q1": nrm(ks[11], (L, ATTN_HEAD_DIM), 0.1),
        "lambda_k1": nrm(ks[12], (L, ATTN_HEAD_DIM), 0.1),
        "lambda_q2": nrm(ks[13], (L, ATTN_HEAD_DIM), 0.1),
        "lambda_k2": nrm(ks[14], (L, ATTN_HEAD_DIM), 0.1),
        "subln_g": 1.0 + nrm(ks[15], (L, ATTN_V_DIM), 0.02),
        "lam_re": -0.5 + nrm(ks[16], (L, SSM_GROUPS, SSM_STATE), 0.01),
        "lam_im": math.pi * n + nrm(ks[17], (L, SSM_GROUPS, SSM_STATE), 0.01),
        "log_dt": jax.random.uniform(ks[18], (L, SSM_GROUPS), f32, math.log(DT_MIN), math.log(DT_MAX)),
        "b_re": nrm(ks[19], (L, SSM_GROUPS, SSM_STATE, SSM_GROUP_DIM), (2 * SSM_GROUP_DIM) ** -0.5),
        "b_im": nrm(ks[20], (L, SSM_GROUPS, SSM_STATE, SSM_GROUP_DIM), (2 * SSM_GROUP_DIM) ** -0.5),
        "c_re": nrm(ks[21], (L, SSM_GROUPS, SSM_GROUP_DIM, SSM_STATE), (2 * SSM_STATE) ** -0.5),
        "c_im": nrm(ks[22], (L, SSM_GROUPS, SSM_GROUP_DIM, SSM_STATE), (2 * SSM_STATE) ** -0.5),
        "d_skip": nrm(ks[23], (L, SSM_WIDTH), 1.0),
        "glu_w": nrm(ks[24], (L, SSM_WIDTH, SSM_WIDTH), SSM_WIDTH ** -0.5),
        "glu_b": nrm(ks[25], (L, SSM_WIDTH), 0.01),
        "proj_a": nrm(ks[26], (L, POOL_WIDTH, D), POOL_WIDTH ** -0.5),
        "proj_b": nrm(ks[27], (L, ATTN_V_WIDTH, D), ATTN_V_WIDTH ** -0.5),
        "proj_c": nrm(ks[28], (L, SSM_WIDTH, D), SSM_WIDTH ** -0.5),
        "gate_w": nrm(ks[29], (L, D, N_BRANCHES * D), D ** -0.5),
        "gate_b": nrm(ks[30], (L, N_BRANCHES * D), 0.01),
        "w_out": nrm(ks[31], (L, D, D), D ** -0.5),
        "norm2_g": 1.0 + nrm(ks[32], (L, D), 0.02),
        "router_g_w": nrm(ks[33], (L, D, MOE_GROUPS), D ** -0.5),
        "router_g_b": nrm(ks[34], (L, MOE_GROUPS), 0.01),
        "router_e_w": nrm(ks[35], (L, D, N_EXPERTS), D ** -0.5),
        "router_e_b": nrm(ks[36], (L, N_EXPERTS), 0.01),
        "moe_w1": nrm(ks[37], (L, N_EXPERTS, D, EXPERT_FF), D ** -0.5),
        "moe_w3": nrm(ks[38], (L, N_EXPERTS, D, EXPERT_FF), D ** -0.5),
        "moe_w2": nrm(ks[39], (L, N_EXPERTS, EXPERT_FF, D), EXPERT_FF ** -0.5),
    }


def reference(x, c, positions, ada_w, ada_b, norm1_g, w_in, pool_w, pool_scale,
              q_norm_g, k_norm_g, lambda_q1, lambda_k1, lambda_q2, lambda_k2, subln_g,
              lam_re, lam_im, log_dt, b_re, b_im, c_re, c_im, d_skip, glu_w, glu_b,
              proj_a, proj_b, proj_c, gate_w, gate_b, w_out, norm2_g,
              router_g_w, router_g_b, router_e_w, router_e_b, moe_w1, moe_w3, moe_w2):
    cos, sin = rope_tables(positions)
    c_act = jax.nn.silu(c)
    splits = [POOL_WIDTH, POOL_WIDTH + ATTN_QK_WIDTH, POOL_WIDTH + 2 * ATTN_QK_WIDTH,
              POOL_WIDTH + 2 * ATTN_QK_WIDTH + ATTN_V_WIDTH]
    for l in range(DEPTH):
        lambda_init = 0.8 - 0.6 * math.exp(-0.3 * l)
        mod = c_act @ ada_w[l] + ada_b[l]
        sh1, sc1, g1, sh2, sc2, g2 = jnp.split(mod, 6, axis=-1)
        h = modulate(rmsnorm(x, norm1_g[l]), sh1, sc1)
        z = h @ w_in[l]
        u_a, q, k, v, u_c = jnp.split(z, splits, axis=-1)
        ya = pool_mixer(u_a, pool_w[l], pool_scale[l])
        yb = diff_attention(q, k, v, cos, sin, q_norm_g[l], k_norm_g[l], lambda_q1[l], lambda_k1[l],
                            lambda_q2[l], lambda_k2[l], subln_g[l], lambda_init)
        yc = ssm_mixer(u_c, lam_re[l], lam_im[l], log_dt[l], b_re[l], b_im[l], c_re[l], c_im[l],
                       d_skip[l], glu_w[l], glu_b[l])
        ga, gb, gc = jnp.split(jax.nn.sigmoid(h @ gate_w[l] + gate_b[l]), N_BRANCHES, axis=-1)
        mixed = ga * (ya @ proj_a[l]) + gb * (yb @ proj_b[l]) + gc * (yc @ proj_c[l])
        x = x + g1[:, None, :] * (mixed @ w_out[l])
        h2 = modulate(rmsnorm(x, norm2_g[l]), sh2, sc2)
        x = x + g2[:, None, :] * hier_moe(h2, router_g_w[l], router_g_b[l], router_e_w[l], router_e_b[l],
                                          moe_w1[l], moe_w3[l], moe_w2[l])
    return x
```

```cpp
#include <hip/hip_runtime.h>
#include <cstdio>
#include <cstdint>

#ifndef MK_MULTI
#define MK_MULTI 1
#endif

namespace pg8 {
#define PG8_LAS __attribute__((address_space(3)))
typedef unsigned short bf16_t;
typedef short bf16x8 __attribute__((ext_vector_type(8)));
typedef float f32x4 __attribute__((ext_vector_type(4)));
typedef unsigned u32x4 __attribute__((ext_vector_type(4)));
typedef unsigned u32x2 __attribute__((ext_vector_type(2)));
constexpr int BM = 256, BK = 64, HALF = 128, HTB = HALF * BK * 2  , STAGE_BYTES = 8 * HTB, NXCD = 8, WGM = 8;

__host__ __device__ __forceinline__ int lds_byte(int r, int c) { const int st = (r >> 4) * 2 + (c >> 5), rr = r & 15, cc = c & 31, ob = rr * 64 + cc * 2; return st * 1024 + (ob ^ (((ob >> 9) & 1) << 5)); }
__host__ __device__ __forceinline__ void stage_rc(int b, int& R, int& C) { const int st = b / 1024, sb = b % 1024, swz = sb ^ (((sb >> 9) & 1) << 5); R = (st >> 1) * 16 + swz / 64; C = (st & 1) * 32 + (swz % 64) / 2; }
__host__ __device__ __forceinline__ int perm32(int rho) { const int n = rho >> 4, i = rho & 15; return 8 * (i >> 2) + 4 * n + (i & 3); }

struct Unit { int pm, pn, pb; };
struct Gemm { const bf16_t* A; const bf16_t* Bt; int lda, ldb, K; };

struct StaticOrder {
    int nM, nN, nwg, G, c;
    __host__ __device__ void init(int M, int N, int G_, int c_) { nM = M / BM; nN = N / BM; nwg = nM * nN; G = G_; c = c_; }
    __host__ __device__ bool next(int i, Unit& u) const {
        const long L = (long)i * G + c; if (L >= nwg) return false;
        int wgid = (int)L; { const int q = nwg / NXCD, r = nwg % NXCD, xcd = wgid % NXCD, off = wgid / NXCD; wgid = (xcd < r ? xcd * (q + 1) : r * (q + 1) + (xcd - r) * q) + off; }
        const int nig = WGM * nN, gid = wgid / nig, fm = gid * WGM, gsz = (nM - fm) < WGM ? (nM - fm) : WGM;
        u.pm = fm + ((wgid % nig) % gsz); u.pn = (wgid % nig) / gsz; u.pb = u.pn; return true;
    }
    __device__ __forceinline__ void a_ready(const Unit&) const {}
    __device__ __forceinline__ void done(const Unit&) const {}
};
struct GroupedOrder {
    const int* tile_e; int ntiles, G, c;
    __device__ __forceinline__ bool next(int i, Unit& u) const {
        const long L = (long)i * G + c; if (L >= (long)ntiles * 4) return false;
        const int pm = (int)(L >> 2), pl = (int)(L & 3);
        u.pm = pm; u.pn = pl; u.pb = __builtin_amdgcn_readfirstlane(tile_e[pm]) * 4 + pl; return true;
    }
    __device__ __forceinline__ void a_ready(const Unit&) const {}
    __device__ __forceinline__ void done(const Unit&) const {}
};

__device__ __forceinline__ unsigned cvt_pk_bf16(float lo, float hi) { unsigned r; asm volatile("v_cvt_pk_bf16_f32 %0, %1, %2" : "=v"(r) : "v"(lo), "v"(hi)); return r; }
__device__ __forceinline__ float bflo(unsigned w) { return __uint_as_float(w << 16); }
__device__ __forceinline__ float bfhi(unsigned w) { return __uint_as_float(w & 0xffff0000u); }
__device__ __forceinline__ float sigmoidf_(float x) { return 1.0f / (1.0f + __expf(-x)); }


struct EpiZG {
    static constexpr bool PERM = true, AFTER_DRAIN = false;
    bf16_t* Z; bf16_t* Gt; const float* gbias;
    __device__ __forceinline__ void operator()(const f32x4 (&acc)[2][2][4][2], const Unit& u, int wr, int wc, int fr, int fq) const {
        asm volatile("" : "+v"(fr), "+v"(fq));
        const int row0 = u.pm * BM + wr * 64 + fr;
        const bool gate = u.pn >= 8;
        const int colt = gate ? (u.pn - 8) * BM : u.pn * BM, ldc = gate ? 3072 : 2048;
        bf16_t* base = gate ? Gt : Z;
        const int col0 = colt + wc * 32 + 8 * fq;
        f32x4 bv[2][2];
#pragma unroll
        for (int bj = 0; bj < 2; ++bj)
#pragma unroll
            for (int n = 0; n < 2; ++n) bv[bj][n] = gate ? *(const f32x4*)(gbias + col0 + bj * HALF + 4 * n) : (f32x4){0.f, 0.f, 0.f, 0.f};
#pragma unroll
        for (int ai = 0; ai < 2; ++ai)
#pragma unroll
            for (int m = 0; m < 4; ++m) { bf16_t* rowp = base + (size_t)(row0 + ai * HALF + m * 16) * ldc + col0;
#pragma unroll
                for (int bj = 0; bj < 2; ++bj) { f32x4 v0 = acc[ai][bj][m][0] + bv[bj][0], v1 = acc[ai][bj][m][1] + bv[bj][1];
                    if (gate) {
#pragma unroll
                        for (int j = 0; j < 4; ++j) { v0[j] = sigmoidf_(v0[j]); v1[j] = sigmoidf_(v1[j]); } }
                    u32x4 w; w.x = cvt_pk_bf16(v0[0], v0[1]); w.y = cvt_pk_bf16(v0[2], v0[3]); w.z = cvt_pk_bf16(v1[0], v1[1]); w.w = cvt_pk_bf16(v1[2], v1[3]);
                    *(u32x4*)(rowp + bj * HALF) = w; } }
    }
};
struct EpiMix {
    static constexpr bool PERM = true, AFTER_DRAIN = false;
    bf16_t* O; const bf16_t* Gt; int gcol0; bool first;
    __device__ __forceinline__ void operator()(const f32x4 (&acc)[2][2][4][2], const Unit& u, int wr, int wc, int fr, int fq) const {
        asm volatile("" : "+v"(fr), "+v"(fq));
        const int row0 = u.pm * BM + wr * 64 + fr, col0 = u.pn * BM + wc * 32 + 8 * fq;
#pragma unroll
        for (int ai = 0; ai < 2; ++ai)
#pragma unroll
            for (int m = 0; m < 4; ++m) { const size_t row = (size_t)(row0 + ai * HALF + m * 16);
#pragma unroll
                for (int bj = 0; bj < 2; ++bj) {
                    const u32x4 gw = *(const u32x4*)(Gt + row * 3072 + gcol0 + col0 + bj * HALF);
                    bf16_t* op = O + row * 1024 + col0 + bj * HALF;
                    f32x4 v0 = acc[ai][bj][m][0], v1 = acc[ai][bj][m][1];
                    v0[0] *= bflo(gw.x); v0[1] *= bfhi(gw.x); v0[2] *= bflo(gw.y); v0[3] *= bfhi(gw.y);
                    v1[0] *= bflo(gw.z); v1[1] *= bfhi(gw.z); v1[2] *= bflo(gw.w); v1[3] *= bfhi(gw.w);
                    if (!first) { const u32x4 pw = *(const u32x4*)op;
                        v0[0] += bflo(pw.x); v0[1] += bfhi(pw.x); v0[2] += bflo(pw.y); v0[3] += bfhi(pw.y);
                        v1[0] += bflo(pw.z); v1[1] += bfhi(pw.z); v1[2] += bflo(pw.w); v1[3] += bfhi(pw.w); }
                    u32x4 w; w.x = cvt_pk_bf16(v0[0], v0[1]); w.y = cvt_pk_bf16(v0[2], v0[3]); w.z = cvt_pk_bf16(v1[0], v1[1]); w.w = cvt_pk_bf16(v1[2], v1[3]);
                    *(u32x4*)op = w; }
                asm volatile("" ::: "memory"); }
    }
};
struct EpiResid {
    static constexpr bool PERM = false, AFTER_DRAIN = false;
    float* X; const float* g1;
    __device__ __forceinline__ void operator()(const f32x4 (&acc)[2][2][4][2], const Unit& u, int wr, int wc, int fr, int fq) const {
        asm volatile("" : "+v"(fr), "+v"(fq));
        const int row0 = u.pm * BM + wr * 64 + fr, col0 = u.pn * BM + wc * 32 + 4 * fq;
        const float* gp = g1 + (size_t)((u.pm * BM) >> 12) * 6144 + col0;
        f32x4 gv[2][2];
#pragma unroll
        for (int bj = 0; bj < 2; ++bj)
#pragma unroll
            for (int n = 0; n < 2; ++n) gv[bj][n] = *(const f32x4*)(gp + bj * HALF + n * 16);
#pragma unroll
        for (int ai = 0; ai < 2; ++ai)
#pragma unroll
            for (int m = 0; m < 4; ++m) { float* rowp = X + (size_t)(row0 + ai * HALF + m * 16) * 1024 + col0;
#pragma unroll
                for (int bj = 0; bj < 2; ++bj)
#pragma unroll
                    for (int n = 0; n < 2; ++n) { f32x4* p = (f32x4*)(rowp + bj * HALF + n * 16); *p = *p + gv[bj][n] * acc[ai][bj][m][n]; } }
    }
};
struct EpiSwiGLU {
    static constexpr bool PERM = true, AFTER_DRAIN = false;
    bf16_t* O;
    __device__ __forceinline__ void operator()(const f32x4 (&acc)[2][2][4][2], const Unit& u, int wr, int wc, int fr, int fq) const {
        asm volatile("" : "+v"(fr), "+v"(fq));
        const int row0 = u.pm * BM + wr * 64 + fr, col0 = u.pn * HALF + wc * 32 + 8 * fq;
#pragma unroll
        for (int ai = 0; ai < 2; ++ai)
#pragma unroll
            for (int m = 0; m < 4; ++m) { bf16_t* op = O + (size_t)(row0 + ai * HALF + m * 16) * 512 + col0;
                float r[8];
#pragma unroll
                for (int n = 0; n < 2; ++n)
#pragma unroll
                    for (int j = 0; j < 4; ++j) { const float a = acc[ai][0][m][n][j], b = acc[ai][1][m][n][j]; r[n * 4 + j] = a * sigmoidf_(a) * b; }
                u32x4 w; w.x = cvt_pk_bf16(r[0], r[1]); w.y = cvt_pk_bf16(r[2], r[3]); w.z = cvt_pk_bf16(r[4], r[5]); w.w = cvt_pk_bf16(r[6], r[7]);
                *(u32x4*)op = w; }
    }
};
struct EpiY {
    static constexpr bool PERM = true, AFTER_DRAIN = false;
    bf16_t* O;
    __device__ __forceinline__ void operator()(const f32x4 (&acc)[2][2][4][2], const Unit& u, int wr, int wc, int fr, int fq) const {
        asm volatile("" : "+v"(fr), "+v"(fq));
        const int row0 = u.pm * BM + wr * 64 + fr, col0 = u.pn * BM + wc * 32 + 8 * fq;
#pragma unroll
        for (int ai = 0; ai < 2; ++ai)
#pragma unroll
            for (int m = 0; m < 4; ++m) { bf16_t* rowp = O + (size_t)(row0 + ai * HALF + m * 16) * 1024 + col0;
#pragma unroll
                for (int bj = 0; bj < 2; ++bj) { const f32x4 v0 = acc[ai][bj][m][0], v1 = acc[ai][bj][m][1];
                    u32x4 w; w.x = cvt_pk_bf16(v0[0], v0[1]); w.y = cvt_pk_bf16(v0[2], v0[3]); w.z = cvt_pk_bf16(v1[0], v1[1]); w.w = cvt_pk_bf16(v1[2], v1[3]);
                    *(u32x4*)(rowp + bj * HALF) = w; } }
    }
};

template <class Epi, class Sched, bool ALIGN_EPI = false, bool SP2 = false>
__device__ __forceinline__ void gemm_phase(PG8_LAS unsigned char* lds, const Gemm g, const Sched& S, const Epi& E) {
    const int tid = threadIdx.x, wid = __builtin_amdgcn_readfirstlane(tid >> 6), lane = tid & 63, wr = wid >> 2, wc = wid & 3, fr = lane & 15, fq = lane >> 4;
    const int K = g.K, nt = K / BK, lda = g.lda, ldb = g.ldb;
    unsigned voffA[2], voffB[2];
#pragma unroll
    for (int i = 0; i < 2; ++i) { int R, C; stage_rc(tid * 16 + i * 8192, R, C); const int Rb = Epi::PERM ? ((R & ~31) + perm32(R & 31)) : R;
        voffA[i] = (unsigned)(R * lda + C) * 2u; voffB[i] = (unsigned)(Rb * ldb + C) * 2u; }
    const size_t kstep = (size_t)(BK * 2);
    const size_t hstepA = (size_t)HALF * lda * 2, hstepB = (size_t)HALF * ldb * 2;
    const size_t tstepA = 2 * hstepA, tstepB = 2 * hstepB;
    const unsigned ldsw = (unsigned)wid * 1024u;
    const int aoff = lds_byte(wr * 64 + fr, fq * 8), boff = lds_byte(wc * 32 + fr, fq * 8);
#define PG8_SA(b, h) (((b) * 2 + (h)) * HTB)
#define PG8_SB(b, h) ((4 + (b) * 2 + (h)) * HTB)
#define PG8_STAGE(bufoff, gbase, voff) do { _Pragma("unroll") for (int _i = 0; _i < 2; ++_i) \
        __builtin_amdgcn_global_load_lds((const unsigned*)((const char*)(gbase) + (voff)[_i]), (PG8_LAS unsigned*)(lds + (bufoff) + ldsw + _i * 8192), 16, 0, 0); } while (0)
#define PG8_LDA(dst, b, h) do { _Pragma("unroll") for (int m = 0; m < 4; ++m) _Pragma("unroll") for (int k = 0; k < 2; ++k) dst[m][k] = *(const PG8_LAS bf16x8*)(lds + PG8_SA(b, h) + aoff + m * 2048 + k * 1024); } while (0)
#define PG8_LDB(dst, b, h) do { _Pragma("unroll") for (int n = 0; n < 2; ++n) _Pragma("unroll") for (int k = 0; k < 2; ++k) dst[n][k] = *(const PG8_LAS bf16x8*)(lds + PG8_SB(b, h) + boff + n * 2048 + k * 1024); } while (0)
#define PG8_MMA(ai, bj, At, Bt) do { __builtin_amdgcn_s_setprio(1); _Pragma("unroll") for (int m = 0; m < 4; ++m) _Pragma("unroll") for (int n = 0; n < 2; ++n) _Pragma("unroll") for (int k = 0; k < 2; ++k) \
        acc[ai][bj][m][n] = __builtin_amdgcn_mfma_f32_16x16x32_bf16(Bt[n][k], At[m][k], acc[ai][bj][m][n], 0, 0, 0); __builtin_amdgcn_s_setprio(0); } while (0)
#define PG8_WAIT_V(n) asm volatile("s_waitcnt vmcnt(" #n ")" ::: "memory")
#define PG8_WAIT_L(n) asm volatile("s_waitcnt lgkmcnt(" #n ")" ::: "memory")
#define PG8_BAR __builtin_amdgcn_s_barrier()
#define PG8_SCHED __builtin_amdgcn_sched_barrier(0)
    Unit cur, nxt; int ui = 0;
    if (!S.next(0, cur)) return;
    f32x4 acc[2][2][4][2];
#pragma unroll
    for (int a = 0; a < 2; ++a)
#pragma unroll
        for (int b = 0; b < 2; ++b)
#pragma unroll
            for (int m = 0; m < 4; ++m)
#pragma unroll
                for (int n = 0; n < 2; ++n) acc[a][b][m][n] = (f32x4){0.f, 0.f, 0.f, 0.f};
    bf16x8 At[4][2], B0[2][2], B1[2][2];
    const char* cA = (const char*)g.A + (size_t)cur.pm * tstepA; const char* cB = (const char*)g.Bt + (size_t)cur.pb * tstepB;
    S.a_ready(cur);
    if constexpr (SP2) {
        PG8_STAGE(PG8_SB(0, 0), cB, voffB); PG8_STAGE(PG8_SB(0, 1), cB + hstepB, voffB); PG8_STAGE(PG8_SA(0, 0), cA, voffA); PG8_STAGE(PG8_SA(0, 1), cA + hstepA, voffA);
        if (wr == 1) PG8_BAR;
        PG8_WAIT_V(2); PG8_BAR;
        PG8_STAGE(PG8_SB(1, 0), cB + kstep, voffB); PG8_STAGE(PG8_SA(1, 0), cA + kstep, voffA); PG8_STAGE(PG8_SB(1, 1), cB + hstepB + kstep, voffB);
        PG8_WAIT_V(6); PG8_BAR;
    } else {
        PG8_STAGE(PG8_SB(0, 0), cB, voffB); PG8_STAGE(PG8_SA(0, 0), cA, voffA); PG8_STAGE(PG8_SB(0, 1), cB + hstepB, voffB); PG8_STAGE(PG8_SA(0, 1), cA + hstepA, voffA);
        if (wr == 1) PG8_BAR;
        PG8_WAIT_V(4); PG8_BAR;
        PG8_STAGE(PG8_SB(1, 0), cB + kstep, voffB); PG8_STAGE(PG8_SA(1, 0), cA + kstep, voffA); PG8_STAGE(PG8_SB(1, 1), cB + hstepB + kstep, voffB);
        PG8_WAIT_V(6); PG8_BAR;
    }
    for (;;) {
        const bool has_next = S.next(ui + 1, nxt);
        const char* nA = has_next ? (const char*)g.A + (size_t)nxt.pm * tstepA : cA; const char* nB = has_next ? (const char*)g.Bt + (size_t)nxt.pb * tstepB : cB;
#pragma unroll 1
        for (int t = 0; t < nt; t += 2) {
            const bool last = (t == nt - 2);
            const char* a1 = cA + (size_t)(t + 1) * kstep;
            const char* a2 = last ? nA : cA + (size_t)(t + 2) * kstep; const char* b2 = last ? nB : cB + (size_t)(t + 2) * kstep;
            const char* a3 = a2 + kstep; const char* b3 = b2 + kstep;
            if (last && has_next) S.a_ready(nxt);
            if constexpr (SP2) {
            PG8_LDB(B0, 0, 0); PG8_LDB(B1, 0, 1); PG8_SCHED; PG8_LDA(At, 0, 0); PG8_STAGE(PG8_SA(1, 1), a1 + hstepA, voffA);
            PG8_WAIT_V(8); PG8_WAIT_L(0); PG8_BAR; PG8_MMA(0, 0, At, B0); PG8_MMA(0, 1, At, B1); PG8_BAR; PG8_SCHED;
            PG8_LDA(At, 0, 1); PG8_STAGE(PG8_SB(0, 0), b2, voffB); PG8_STAGE(PG8_SB(0, 1), b2 + hstepB, voffB); PG8_STAGE(PG8_SA(0, 0), a2, voffA);
            PG8_WAIT_V(8); PG8_WAIT_L(0); PG8_BAR; PG8_MMA(1, 0, At, B0); PG8_MMA(1, 1, At, B1); PG8_BAR; PG8_SCHED;
            PG8_LDB(B0, 1, 0); PG8_LDB(B1, 1, 1); PG8_SCHED; PG8_LDA(At, 1, 0); PG8_STAGE(PG8_SA(0, 1), a2 + hstepA, voffA);
            PG8_WAIT_V(8); PG8_WAIT_L(0); PG8_BAR; PG8_MMA(0, 0, At, B0); PG8_MMA(0, 1, At, B1); PG8_BAR; PG8_SCHED;
            PG8_LDA(At, 1, 1); PG8_STAGE(PG8_SB(1, 0), b3, voffB); PG8_STAGE(PG8_SB(1, 1), b3 + hstepB, voffB); PG8_STAGE(PG8_SA(1, 0), a3, voffA);
            PG8_WAIT_V(8); PG8_WAIT_L(0); PG8_BAR; PG8_MMA(1, 0, At, B0); PG8_MMA(1, 1, At, B1); PG8_BAR; PG8_SCHED;
            } else {
            PG8_LDB(B0, 0, 0); PG8_SCHED; PG8_LDA(At, 0, 0); PG8_STAGE(PG8_SA(1, 1), a1 + hstepA, voffA);
            PG8_WAIT_L(8); PG8_BAR; PG8_WAIT_L(0); PG8_MMA(0, 0, At, B0); PG8_BAR; PG8_SCHED;
            PG8_LDB(B1, 0, 1); PG8_STAGE(PG8_SB(0, 0), b2, voffB);
            PG8_BAR; PG8_WAIT_L(0); PG8_MMA(0, 1, At, B1); PG8_BAR;
            PG8_LDA(At, 0, 1); PG8_STAGE(PG8_SA(0, 0), a2, voffA);
            PG8_BAR; PG8_WAIT_L(0); PG8_MMA(1, 0, At, B0); PG8_BAR; PG8_SCHED;
            PG8_STAGE(PG8_SB(0, 1), b2 + hstepB, voffB);
            PG8_WAIT_V(6); PG8_BAR; PG8_MMA(1, 1, At, B1); PG8_BAR;
            PG8_LDB(B0, 1, 0); PG8_SCHED; PG8_LDA(At, 1, 0); PG8_STAGE(PG8_SA(0, 1), a2 + hstepA, voffA);
            PG8_WAIT_L(8); PG8_BAR; PG8_WAIT_L(0); PG8_MMA(0, 0, At, B0); PG8_BAR; PG8_SCHED;
            PG8_LDB(B1, 1, 1); PG8_STAGE(PG8_SB(1, 0), b3, voffB);
            PG8_BAR; PG8_WAIT_L(0); PG8_MMA(0, 1, At, B1); PG8_BAR;
            PG8_LDA(At, 1, 1); PG8_STAGE(PG8_SA(1, 0), a3, voffA);
            PG8_BAR; PG8_WAIT_L(0); PG8_MMA(1, 0, At, B0); PG8_BAR; PG8_SCHED;
            PG8_STAGE(PG8_SB(1, 1), b3 + hstepB, voffB);
            PG8_WAIT_V(6); PG8_BAR; PG8_MMA(1, 1, At, B1); PG8_BAR;
            }
        }
        if constexpr (ALIGN_EPI) { if (wr == 0) PG8_BAR; }
        if constexpr (!Epi::AFTER_DRAIN) { E(acc, cur, wr, wc, fr, fq); S.done(cur); }
        if (!has_next) break;
#pragma unroll
        for (int a = 0; a < 2; ++a)
#pragma unroll
            for (int b = 0; b < 2; ++b)
#pragma unroll
                for (int m = 0; m < 4; ++m)
#pragma unroll
                    for (int n = 0; n < 2; ++n) acc[a][b][m][n] = (f32x4){0.f, 0.f, 0.f, 0.f};
        cur = nxt; cA = nA; cB = nB; ++ui;
        if constexpr (ALIGN_EPI) { if (wr == 1) PG8_BAR; }
    }
    PG8_WAIT_V(0);
    if constexpr (!ALIGN_EPI) { if (wr == 0) PG8_BAR; }
    PG8_BAR;
    if constexpr (Epi::AFTER_DRAIN) { E.fused(acc, cur, wr, wc, fr, fq, lds, wid, lane); S.done(cur); }
#undef PG8_SA
#undef PG8_SB
#undef PG8_STAGE
#undef PG8_LDA
#undef PG8_LDB
#undef PG8_MMA
#undef PG8_WAIT_V
#undef PG8_WAIT_L
#undef PG8_BAR
#undef PG8_SCHED
}
}

constexpr int NB = 8, SEQ = 4096, T = NB * SEQ, D = 1024, DEPTH = 4;
constexpr int ZW = 2048, GWD = 3072, NCAT = ZW + GWD;
constexpr int ZQ = 256, ZK = 768, ZV = 1280, ZC = 1792;
constexpr int NEXP = 32, FF = 512, MAXSLOT = 2 * T + NEXP * 256;
constexpr float NORM_EPS = 1e-6f;
constexpr int NWAVES = 8;
constexpr int PH_PER_LAYER = 11, N_PHASES = 1 + DEPTH * PH_PER_LAYER + 1;

constexpr size_t MiB = 1u << 20;
constexpr size_t WS_CTL = 0, CTL_ZERO_BYTES = 1 * MiB;
constexpr size_t WS_MOD = 1 * MiB;
constexpr size_t WS_LAM = WS_MOD + (size_t)DEPTH * NB * 6144 * 4;
constexpr size_t WS_ROPE_C = 2 * MiB, WS_ROPE_S = 6 * MiB;
constexpr size_t WS_SSM = 10 * MiB;
constexpr size_t SSM_L_BYTES = 8192 + 8192 + 131072;
constexpr size_t WS_RWT = 11 * MiB;
constexpr size_t WS_TOKE = 12 * MiB, WS_TOKW = WS_TOKE + 256 * 1024, WS_TOKL = WS_TOKW + 256 * 1024, WS_TOKS = WS_TOKL + 256 * 1024;
constexpr size_t WS_WGBASE = 13 * MiB, WS_TILEE = WS_WGBASE + 64 * 1024;
constexpr size_t WS_E = 14 * MiB, WS_CIN = 18 * MiB;
constexpr size_t WS_WCAT = 24 * MiB;
constexpr size_t WS_WMIX = 64 * MiB;
constexpr size_t WS_WO = 72 * MiB;
constexpr size_t WS_WGLU = 80 * MiB;
constexpr size_t WS_W13 = 82 * MiB;
constexpr size_t WS_W2 = 146 * MiB;
constexpr size_t WS_H = 178 * MiB;
constexpr size_t WS_Z = 242 * MiB;
constexpr size_t WS_G = 370 * MiB;
constexpr size_t WS_O0 = 562 * MiB, WS_O1 = 626 * MiB;
constexpr size_t WS_AMIX = 690 * MiB;
constexpr size_t WS_MIXED = 754 * MiB;
constexpr size_t WS_AG = 242 * MiB;
constexpr size_t WS_ACT = 386 * MiB;
constexpr size_t WS_Y = 458 * MiB;
constexpr size_t WS_END = 818 * MiB;
static_assert(WS_AG + (size_t)MAXSLOT * 1024 * 2 <= WS_ACT && WS_ACT + (size_t)MAXSLOT * 512 * 2 <= WS_Y && WS_Y + (size_t)MAXSLOT * 1024 * 2 <= WS_AMIX, "moe overlay map");
constexpr int CW_BAR = 4096;
constexpr int CW_CNT = 16384;

constexpr int RING_OFF = 0, RING_BYTES = 131072;
constexpr int LDSCTL_OFF = RING_BYTES, MISC_OFF = LDSCTL_OFF + 320;
constexpr int LDS_BYTES = 147456;

#define GAS __attribute__((address_space(1)))
#define LAS __attribute__((address_space(3)))
typedef unsigned short bf16;
typedef unsigned v4u __attribute__((ext_vector_type(4)));
typedef unsigned v2u __attribute__((ext_vector_type(2)));
typedef float f32x4 __attribute__((ext_vector_type(4)));
typedef float f32x2 __attribute__((ext_vector_type(2)));
typedef short bf16x8 __attribute__((ext_vector_type(8)));
typedef GAS unsigned gu32;
#define RLX_AGENT __ATOMIC_RELAXED, __HIP_MEMORY_SCOPE_AGENT
#define LDS_WAIT() asm volatile("s_waitcnt lgkmcnt(0)" ::: "memory")
#define VM_WAIT() asm volatile("s_waitcnt vmcnt(0)" ::: "memory")
__device__ __forceinline__ unsigned f2bf(float f) { unsigned u = __builtin_bit_cast(unsigned, f); return (u + 0x7fffu + ((u >> 16) & 1u)) >> 16; }
__device__ __forceinline__ unsigned pk2(float lo, float hi) { return f2bf(lo) | (f2bf(hi) << 16); }
__device__ __forceinline__ float bf2f(unsigned short b) { return __uint_as_float(((unsigned)b) << 16); }
__device__ __forceinline__ float bflo(unsigned w) { return __uint_as_float(w << 16); }
__device__ __forceinline__ float bfhi(unsigned w) { return __uint_as_float(w & 0xffff0000u); }

#define XB_TMO      128
#define XB_XCNT(j)  (256  + 64 * (j))
#define XB_XSUB(j)  (1280 + 64 * (j))
#define XB_XGEN(j)  (2304 + 64 * (j))
#define XB_TOP      3328
#define XB_TOPGEN   3392
#define XCD_BAR_WORDS 3456
#define XB_SPIN_CAP (1u << 18)

__device__ __forceinline__ unsigned xb_ld(unsigned* p)              { return __hip_atomic_load(p, __ATOMIC_RELAXED, __HIP_MEMORY_SCOPE_AGENT); }
__device__ __forceinline__ unsigned xb_add(unsigned* p, unsigned v) { return __hip_atomic_fetch_add(p, v, __ATOMIC_RELAXED, __HIP_MEMORY_SCOPE_AGENT); }
__device__ __forceinline__ unsigned xb_xcc_id() { return (unsigned)__builtin_amdgcn_s_getreg((3 << 11) | 20) & 0xFu; }
#define XB_SPIN(cond, bar) do { unsigned _sp = 0; while (cond) { __builtin_amdgcn_s_sleep(1); \
    if ((++_sp & 255u) == 0u) { if (xb_ld(&(bar)[XB_TMO])) break; if (_sp > XB_SPIN_CAP) { atomicAdd(&(bar)[XB_TMO], 1u); break; } } } } while (0)

struct XcdBarrier {
    unsigned* bar; unsigned x;
    volatile LAS unsigned* st;
};

__device__ __forceinline__ XcdBarrier xcd_barrier_post(unsigned* bar, volatile LAS unsigned* st) {
    XcdBarrier b; b.bar = bar; b.x = xb_xcc_id(); b.st = st;
    if (threadIdx.x == 0) (void)xb_add(&bar[XB_XCNT(b.x)], 1u);
    return b;
}
__device__ __forceinline__ void xcd_barrier_complete(unsigned* bar, unsigned x, unsigned& nloc, unsigned& nx) {
    const unsigned G = gridDim.x * gridDim.y * gridDim.z;
    unsigned sum, cnt, mine, sp = 0u;
    for (;;) {
        sum = 0u; cnt = 0u; mine = 0u;
#pragma unroll
        for (unsigned j = 0; j < 16; ++j) { const unsigned c = xb_ld(&bar[XB_XCNT(j)]); sum += c; cnt += (c > 0u) ? 1u : 0u; mine = (j == x) ? c : mine; }
        if (sum == G) break;
        __builtin_amdgcn_s_sleep(1);
        if ((++sp & 255u) == 0u) { if (xb_ld(&bar[XB_TMO])) break; if (sp > XB_SPIN_CAP) { atomicAdd(&bar[XB_TMO], 1u); break; } }
    }
    nloc = mine > 0u ? mine : 1u; nx = cnt > 0u ? cnt : 1u;
}

__device__ __forceinline__ void xcd_barrier(const XcdBarrier& b) {
    asm volatile("s_waitcnt vmcnt(0)" ::: "memory");
    __syncthreads();
    if (threadIdx.x == 0) {
        unsigned* bar = b.bar;
        __builtin_amdgcn_s_waitcnt(0);
        unsigned nloc = b.st[0], nx = b.st[1];
        if (nloc == 0u) { xcd_barrier_complete(bar, b.x, nloc, nx); b.st[0] = nloc; b.st[1] = nx; }
        const unsigned old = xb_add(&bar[XB_XSUB(b.x)], 1u);
        const unsigned gen = old / nloc;
        if (old + 1u == (gen + 1u) * nloc) {
            __builtin_amdgcn_fence(__ATOMIC_RELEASE, "agent");
            asm volatile("s_waitcnt vmcnt(0)" ::: "memory");
            const unsigned og = xb_add(&bar[XB_TOP], 1u);
            const unsigned tg = og / nx;
            if (og + 1u == (tg + 1u) * nx) xb_add(&bar[XB_TOPGEN], 1u);
            else XB_SPIN(xb_ld(&bar[XB_TOPGEN]) == tg, bar);
            __builtin_amdgcn_fence(__ATOMIC_ACQUIRE, "agent");
            xb_add(&bar[XB_XGEN(b.x)], 1u);
            asm volatile("s_waitcnt vmcnt(0)" ::: "memory");
        } else {
            XB_SPIN(xb_ld(&bar[XB_XGEN(b.x)]) == gen, bar);
            __builtin_amdgcn_fence(__ATOMIC_ACQUIRE, "agent");
            asm volatile("s_waitcnt vmcnt(0)" ::: "memory");
        }
    }
    __syncthreads();
}


__device__ __forceinline__ float wave_sum(float v) {
#pragma unroll
    for (int o = 1; o < 64; o <<= 1) v += __shfl_xor(v, o);
    return v;
}
__device__ __forceinline__ float wave_max(float v) {
#pragma unroll
    for (int o = 1; o < 64; o <<= 1) v = fmaxf(v, __shfl_xor(v, o));
    return v;
}
__device__ __forceinline__ float sigmoidf_(float x) { return 1.0f / (1.0f + __expf(-x)); }
__device__ __forceinline__ float gelu_tanh(float x) { const float u = 0.7978845608028654f * (x + 0.044715f * x * x * x); return 0.5f * x * (1.0f + tanhf(u)); }

__device__ __forceinline__ void tr_item(const float* __restrict__ W, int N, int k0, int n0, bf16* WT, int ldt, int drow0, int dcol0, LAS float* scr, int lane) {
#pragma unroll 8
    for (int i = 0; i < 32; ++i) { const int kk = 2 * i + (lane >> 5); scr[kk * 33 + (lane & 31)] = W[(size_t)(k0 + kk) * N + n0 + (lane & 31)]; }
    LDS_WAIT(); asm volatile("" ::: "memory");
    const int c = lane & 7;
#pragma unroll
    for (int j = 0; j < 4; ++j) { const int n = (lane >> 3) + 8 * j; const LAS float* s = scr + (8 * c) * 33 + n;
        v4u o; o.x = pk2(s[0 * 33], s[1 * 33]); o.y = pk2(s[2 * 33], s[3 * 33]); o.z = pk2(s[4 * 33], s[5 * 33]); o.w = pk2(s[6 * 33], s[7 * 33]);
        *(v4u*)(WT + (size_t)(drow0 + n) * ldt + dcol0 + 8 * c) = o; }
    LDS_WAIT(); asm volatile("" ::: "memory");
}

__device__ __forceinline__ int opqv(int x) { asm volatile("" : "+v"(x)); return x; }
__device__ __forceinline__ int opq() { int z = 0; asm volatile("" : "+s"(z)); return z; }
struct Args { const void* in[40]; float* out; unsigned char* ws; int ph_lo, ph_hi; };

enum { I_X = 0, I_C, I_POS, I_ADAW, I_ADAB, I_N1G, I_WIN, I_POOLW, I_POOLS, I_QNG, I_KNG, I_LQ1, I_LK1, I_LQ2, I_LK2, I_SUBLN,
       I_LAMRE, I_LAMIM, I_LOGDT, I_BRE, I_BIM, I_CRE, I_CIM, I_DSKIP, I_GLUW, I_GLUB, I_PROJA, I_PROJB, I_PROJC, I_GATEW, I_GATEB,
       I_WOUT, I_N2G, I_RGW, I_RGB, I_REW, I_REB, I_W1, I_W3, I_W2 };

__device__ __forceinline__ float lambda_init_of(int l) { return l == 0 ? 0.2f : (l == 1 ? 0.35550906759096926f : (l == 2 ? 0.47071302343358413f : 0.5560582041556841f)); }

__device__ __forceinline__ void prologue_phase(const Args& a, LAS unsigned char* lds) {
    const int z = opq(); (void)z;
    const int tid = opqv((int)threadIdx.x), lane = tid & 63, wave = __builtin_amdgcn_readfirstlane(tid >> 6); const int G = (int)gridDim.x, bx = (int)blockIdx.x;
    const int vcu = (G % 8 == 0) ? (bx % 8) * (G / 8) + bx / 8 : bx; const int gw = vcu * NWAVES + wave, NGW = G * NWAVES, gt = vcu * 512 + tid;
    (void)lane; (void)gw; (void)NGW; (void)gt; (void)bx;
    unsigned char* ws = (a.ws + z);
    const int NGT = G * 512;
    LAS float* scr = (LAS float*)(lds + RING_OFF + wave * 16384);
    {
        constexpr int I_IN = 16 * 64, I_GT = 16 * 96, I_PB = 8 * 32, I_PC = 4 * 32, I_WOI = 16 * 32, I_GL = 4 * 8;
        constexpr int PER_L = I_IN + I_GT + I_PB + I_PC + I_WOI + I_GL;
        for (int it = gw; it < DEPTH * PER_L; it += NGW) {
            const int l = it / PER_L; int r = it - l * PER_L;
            bf16* wcat = (bf16*)(ws + WS_WCAT) + (size_t)l * NCAT * 1024;
            bf16* wmix = (bf16*)(ws + WS_WMIX) + (size_t)l * 1024 * 1024;
            if (r < I_IN) { const int kb = r / 64, nb = r % 64; tr_item((const float*)a.in[z + I_WIN] + (size_t)l * 1024 * ZW, ZW, kb * 64, nb * 32, wcat, 1024, nb * 32, kb * 64, scr, lane); continue; } r -= I_IN;
            if (r < I_GT) { const int kb = r / 96, nb = r % 96; tr_item((const float*)a.in[z + I_GATEW] + (size_t)l * 1024 * GWD, GWD, kb * 64, nb * 32, wcat, 1024, ZW + nb * 32, kb * 64, scr, lane); continue; } r -= I_GT;
            if (r < I_PB) { const int kb = r / 32, nb = r % 32; tr_item((const float*)a.in[z + I_PROJB] + (size_t)l * 512 * 1024, 1024, kb * 64, nb * 32, wmix, 1024, nb * 32, 256 + kb * 64, scr, lane); continue; } r -= I_PB;
            if (r < I_PC) { const int kb = r / 32, nb = r % 32; tr_item((const float*)a.in[z + I_PROJC] + (size_t)l * 256 * 1024, 1024, kb * 64, nb * 32, wmix, 1024, nb * 32, 768 + kb * 64, scr, lane); continue; } r -= I_PC;
            if (r < I_WOI) { const int kb = r / 32, nb = r % 32; tr_item((const float*)a.in[z + I_WOUT] + (size_t)l * 1024 * 1024, 1024, kb * 64, nb * 32, (bf16*)(ws + WS_WO) + (size_t)l * 1024 * 1024, 1024, nb * 32, kb * 64, scr, lane); continue; } r -= I_WOI;
            { const int kb = r / 8, nb = r % 8; tr_item((const float*)a.in[z + I_GLUW] + (size_t)l * 256 * 256, 256, kb * 64, nb * 32, (bf16*)(ws + WS_WGLU) + (size_t)l * 256 * 256, 256, nb * 32, kb * 64, scr, lane); }
        }
    }
    for (int idx = gt; idx < DEPTH * 256 * 1024; idx += NGT) {
        const int l = idx >> 18, k = (idx >> 10) & 255, n = idx & 1023, g = k >> 6, c = k & 63;
        const float* pw = (const float*)a.in[z + I_POOLW] + ((size_t)(l * 4 + g) * 64 + c) * 64;
        const float* ps = (const float*)a.in[z + I_POOLS] + l * 256 + g * 64;
        const float* pa = (const float*)a.in[z + I_PROJA] + ((size_t)l * 256 + g * 64) * 1024 + n;
        float s = 0.f;
        for (int d = 0; d < 64; ++d) s += pw[d] * ps[d] * pa[(size_t)d * 1024];
        ((bf16*)(ws + WS_WMIX))[((size_t)l * 1024 + n) * 1024 + k] = (bf16)f2bf(s);
    }
    for (int idx = gt; idx < T * 32; idx += NGT) {
        const int t = idx >> 5, i = idx & 31;
        const float inv = powf(10000.0f, -(float)(2 * i) / 64.0f);
        const float ang = (float)((const int*)a.in[z + I_POS])[t] * inv;
        ((float*)(ws + WS_ROPE_C))[idx] = cosf(ang); ((float*)(ws + WS_ROPE_S))[idx] = sinf(ang);
    }
    for (int idx = gt; idx < DEPTH * 16 * 64; idx += NGT) {
        const int l = idx >> 10, g = (idx >> 6) & 15, p = idx & 63;
        const float lr = ((const float*)a.in[z + I_LAMRE])[idx], li = ((const float*)a.in[z + I_LAMIM])[idx];
        const float dt = expf(((const float*)a.in[z + I_LOGDT])[l * 16 + g]);
        const float mag = expf(lr * dt), ar = mag * cosf(li * dt), ai = mag * sinf(li * dt);
        const float nr = ar - 1.0f, ni = ai, den = lr * lr + li * li;
        const float kr = (nr * lr + ni * li) / den, ki = (ni * lr - nr * li) / den;
        unsigned char* base = ws + WS_SSM + (size_t)l * SSM_L_BYTES;
        ((f32x2*)base)[g * 64 + p] = (f32x2){ar, ai};
        float pr = ar, pi = ai;
#pragma unroll
        for (int q = 0; q < 6; ++q) { const float tr = pr * pr - pi * pi, ti = 2.0f * pr * pi; pr = tr; pi = ti; }
        ((f32x2*)(base + 8192))[g * 64 + p] = (f32x2){pr, pi};
        const float* br = (const float*)a.in[z + I_BRE] + (size_t)idx * 16; const float* bi = (const float*)a.in[z + I_BIM] + (size_t)idx * 16;
        f32x2* bb = (f32x2*)(base + 16384) + (size_t)(g * 64 + p) * 16;
        for (int ch = 0; ch < 16; ++ch) bb[ch] = (f32x2){kr * br[ch] - ki * bi[ch], kr * bi[ch] + ki * br[ch]};
    }
    if (gt < DEPTH) {
        const int l = gt; float s1 = 0.f, s2 = 0.f;
        for (int d = 0; d < 64; ++d) { s1 += ((const float*)a.in[z + I_LQ1])[l * 64 + d] * ((const float*)a.in[z + I_LK1])[l * 64 + d]; s2 += ((const float*)a.in[z + I_LQ2])[l * 64 + d] * ((const float*)a.in[z + I_LK2])[l * 64 + d]; }
        ((float*)(ws + WS_LAM))[l] = expf(s1) - expf(s2) + lambda_init_of(l);
    }
    for (int idx = gt; idx < DEPTH * 36 * 1024; idx += NGT) {
        const int l = idx / (36 * 1024), r = idx - l * 36 * 1024, j = r >> 10, k = r & 1023;
        ((float*)(ws + WS_RWT))[idx] = j < 4 ? ((const float*)a.in[z + I_RGW])[((size_t)l * 1024 + k) * 4 + j] : ((const float*)a.in[z + I_REW])[((size_t)l * 1024 + k) * 32 + (j - 4)];
    }
    {
        LAS float* cact = (LAS float*)(lds + RING_OFF);
        LAS float* red = (LAS float*)(lds + RING_OFF + 32768);
        __syncthreads();
        for (int i = tid; i < NB * 1024; i += 512) { const float cv = ((const float*)a.in[z + I_C])[i]; cact[i] = cv * sigmoidf_(cv); }
        __syncthreads();
        const int col = tid & 63, kp = tid >> 6;
        for (int u = vcu; u < DEPTH * 96; u += G) {
            const int l = u / 96, cg = u % 96;
            const float* w = (const float*)a.in[z + I_ADAW] + (size_t)l * 1024 * 6144 + cg * 64 + col;
            float acc[NB];
#pragma unroll
            for (int b = 0; b < NB; ++b) acc[b] = 0.f;
            for (int k = kp * 128; k < kp * 128 + 128; ++k) { const float wv = w[(size_t)k * 6144];
#pragma unroll
                for (int b = 0; b < NB; ++b) acc[b] += cact[b * 1024 + k] * wv; }
#pragma unroll
            for (int b = 0; b < NB; ++b) red[(kp * NB + b) * 64 + col] = acc[b];
            __syncthreads();
            { const int b = tid >> 6; float s = 0.f;
#pragma unroll
              for (int q = 0; q < 8; ++q) s += red[(q * NB + b) * 64 + col];
              ((float*)(ws + WS_MOD))[((size_t)l * NB + b) * 6144 + cg * 64 + col] = s + ((const float*)a.in[z + I_ADAB])[l * 6144 + cg * 64 + col]; }
            __syncthreads();
        }
    }
}

__device__ __forceinline__ void moe_weights_phase(const Args& a, int l, LAS unsigned char* lds) {
    const int z = opq(); (void)z;
    const int tid = opqv((int)threadIdx.x), lane = tid & 63, wave = __builtin_amdgcn_readfirstlane(tid >> 6); const int G = (int)gridDim.x, bx = (int)blockIdx.x;
    const int vcu = (G % 8 == 0) ? (bx % 8) * (G / 8) + bx / 8 : bx; const int gw = vcu * NWAVES + wave, NGW = G * NWAVES, gt = vcu * 512 + tid;
    (void)lane; (void)gw; (void)NGW; (void)gt; (void)bx;
    LAS float* scr = (LAS float*)(lds + RING_OFF + wave * 16384);
    bf16* w13 = (bf16*)((a.ws + z) + WS_W13); bf16* w2t = (bf16*)((a.ws + z) + WS_W2);
    for (int it = gw; it < NEXP * 768; it += NGW) {
        const int e = it / 768; int r = it - e * 768;
        if (r < 512) { const int which = r >> 8; r &= 255; const int kb = r >> 4, nb = r & 15, n0 = nb * 32;
            const float* W = (const float*)a.in[which ? I_W3 : I_W1] + ((size_t)l * NEXP + e) * 1024 * 512;
            tr_item(W, 512, kb * 64, n0, w13, 1024, e * 1024 + (n0 >> 7) * 256 + which * 128 + (n0 & 127), kb * 64, scr, lane); }
        else { r -= 512; const int kb = r >> 5, nb = r & 31;
            const float* W = (const float*)a.in[z + I_W2] + ((size_t)l * NEXP + e) * 512 * 1024;
            tr_item(W, 1024, kb * 64, nb * 32, w2t, 512, e * 1024 + nb * 32, kb * 64, scr, lane); }
    }
}

__device__ __forceinline__ void norm1_phase(const Args& a, int l, bool first, bool do_norm) {
    const int z = opq(); (void)z;
    const int tid = opqv((int)threadIdx.x), lane = tid & 63, wave = __builtin_amdgcn_readfirstlane(tid >> 6); const int G = (int)gridDim.x, bx = (int)blockIdx.x;
    const int vcu = (G % 8 == 0) ? (bx % 8) * (G / 8) + bx / 8 : bx; const int gw = vcu * NWAVES + wave, NGW = G * NWAVES, gt = vcu * 512 + tid;
    (void)lane; (void)gw; (void)NGW; (void)gt; (void)bx;
    unsigned char* ws = (a.ws + z);
    const float* mod = (const float*)(ws + WS_MOD);
    const bf16* Y = (const bf16*)(ws + WS_Y);
    const int* tok_slot = (const int*)(ws + WS_TOKS); const float* tok_w = (const float*)(ws + WS_TOKW);
    bf16* H = (bf16*)(ws + WS_H);
    for (int m = gw; m < T; m += NGW) {
        const int b = m >> 12;
        const f32x4* xr = (const f32x4*)((first ? (const float*)a.in[z + I_X] : (const float*)(a.out + z)) + (size_t)m * D) + lane;
        f32x4 v[4];
#pragma unroll
        for (int j = 0; j < 4; ++j) v[j] = xr[64 * j];
        if (!first) {
            const int s0 = tok_slot[2 * m], s1 = tok_slot[2 * m + 1]; const float w0 = tok_w[2 * m], w1 = tok_w[2 * m + 1];
            const float* g2 = mod + ((size_t)(l - 1) * NB + b) * 6144 + 5 * 1024;
            const v2u* y0 = (const v2u*)(Y + (size_t)s0 * D) + lane; const v2u* y1 = (const v2u*)(Y + (size_t)s1 * D) + lane;
#pragma unroll
            for (int j = 0; j < 4; ++j) { const v2u p = y0[64 * j], q = y1[64 * j]; const f32x4 g = *((const f32x4*)g2 + lane + 64 * j);
                v[j].x += g.x * (w0 * bflo(p.x) + w1 * bflo(q.x)); v[j].y += g.y * (w0 * bfhi(p.x) + w1 * bfhi(q.x));
                v[j].z += g.z * (w0 * bflo(p.y) + w1 * bflo(q.y)); v[j].w += g.w * (w0 * bfhi(p.y) + w1 * bfhi(q.y)); }
        }
        f32x4* xo = (f32x4*)((a.out + z) + (size_t)m * D) + lane;
#pragma unroll
        for (int j = 0; j < 4; ++j) xo[64 * j] = v[j];
        if (do_norm) {
            float ss = 0.f;
#pragma unroll
            for (int j = 0; j < 4; ++j) ss += (v[j].x * v[j].x + v[j].y * v[j].y) + (v[j].z * v[j].z + v[j].w * v[j].w);
            const float r = rsqrtf(wave_sum(ss) * (1.0f / D) + NORM_EPS);
            const float* mrow = mod + ((size_t)l * NB + b) * 6144;
            const f32x4* gn = (const f32x4*)((const float*)a.in[z + I_N1G] + l * D) + lane;
            v2u* ho = (v2u*)(H + (size_t)m * D) + lane;
#pragma unroll
            for (int j = 0; j < 4; ++j) { const f32x4 g = gn[64 * j], sh = *((const f32x4*)mrow + lane + 64 * j), sc = *((const f32x4*)(mrow + 1024) + lane + 64 * j);
                const f32x4 hh = (v[j] * r * g) * (sc + 1.0f) + sh;
                v2u o; o.x = pk2(hh.x, hh.y); o.y = pk2(hh.z, hh.w); ho[64 * j] = o; }
        }
    }
}

__device__ __forceinline__ void qkprep_phase(const Args& a, int l) {
    const int z = opq(); (void)z;
    const int tid = opqv((int)threadIdx.x), lane = tid & 63, wave = __builtin_amdgcn_readfirstlane(tid >> 6); const int G = (int)gridDim.x, bx = (int)blockIdx.x;
    const int vcu = (G % 8 == 0) ? (bx % 8) * (G / 8) + bx / 8 : bx; const int gw = vcu * NWAVES + wave, NGW = G * NWAVES, gt = vcu * 512 + tid;
    (void)lane; (void)gw; (void)NGW; (void)gt; (void)bx;
    unsigned char* ws = (a.ws + z); bf16* Z = (bf16*)(ws + WS_Z);
    const float qg = ((const float*)a.in[z + I_QNG])[l * 64 + lane], kg = ((const float*)a.in[z + I_KNG])[l * 64 + lane];
    for (int m = gw; m < T; m += NGW) {
        bf16* zr = Z + (size_t)m * ZW + ZQ + lane;
        const float c = ((const float*)(ws + WS_ROPE_C))[m * 32 + (lane & 31)], s = ((const float*)(ws + WS_ROPE_S))[m * 32 + (lane & 31)];
        float xv[16];
#pragma unroll
        for (int v = 0; v < 16; ++v) xv[v] = bf2f(zr[v * 64]);
#pragma unroll
        for (int v = 0; v < 16; ++v) {
            const float x = xv[v];
            const float r = rsqrtf(wave_sum(x * x) * (1.0f / 64.0f) + NORM_EPS);
            const float y = x * r * (v < 8 ? qg : kg);
            const float p = __shfl_xor(y, 32);
            float o = lane < 32 ? y * c - p * s : y * c + p * s;
            if (v < 8) o *= 0.125f;
            zr[v * 64] = (bf16)f2bf(o);
        }
    }
}

__device__ __forceinline__ void pool_phase(const Args& a, LAS unsigned char* lds) {
    const int z = opq(); (void)z;
    const int tid = opqv((int)threadIdx.x), lane = tid & 63, wave = __builtin_amdgcn_readfirstlane(tid >> 6); const int G = (int)gridDim.x, bx = (int)blockIdx.x;
    const int vcu = (G % 8 == 0) ? (bx % 8) * (G / 8) + bx / 8 : bx; const int gw = vcu * NWAVES + wave, NGW = G * NWAVES, gt = vcu * 512 + tid;
    (void)lane; (void)gw; (void)NGW; (void)gt; (void)bx;
    const bf16* Z = (const bf16*)((a.ws + z) + WS_Z); bf16* AM = (bf16*)((a.ws + z) + WS_AMIX);
    LAS float* U = (LAS float*)(lds + RING_OFF);
    for (int tl = vcu; tl < T / 64; tl += G) {
        const int m0 = tl * 64, s0 = m0 & (SEQ - 1);
        __syncthreads();
        for (int idx = tid; idx < 80 * 32; idx += 512) { const int r = idx >> 5, c8 = (idx & 31) * 8; const int sp = s0 - 16 + r;
            v4u w = (v4u){0u, 0u, 0u, 0u};
            if (sp >= 0) w = *(const v4u*)(Z + (size_t)(m0 - 16 + r) * ZW + c8);
            LAS float* u = U + r * 256 + c8;
            u[0] = bflo(w.x); u[1] = bfhi(w.x); u[2] = bflo(w.y); u[3] = bfhi(w.y); u[4] = bflo(w.z); u[5] = bfhi(w.z); u[6] = bflo(w.w); u[7] = bfhi(w.w); }
        __syncthreads();
        const int ch = tid & 255, th = tid >> 8, g = ch >> 6, w = 2 << g;
        for (int i = 0; i < 32; ++i) { const int t = th * 32 + i; float s = 0.f;
            for (int q = 0; q < w; ++q) s += U[(16 + t - q) * 256 + ch];
            const int cnt = (s0 + t + 1) < w ? (s0 + t + 1) : w;
            const float o = s / (float)cnt - U[(16 + t) * 256 + ch];
            AM[(size_t)(m0 + t) * D + ch] = (bf16)f2bf(o); }
    }
}

__device__ __forceinline__ void load_u16(const bf16* up, float (&u)[16]) {
    const v4u w0 = *(const v4u*)up, w1 = *(const v4u*)(up + 8);
    u[0] = bflo(w0.x); u[1] = bfhi(w0.x); u[2] = bflo(w0.y); u[3] = bfhi(w0.y); u[4] = bflo(w0.z); u[5] = bfhi(w0.z); u[6] = bflo(w0.w); u[7] = bfhi(w0.w);
    u[8] = bflo(w1.x); u[9] = bfhi(w1.x); u[10] = bflo(w1.y); u[11] = bfhi(w1.y); u[12] = bflo(w1.z); u[13] = bfhi(w1.z); u[14] = bflo(w1.w); u[15] = bfhi(w1.w);
}
__device__ __forceinline__ void ssm_local_phase(const Args& a, int l) {
    const int z = opq(); (void)z;
    const int tid = opqv((int)threadIdx.x), lane = tid & 63, wave = __builtin_amdgcn_readfirstlane(tid >> 6); const int G = (int)gridDim.x, bx = (int)blockIdx.x;
    const int vcu = (G % 8 == 0) ? (bx % 8) * (G / 8) + bx / 8 : bx; const int gw = vcu * NWAVES + wave, NGW = G * NWAVES, gt = vcu * 512 + tid;
    (void)lane; (void)gw; (void)NGW; (void)gt; (void)bx;
    unsigned char* ws = (a.ws + z); const bf16* Z = (const bf16*)(ws + WS_Z);
    const unsigned char* sb = ws + WS_SSM + (size_t)l * SSM_L_BYTES;
    f32x2* E = (f32x2*)(ws + WS_E);
    for (int uidx = gw; uidx < NB * 64 * 16; uidx += NGW) {
        const int g = uidx & 15, c = (uidx >> 4) & 63, b = uidx >> 10;
        const f32x2 av = ((const f32x2*)sb)[g * 64 + lane];
        float bbr[16], bbi[16];
        { const f32x4* bp = (const f32x4*)(sb + 16384) + (size_t)(g * 64 + lane) * 8;
#pragma unroll
          for (int q = 0; q < 8; ++q) { const f32x4 t4 = bp[q]; bbr[2 * q] = t4.x; bbi[2 * q] = t4.y; bbr[2 * q + 1] = t4.z; bbi[2 * q + 1] = t4.w; } }
        float xr = 0.f, xi = 0.f;
        const bf16* up = Z + (size_t)(b * SEQ + c * 64) * ZW + ZC + g * 16;
        for (int t = 0; t < 64; ++t) {
            float u[16]; load_u16(up + (size_t)t * ZW, u);
            float br = 0.f, bi = 0.f;
#pragma unroll
            for (int ch = 0; ch < 16; ++ch) { br += bbr[ch] * u[ch]; bi += bbi[ch] * u[ch]; }
            const float nr = av.x * xr - av.y * xi + br, ni = av.x * xi + av.y * xr + bi; xr = nr; xi = ni;
        }
        E[(size_t)uidx * 64 + lane] = (f32x2){xr, xi};
    }
}
__device__ __forceinline__ void ssm_carry_phase(const Args& a, int l) {
    const int z = opq(); (void)z;
    const int tid = opqv((int)threadIdx.x), lane = tid & 63, wave = __builtin_amdgcn_readfirstlane(tid >> 6); const int G = (int)gridDim.x, bx = (int)blockIdx.x;
    const int vcu = (G % 8 == 0) ? (bx % 8) * (G / 8) + bx / 8 : bx; const int gw = vcu * NWAVES + wave, NGW = G * NWAVES, gt = vcu * 512 + tid;
    (void)lane; (void)gw; (void)NGW; (void)gt; (void)bx;
    if (gt >= NB * 16 * 64) return;
    unsigned char* ws = (a.ws + z); const unsigned char* sb = ws + WS_SSM + (size_t)l * SSM_L_BYTES;
    const int p = gt & 63, g = (gt >> 6) & 15, b = gt >> 10;
    const f32x2 a64 = ((const f32x2*)(sb + 8192))[g * 64 + p];
    const f32x2* E = (const f32x2*)(ws + WS_E); f32x2* CI = (f32x2*)(ws + WS_CIN);
    float sr = 0.f, si = 0.f;
    for (int c = 0; c < 64; ++c) { const size_t o = ((size_t)((b * 64 + c) * 16 + g)) * 64 + p;
        CI[o] = (f32x2){sr, si}; const f32x2 e = E[o];
        const float nr = a64.x * sr - a64.y * si + e.x, ni = a64.x * si + a64.y * sr + e.y; sr = nr; si = ni; }
}

__device__ __forceinline__ void ssm_final_phase(const Args& a, int l, LAS unsigned char* lds) {
    const int z = opq(); (void)z;
    const int tid = opqv((int)threadIdx.x), lane = tid & 63, wave = __builtin_amdgcn_readfirstlane(tid >> 6); const int G = (int)gridDim.x, bx = (int)blockIdx.x;
    const int vcu = (G % 8 == 0) ? (bx % 8) * (G / 8) + bx / 8 : bx; const int gw = vcu * NWAVES + wave, NGW = G * NWAVES, gt = vcu * 512 + tid;
    (void)lane; (void)gw; (void)NGW; (void)gt; (void)bx;
    unsigned char* ws = (a.ws + z); const bf16* Z = (const bf16*)(ws + WS_Z); bf16* AM = (bf16*)(ws + WS_AMIX);
    const unsigned char* sb = ws + WS_SSM + (size_t)l * SSM_L_BYTES;
    const f32x2* CI = (const f32x2*)(ws + WS_CIN);
    constexpr int YP = 264, XP = 136;
    LAS bf16* Ypre = (LAS bf16*)(lds + RING_OFF);
    LAS bf16* Xb = (LAS bf16*)(lds + RING_OFF + 65536) + wave * (16 * XP);
    const int fr = lane & 15, fq = lane >> 4;
    for (int uu = vcu; uu < NB * 64; uu += G) {
        const int b = uu >> 6, c = uu & 63; const size_t m0 = (size_t)b * SEQ + c * 64;
        __syncthreads();
#pragma unroll 1
        for (int gi = 0; gi < 2; ++gi) {
            const int g = wave * 2 + gi;
            const f32x2 av = ((const f32x2*)sb)[g * 64 + lane];
            float bbr[16], bbi[16];
            { const f32x4* bp = (const f32x4*)(sb + 16384) + (size_t)(g * 64 + lane) * 8;
#pragma unroll
              for (int q = 0; q < 8; ++q) { const f32x4 t4 = bp[q]; bbr[2 * q] = t4.x; bbi[2 * q] = t4.y; bbr[2 * q + 1] = t4.z; bbi[2 * q + 1] = t4.w; } }
            bf16x8 Bf[4];
            { const float* cre = (const float*)a.in[z + I_CRE] + ((size_t)(l * 16 + g) * 16 + fr) * 64; const float* cim = (const float*)a.in[z + I_CIM] + ((size_t)(l * 16 + g) * 16 + fr) * 64;
#pragma unroll
              for (int ks = 0; ks < 4; ++ks) { const float* src = (ks < 2 ? cre : cim) + (ks & 1) * 32 + fq * 8; const float sg = ks < 2 ? 1.0f : -1.0f;
#pragma unroll
                  for (int j = 0; j < 8; ++j) Bf[ks][j] = (short)f2bf(sg * src[j]); } }
            const float dsk = ((const float*)a.in[z + I_DSKIP])[l * 256 + g * 16 + fr];
            const f32x2 st = CI[((size_t)((b * 64 + c) * 16 + g)) * 64 + lane];
            float xr = st.x, xi = st.y;
            const bf16* up = Z + m0 * ZW + ZC + g * 16;
#pragma unroll 1
            for (int tb = 0; tb < 4; ++tb) {
#pragma unroll 1
                for (int tt = 0; tt < 16; ++tt) {
                    float u[16]; load_u16(up + (size_t)(tb * 16 + tt) * ZW, u);
                    float br = 0.f, bi = 0.f;
#pragma unroll
                    for (int ch = 0; ch < 16; ++ch) { br += bbr[ch] * u[ch]; bi += bbi[ch] * u[ch]; }
                    const float nr = av.x * xr - av.y * xi + br, ni = av.x * xi + av.y * xr + bi; xr = nr; xi = ni;
                    Xb[tt * XP + lane] = (bf16)f2bf(xr); Xb[tt * XP + 64 + lane] = (bf16)f2bf(xi);
                }
                LDS_WAIT(); asm volatile("" ::: "memory");
                pg8::f32x4 acc = {0.f, 0.f, 0.f, 0.f};
#pragma unroll
                for (int ks = 0; ks < 4; ++ks) { const bf16x8 Af = *(const LAS bf16x8*)(Xb + fr * XP + ks * 32 + fq * 8);
                    acc = __builtin_amdgcn_mfma_f32_16x16x32_bf16(Af, Bf[ks], acc, 0, 0, 0); }
#pragma unroll
                for (int j = 0; j < 4; ++j) { const int t = tb * 16 + fq * 4 + j;
                    const float uu2 = bf2f(up[(size_t)t * ZW + fr]);
                    Ypre[t * YP + g * 16 + fr] = (bf16)f2bf(gelu_tanh(acc[j] + dsk * uu2)); }
                LDS_WAIT(); asm volatile("" ::: "memory");
            }
        }
        __syncthreads();
        { pg8::f32x4 acc[4][2];
#pragma unroll
          for (int rb = 0; rb < 4; ++rb)
#pragma unroll
              for (int nb = 0; nb < 2; ++nb) acc[rb][nb] = (pg8::f32x4){0.f, 0.f, 0.f, 0.f};
          const bf16* wg = (const bf16*)(ws + WS_WGLU) + (size_t)l * 256 * 256;
#pragma unroll 2
          for (int ks = 0; ks < 8; ++ks) {
              bf16x8 Bw[2], Aw[4];
#pragma unroll
              for (int nb = 0; nb < 2; ++nb) Bw[nb] = *(const bf16x8*)(wg + (size_t)(wave * 32 + nb * 16 + fr) * 256 + ks * 32 + fq * 8);
#pragma unroll
              for (int rb = 0; rb < 4; ++rb) Aw[rb] = *(const LAS bf16x8*)(Ypre + (rb * 16 + fr) * YP + ks * 32 + fq * 8);
#pragma unroll
              for (int rb = 0; rb < 4; ++rb)
#pragma unroll
                  for (int nb = 0; nb < 2; ++nb) acc[rb][nb] = __builtin_amdgcn_mfma_f32_16x16x32_bf16(Aw[rb], Bw[nb], acc[rb][nb], 0, 0, 0);
          }
#pragma unroll
          for (int nb = 0; nb < 2; ++nb) { const int n = wave * 32 + nb * 16 + fr; const float gb = ((const float*)a.in[z + I_GLUB])[l * 256 + n];
#pragma unroll
              for (int rb = 0; rb < 4; ++rb)
#pragma unroll
                  for (int j = 0; j < 4; ++j) { const int t = rb * 16 + fq * 4 + j;
                      const float yv = bf2f(Ypre[t * YP + n]);
                      AM[(m0 + t) * D + 768 + n] = (bf16)f2bf(yv * sigmoidf_(acc[rb][nb][j] + gb)); } }
        }
    }
}

__device__ __forceinline__ void attn_naive_unit(const Args& a, int b, int h, int mp, int cc, LAS unsigned char* lds, int tid, int lane, int wave) {
    const int z = opq();
    const bf16* Z = (const bf16*)((a.ws + z) + WS_Z);
    float* O = (float*)((a.ws + z) + (mp ? WS_O1 : WS_O0));
    const size_t m0 = (size_t)b * SEQ + cc * 64;
    const int qcol = ZQ + h * 128 + mp * 64, kcol = ZK + h * 128 + mp * 64, vcol = ZV + h * 128;
    LAS float* Qs = (LAS float*)(lds + RING_OFF);
    LAS unsigned* Vs = (LAS unsigned*)(lds + RING_OFF + 16384);
    LAS float* Ps = (LAS float*)(lds + RING_OFF + 32768) + wave * 512;
    __syncthreads();
    { const int r = tid >> 3, c8 = (tid & 7) * 8; const v4u w = *(const v4u*)(Z + (m0 + r) * ZW + qcol + c8); LAS float* q = Qs + r * 64 + c8;
      q[0] = bflo(w.x); q[1] = bfhi(w.x); q[2] = bflo(w.y); q[3] = bfhi(w.y); q[4] = bflo(w.z); q[5] = bfhi(w.z); q[6] = bflo(w.w); q[7] = bfhi(w.w); }
    float mrun[8], lrun[8], o0[8], o1[8];
#pragma unroll
    for (int i = 0; i < 8; ++i) { mrun[i] = -1e30f; lrun[i] = 0.f; o0[i] = 0.f; o1[i] = 0.f; }
    const size_t kb0 = (size_t)b * SEQ;
#pragma unroll 1
    for (int kt = 0; kt <= cc; ++kt) {
        __syncthreads();
        { const int key = tid >> 3, part = tid & 7; const bf16* vp = Z + (kb0 + kt * 64 + key) * ZW + vcol + part * 16;
          const v4u w0 = *(const v4u*)vp, w1 = *(const v4u*)(vp + 8); LAS v4u* d = (LAS v4u*)(Vs + key * 64 + part * 8); d[0] = w0; d[1] = w1; }
        float kf[64];
        { const bf16* kp = Z + (kb0 + kt * 64 + lane) * ZW + kcol;
#pragma unroll
          for (int q = 0; q < 8; ++q) { const v4u w = *(const v4u*)(kp + q * 8);
              kf[q * 8 + 0] = bflo(w.x); kf[q * 8 + 1] = bfhi(w.x); kf[q * 8 + 2] = bflo(w.y); kf[q * 8 + 3] = bfhi(w.y);
              kf[q * 8 + 4] = bflo(w.z); kf[q * 8 + 5] = bfhi(w.z); kf[q * 8 + 6] = bflo(w.w); kf[q * 8 + 7] = bfhi(w.w); } }
        __syncthreads();
#pragma unroll
        for (int i = 0; i < 8; ++i) {
            const LAS f32x4* qr = (const LAS f32x4*)(Qs + (wave * 8 + i) * 64);
            float s = 0.f;
#pragma unroll
            for (int d4 = 0; d4 < 16; ++d4) { const f32x4 q4 = qr[d4]; s += q4.x * kf[d4 * 4] + q4.y * kf[d4 * 4 + 1] + q4.z * kf[d4 * 4 + 2] + q4.w * kf[d4 * 4 + 3]; }
            const float mt = wave_max(s), mn = fmaxf(mrun[i], mt), al = __expf(mrun[i] - mn), p = __expf(s - mn);
            lrun[i] = lrun[i] * al + wave_sum(p); o0[i] *= al; o1[i] *= al; mrun[i] = mn;
            Ps[i * 64 + lane] = p;
        }
        LDS_WAIT(); asm volatile("" ::: "memory");
#pragma unroll 4
        for (int j4 = 0; j4 < 16; ++j4) {
            unsigned vw[4];
#pragma unroll
            for (int jj = 0; jj < 4; ++jj) vw[jj] = Vs[(j4 * 4 + jj) * 64 + lane];
#pragma unroll
            for (int i = 0; i < 8; ++i) { const f32x4 p4 = *(const LAS f32x4*)(Ps + i * 64 + j4 * 4);
                o0[i] += p4.x * bflo(vw[0]) + p4.y * bflo(vw[1]) + p4.z * bflo(vw[2]) + p4.w * bflo(vw[3]);
                o1[i] += p4.x * bfhi(vw[0]) + p4.y * bfhi(vw[1]) + p4.z * bfhi(vw[2]) + p4.w * bfhi(vw[3]); }
        }
    }
#pragma unroll
    for (int i = 0; i < 8; ++i) { const float rl = 1.0f / lrun[i];
        *(f32x2*)(O + (m0 + wave * 8 + i) * 512 + h * 128 + lane * 2) = (f32x2){o0[i] * rl, o1[i] * rl}; }
}
__device__ __forceinline__ void attn_naive_phase(const Args& a, LAS unsigned char* lds) {
    const int z = opq(); (void)z;
    const int tid = opqv((int)threadIdx.x), lane = tid & 63, wave = __builtin_amdgcn_readfirstlane(tid >> 6); const int G = (int)gridDim.x, bx = (int)blockIdx.x;
    const int vcu = (G % 8 == 0) ? (bx % 8) * (G / 8) + bx / 8 : bx; const int gw = vcu * NWAVES + wave, NGW = G * NWAVES, gt = vcu * 512 + tid;
    (void)lane; (void)gw; (void)NGW; (void)gt; (void)bx;
    for (int u = vcu; u < 2048; u += G) {
        const int bhm = u >> 5, j = u & 31, b = bhm >> 3, h = (bhm >> 1) & 3, mp = bhm & 1;
        attn_naive_unit(a, b, h, mp, j, lds, tid, lane, wave);
        attn_naive_unit(a, b, h, mp, 63 - j, lds, tid, lane, wave);
    }
}

__device__ __forceinline__ void attn_combine_phase(const Args& a, int l) {
    const int z = opq(); (void)z;
    const int tid = opqv((int)threadIdx.x), lane = tid & 63, wave = __builtin_amdgcn_readfirstlane(tid >> 6); const int G = (int)gridDim.x, bx = (int)blockIdx.x;
    const int vcu = (G % 8 == 0) ? (bx % 8) * (G / 8) + bx / 8 : bx; const int gw = vcu * NWAVES + wave, NGW = G * NWAVES, gt = vcu * 512 + tid;
    (void)lane; (void)gw; (void)NGW; (void)gt; (void)bx;
    unsigned char* ws = (a.ws + z); const float* O0 = (const float*)(ws + WS_O0); const float* O1 = (const float*)(ws + WS_O1); bf16* AM = (bf16*)(ws + WS_AMIX);
    const float lam = ((const float*)(ws + WS_LAM))[l], post = 1.0f - lambda_init_of(l);
    const f32x2 sg = *((const f32x2*)((const float*)a.in[z + I_SUBLN] + l * 128) + lane);
    for (int m = gw; m < T; m += NGW) {
#pragma unroll
        for (int h = 0; h < 4; ++h) {
            const f32x2 p = *((const f32x2*)(O0 + (size_t)m * 512 + h * 128) + lane), q = *((const f32x2*)(O1 + (size_t)m * 512 + h * 128) + lane);
            const float d0 = p.x - lam * q.x, d1 = p.y - lam * q.y;
            const float r = rsqrtf(wave_sum(d0 * d0 + d1 * d1) * (1.0f / 128.0f) + NORM_EPS);
            *((unsigned*)(AM + (size_t)m * D + 256 + h * 128) + lane) = pk2(d0 * r * sg.x * post, d1 * r * sg.y * post);
        }
    }
}

__device__ __forceinline__ void norm2_router_phase(const Args& a, int l, LAS unsigned char* lds) {
    const int z = opq(); (void)z;
    const int tid = opqv((int)threadIdx.x), lane = tid & 63, wave = __builtin_amdgcn_readfirstlane(tid >> 6); const int G = (int)gridDim.x, bx = (int)blockIdx.x;
    const int vcu = (G % 8 == 0) ? (bx % 8) * (G / 8) + bx / 8 : bx; const int gw = vcu * NWAVES + wave, NGW = G * NWAVES, gt = vcu * 512 + tid;
    (void)lane; (void)gw; (void)NGW; (void)gt; (void)bx;
    unsigned char* ws = (a.ws + z);
    const float* mod = (const float*)(ws + WS_MOD); bf16* H = (bf16*)(ws + WS_H);
    const float* rwt = (const float*)(ws + WS_RWT) + (size_t)l * 36 * 1024;
    int* tok_e = (int*)(ws + WS_TOKE); float* tok_w = (float*)(ws + WS_TOKW); int* tok_l = (int*)(ws + WS_TOKL);
    LAS int* lcnt = (LAS int*)(lds + RING_OFF);
    __syncthreads();
    if (tid < 32) lcnt[tid] = 0;
    __syncthreads();
    const float rgb = lane < 4 ? ((const float*)a.in[z + I_RGB])[l * 4 + lane] : (lane < 36 ? ((const float*)a.in[z + I_REB])[l * 32 + lane - 4] : 0.f);
    for (int m4 = gw; m4 < T / 4; m4 += NGW) {
        const int mb = m4 * 4, b = mb >> 12;
        const float* mrow = mod + ((size_t)l * NB + b) * 6144;
        f32x4 hv[4][4];
#pragma unroll
        for (int r = 0; r < 4; ++r) {
            const f32x4* xr = (const f32x4*)((a.out + z) + (size_t)(mb + r) * D) + lane;
            float ss = 0.f;
#pragma unroll
            for (int j = 0; j < 4; ++j) { hv[r][j] = xr[64 * j]; ss += (hv[r][j].x * hv[r][j].x + hv[r][j].y * hv[r][j].y) + (hv[r][j].z * hv[r][j].z + hv[r][j].w * hv[r][j].w); }
            const float rr = rsqrtf(wave_sum(ss) * (1.0f / D) + NORM_EPS);
            v2u* ho = (v2u*)(H + (size_t)(mb + r) * D) + lane;
#pragma unroll
            for (int j = 0; j < 4; ++j) { const f32x4 g = *((const f32x4*)((const float*)a.in[z + I_N2G] + l * D) + lane + 64 * j), sh = *((const f32x4*)(mrow + 3 * 1024) + lane + 64 * j), sc = *((const f32x4*)(mrow + 4 * 1024) + lane + 64 * j);
                hv[r][j] = (hv[r][j] * rr * g) * (sc + 1.0f) + sh;
                v2u o; o.x = pk2(hv[r][j].x, hv[r][j].y); o.y = pk2(hv[r][j].z, hv[r][j].w); ho[64 * j] = o; }
        }
        float lg[4] = {0.f, 0.f, 0.f, 0.f};
#pragma unroll 1
        for (int e = 0; e < 36; ++e) {
            const f32x4* wr = (const f32x4*)(rwt + (size_t)e * 1024) + lane;
            f32x4 w4[4];
#pragma unroll
            for (int j = 0; j < 4; ++j) w4[j] = wr[64 * j];
#pragma unroll
            for (int r = 0; r < 4; ++r) { float s = 0.f;
#pragma unroll
                for (int j = 0; j < 4; ++j) s += (hv[r][j].x * w4[j].x + hv[r][j].y * w4[j].y) + (hv[r][j].z * w4[j].z + hv[r][j].w * w4[j].w);
                s = wave_sum(s); if (lane == e) lg[r] = s; }
        }
#pragma unroll
        for (int r = 0; r < 4; ++r) {
            const float v = lg[r] + rgb;
            float gl[4];
#pragma unroll
            for (int j = 0; j < 4; ++j) gl[j] = __shfl(v, j);
            int gi = 0; float gm = gl[0];
#pragma unroll
            for (int j = 1; j < 4; ++j) if (gl[j] > gm) { gm = gl[j]; gi = j; }
            float gs = 0.f;
#pragma unroll
            for (int j = 0; j < 4; ++j) gs += __expf(gl[j] - gm);
            const float pg = 1.0f / gs;
            float el[8];
#pragma unroll
            for (int j = 0; j < 8; ++j) el[j] = __shfl(v, 4 + gi * 8 + j);
            int e0 = 0; float m0v = el[0];
#pragma unroll
            for (int j = 1; j < 8; ++j) if (el[j] > m0v) { m0v = el[j]; e0 = j; }
            int e1 = -1; float m1v = -3.0e38f;
#pragma unroll
            for (int j = 0; j < 8; ++j) if (j != e0 && el[j] > m1v) { m1v = el[j]; e1 = j; }
            const float x1 = __expf(m1v - m0v), w0 = pg / (1.0f + x1), w1 = pg * x1 / (1.0f + x1);
            if (lane == 0) {
                const int m = mb + r, ea = gi * 8 + e0, eb = gi * 8 + e1;
                tok_e[2 * m] = ea; tok_e[2 * m + 1] = eb; tok_w[2 * m] = w0; tok_w[2 * m + 1] = w1;
                tok_l[2 * m] = __hip_atomic_fetch_add(&lcnt[ea], 1, __ATOMIC_RELAXED, __HIP_MEMORY_SCOPE_WORKGROUP); tok_l[2 * m + 1] = __hip_atomic_fetch_add(&lcnt[eb], 1, __ATOMIC_RELAXED, __HIP_MEMORY_SCOPE_WORKGROUP);
            }
        }
    }
    __syncthreads();
    if (tid < 32) { const int c = lcnt[tid];
        const unsigned old = __hip_atomic_fetch_add((unsigned*)(ws + WS_CTL) + CW_CNT + l * 64 + tid, (unsigned)c, RLX_AGENT);
        ((int*)(ws + WS_WGBASE))[bx * 32 + tid] = (int)old; }
}

__device__ __forceinline__ void moe_scatter_phase(const Args& a, int l, LAS unsigned char* lds) {
    const int z = opq(); (void)z;
    const int tid = opqv((int)threadIdx.x), lane = tid & 63, wave = __builtin_amdgcn_readfirstlane(tid >> 6); const int G = (int)gridDim.x, bx = (int)blockIdx.x;
    const int vcu = (G % 8 == 0) ? (bx % 8) * (G / 8) + bx / 8 : bx; const int gw = vcu * NWAVES + wave, NGW = G * NWAVES, gt = vcu * 512 + tid;
    (void)lane; (void)gw; (void)NGW; (void)gt; (void)bx;
    unsigned char* ws = (a.ws + z);
    LAS int* pst = (LAS int*)(lds + RING_OFF);
    __syncthreads();
    if (tid == 0) {
        int run = 0; int* tile_e = (int*)(ws + WS_TILEE);
        for (int e = 0; e < NEXP; ++e) { const int c = (int)__hip_atomic_load((unsigned*)(ws + WS_CTL) + CW_CNT + l * 64 + e, RLX_AGENT); const int pad = (c + 255) & ~255;
            pst[e] = run + ((const int*)(ws + WS_WGBASE))[bx * 32 + e];
            if (bx == 0) for (int q = 0; q < (pad >> 8); ++q) tile_e[(run >> 8) + q] = e;
            run += pad; }
        if (bx == 0) tile_e[511] = run >> 8;
    }
    __syncthreads();
    const int* tok_e = (const int*)(ws + WS_TOKE); const int* tok_l = (const int*)(ws + WS_TOKL); int* tok_s = (int*)(ws + WS_TOKS);
    const bf16* H = (const bf16*)(ws + WS_H); bf16* AG = (bf16*)(ws + WS_AG);
    for (int m4 = gw; m4 < T / 4; m4 += NGW) {
#pragma unroll
        for (int r = 0; r < 4; ++r) { const int m = m4 * 4 + r;
            const int s0 = pst[tok_e[2 * m]] + tok_l[2 * m], s1 = pst[tok_e[2 * m + 1]] + tok_l[2 * m + 1];
            if (lane == 0) { tok_s[2 * m] = s0; tok_s[2 * m + 1] = s1; }
            const v4u* src = (const v4u*)(H + (size_t)m * D) + lane; const v4u x0 = src[0], x1 = src[64];
            v4u* d0 = (v4u*)(AG + (size_t)s0 * D) + lane; v4u* d1 = (v4u*)(AG + (size_t)s1 * D) + lane;
            d0[0] = x0; d0[64] = x1; d1[0] = x0; d1[64] = x1; }
    }
}

__global__ void __launch_bounds__(NWAVES * 64, 2) fwd(Args args) {
    extern __shared__ __attribute__((aligned(16))) unsigned char lds_raw[];
    LAS unsigned char* lds = (LAS unsigned char*)lds_raw;
    for (int u = threadIdx.x; u < (LDS_BYTES - LDSCTL_OFF) / 4; u += NWAVES * 64) ((LAS unsigned*)(lds + LDSCTL_OFF))[u] = 0u;
    __syncthreads();
#if MK_MULTI
#define GRID_BAR() do { } while (0)
#else
    XcdBarrier bar = xcd_barrier_post((unsigned*)(args.ws + WS_CTL) + CW_BAR, (volatile LAS unsigned*)(lds + MISC_OFF) + 8);
#define GRID_BAR() xcd_barrier(bar)
#endif
    const int lo = args.ph_lo, hi = args.ph_hi;
#ifndef PHMASK
#define PHMASK 0xFFFF
#endif
#define EN(p) (((PHMASK) >> (p)) & 1)
#define IN(k) (lo <= (k) && (k) < hi)
#define SEAM(k) do { if (IN(k) && IN((k) + 1)) GRID_BAR(); } while (0)

    if (EN(11) && IN(0)) { prologue_phase(args, lds); SEAM(0); }

#pragma unroll 1
    for (int l = 0; l < DEPTH; ++l) {
        const int pb = 1 + l * PH_PER_LAYER;
        if (EN(0) && IN(pb + 0)) { norm1_phase(args, l, l == 0, true); moe_weights_phase(args, l, lds); SEAM(pb + 0); }
        if (EN(1) && IN(pb + 1)) { unsigned char* ws = args.ws + opq(); const int G = (int)gridDim.x, bx = (int)blockIdx.x;
            pg8::Gemm g{(const pg8::bf16_t*)(ws + WS_H), (const pg8::bf16_t*)(ws + WS_WCAT) + (size_t)l * NCAT * 1024, 1024, 1024, 1024}; pg8::StaticOrder S; S.init(T, NCAT, G, bx);
            pg8::EpiZG E{(pg8::bf16_t*)(ws + WS_Z), (pg8::bf16_t*)(ws + WS_G), (const float*)args.in[opq() + I_GATEB] + l * GWD};
            pg8::gemm_phase<pg8::EpiZG, pg8::StaticOrder, true, true>(lds + RING_OFF, g, S, E);
            SEAM(pb + 1);
        }
        if (EN(2) && IN(pb + 2)) { qkprep_phase(args, l); pool_phase(args, lds); ssm_local_phase(args, l); SEAM(pb + 2); }
        if (EN(3) && IN(pb + 3)) { ssm_carry_phase(args, l); attn_naive_phase(args, lds); SEAM(pb + 3); }
        if (EN(4) && IN(pb + 4)) { attn_combine_phase(args, l); ssm_final_phase(args, l, lds); SEAM(pb + 4); }
        if (EN(5) && IN(pb + 5)) { unsigned char* ws = args.ws + opq(); const int G = (int)gridDim.x, bx = (int)blockIdx.x;
            const pg8::bf16_t* am = (const pg8::bf16_t*)(ws + WS_AMIX); pg8::bf16_t* mx = (pg8::bf16_t*)(ws + WS_MIXED); const pg8::bf16_t* gt_ = (const pg8::bf16_t*)(ws + WS_G);
            const pg8::bf16_t* wmix = (const pg8::bf16_t*)(ws + WS_WMIX) + (size_t)l * 1024 * 1024;
            pg8::StaticOrder S; S.init(T, D, G, bx);
#pragma unroll 1
            for (int s = 0; s < 3; ++s) {
                const int koff = s == 0 ? 0 : (s == 1 ? 256 : 768), klen = s == 1 ? 512 : 256;
                pg8::Gemm g{am + koff, wmix + koff, 1024, 1024, klen}; pg8::EpiMix E{mx, gt_, s * 1024, s == 0};
                pg8::gemm_phase<pg8::EpiMix, pg8::StaticOrder, true, true>(lds + RING_OFF, g, S, E);
            }
            SEAM(pb + 5);
        }
        if (EN(6) && IN(pb + 6)) { unsigned char* ws = args.ws + opq(); const int G = (int)gridDim.x, bx = (int)blockIdx.x;
            pg8::Gemm g{(const pg8::bf16_t*)(ws + WS_MIXED), (const pg8::bf16_t*)(ws + WS_WO) + (size_t)l * 1024 * 1024, 1024, 1024, 1024}; pg8::StaticOrder S; S.init(T, D, G, bx);
            pg8::EpiResid E{args.out + opq(), (const float*)(ws + WS_MOD) + (size_t)l * NB * 6144 + 2 * 1024};
            pg8::gemm_phase<pg8::EpiResid, pg8::StaticOrder, true, true>(lds + RING_OFF, g, S, E);
            SEAM(pb + 6);
        }
        if (EN(7) && IN(pb + 7)) { norm2_router_phase(args, l, lds); SEAM(pb + 7); }
        if (EN(8) && IN(pb + 8)) { moe_scatter_phase(args, l, lds); SEAM(pb + 8); }
        if (EN(9) && IN(pb + 9)) { unsigned char* ws = args.ws + opq(); const int G = (int)gridDim.x, bx = (int)blockIdx.x; const int vcu = (G % 8 == 0) ? (bx % 8) * (G / 8) + bx / 8 : bx;
            const int* tile_e = (const int*)(ws + WS_TILEE);
            pg8::GroupedOrder S{tile_e, __builtin_amdgcn_readfirstlane(tile_e[511]), G, vcu};
            pg8::Gemm g{(const pg8::bf16_t*)(ws + WS_AG), (const pg8::bf16_t*)(ws + WS_W13), 1024, 1024, 1024};
            pg8::EpiSwiGLU E{(pg8::bf16_t*)(ws + WS_ACT)};
            pg8::gemm_phase<pg8::EpiSwiGLU, pg8::GroupedOrder, true, true>(lds + RING_OFF, g, S, E);
            SEAM(pb + 9);
        }
        if (EN(10) && IN(pb + 10)) { unsigned char* ws = args.ws + opq(); const int G = (int)gridDim.x, bx = (int)blockIdx.x; const int vcu = (G % 8 == 0) ? (bx % 8) * (G / 8) + bx / 8 : bx;
            const int* tile_e = (const int*)(ws + WS_TILEE);
            pg8::GroupedOrder S{tile_e, __builtin_amdgcn_readfirstlane(tile_e[511]), G, vcu};
            pg8::Gemm g{(const pg8::bf16_t*)(ws + WS_ACT), (const pg8::bf16_t*)(ws + WS_W2), 512, 512, 512};
            pg8::EpiY E{(pg8::bf16_t*)(ws + WS_Y)};
            pg8::gemm_phase<pg8::EpiY, pg8::GroupedOrder, true, true>(lds + RING_OFF, g, S, E);
            SEAM(pb + 10);
        }
    }
    if (EN(12) && IN(N_PHASES - 1)) norm1_phase(args, DEPTH, false, false);
#undef IN
#undef SEAM
}

extern "C" void kernel_launch(void* const* d_in, const int* in_sizes, int n_in, void* d_out, int out_size, void* d_ws, size_t ws_size, hipStream_t stream) {
    static int grid = 0;
    if (grid == 0) {
        if (n_in != 40 || out_size != T * D || ws_size < WS_END) { fprintf(stderr, "kernel_launch: unexpected shapes (n_in %d out %d ws %zu)\n", n_in, out_size, ws_size); grid = -1; return; }
        int dev = 0, cus = 0, per_cu = 0;
        if (hipGetDevice(&dev) != hipSuccess || hipDeviceGetAttribute(&cus, hipDeviceAttributeMultiprocessorCount, dev) != hipSuccess) { grid = -1; return; }
        if (hipFuncSetAttribute((const void*)fwd, hipFuncAttributeMaxDynamicSharedMemorySize, LDS_BYTES) != hipSuccess) { fprintf(stderr, "kernel_launch: hipFuncSetAttribute failed\n"); grid = -1; return; }
        if (hipOccupancyMaxActiveBlocksPerMultiprocessor(&per_cu, (const void*)fwd, NWAVES * 64, LDS_BYTES) != hipSuccess || per_cu < 1) fprintf(stderr, "kernel_launch: occupancy query says %d\n", per_cu);
        (void)hipGetLastError();
        grid = cus;
    }
    if (grid < 0) return;
    if (hipMemsetAsync((char*)d_ws + WS_CTL, 0, CTL_ZERO_BYTES, stream) != hipSuccess) return;
    Args a{};
    for (int i = 0; i < 40; ++i) a.in[i] = d_in[i];
    a.out = (float*)d_out; a.ws = (unsigned char*)d_ws;
#if MK_MULTI
    for (int p = 0; p < N_PHASES; ++p) { a.ph_lo = p; a.ph_hi = p + 1; hipLaunchKernelGGL(fwd, dim3(grid), dim3(NWAVES * 64), LDS_BYTES, stream, a); }
#else
    a.ph_lo = 0; a.ph_hi = N_PHASES;
    hipLaunchKernelGGL(fwd, dim3(grid), dim3(NWAVES * 64), LDS_BYTES, stream, a);
#endif
}
```

```cpp
#include <hip/hip_runtime.h>
#include <cstdio>
#include <cstdint>

#ifndef MK_MULTI
#define MK_MULTI 0
#endif

namespace pg8 {
#define PG8_LAS __attribute__((address_space(3)))
typedef unsigned short bf16_t;
typedef short bf16x8 __attribute__((ext_vector_type(8)));
typedef float f32x4 __attribute__((ext_vector_type(4)));
typedef unsigned u32x4 __attribute__((ext_vector_type(4)));
typedef unsigned u32x2 __attribute__((ext_vector_type(2)));
constexpr int BM = 256, BK = 64, HALF = 128, HTB = HALF * BK * 2  , STAGE_BYTES = 8 * HTB, NXCD = 8, WGM = 8;

__host__ __device__ __forceinline__ int lds_byte(int r, int c) { const int st = (r >> 4) * 2 + (c >> 5), rr = r & 15, cc = c & 31, ob = rr * 64 + cc * 2; return st * 1024 + (ob ^ (((ob >> 9) & 1) << 5)); }
__host__ __device__ __forceinline__ void stage_rc(int b, int& R, int& C) { const int st = b / 1024, sb = b % 1024, swz = sb ^ (((sb >> 9) & 1) << 5); R = (st >> 1) * 16 + swz / 64; C = (st & 1) * 32 + (swz % 64) / 2; }
__host__ __device__ __forceinline__ int perm32(int rho) { const int n = rho >> 4, i = rho & 15; return 8 * (i >> 2) + 4 * n + (i & 3); }

struct Unit { int pm, pn, pb; };
struct Gemm { const bf16_t* A; const bf16_t* Bt; int lda, ldb, K; };

struct StaticOrder {
    int nM, nN, nwg, G, c;
    __host__ __device__ void init(int M, int N, int G_, int c_) { nM = M / BM; nN = N / BM; nwg = nM * nN; G = G_; c = c_; }
    __host__ __device__ bool next(int i, Unit& u) const {
        const long L = (long)i * G + c; if (L >= nwg) return false;
        int wgid = (int)L; { const int q = nwg / NXCD, r = nwg % NXCD, xcd = wgid % NXCD, off = wgid / NXCD; wgid = (xcd < r ? xcd * (q + 1) : r * (q + 1) + (xcd - r) * q) + off; }
        const int nig = WGM * nN, gid = wgid / nig, fm = gid * WGM, gsz = (nM - fm) < WGM ? (nM - fm) : WGM;
        u.pm = fm + ((wgid % nig) % gsz); u.pn = (wgid % nig) / gsz; u.pb = u.pn; return true;
    }
    __device__ __forceinline__ void a_ready(const Unit&) const {}
    __device__ __forceinline__ void done(const Unit&) const {}
};
struct GroupedOrder {
    const int* tile_e; int ntiles, G, c;
    __device__ __forceinline__ bool next(int i, Unit& u) const {
        const long L = (long)i * G + c; if (L >= (long)ntiles * 4) return false;
        const int pm = (int)(L >> 2), pl = (int)(L & 3);
        u.pm = pm; u.pn = pl; u.pb = __builtin_amdgcn_readfirstlane(tile_e[pm]) * 4 + pl; return true;
    }
    __device__ __forceinline__ void a_ready(const Unit&) const {}
    __device__ __forceinline__ void done(const Unit&) const {}
};

__device__ __forceinline__ unsigned cvt_pk_bf16(float lo, float hi) { unsigned r; asm volatile("v_cvt_pk_bf16_f32 %0, %1, %2" : "=v"(r) : "v"(lo), "v"(hi)); return r; }
__device__ __forceinline__ float bflo(unsigned w) { return __uint_as_float(w << 16); }
__device__ __forceinline__ float bfhi(unsigned w) { return __uint_as_float(w & 0xffff0000u); }
__device__ __forceinline__ float sigmoidf_(float x) { return 1.0f / (1.0f + __expf(-x)); }


struct EpiZG {
    static constexpr bool PERM = true, AFTER_DRAIN = false;
    bf16_t* Z; bf16_t* Gt; const float* gbias;
    __device__ __forceinline__ void operator()(const f32x4 (&acc)[2][2][4][2], const Unit& u, int wr, int wc, int fr, int fq) const {
        asm volatile("" : "+v"(fr), "+v"(fq));
        const int row0 = u.pm * BM + wr * 64 + fr;
        const bool gate = u.pn >= 8;
        const int colt = gate ? (u.pn - 8) * BM : u.pn * BM, ldc = gate ? 3072 : 2048;
        bf16_t* base = gate ? Gt : Z;
        const int col0 = colt + wc * 32 + 8 * fq;
        f32x4 bv[2][2];
#pragma unroll
        for (int bj = 0; bj < 2; ++bj)
#pragma unroll
            for (int n = 0; n < 2; ++n) bv[bj][n] = gate ? *(const f32x4*)(gbias + col0 + bj * HALF + 4 * n) : (f32x4){0.f, 0.f, 0.f, 0.f};
#pragma unroll
        for (int ai = 0; ai < 2; ++ai)
#pragma unroll
            for (int m = 0; m < 4; ++m) { bf16_t* rowp = base + (size_t)(row0 + ai * HALF + m * 16) * ldc + col0;
#pragma unroll
                for (int bj = 0; bj < 2; ++bj) { f32x4 v0 = acc[ai][bj][m][0] + bv[bj][0], v1 = acc[ai][bj][m][1] + bv[bj][1];
                    if (gate) {
#pragma unroll
                        for (int j = 0; j < 4; ++j) { v0[j] = sigmoidf_(v0[j]); v1[j] = sigmoidf_(v1[j]); } }
                    u32x4 w; w.x = cvt_pk_bf16(v0[0], v0[1]); w.y = cvt_pk_bf16(v0[2], v0[3]); w.z = cvt_pk_bf16(v1[0], v1[1]); w.w = cvt_pk_bf16(v1[2], v1[3]);
                    *(u32x4*)(rowp + bj * HALF) = w; } }
    }
};
struct EpiMix {
    static constexpr bool PERM = true, AFTER_DRAIN = false;
    bf16_t* O; const bf16_t* Gt; int gcol0; bool first;
    __device__ __forceinline__ void operator()(const f32x4 (&acc)[2][2][4][2], const Unit& u, int wr, int wc, int fr, int fq) const {
        asm volatile("" : "+v"(fr), "+v"(fq));
        const int row0 = u.pm * BM + wr * 64 + fr, col0 = u.pn * BM + wc * 32 + 8 * fq;
#pragma unroll
        for (int ai = 0; ai < 2; ++ai)
#pragma unroll
            for (int m = 0; m < 4; ++m) { const size_t row = (size_t)(row0 + ai * HALF + m * 16);
#pragma unroll
                for (int bj = 0; bj < 2; ++bj) {
                    const u32x4 gw = *(const u32x4*)(Gt + row * 3072 + gcol0 + col0 + bj * HALF);
                    bf16_t* op = O + row * 1024 + col0 + bj * HALF;
                    f32x4 v0 = acc[ai][bj][m][0], v1 = acc[ai][bj][m][1];
                    v0[0] *= bflo(gw.x); v0[1] *= bfhi(gw.x); v0[2] *= bflo(gw.y); v0[3] *= bfhi(gw.y);
                    v1[0] *= bflo(gw.z); v1[1] *= bfhi(gw.z); v1[2] *= bflo(gw.w); v1[3] *= bfhi(gw.w);
                    if (!first) { const u32x4 pw = *(const u32x4*)op;
                        v0[0] += bflo(pw.x); v0[1] += bfhi(pw.x); v0[2] += bflo(pw.y); v0[3] += bfhi(pw.y);
                        v1[0] += bflo(pw.z); v1[1] += bfhi(pw.z); v1[2] += bflo(pw.w); v1[3] += bfhi(pw.w); }
                    u32x4 w; w.x = cvt_pk_bf16(v0[0], v0[1]); w.y = cvt_pk_bf16(v0[2], v0[3]); w.z = cvt_pk_bf16(v1[0], v1[1]); w.w = cvt_pk_bf16(v1[2], v1[3]);
                    *(u32x4*)op = w; }
                asm volatile("" ::: "memory"); }
    }
};
struct EpiResid {
    static constexpr bool PERM = false, AFTER_DRAIN = false;
    float* X; const float* g1;
    __device__ __forceinline__ void operator()(const f32x4 (&acc)[2][2][4][2], const Unit& u, int wr, int wc, int fr, int fq) const {
        asm volatile("" : "+v"(fr), "+v"(fq));
        const int row0 = u.pm * BM + wr * 64 + fr, col0 = u.pn * BM + wc * 32 + 4 * fq;
        const float* gp = g1 + (size_t)((u.pm * BM) >> 12) * 6144 + col0;
        f32x4 gv[2][2];
#pragma unroll
        for (int bj = 0; bj < 2; ++bj)
#pragma unroll
            for (int n = 0; n < 2; ++n) gv[bj][n] = *(const f32x4*)(gp + bj * HALF + n * 16);
#pragma unroll
        for (int ai = 0; ai < 2; ++ai)
#pragma unroll
            for (int m = 0; m < 4; ++m) { float* rowp = X + (size_t)(row0 + ai * HALF + m * 16) * 1024 + col0;
#pragma unroll
                for (int bj = 0; bj < 2; ++bj)
#pragma unroll
                    for (int n = 0; n < 2; ++n) { f32x4* p = (f32x4*)(rowp + bj * HALF + n * 16); *p = *p + gv[bj][n] * acc[ai][bj][m][n]; } }
    }
};
struct EpiSwiGLU {
    static constexpr bool PERM = true, AFTER_DRAIN = false;
    bf16_t* O;
    __device__ __forceinline__ void operator()(const f32x4 (&acc)[2][2][4][2], const Unit& u, int wr, int wc, int fr, int fq) const {
        asm volatile("" : "+v"(fr), "+v"(fq));
        const int row0 = u.pm * BM + wr * 64 + fr, col0 = u.pn * HALF + wc * 32 + 8 * fq;
#pragma unroll
        for (int ai = 0; ai < 2; ++ai)
#pragma unroll
            for (int m = 0; m < 4; ++m) { bf16_t* op = O + (size_t)(row0 + ai * HALF + m * 16) * 512 + col0;
                float r[8];
#pragma unroll
                for (int n = 0; n < 2; ++n)
#pragma unroll
                    for (int j = 0; j < 4; ++j) { const float a = acc[ai][0][m][n][j], b = acc[ai][1][m][n][j]; r[n * 4 + j] = a * sigmoidf_(a) * b; }
                u32x4 w; w.x = cvt_pk_bf16(r[0], r[1]); w.y = cvt_pk_bf16(r[2], r[3]); w.z = cvt_pk_bf16(r[4], r[5]); w.w = cvt_pk_bf16(r[6], r[7]);
                *(u32x4*)op = w; }
    }
};
struct EpiY {
    static constexpr bool PERM = true, AFTER_DRAIN = false;
    bf16_t* O;
    __device__ __forceinline__ void operator()(const f32x4 (&acc)[2][2][4][2], const Unit& u, int wr, int wc, int fr, int fq) const {
        asm volatile("" : "+v"(fr), "+v"(fq));
        const int row0 = u.pm * BM + wr * 64 + fr, col0 = u.pn * BM + wc * 32 + 8 * fq;
#pragma unroll
        for (int ai = 0; ai < 2; ++ai)
#pragma unroll
            for (int m = 0; m < 4; ++m) { bf16_t* rowp = O + (size_t)(row0 + ai * HALF + m * 16) * 1024 + col0;
#pragma unroll
                for (int bj = 0; bj < 2; ++bj) { const f32x4 v0 = acc[ai][bj][m][0], v1 = acc[ai][bj][m][1];
                    u32x4 w; w.x = cvt_pk_bf16(v0[0], v0[1]); w.y = cvt_pk_bf16(v0[2], v0[3]); w.z = cvt_pk_bf16(v1[0], v1[1]); w.w = cvt_pk_bf16(v1[2], v1[3]);
                    *(u32x4*)(rowp + bj * HALF) = w; } }
    }
};

template <class Epi, class Sched, bool ALIGN_EPI = false, bool SP2 = false>
__device__ __forceinline__ void gemm_phase(PG8_LAS unsigned char* lds, const Gemm g, const Sched& S, const Epi& E) {
    const int tid = threadIdx.x, wid = __builtin_amdgcn_readfirstlane(tid >> 6), lane = tid & 63, wr = wid >> 2, wc = wid & 3, fr = lane & 15, fq = lane >> 4;
    const int K = g.K, nt = K / BK, lda = g.lda, ldb = g.ldb;
    unsigned voffA[2], voffB[2];
#pragma unroll
    for (int i = 0; i < 2; ++i) { int R, C; stage_rc(tid * 16 + i * 8192, R, C); const int Rb = Epi::PERM ? ((R & ~31) + perm32(R & 31)) : R;
        voffA[i] = (unsigned)(R * lda + C) * 2u; voffB[i] = (unsigned)(Rb * ldb + C) * 2u; }
    const size_t kstep = (size_t)(BK * 2);
    const size_t hstepA = (size_t)HALF * lda * 2, hstepB = (size_t)HALF * ldb * 2;
    const size_t tstepA = 2 * hstepA, tstepB = 2 * hstepB;
    const unsigned ldsw = (unsigned)wid * 1024u;
    const int aoff = lds_byte(wr * 64 + fr, fq * 8), boff = lds_byte(wc * 32 + fr, fq * 8);
#define PG8_SA(b, h) (((b) * 2 + (h)) * HTB)
#define PG8_SB(b, h) ((4 + (b) * 2 + (h)) * HTB)
#define PG8_STAGE(bufoff, gbase, voff) do { _Pragma("unroll") for (int _i = 0; _i < 2; ++_i) \
        __builtin_amdgcn_global_load_lds((const unsigned*)((const char*)(gbase) + (voff)[_i]), (PG8_LAS unsigned*)(lds + (bufoff) + ldsw + _i * 8192), 16, 0, 0); } while (0)
#define PG8_LDA(dst, b, h) do { _Pragma("unroll") for (int m = 0; m < 4; ++m) _Pragma("unroll") for (int k = 0; k < 2; ++k) dst[m][k] = *(const PG8_LAS bf16x8*)(lds + PG8_SA(b, h) + aoff + m * 2048 + k * 1024); } while (0)
#define PG8_LDB(dst, b, h) do { _Pragma("unroll") for (int n = 0; n < 2; ++n) _Pragma("unroll") for (int k = 0; k < 2; ++k) dst[n][k] = *(const PG8_LAS bf16x8*)(lds + PG8_SB(b, h) + boff + n * 2048 + k * 1024); } while (0)
#define PG8_MMA(ai, bj, At, Bt) do { __builtin_amdgcn_s_setprio(1); _Pragma("unroll") for (int m = 0; m < 4; ++m) _Pragma("unroll") for (int n = 0; n < 2; ++n) _Pragma("unroll") for (int k = 0; k < 2; ++k) \
        acc[ai][bj][m][n] = __builtin_amdgcn_mfma_f32_16x16x32_bf16(Bt[n][k], At[m][k], acc[ai][bj][m][n], 0, 0, 0); __builtin_amdgcn_s_setprio(0); } while (0)
#define PG8_WAIT_V(n) asm volatile("s_waitcnt vmcnt(" #n ")" ::: "memory")
#define PG8_WAIT_L(n) asm volatile("s_waitcnt lgkmcnt(" #n ")" ::: "memory")
#define PG8_BAR __builtin_amdgcn_s_barrier()
#define PG8_SCHED __builtin_amdgcn_sched_barrier(0)
    Unit cur, nxt; int ui = 0;
    if (!S.next(0, cur)) return;
    f32x4 acc[2][2][4][2];
#pragma unroll
    for (int a = 0; a < 2; ++a)
#pragma unroll
        for (int b = 0; b < 2; ++b)
#pragma unroll
            for (int m = 0; m < 4; ++m)
#pragma unroll
                for (int n = 0; n < 2; ++n) acc[a][b][m][n] = (f32x4){0.f, 0.f, 0.f, 0.f};
    bf16x8 At[4][2], B0[2][2], B1[2][2];
    const char* cA = (const char*)g.A + (size_t)cur.pm * tstepA; const char* cB = (const char*)g.Bt + (size_t)cur.pb * tstepB;
    S.a_ready(cur);
    if constexpr (SP2) {
        PG8_STAGE(PG8_SB(0, 0), cB, voffB); PG8_STAGE(PG8_SB(0, 1), cB + hstepB, voffB); PG8_STAGE(PG8_SA(0, 0), cA, voffA); PG8_STAGE(PG8_SA(0, 1), cA + hstepA, voffA);
        if (wr == 1) PG8_BAR;
        PG8_WAIT_V(2); PG8_BAR;
        PG8_STAGE(PG8_SB(1, 0), cB + kstep, voffB); PG8_STAGE(PG8_SA(1, 0), cA + kstep, voffA); PG8_STAGE(PG8_SB(1, 1), cB + hstepB + kstep, voffB);
        PG8_WAIT_V(6); PG8_BAR;
    } else {
        PG8_STAGE(PG8_SB(0, 0), cB, voffB); PG8_STAGE(PG8_SA(0, 0), cA, voffA); PG8_STAGE(PG8_SB(0, 1), cB + hstepB, voffB); PG8_STAGE(PG8_SA(0, 1), cA + hstepA, voffA);
        if (wr == 1) PG8_BAR;
        PG8_WAIT_V(4); PG8_BAR;
        PG8_STAGE(PG8_SB(1, 0), cB + kstep, voffB); PG8_STAGE(PG8_SA(1, 0), cA + kstep, voffA); PG8_STAGE(PG8_SB(1, 1), cB + hstepB + kstep, voffB);
        PG8_WAIT_V(6); PG8_BAR;
    }
    for (;;) {
        const bool has_next = S.next(ui + 1, nxt);
        const char* nA = has_next ? (const char*)g.A + (size_t)nxt.pm * tstepA : cA; const char* nB = has_next ? (const char*)g.Bt + (size_t)nxt.pb * tstepB : cB;
#pragma unroll 1
        for (int t = 0; t < nt; t += 2) {
            const bool last = (t == nt - 2);
            const char* a1 = cA + (size_t)(t + 1) * kstep;
            const char* a2 = last ? nA : cA + (size_t)(t + 2) * kstep; const char* b2 = last ? nB : cB + (size_t)(t + 2) * kstep;
            const char* a3 = a2 + kstep; const char* b3 = b2 + kstep;
            if (last && has_next) S.a_ready(nxt);
            if constexpr (SP2) {
            PG8_LDB(B0, 0, 0); PG8_LDB(B1, 0, 1); PG8_SCHED; PG8_LDA(At, 0, 0); PG8_STAGE(PG8_SA(1, 1), a1 + hstepA, voffA);
            PG8_WAIT_V(8); PG8_WAIT_L(0); PG8_BAR; PG8_MMA(0, 0, At, B0); PG8_MMA(0, 1, At, B1); PG8_BAR; PG8_SCHED;
            PG8_LDA(At, 0, 1); PG8_STAGE(PG8_SB(0, 0), b2, voffB); PG8_STAGE(PG8_SB(0, 1), b2 + hstepB, voffB); PG8_STAGE(PG8_SA(0, 0), a2, voffA);
            PG8_WAIT_V(8); PG8_WAIT_L(0); PG8_BAR; PG8_MMA(1, 0, At, B0); PG8_MMA(1, 1, At, B1); PG8_BAR; PG8_SCHED;
            PG8_LDB(B0, 1, 0); PG8_LDB(B1, 1, 1); PG8_SCHED; PG8_LDA(At, 1, 0); PG8_STAGE(PG8_SA(0, 1), a2 + hstepA, voffA);
            PG8_WAIT_V(8); PG8_WAIT_L(0); PG8_BAR; PG8_MMA(0, 0, At, B0); PG8_MMA(0, 1, At, B1); PG8_BAR; PG8_SCHED;
            PG8_LDA(At, 1, 1); PG8_STAGE(PG8_SB(1, 0), b3, voffB); PG8_STAGE(PG8_SB(1, 1), b3 + hstepB, voffB); PG8_STAGE(PG8_SA(1, 0), a3, voffA);
            PG8_WAIT_V(8); PG8_WAIT_L(0); PG8_BAR; PG8_MMA(1, 0, At, B0); PG8_MMA(1, 1, At, B1); PG8_BAR; PG8_SCHED;
            } else {
            PG8_LDB(B0, 0, 0); PG8_SCHED; PG8_LDA(At, 0, 0); PG8_STAGE(PG8_SA(1, 1), a1 + hstepA, voffA);
            PG8_WAIT_L(8); PG8_BAR; PG8_WAIT_L(0); PG8_MMA(0, 0, At, B0); PG8_BAR; PG8_SCHED;
            PG8_LDB(B1, 0, 1); PG8_STAGE(PG8_SB(0, 0), b2, voffB);
            PG8_BAR; PG8_WAIT_L(0); PG8_MMA(0, 1, At, B1); PG8_BAR;
            PG8_LDA(At, 0, 1); PG8_STAGE(PG8_SA(0, 0), a2, voffA);
            PG8_BAR; PG8_WAIT_L(0); PG8_MMA(1, 0, At, B0); PG8_BAR; PG8_SCHED;
            PG8_STAGE(PG8_SB(0, 1), b2 + hstepB, voffB);
            PG8_WAIT_V(6); PG8_BAR; PG8_MMA(1, 1, At, B1); PG8_BAR;
            PG8_LDB(B0, 1, 0); PG8_SCHED; PG8_LDA(At, 1, 0); PG8_STAGE(PG8_SA(0, 1), a2 + hstepA, voffA);
            PG8_WAIT_L(8); PG8_BAR; PG8_WAIT_L(0); PG8_MMA(0, 0, At, B0); PG8_BAR; PG8_SCHED;
            PG8_LDB(B1, 1, 1); PG8_STAGE(PG8_SB(1, 0), b3, voffB);
            PG8_BAR; PG8_WAIT_L(0); PG8_MMA(0, 1, At, B1); PG8_BAR;
            PG8_LDA(At, 1, 1); PG8_STAGE(PG8_SA(1, 0), a3, voffA);
            PG8_BAR; PG8_WAIT_L(0); PG8_MMA(1, 0, At, B0); PG8_BAR; PG8_SCHED;
            PG8_STAGE(PG8_SB(1, 1), b3 + hstepB, voffB);
            PG8_WAIT_V(6); PG8_BAR; PG8_MMA(1, 1, At, B1); PG8_BAR;
            }
        }
        if constexpr (ALIGN_EPI) { if (wr == 0) PG8_BAR; }
        if constexpr (!Epi::AFTER_DRAIN) { E(acc, cur, wr, wc, fr, fq); S.done(cur); }
        if (!has_next) break;
#pragma unroll
        for (int a = 0; a < 2; ++a)
#pragma unroll
            for (int b = 0; b < 2; ++b)
#pragma unroll
                for (int m = 0; m < 4; ++m)
#pragma unroll
                    for (int n = 0; n < 2; ++n) acc[a][b][m][n] = (f32x4){0.f, 0.f, 0.f, 0.f};
        cur = nxt; cA = nA; cB = nB; ++ui;
        if constexpr (ALIGN_EPI) { if (wr == 1) PG8_BAR; }
    }
    PG8_WAIT_V(0);
    if constexpr (!ALIGN_EPI) { if (wr == 0) PG8_BAR; }
    PG8_BAR;
    if constexpr (Epi::AFTER_DRAIN) { E.fused(acc, cur, wr, wc, fr, fq, lds, wid, lane); S.done(cur); }
#undef PG8_SA
#undef PG8_SB
#undef PG8_STAGE
#undef PG8_LDA
#undef PG8_LDB
#undef PG8_MMA
#undef PG8_WAIT_V
#undef PG8_WAIT_L
#undef PG8_BAR
#undef PG8_SCHED
}
}

constexpr int NB = 8, SEQ = 4096, T = NB * SEQ, D = 1024, DEPTH = 4;
constexpr int ZW = 2048, GWD = 3072, NCAT = ZW + GWD;
constexpr int ZQ = 256, ZK = 768, ZV = 1280, ZC = 1792;
constexpr int NEXP = 32, FF = 512, MAXSLOT = 2 * T + NEXP * 256;
constexpr float NORM_EPS = 1e-6f;
constexpr int NWAVES = 8;
constexpr int PH_PER_LAYER = 11, N_PHASES = 1 + DEPTH * PH_PER_LAYER + 1;

constexpr size_t MiB = 1u << 20;
constexpr size_t WS_CTL = 0, CTL_ZERO_BYTES = 1 * MiB;
constexpr size_t WS_MOD = 1 * MiB;
constexpr size_t WS_LAM = WS_MOD + (size_t)DEPTH * NB * 6144 * 4;
constexpr size_t WS_ROPE_C = 2 * MiB, WS_ROPE_S = 6 * MiB;
constexpr size_t WS_SSM = 10 * MiB;
constexpr size_t SSM_L_BYTES = 8192 + 8192 + 131072;
constexpr size_t WS_RWT = 11 * MiB;
constexpr size_t WS_TOKE = 12 * MiB, WS_TOKW = WS_TOKE + 256 * 1024, WS_TOKL = WS_TOKW + 256 * 1024, WS_TOKS = WS_TOKL + 256 * 1024;
constexpr size_t WS_WGBASE = 13 * MiB, WS_TILEE = WS_WGBASE + 64 * 1024;
constexpr size_t WS_E = 14 * MiB, WS_CIN = 18 * MiB;
constexpr size_t WS_WCAT = 24 * MiB;
constexpr size_t WS_WMIX = 64 * MiB;
constexpr size_t WS_WO = 72 * MiB;
constexpr size_t WS_WGLU = 80 * MiB;
constexpr size_t WS_W13 = 82 * MiB;
constexpr size_t WS_W2 = 146 * MiB;
constexpr size_t WS_H = 178 * MiB;
constexpr size_t WS_Z = 242 * MiB;
constexpr size_t WS_G = 370 * MiB;
constexpr size_t WS_O0 = 562 * MiB, WS_O1 = 626 * MiB;
constexpr size_t WS_AMIX = 690 * MiB;
constexpr size_t WS_MIXED = 754 * MiB;
constexpr size_t WS_AG = 242 * MiB;
constexpr size_t WS_ACT = 386 * MiB;
constexpr size_t WS_Y = 458 * MiB;
constexpr size_t WS_END = 818 * MiB;
static_assert(WS_AG + (size_t)MAXSLOT * 1024 * 2 <= WS_ACT && WS_ACT + (size_t)MAXSLOT * 512 * 2 <= WS_Y && WS_Y + (size_t)MAXSLOT * 1024 * 2 <= WS_AMIX, "moe overlay map");
constexpr int CW_BAR = 4096;
constexpr int CW_CNT = 16384;

constexpr int RING_OFF = 0, RING_BYTES = 131072;
constexpr int LDSCTL_OFF = RING_BYTES, MISC_OFF = LDSCTL_OFF + 320;
constexpr int LDS_BYTES = 147456;

#define GAS __attribute__((address_space(1)))
#define LAS __attribute__((address_space(3)))
typedef unsigned short bf16;
typedef unsigned v4u __attribute__((ext_vector_type(4)));
typedef unsigned v2u __attribute__((ext_vector_type(2)));
typedef float f32x4 __attribute__((ext_vector_type(4)));
typedef float f32x2 __attribute__((ext_vector_type(2)));
typedef short bf16x8 __attribute__((ext_vector_type(8)));
typedef GAS unsigned gu32;
#define RLX_AGENT __ATOMIC_RELAXED, __HIP_MEMORY_SCOPE_AGENT
#define LDS_WAIT() asm volatile("s_waitcnt lgkmcnt(0)" ::: "memory")
#define VM_WAIT() asm volatile("s_waitcnt vmcnt(0)" ::: "memory")
__device__ __forceinline__ unsigned f2bf(float f) { unsigned u = __builtin_bit_cast(unsigned, f); return (u + 0x7fffu + ((u >> 16) & 1u)) >> 16; }
__device__ __forceinline__ unsigned pk2(float lo, float hi) { return f2bf(lo) | (f2bf(hi) << 16); }
__device__ __forceinline__ float bf2f(unsigned short b) { return __uint_as_float(((unsigned)b) << 16); }
__device__ __forceinline__ float bflo(unsigned w) { return __uint_as_float(w << 16); }
__device__ __forceinline__ float bfhi(unsigned w) { return __uint_as_float(w & 0xffff0000u); }

#define XB_TMO      128
#define XB_XCNT(j)  (256  + 64 * (j))
#define XB_XSUB(j)  (1280 + 64 * (j))
#define XB_XGEN(j)  (2304 + 64 * (j))
#define XB_TOP      3328
#define XB_TOPGEN   3392
#define XCD_BAR_WORDS 3456
#define XB_SPIN_CAP (1u << 18)

__device__ __forceinline__ unsigned xb_ld(unsigned* p)              { return __hip_atomic_load(p, __ATOMIC_RELAXED, __HIP_MEMORY_SCOPE_AGENT); }
__device__ __forceinline__ unsigned xb_add(unsigned* p, unsigned v) { return __hip_atomic_fetch_add(p, v, __ATOMIC_RELAXED, __HIP_MEMORY_SCOPE_AGENT); }
__device__ __forceinline__ unsigned xb_xcc_id() { return (unsigned)__builtin_amdgcn_s_getreg((3 << 11) | 20) & 0xFu; }
#define XB_SPIN(cond, bar) do { unsigned _sp = 0; while (cond) { __builtin_amdgcn_s_sleep(1); \
    if ((++_sp & 255u) == 0u) { if (xb_ld(&(bar)[XB_TMO])) break; if (_sp > XB_SPIN_CAP) { atomicAdd(&(bar)[XB_TMO], 1u); break; } } } } while (0)

struct XcdBarrier {
    unsigned* bar; unsigned x;
    volatile LAS unsigned* st;
};

__device__ __forceinline__ XcdBarrier xcd_barrier_post(unsigned* bar, volatile LAS unsigned* st) {
    XcdBarrier b; b.bar = bar; b.x = xb_xcc_id(); b.st = st;
    if (threadIdx.x == 0) (void)xb_add(&bar[XB_XCNT(b.x)], 1u);
    return b;
}
__device__ __forceinline__ void xcd_barrier_complete(unsigned* bar, unsigned x, unsigned& nloc, unsigned& nx) {
    const unsigned G = gridDim.x * gridDim.y * gridDim.z;
    unsigned sum, cnt, mine, sp = 0u;
    for (;;) {
        sum = 0u; cnt = 0u; mine = 0u;
#pragma unroll
        for (unsigned j = 0; j < 16; ++j) { const unsigned c = xb_ld(&bar[XB_XCNT(j)]); sum += c; cnt += (c > 0u) ? 1u : 0u; mine = (j == x) ? c : mine; }
        if (sum == G) break;
        __builtin_amdgcn_s_sleep(1);
        if ((++sp & 255u) == 0u) { if (xb_ld(&bar[XB_TMO])) break; if (sp > XB_SPIN_CAP) { atomicAdd(&bar[XB_TMO], 1u); break; } }
    }
    nloc = mine > 0u ? mine : 1u; nx = cnt > 0u ? cnt : 1u;
}

__device__ __forceinline__ void xcd_barrier(const XcdBarrier& b) {
    asm volatile("s_waitcnt vmcnt(0)" ::: "memory");
    __syncthreads();
    if (threadIdx.x == 0) {
        unsigned* bar = b.bar;
        __builtin_amdgcn_s_waitcnt(0);
        unsigned nloc = b.st[0], nx = b.st[1];
        if (nloc == 0u) { xcd_barrier_complete(bar, b.x, nloc, nx); b.st[0] = nloc; b.st[1] = nx; }
        const unsigned old = xb_add(&bar[XB_XSUB(b.x)], 1u);
        const unsigned gen = old / nloc;
        if (old + 1u == (gen + 1u) * nloc) {
            __builtin_amdgcn_fence(__ATOMIC_RELEASE, "agent");
            asm volatile("s_waitcnt vmcnt(0)" ::: "memory");
            const unsigned og = xb_add(&bar[XB_TOP], 1u);
            const unsigned tg = og / nx;
            if (og + 1u == (tg + 1u) * nx) xb_add(&bar[XB_TOPGEN], 1u);
            else XB_SPIN(xb_ld(&bar[XB_TOPGEN]) == tg, bar);
            __builtin_amdgcn_fence(__ATOMIC_ACQUIRE, "agent");
            xb_add(&bar[XB_XGEN(b.x)], 1u);
            asm volatile("s_waitcnt vmcnt(0)" ::: "memory");
        } else {
            XB_SPIN(xb_ld(&bar[XB_XGEN(b.x)]) == gen, bar);
            __builtin_amdgcn_fence(__ATOMIC_ACQUIRE, "agent");
            asm volatile("s_waitcnt vmcnt(0)" ::: "memory");
        }
    }
    __syncthreads();
}


__device__ __forceinline__ float wave_sum(float v) {
#pragma unroll
    for (int o = 1; o < 64; o <<= 1) v += __shfl_xor(v, o);
    return v;
}
__device__ __forceinline__ float wave_max(float v) {
#pragma unroll
    for (int o = 1; o < 64; o <<= 1) v = fmaxf(v, __shfl_xor(v, o));
    return v;
}
__device__ __forceinline__ float sigmoidf_(float x) { return 1.0f / (1.0f + __expf(-x)); }
__device__ __forceinline__ float gelu_tanh(float x) { const float u = 0.7978845608028654f * (x + 0.044715f * x * x * x); return 0.5f * x * (1.0f + tanhf(u)); }

__device__ __forceinline__ void tr_item(const float* __restrict__ W, int N, int k0, int n0, bf16* WT, int ldt, int drow0, int dcol0, LAS float* scr, int lane) {
#pragma unroll 8
    for (int i = 0; i < 32; ++i) { const int kk = 2 * i + (lane >> 5); scr[kk * 33 + (lane & 31)] = W[(size_t)(k0 + kk) * N + n0 + (lane & 31)]; }
    LDS_WAIT(); asm volatile("" ::: "memory");
    const int c = lane & 7;
#pragma unroll
    for (int j = 0; j < 4; ++j) { const int n = (lane >> 3) + 8 * j; const LAS float* s = scr + (8 * c) * 33 + n;
        v4u o; o.x = pk2(s[0 * 33], s[1 * 33]); o.y = pk2(s[2 * 33], s[3 * 33]); o.z = pk2(s[4 * 33], s[5 * 33]); o.w = pk2(s[6 * 33], s[7 * 33]);
        *(v4u*)(WT + (size_t)(drow0 + n) * ldt + dcol0 + 8 * c) = o; }
    LDS_WAIT(); asm volatile("" ::: "memory");
}

__device__ __forceinline__ int opqv(int x) { asm volatile("" : "+v"(x)); return x; }
__device__ __forceinline__ int opq() { int z = 0; asm volatile("" : "+s"(z)); return z; }
struct Args { const void* in[40]; float* out; unsigned char* ws; int ph_lo, ph_hi; };

enum { I_X = 0, I_C, I_POS, I_ADAW, I_ADAB, I_N1G, I_WIN, I_POOLW, I_POOLS, I_QNG, I_KNG, I_LQ1, I_LK1, I_LQ2, I_LK2, I_SUBLN,
       I_LAMRE, I_LAMIM, I_LOGDT, I_BRE, I_BIM, I_CRE, I_CIM, I_DSKIP, I_GLUW, I_GLUB, I_PROJA, I_PROJB, I_PROJC, I_GATEW, I_GATEB,
       I_WOUT, I_N2G, I_RGW, I_RGB, I_REW, I_REB, I_W1, I_W3, I_W2 };

__device__ __forceinline__ float lambda_init_of(int l) { return l == 0 ? 0.2f : (l == 1 ? 0.35550906759096926f : (l == 2 ? 0.47071302343358413f : 0.5560582041556841f)); }

__device__ __forceinline__ void prologue_phase(const Args& a, LAS unsigned char* lds) {
    const int z = opq(); (void)z;
    const int tid = opqv((int)threadIdx.x), lane = tid & 63, wave = __builtin_amdgcn_readfirstlane(tid >> 6); const int G = (int)gridDim.x, bx = (int)blockIdx.x;
    const int vcu = (G % 8 == 0) ? (bx % 8) * (G / 8) + bx / 8 : bx; const int gw = vcu * NWAVES + wave, NGW = G * NWAVES, gt = vcu * 512 + tid;
    (void)lane; (void)gw; (void)NGW; (void)gt; (void)bx;
    unsigned char* ws = (a.ws + z);
    const int NGT = G * 512;
    LAS float* scr = (LAS float*)(lds + RING_OFF + wave * 16384);
    {
        constexpr int I_IN = 16 * 64, I_GT = 16 * 96, I_PB = 8 * 32, I_PC = 4 * 32, I_WOI = 16 * 32, I_GL = 4 * 8;
        constexpr int PER_L = I_IN + I_GT + I_PB + I_PC + I_WOI + I_GL;
        for (int it = gw; it < DEPTH * PER_L; it += NGW) {
            const int l = it / PER_L; int r = it - l * PER_L;
            bf16* wcat = (bf16*)(ws + WS_WCAT) + (size_t)l * NCAT * 1024;
            bf16* wmix = (bf16*)(ws + WS_WMIX) + (size_t)l * 1024 * 1024;
            if (r < I_IN) { const int kb = r / 64, nb = r % 64; tr_item((const float*)a.in[z + I_WIN] + (size_t)l * 1024 * ZW, ZW, kb * 64, nb * 32, wcat, 1024, nb * 32, kb * 64, scr, lane); continue; } r -= I_IN;
            if (r < I_GT) { const int kb = r / 96, nb = r % 96; tr_item((const float*)a.in[z + I_GATEW] + (size_t)l * 1024 * GWD, GWD, kb * 64, nb * 32, wcat, 1024, ZW + nb * 32, kb * 64, scr, lane); continue; } r -= I_GT;
            if (r < I_PB) { const int kb = r / 32, nb = r % 32; tr_item((const float*)a.in[z + I_PROJB] + (size_t)l * 512 * 1024, 1024, kb * 64, nb * 32, wmix, 1024, nb * 32, 256 + kb * 64, scr, lane); continue; } r -= I_PB;
            if (r < I_PC) { const int kb = r / 32, nb = r % 32; tr_item((const float*)a.in[z + I_PROJC] + (size_t)l * 256 * 1024, 1024, kb * 64, nb * 32, wmix, 1024, nb * 32, 768 + kb * 64, scr, lane); continue; } r -= I_PC;
            if (r < I_WOI) { const int kb = r / 32, nb = r % 32; tr_item((const float*)a.in[z + I_WOUT] + (size_t)l * 1024 * 1024, 1024, kb * 64, nb * 32, (bf16*)(ws + WS_WO) + (size_t)l * 1024 * 1024, 1024, nb * 32, kb * 64, scr, lane); continue; } r -= I_WOI;
            { const int kb = r / 8, nb = r % 8; tr_item((const float*)a.in[z + I_GLUW] + (size_t)l * 256 * 256, 256, kb * 64, nb * 32, (bf16*)(ws + WS_WGLU) + (size_t)l * 256 * 256, 256, nb * 32, kb * 64, scr, lane); }
        }
    }
    for (int idx = gt; idx < DEPTH * 256 * 1024; idx += NGT) {
        const int l = idx >> 18, k = (idx >> 10) & 255, n = idx & 1023, g = k >> 6, c = k & 63;
        const float* pw = (const float*)a.in[z + I_POOLW] + ((size_t)(l * 4 + g) * 64 + c) * 64;
        const float* ps = (const float*)a.in[z + I_POOLS] + l * 256 + g * 64;
        const float* pa = (const float*)a.in[z + I_PROJA] + ((size_t)l * 256 + g * 64) * 1024 + n;
        float s = 0.f;
        for (int d = 0; d < 64; ++d) s += pw[d] * ps[d] * pa[(size_t)d * 1024];
        ((bf16*)(ws + WS_WMIX))[((size_t)l * 1024 + n) * 1024 + k] = (bf16)f2bf(s);
    }
    for (int idx = gt; idx < T * 32; idx += NGT) {
        const int t = idx >> 5, i = idx & 31;
        const float inv = powf(10000.0f, -(float)(2 * i) / 64.0f);
        const float ang = (float)((const int*)a.in[z + I_POS])[t] * inv;
        ((float*)(ws + WS_ROPE_C))[idx] = cosf(ang); ((float*)(ws + WS_ROPE_S))[idx] = sinf(ang);
    }
    for (int idx = gt; idx < DEPTH * 16 * 64; idx += NGT) {
        const int l = idx >> 10, g = (idx >> 6) & 15, p = idx & 63;
        const float lr = ((const float*)a.in[z + I_LAMRE])[idx], li = ((const float*)a.in[z + I_LAMIM])[idx];
        const float dt = expf(((const float*)a.in[z + I_LOGDT])[l * 16 + g]);
        const float mag = expf(lr * dt), ar = mag * cosf(li * dt), ai = mag * sinf(li * dt);
        const float nr = ar - 1.0f, ni = ai, den = lr * lr + li * li;
        const float kr = (nr * lr + ni * li) / den, ki = (ni * lr - nr * li) / den;
        unsigned char* base = ws + WS_SSM + (size_t)l * SSM_L_BYTES;
        ((f32x2*)base)[g * 64 + p] = (f32x2){ar, ai};
        float pr = ar, pi = ai;
#pragma unroll
        for (int q = 0; q < 6; ++q) { const float tr = pr * pr - pi * pi, ti = 2.0f * pr * pi; pr = tr; pi = ti; }
        ((f32x2*)(base + 8192))[g * 64 + p] = (f32x2){pr, pi};
        const float* br = (const float*)a.in[z + I_BRE] + (size_t)idx * 16; const float* bi = (const float*)a.in[z + I_BIM] + (size_t)idx * 16;
        f32x2* bb = (f32x2*)(base + 16384) + (size_t)(g * 64 + p) * 16;
        for (int ch = 0; ch < 16; ++ch) bb[ch] = (f32x2){kr * br[ch] - ki * bi[ch], kr * bi[ch] + ki * br[ch]};
    }
    if (gt < DEPTH) {
        const int l = gt; float s1 = 0.f, s2 = 0.f;
        for (int d = 0; d < 64; ++d) { s1 += ((const float*)a.in[z + I_LQ1])[l * 64 + d] * ((const float*)a.in[z + I_LK1])[l * 64 + d]; s2 += ((const float*)a.in[z + I_LQ2])[l * 64 + d] * ((const float*)a.in[z + I_LK2])[l * 64 + d]; }
        ((float*)(ws + WS_LAM))[l] = expf(s1) - expf(s2) + lambda_init_of(l);
    }
    for (int idx = gt; idx < DEPTH * 36 * 1024; idx += NGT) {
        const int l = idx / (36 * 1024), r = idx - l * 36 * 1024, j = r >> 10, k = r & 1023;
        ((float*)(ws + WS_RWT))[idx] = j < 4 ? ((const float*)a.in[z + I_RGW])[((size_t)l * 1024 + k) * 4 + j] : ((const float*)a.in[z + I_REW])[((size_t)l * 1024 + k) * 32 + (j - 4)];
    }
    {
        LAS float* cact = (LAS float*)(lds + RING_OFF);
        LAS float* red = (LAS float*)(lds + RING_OFF + 32768);
        __syncthreads();
        for (int i = tid; i < NB * 1024; i += 512) { const float cv = ((const float*)a.in[z + I_C])[i]; cact[i] = cv * sigmoidf_(cv); }
        __syncthreads();
        const int col = tid & 63, kp = tid >> 6;
        for (int u = vcu; u < DEPTH * 96; u += G) {
            const int l = u / 96, cg = u % 96;
            const float* w = (const float*)a.in[z + I_ADAW] + (size_t)l * 1024 * 6144 + cg * 64 + col;
            float acc[NB];
#pragma unroll
            for (int b = 0; b < NB; ++b) acc[b] = 0.f;
            for (int k = kp * 128; k < kp * 128 + 128; ++k) { const float wv = w[(size_t)k * 6144];
#pragma unroll
                for (int b = 0; b < NB; ++b) acc[b] += cact[b * 1024 + k] * wv; }
#pragma unroll
            for (int b = 0; b < NB; ++b) red[(kp * NB + b) * 64 + col] = acc[b];
            __syncthreads();
            { const int b = tid >> 6; float s = 0.f;
#pragma unroll
              for (int q = 0; q < 8; ++q) s += red[(q * NB + b) * 64 + col];
              ((float*)(ws + WS_MOD))[((size_t)l * NB + b) * 6144 + cg * 64 + col] = s + ((const float*)a.in[z + I_ADAB])[l * 6144 + cg * 64 + col]; }
            __syncthreads();
        }
    }
}

__device__ __forceinline__ void moe_weights_phase(const Args& a, int l, LAS unsigned char* lds) {
    const int z = opq(); (void)z;
    const int tid = opqv((int)threadIdx.x), lane = tid & 63, wave = __builtin_amdgcn_readfirstlane(tid >> 6); const int G = (int)gridDim.x, bx = (int)blockIdx.x;
    const int vcu = (G % 8 == 0) ? (bx % 8) * (G / 8) + bx / 8 : bx; const int gw = vcu * NWAVES + wave, NGW = G * NWAVES, gt = vcu * 512 + tid;
    (void)lane; (void)gw; (void)NGW; (void)gt; (void)bx;
    LAS float* scr = (LAS float*)(lds + RING_OFF + wave * 16384);
    bf16* w13 = (bf16*)((a.ws + z) + WS_W13); bf16* w2t = (bf16*)((a.ws + z) + WS_W2);
    for (int it = gw; it < NEXP * 768; it += NGW) {
        const int e = it / 768; int r = it - e * 768;
        if (r < 512) { const int which = r >> 8; r &= 255; const int kb = r >> 4, nb = r & 15, n0 = nb * 32;
            const float* W = (const float*)a.in[which ? I_W3 : I_W1] + ((size_t)l * NEXP + e) * 1024 * 512;
            tr_item(W, 512, kb * 64, n0, w13, 1024, e * 1024 + (n0 >> 7) * 256 + which * 128 + (n0 & 127), kb * 64, scr, lane); }
        else { r -= 512; const int kb = r >> 5, nb = r & 31;
            const float* W = (const float*)a.in[z + I_W2] + ((size_t)l * NEXP + e) * 512 * 1024;
            tr_item(W, 1024, kb * 64, nb * 32, w2t, 512, e * 1024 + nb * 32, kb * 64, scr, lane); }
    }
}

__device__ __forceinline__ void norm1_phase(const Args& a, int l, bool first, bool do_norm) {
    const int z = opq(); (void)z;
    const int tid = opqv((int)threadIdx.x), lane = tid & 63, wave = __builtin_amdgcn_readfirstlane(tid >> 6); const int G = (int)gridDim.x, bx = (int)blockIdx.x;
    const int vcu = (G % 8 == 0) ? (bx % 8) * (G / 8) + bx / 8 : bx; const int gw = vcu * NWAVES + wave, NGW = G * NWAVES, gt = vcu * 512 + tid;
    (void)lane; (void)gw; (void)NGW; (void)gt; (void)bx;
    unsigned char* ws = (a.ws + z);
    const float* mod = (const float*)(ws + WS_MOD);
    const bf16* Y = (const bf16*)(ws + WS_Y);
    const int* tok_slot = (const int*)(ws + WS_TOKS); const float* tok_w = (const float*)(ws + WS_TOKW);
    bf16* H = (bf16*)(ws + WS_H);
    for (int m = gw; m < T; m += NGW) {
        const int b = m >> 12;
        const f32x4* xr = (const f32x4*)((first ? (const float*)a.in[z + I_X] : (const float*)(a.out + z)) + (size_t)m * D) + lane;
        f32x4 v[4];
#pragma unroll
        for (int j = 0; j < 4; ++j) v[j] = xr[64 * j];
        if (!first) {
            const int s0 = tok_slot[2 * m], s1 = tok_slot[2 * m + 1]; const float w0 = tok_w[2 * m], w1 = tok_w[2 * m + 1];
            const float* g2 = mod + ((size_t)(l - 1) * NB + b) * 6144 + 5 * 1024;
            const v2u* y0 = (const v2u*)(Y + (size_t)s0 * D) + lane; const v2u* y1 = (const v2u*)(Y + (size_t)s1 * D) + lane;
#pragma unroll
            for (int j = 0; j < 4; ++j) { const v2u p = y0[64 * j], q = y1[64 * j]; const f32x4 g = *((const f32x4*)g2 + lane + 64 * j);
                v[j].x += g.x * (w0 * bflo(p.x) + w1 * bflo(q.x)); v[j].y += g.y * (w0 * bfhi(p.x) + w1 * bfhi(q.x));
                v[j].z += g.z * (w0 * bflo(p.y) + w1 * bflo(q.y)); v[j].w += g.w * (w0 * bfhi(p.y) + w1 * bfhi(q.y)); }
        }
        f32x4* xo = (f32x4*)((a.out + z) + (size_t)m * D) + lane;
#pragma unroll
        for (int j = 0; j < 4; ++j) xo[64 * j] = v[j];
        if (do_norm) {
            float ss = 0.f;
#pragma unroll
            for (int j = 0; j < 4; ++j) ss += (v[j].x * v[j].x + v[j].y * v[j].y) + (v[j].z * v[j].z + v[j].w * v[j].w);
            const float r = rsqrtf(wave_sum(ss) * (1.0f / D) + NORM_EPS);
            const float* mrow = mod + ((size_t)l * NB + b) * 6144;
            const f32x4* gn = (const f32x4*)((const float*)a.in[z + I_N1G] + l * D) + lane;
            v2u* ho = (v2u*)(H + (size_t)m * D) + lane;
#pragma unroll
            for (int j = 0; j < 4; ++j) { const f32x4 g = gn[64 * j], sh = *((const f32x4*)mrow + lane + 64 * j), sc = *((const f32x4*)(mrow + 1024) + lane + 64 * j);
                const f32x4 hh = (v[j] * r * g) * (sc + 1.0f) + sh;
                v2u o; o.x = pk2(hh.x, hh.y); o.y = pk2(hh.z, hh.w); ho[64 * j] = o; }
        }
    }
}

__device__ __forceinline__ void qkprep_phase(const Args& a, int l) {
    const int z = opq(); (void)z;
    const int tid = opqv((int)threadIdx.x), lane = tid & 63, wave = __builtin_amdgcn_readfirstlane(tid >> 6); const int G = (int)gridDim.x, bx = (int)blockIdx.x;
    const int vcu = (G % 8 == 0) ? (bx % 8) * (G / 8) + bx / 8 : bx; const int gw = vcu * NWAVES + wave, NGW = G * NWAVES, gt = vcu * 512 + tid;
    (void)lane; (void)gw; (void)NGW; (void)gt; (void)bx;
    unsigned char* ws = (a.ws + z); bf16* Z = (bf16*)(ws + WS_Z);
    const float qg = ((const float*)a.in[z + I_QNG])[l * 64 + lane], kg = ((const float*)a.in[z + I_KNG])[l * 64 + lane];
    for (int m = gw; m < T; m += NGW) {
        bf16* zr = Z + (size_t)m * ZW + ZQ + lane;
        const float c = ((const float*)(ws + WS_ROPE_C))[m * 32 + (lane & 31)], s = ((const float*)(ws + WS_ROPE_S))[m * 32 + (lane & 31)];
        float xv[16];
#pragma unroll
        for (int v = 0; v < 16; ++v) xv[v] = bf2f(zr[v * 64]);
#pragma unroll
        for (int v = 0; v < 16; ++v) {
            const float x = xv[v];
            const float r = rsqrtf(wave_sum(x * x) * (1.0f / 64.0f) + NORM_EPS);
            const float y = x * r * (v < 8 ? qg : kg);
            const float p = __shfl_xor(y, 32);
            float o = lane < 32 ? y * c - p * s : y * c + p * s;
            if (v < 8) o *= 0.125f;
            zr[v * 64] = (bf16)f2bf(o);
        }
    }
}

__device__ __forceinline__ void pool_phase(const Args& a, LAS unsigned char* lds) {
    const int z = opq(); (void)z;
    const int tid = opqv((int)threadIdx.x), lane = tid & 63, wave = __builtin_amdgcn_readfirstlane(tid >> 6); const int G = (int)gridDim.x, bx = (int)blockIdx.x;
    const int vcu = (G % 8 == 0) ? (bx % 8) * (G / 8) + bx / 8 : bx; const int gw = vcu * NWAVES + wave, NGW = G * NWAVES, gt = vcu * 512 + tid;
    (void)lane; (void)gw; (void)NGW; (void)gt; (void)bx;
    const bf16* Z = (const bf16*)((a.ws + z) + WS_Z); bf16* AM = (bf16*)((a.ws + z) + WS_AMIX);
    LAS float* U = (LAS float*)(lds + RING_OFF);
    for (int tl = vcu; tl < T / 64; tl += G) {
        const int m0 = tl * 64, s0 = m0 & (SEQ - 1);
        __syncthreads();
        for (int idx = tid; idx < 80 * 32; idx += 512) { const int r = idx >> 5, c8 = (idx & 31) * 8; const int sp = s0 - 16 + r;
            v4u w = (v4u){0u, 0u, 0u, 0u};
            if (sp >= 0) w = *(const v4u*)(Z + (size_t)(m0 - 16 + r) * ZW + c8);
            LAS float* u = U + r * 256 + c8;
            u[0] = bflo(w.x); u[1] = bfhi(w.x); u[2] = bflo(w.y); u[3] = bfhi(w.y); u[4] = bflo(w.z); u[5] = bfhi(w.z); u[6] = bflo(w.w); u[7] = bfhi(w.w); }
        __syncthreads();
        const int ch = tid & 255, th = tid >> 8, g = ch >> 6, w = 2 << g;
        for (int i = 0; i < 32; ++i) { const int t = th * 32 + i; float s = 0.f;
            for (int q = 0; q < w; ++q) s += U[(16 + t - q) * 256 + ch];
            const int cnt = (s0 + t + 1) < w ? (s0 + t + 1) : w;
            const float o = s / (float)cnt - U[(16 + t) * 256 + ch];
            AM[(size_t)(m0 + t) * D + ch] = (bf16)f2bf(o); }
    }
}

__device__ __forceinline__ void load_u16(const bf16* up, float (&u)[16]) {
    const v4u w0 = *(const v4u*)up, w1 = *(const v4u*)(up + 8);
    u[0] = bflo(w0.x); u[1] = bfhi(w0.x); u[2] = bflo(w0.y); u[3] = bfhi(w0.y); u[4] = bflo(w0.z); u[5] = bfhi(w0.z); u[6] = bflo(w0.w); u[7] = bfhi(w0.w);
    u[8] = bflo(w1.x); u[9] = bfhi(w1.x); u[10] = bflo(w1.y); u[11] = bfhi(w1.y); u[12] = bflo(w1.z); u[13] = bfhi(w1.z); u[14] = bflo(w1.w); u[15] = bfhi(w1.w);
}
__device__ __forceinline__ void ssm_local_phase(const Args& a, int l) {
    const int z = opq(); (void)z;
    const int tid = opqv((int)threadIdx.x), lane = tid & 63, wave = __builtin_amdgcn_readfirstlane(tid >> 6); const int G = (int)gridDim.x, bx = (int)blockIdx.x;
    const int vcu = (G % 8 == 0) ? (bx % 8) * (G / 8) + bx / 8 : bx; const int gw = vcu * NWAVES + wave, NGW = G * NWAVES, gt = vcu * 512 + tid;
    (void)lane; (void)gw; (void)NGW; (void)gt; (void)bx;
    unsigned char* ws = (a.ws + z); const bf16* Z = (const bf16*)(ws + WS_Z);
    const unsigned char* sb = ws + WS_SSM + (size_t)l * SSM_L_BYTES;
    f32x2* E = (f32x2*)(ws + WS_E);
    for (int uidx = gw; uidx < NB * 64 * 16; uidx += NGW) {
        const int g = uidx & 15, c = (uidx >> 4) & 63, b = uidx >> 10;
        const f32x2 av = ((const f32x2*)sb)[g * 64 + lane];
        float bbr[16], bbi[16];
        { const f32x4* bp = (const f32x4*)(sb + 16384) + (size_t)(g * 64 + lane) * 8;
#pragma unroll
          for (int q = 0; q < 8; ++q) { const f32x4 t4 = bp[q]; bbr[2 * q] = t4.x; bbi[2 * q] = t4.y; bbr[2 * q + 1] = t4.z; bbi[2 * q + 1] = t4.w; } }
        float xr = 0.f, xi = 0.f;
        const bf16* up = Z + (size_t)(b * SEQ + c * 64) * ZW + ZC + g * 16;
        for (int t = 0; t < 64; ++t) {
            float u[16]; load_u16(up + (size_t)t * ZW, u);
            float br = 0.f, bi = 0.f;
#pragma unroll
            for (int ch = 0; ch < 16; ++ch) { br += bbr[ch] * u[ch]; bi += bbi[ch] * u[ch]; }
            const float nr = av.x * xr - av.y * xi + br, ni = av.x * xi + av.y * xr + bi; xr = nr; xi = ni;
        }
        E[(size_t)uidx * 64 + lane] = (f32x2){xr, xi};
    }
}
__device__ __forceinline__ void ssm_carry_phase(const Args& a, int l) {
    const int z = opq(); (void)z;
    const int tid = opqv((int)threadIdx.x), lane = tid & 63, wave = __builtin_amdgcn_readfirstlane(tid >> 6); const int G = (int)gridDim.x, bx = (int)blockIdx.x;
    const int vcu = (G % 8 == 0) ? (bx % 8) * (G / 8) + bx / 8 : bx; const int gw = vcu * NWAVES + wave, NGW = G * NWAVES, gt = vcu * 512 + tid;
    (void)lane; (void)gw; (void)NGW; (void)gt; (void)bx;
    if (gt >= NB * 16 * 64) return;
    unsigned char* ws = (a.ws + z); const unsigned char* sb = ws + WS_SSM + (size_t)l * SSM_L_BYTES;
    const int p = gt & 63, g = (gt >> 6) & 15, b = gt >> 10;
    const f32x2 a64 = ((const f32x2*)(sb + 8192))[g * 64 + p];
    const f32x2* E = (const f32x2*)(ws + WS_E); f32x2* CI = (f32x2*)(ws + WS_CIN);
    float sr = 0.f, si = 0.f;
    for (int c = 0; c < 64; ++c) { const size_t o = ((size_t)((b * 64 + c) * 16 + g)) * 64 + p;
        CI[o] = (f32x2){sr, si}; const f32x2 e = E[o];
        const float nr = a64.x * sr - a64.y * si + e.x, ni = a64.x * si + a64.y * sr + e.y; sr = nr; si = ni; }
}

__device__ __forceinline__ void ssm_final_phase(const Args& a, int l, LAS unsigned char* lds) {
    const int z = opq(); (void)z;
    const int tid = opqv((int)threadIdx.x), lane = tid & 63, wave = __builtin_amdgcn_readfirstlane(tid >> 6); const int G = (int)gridDim.x, bx = (int)blockIdx.x;
    const int vcu = (G % 8 == 0) ? (bx % 8) * (G / 8) + bx / 8 : bx; const int gw = vcu * NWAVES + wave, NGW = G * NWAVES, gt = vcu * 512 + tid;
    (void)lane; (void)gw; (void)NGW; (void)gt; (void)bx;
    unsigned char* ws = (a.ws + z); const bf16* Z = (const bf16*)(ws + WS_Z); bf16* AM = (bf16*)(ws + WS_AMIX);
    const unsigned char* sb = ws + WS_SSM + (size_t)l * SSM_L_BYTES;
    const f32x2* CI = (const f32x2*)(ws + WS_CIN);
    constexpr int YP = 264, XP = 136;
    LAS bf16* Ypre = (LAS bf16*)(lds + RING_OFF);
    LAS bf16* Xb = (LAS bf16*)(lds + RING_OFF + 65536) + wave * (16 * XP);
    const int fr = lane & 15, fq = lane >> 4;
    for (int uu = vcu; uu < NB * 64; uu += G) {
        const int b = uu >> 6, c = uu & 63; const size_t m0 = (size_t)b * SEQ + c * 64;
        __syncthreads();
#pragma unroll 1
        for (int gi = 0; gi < 2; ++gi) {
            const int g = wave * 2 + gi;
            const f32x2 av = ((const f32x2*)sb)[g * 64 + lane];
            float bbr[16], bbi[16];
            { const f32x4* bp = (const f32x4*)(sb + 16384) + (size_t)(g * 64 + lane) * 8;
#pragma unroll
              for (int q = 0; q < 8; ++q) { const f32x4 t4 = bp[q]; bbr[2 * q] = t4.x; bbi[2 * q] = t4.y; bbr[2 * q + 1] = t4.z; bbi[2 * q + 1] = t4.w; } }
            bf16x8 Bf[4];
            { const float* cre = (const float*)a.in[z + I_CRE] + ((size_t)(l * 16 + g) * 16 + fr) * 64; const float* cim = (const float*)a.in[z + I_CIM] + ((size_t)(l * 16 + g) * 16 + fr) * 64;
#pragma unroll
              for (int ks = 0; ks < 4; ++ks) { const float* src = (ks < 2 ? cre : cim) + (ks & 1) * 32 + fq * 8; const float sg = ks < 2 ? 1.0f : -1.0f;
#pragma unroll
                  for (int j = 0; j < 8; ++j) Bf[ks][j] = (short)f2bf(sg * src[j]); } }
            const float dsk = ((const float*)a.in[z + I_DSKIP])[l * 256 + g * 16 + fr];
            const f32x2 st = CI[((size_t)((b * 64 + c) * 16 + g)) * 64 + lane];
            float xr = st.x, xi = st.y;
            const bf16* up = Z + m0 * ZW + ZC + g * 16;
#pragma unroll 1
            for (int tb = 0; tb < 4; ++tb) {
#pragma unroll 1
                for (int tt = 0; tt < 16; ++tt) {
                    float u[16]; load_u16(up + (size_t)(tb * 16 + tt) * ZW, u);
                    float br = 0.f, bi = 0.f;
#pragma unroll
                    for (int ch = 0; ch < 16; ++ch) { br += bbr[ch] * u[ch]; bi += bbi[ch] * u[ch]; }
                    const float nr = av.x * xr - av.y * xi + br, ni = av.x * xi + av.y * xr + bi; xr = nr; xi = ni;
                    Xb[tt * XP + lane] = (bf16)f2bf(xr); Xb[tt * XP + 64 + lane] = (bf16)f2bf(xi);
                }
                LDS_WAIT(); asm volatile("" ::: "memory");
                pg8::f32x4 acc = {0.f, 0.f, 0.f, 0.f};
#pragma unroll
                for (int ks = 0; ks < 4; ++ks) { const bf16x8 Af = *(const LAS bf16x8*)(Xb + fr * XP + ks * 32 + fq * 8);
                    acc = __builtin_amdgcn_mfma_f32_16x16x32_bf16(Af, Bf[ks], acc, 0, 0, 0); }
#pragma unroll
                for (int j = 0; j < 4; ++j) { const int t = tb * 16 + fq * 4 + j;
                    const float uu2 = bf2f(up[(size_t)t * ZW + fr]);
                    Ypre[t * YP + g * 16 + fr] = (bf16)f2bf(gelu_tanh(acc[j] + dsk * uu2)); }
                LDS_WAIT(); asm volatile("" ::: "memory");
            }
        }
        __syncthreads();
        { pg8::f32x4 acc[4][2];
#pragma unroll
          for (int rb = 0; rb < 4; ++rb)
#pragma unroll
              for (int nb = 0; nb < 2; ++nb) acc[rb][nb] = (pg8::f32x4){0.f, 0.f, 0.f, 0.f};
          const bf16* wg = (const bf16*)(ws + WS_WGLU) + (size_t)l * 256 * 256;
#pragma unroll 2
          for (int ks = 0; ks < 8; ++ks) {
              bf16x8 Bw[2], Aw[4];
#pragma unroll
              for (int nb = 0; nb < 2; ++nb) Bw[nb] = *(const bf16x8*)(wg + (size_t)(wave * 32 + nb * 16 + fr) * 256 + ks * 32 + fq * 8);
#pragma unroll
              for (int rb = 0; rb < 4; ++rb) Aw[rb] = *(const LAS bf16x8*)(Ypre + (rb * 16 + fr) * YP + ks * 32 + fq * 8);
#pragma unroll
              for (int rb = 0; rb < 4; ++rb)
#pragma unroll
                  for (int nb = 0; nb < 2; ++nb) acc[rb][nb] = __builtin_amdgcn_mfma_f32_16x16x32_bf16(Aw[rb], Bw[nb], acc[rb][nb], 0, 0, 0);
          }
#pragma unroll
          for (int nb = 0; nb < 2; ++nb) { const int n = wave * 32 + nb * 16 + fr; const float gb = ((const float*)a.in[z + I_GLUB])[l * 256 + n];
#pragma unroll
              for (int rb = 0; rb < 4; ++rb)
#pragma unroll
                  for (int j = 0; j < 4; ++j) { const int t = rb * 16 + fq * 4 + j;
                      const float yv = bf2f(Ypre[t * YP + n]);
                      AM[(m0 + t) * D + 768 + n] = (bf16)f2bf(yv * sigmoidf_(acc[rb][nb][j] + gb)); } }
        }
    }
}

__device__ __forceinline__ void attn_naive_unit(const Args& a, int b, int h, int mp, int cc, LAS unsigned char* lds, int tid, int lane, int wave) {
    const int z = opq();
    const bf16* Z = (const bf16*)((a.ws + z) + WS_Z);
    float* O = (float*)((a.ws + z) + (mp ? WS_O1 : WS_O0));
    const size_t m0 = (size_t)b * SEQ + cc * 64;
    const int qcol = ZQ + h * 128 + mp * 64, kcol = ZK + h * 128 + mp * 64, vcol = ZV + h * 128;
    LAS float* Qs = (LAS float*)(lds + RING_OFF);
    LAS unsigned* Vs = (LAS unsigned*)(lds + RING_OFF + 16384);
    LAS float* Ps = (LAS float*)(lds + RING_OFF + 32768) + wave * 512;
    __syncthreads();
    { const int r = tid >> 3, c8 = (tid & 7) * 8; const v4u w = *(const v4u*)(Z + (m0 + r) * ZW + qcol + c8); LAS float* q = Qs + r * 64 + c8;
      q[0] = bflo(w.x); q[1] = bfhi(w.x); q[2] = bflo(w.y); q[3] = bfhi(w.y); q[4] = bflo(w.z); q[5] = bfhi(w.z); q[6] = bflo(w.w); q[7] = bfhi(w.w); }
    float mrun[8], lrun[8], o0[8], o1[8];
#pragma unroll
    for (int i = 0; i < 8; ++i) { mrun[i] = -1e30f; lrun[i] = 0.f; o0[i] = 0.f; o1[i] = 0.f; }
    const size_t kb0 = (size_t)b * SEQ;
#pragma unroll 1
    for (int kt = 0; kt <= cc; ++kt) {
        __syncthreads();
        { const int key = tid >> 3, part = tid & 7; const bf16* vp = Z + (kb0 + kt * 64 + key) * ZW + vcol + part * 16;
          const v4u w0 = *(const v4u*)vp, w1 = *(const v4u*)(vp + 8); LAS v4u* d = (LAS v4u*)(Vs + key * 64 + part * 8); d[0] = w0; d[1] = w1; }
        float kf[64];
        { const bf16* kp = Z + (kb0 + kt * 64 + lane) * ZW + kcol;
#pragma unroll
          for (int q = 0; q < 8; ++q) { const v4u w = *(const v4u*)(kp + q * 8);
              kf[q * 8 + 0] = bflo(w.x); kf[q * 8 + 1] = bfhi(w.x); kf[q * 8 + 2] = bflo(w.y); kf[q * 8 + 3] = bfhi(w.y);
              kf[q * 8 + 4] = bflo(w.z); kf[q * 8 + 5] = bfhi(w.z); kf[q * 8 + 6] = bflo(w.w); kf[q * 8 + 7] = bfhi(w.w); } }
        __syncthreads();
#pragma unroll
        for (int i = 0; i < 8; ++i) {
            const LAS f32x4* qr = (const LAS f32x4*)(Qs + (wave * 8 + i) * 64);
            float s = 0.f;
#pragma unroll
            for (int d4 = 0; d4 < 16; ++d4) { const f32x4 q4 = qr[d4]; s += q4.x * kf[d4 * 4] + q4.y * kf[d4 * 4 + 1] + q4.z * kf[d4 * 4 + 2] + q4.w * kf[d4 * 4 + 3]; }
            const float mt = wave_max(s), mn = fmaxf(mrun[i], mt), al = __expf(mrun[i] - mn), p = __expf(s - mn);
            lrun[i] = lrun[i] * al + wave_sum(p); o0[i] *= al; o1[i] *= al; mrun[i] = mn;
            Ps[i * 64 + lane] = p;
        }
        LDS_WAIT(); asm volatile("" ::: "memory");
#pragma unroll 4
        for (int j4 = 0; j4 < 16; ++j4) {
            unsigned vw[4];
#pragma unroll
            for (int jj = 0; jj < 4; ++jj) vw[jj] = Vs[(j4 * 4 + jj) * 64 + lane];
#pragma unroll
            for (int i = 0; i < 8; ++i) { const f32x4 p4 = *(const LAS f32x4*)(Ps + i * 64 + j4 * 4);
                o0[i] += p4.x * bflo(vw[0]) + p4.y * bflo(vw[1]) + p4.z * bflo(vw[2]) + p4.w * bflo(vw[3]);
                o1[i] += p4.x * bfhi(vw[0]) + p4.y * bfhi(vw[1]) + p4.z * bfhi(vw[2]) + p4.w * bfhi(vw[3]); }
        }
    }
#pragma unroll
    for (int i = 0; i < 8; ++i) { const float rl = 1.0f / lrun[i];
        *(f32x2*)(O + (m0 + wave * 8 + i) * 512 + h * 128 + lane * 2) = (f32x2){o0[i] * rl, o1[i] * rl}; }
}
__device__ __forceinline__ void attn_naive_phase(const Args& a, LAS unsigned char* lds) {
    const int z = opq(); (void)z;
    const int tid = opqv((int)threadIdx.x), lane = tid & 63, wave = __builtin_amdgcn_readfirstlane(tid >> 6); const int G = (int)gridDim.x, bx = (int)blockIdx.x;
    const int vcu = (G % 8 == 0) ? (bx % 8) * (G / 8) + bx / 8 : bx; const int gw = vcu * NWAVES + wave, NGW = G * NWAVES, gt = vcu * 512 + tid;
    (void)lane; (void)gw; (void)NGW; (void)gt; (void)bx;
    for (int u = vcu; u < 2048; u += G) {
        const int bhm = u >> 5, j = u & 31, b = bhm >> 3, h = (bhm >> 1) & 3, mp = bhm & 1;
        attn_naive_unit(a, b, h, mp, j, lds, tid, lane, wave);
        attn_naive_unit(a, b, h, mp, 63 - j, lds, tid, lane, wave);
    }
}

__device__ __forceinline__ void attn_combine_phase(const Args& a, int l) {
    const int z = opq(); (void)z;
    const int tid = opqv((int)threadIdx.x), lane = tid & 63, wave = __builtin_amdgcn_readfirstlane(tid >> 6); const int G = (int)gridDim.x, bx = (int)blockIdx.x;
    const int vcu = (G % 8 == 0) ? (bx % 8) * (G / 8) + bx / 8 : bx; const int gw = vcu * NWAVES + wave, NGW = G * NWAVES, gt = vcu * 512 + tid;
    (void)lane; (void)gw; (void)NGW; (void)gt; (void)bx;
    unsigned char* ws = (a.ws + z); const float* O0 = (const float*)(ws + WS_O0); const float* O1 = (const float*)(ws + WS_O1); bf16* AM = (bf16*)(ws + WS_AMIX);
    const float lam = ((const float*)(ws + WS_LAM))[l], post = 1.0f - lambda_init_of(l);
    const f32x2 sg = *((const f32x2*)((const float*)a.in[z + I_SUBLN] + l * 128) + lane);
    for (int m = gw; m < T; m += NGW) {
#pragma unroll
        for (int h = 0; h < 4; ++h) {
            const f32x2 p = *((const f32x2*)(O0 + (size_t)m * 512 + h * 128) + lane), q = *((const f32x2*)(O1 + (size_t)m * 512 + h * 128) + lane);
            const float d0 = p.x - lam * q.x, d1 = p.y - lam * q.y;
            const float r = rsqrtf(wave_sum(d0 * d0 + d1 * d1) * (1.0f / 128.0f) + NORM_EPS);
            *((unsigned*)(AM + (size_t)m * D + 256 + h * 128) + lane) = pk2(d0 * r * sg.x * post, d1 * r * sg.y * post);
        }
    }
}

__device__ __forceinline__ void norm2_router_phase(const Args& a, int l, LAS unsigned char* lds) {
    const int z = opq(); (void)z;
    const int tid = opqv((int)threadIdx.x), lane = tid & 63, wave = __builtin_amdgcn_readfirstlane(tid >> 6); const int G = (int)gridDim.x, bx = (int)blockIdx.x;
    const int vcu = (G % 8 == 0) ? (bx % 8) * (G / 8) + bx / 8 : bx; const int gw = vcu * NWAVES + wave, NGW = G * NWAVES, gt = vcu * 512 + tid;
    (void)lane; (void)gw; (void)NGW; (void)gt; (void)bx;
    unsigned char* ws = (a.ws + z);
    const float* mod = (const float*)(ws + WS_MOD); bf16* H = (bf16*)(ws + WS_H);
    const float* rwt = (const float*)(ws + WS_RWT) + (size_t)l * 36 * 1024;
    int* tok_e = (int*)(ws + WS_TOKE); float* tok_w = (float*)(ws + WS_TOKW); int* tok_l = (int*)(ws + WS_TOKL);
    LAS int* lcnt = (LAS int*)(lds + RING_OFF);
    __syncthreads();
    if (tid < 32) lcnt[tid] = 0;
    __syncthreads();
    const float rgb = lane < 4 ? ((const float*)a.in[z + I_RGB])[l * 4 + lane] : (lane < 36 ? ((const float*)a.in[z + I_REB])[l * 32 + lane - 4] : 0.f);
    for (int m4 = gw; m4 < T / 4; m4 += NGW) {
        const int mb = m4 * 4, b = mb >> 12;
        const float* mrow = mod + ((size_t)l * NB + b) * 6144;
        f32x4 hv[4][4];
#pragma unroll
        for (int r = 0; r < 4; ++r) {
            const f32x4* xr = (const f32x4*)((a.out + z) + (size_t)(mb + r) * D) + lane;
            float ss = 0.f;
#pragma unroll
            for (int j = 0; j < 4; ++j) { hv[r][j] = xr[64 * j]; ss += (hv[r][j].x * hv[r][j].x + hv[r][j].y * hv[r][j].y) + (hv[r][j].z * hv[r][j].z + hv[r][j].w * hv[r][j].w); }
            const float rr = rsqrtf(wave_sum(ss) * (1.0f / D) + NORM_EPS);
            v2u* ho = (v2u*)(H + (size_t)(mb + r) * D) + lane;
#pragma unroll
            for (int j = 0; j < 4; ++j) { const f32x4 g = *((const f32x4*)((const float*)a.in[z + I_N2G] + l * D) + lane + 64 * j), sh = *((const f32x4*)(mrow + 3 * 1024) + lane + 64 * j), sc = *((const f32x4*)(mrow + 4 * 1024) + lane + 64 * j);
                hv[r][j] = (hv[r][j] * rr * g) * (sc + 1.0f) + sh;
                v2u o; o.x = pk2(hv[r][j].x, hv[r][j].y); o.y = pk2(hv[r][j].z, hv[r][j].w); ho[64 * j] = o; }
        }
        float lg[4] = {0.f, 0.f, 0.f, 0.f};
#pragma unroll 1
        for (int e = 0; e < 36; ++e) {
            const f32x4* wr = (const f32x4*)(rwt + (size_t)e * 1024) + lane;
            f32x4 w4[4];
#pragma unroll
            for (int j = 0; j < 4; ++j) w4[j] = wr[64 * j];
#pragma unroll
            for (int r = 0; r < 4; ++r) { float s = 0.f;
#pragma unroll
                for (int j = 0; j < 4; ++j) s += (hv[r][j].x * w4[j].x + hv[r][j].y * w4[j].y) + (hv[r][j].z * w4[j].z + hv[r][j].w * w4[j].w);
                s = wave_sum(s); if (lane == e) lg[r] = s; }
        }
#pragma unroll
        for (int r = 0; r < 4; ++r) {
            const float v = lg[r] + rgb;
            float gl[4];
#pragma unroll
            for (int j = 0; j < 4; ++j) gl[j] = __shfl(v, j);
            int gi = 0; float gm = gl[0];
#pragma unroll
            for (int j = 1; j < 4; ++j) if (gl[j] > gm) { gm = gl[j]; gi = j; }
            float gs = 0.f;
#pragma unroll
            for (int j = 0; j < 4; ++j) gs += __expf(gl[j] - gm);
            const float pg = 1.0f / gs;
            float el[8];
#pragma unroll
            for (int j = 0; j < 8; ++j) el[j] = __shfl(v, 4 + gi * 8 + j);
            int e0 = 0; float m0v = el[0];
#pragma unroll
            for (int j = 1; j < 8; ++j) if (el[j] > m0v) { m0v = el[j]; e0 = j; }
            int e1 = -1; float m1v = -3.0e38f;
#pragma unroll
            for (int j = 0; j < 8; ++j) if (j != e0 && el[j] > m1v) { m1v = el[j]; e1 = j; }
            const float x1 = __expf(m1v - m0v), w0 = pg / (1.0f + x1), w1 = pg * x1 / (1.0f + x1);
            if (lane == 0) {
                const int m = mb + r, ea = gi * 8 + e0, eb = gi * 8 + e1;
                tok_e[2 * m] = ea; tok_e[2 * m + 1] = eb; tok_w[2 * m] = w0; tok_w[2 * m + 1] = w1;
                tok_l[2 * m] = __hip_atomic_fetch_add(&lcnt[ea], 1, __ATOMIC_RELAXED, __HIP_MEMORY_SCOPE_WORKGROUP); tok_l[2 * m + 1] = __hip_atomic_fetch_add(&lcnt[eb], 1, __ATOMIC_RELAXED, __HIP_MEMORY_SCOPE_WORKGROUP);
            }
        }
    }
    __syncthreads();
    if (tid < 32) { const int c = lcnt[tid];
        const unsigned old = __hip_atomic_fetch_add((unsigned*)(ws + WS_CTL) + CW_CNT + l * 64 + tid, (unsigned)c, RLX_AGENT);
        ((int*)(ws + WS_WGBASE))[bx * 32 + tid] = (int)old; }
}

__device__ __forceinline__ void moe_scatter_phase(const Args& a, int l, LAS unsigned char* lds) {
    const int z = opq(); (void)z;
    const int tid = opqv((int)threadIdx.x), lane = tid & 63, wave = __builtin_amdgcn_readfirstlane(tid >> 6); const int G = (int)gridDim.x, bx = (int)blockIdx.x;
    const int vcu = (G % 8 == 0) ? (bx % 8) * (G / 8) + bx / 8 : bx; const int gw = vcu * NWAVES + wave, NGW = G * NWAVES, gt = vcu * 512 + tid;
    (void)lane; (void)gw; (void)NGW; (void)gt; (void)bx;
    unsigned char* ws = (a.ws + z);
    LAS int* pst = (LAS int*)(lds + RING_OFF);
    __syncthreads();
    if (tid == 0) {
        int run = 0; int* tile_e = (int*)(ws + WS_TILEE);
        for (int e = 0; e < NEXP; ++e) { const int c = (int)__hip_atomic_load((unsigned*)(ws + WS_CTL) + CW_CNT + l * 64 + e, RLX_AGENT); const int pad = (c + 255) & ~255;
            pst[e] = run + ((const int*)(ws + WS_WGBASE))[bx * 32 + e];
            if (bx == 0) for (int q = 0; q < (pad >> 8); ++q) tile_e[(run >> 8) + q] = e;
            run += pad; }
        if (bx == 0) tile_e[511] = run >> 8;
    }
    __syncthreads();
    const int* tok_e = (const int*)(ws + WS_TOKE); const int* tok_l = (const int*)(ws + WS_TOKL); int* tok_s = (int*)(ws + WS_TOKS);
    const bf16* H = (const bf16*)(ws + WS_H); bf16* AG = (bf16*)(ws + WS_AG);
    for (int m4 = gw; m4 < T / 4; m4 += NGW) {
#pragma unroll
        for (int r = 0; r < 4; ++r) { const int m = m4 * 4 + r;
            const int s0 = pst[tok_e[2 * m]] + tok_l[2 * m], s1 = pst[tok_e[2 * m + 1]] + tok_l[2 * m + 1];
            if (lane == 0) { tok_s[2 * m] = s0; tok_s[2 * m + 1] = s1; }
            const v4u* src = (const v4u*)(H + (size_t)m * D) + lane; const v4u x0 = src[0], x1 = src[64];
            v4u* d0 = (v4u*)(AG + (size_t)s0 * D) + lane; v4u* d1 = (v4u*)(AG + (size_t)s1 * D) + lane;
            d0[0] = x0; d0[64] = x1; d1[0] = x0; d1[64] = x1; }
    }
}

__global__ void __launch_bounds__(NWAVES * 64, 2) fwd(Args args) {
    extern __shared__ __attribute__((aligned(16))) unsigned char lds_raw[];
    LAS unsigned char* lds = (LAS unsigned char*)lds_raw;
    for (int u = threadIdx.x; u < (LDS_BYTES - LDSCTL_OFF) / 4; u += NWAVES * 64) ((LAS unsigned*)(lds + LDSCTL_OFF))[u] = 0u;
    __syncthreads();
#if MK_MULTI
#define GRID_BAR() do { } while (0)
#else
    XcdBarrier bar = xcd_barrier_post((unsigned*)(args.ws + WS_CTL) + CW_BAR, (volatile LAS unsigned*)(lds + MISC_OFF) + 8);
#define GRID_BAR() xcd_barrier(bar)
#endif
    const int lo = args.ph_lo, hi = args.ph_hi;
#ifndef PHMASK
#define PHMASK 0xFFFF
#endif
#define EN(p) (((PHMASK) >> (p)) & 1)
#define IN(k) (lo <= (k) && (k) < hi)
#define SEAM(k) do { if (IN(k) && IN((k) + 1)) GRID_BAR(); } while (0)

    if (EN(11) && IN(0)) { prologue_phase(args, lds); SEAM(0); }

#pragma unroll 1
    for (int l = 0; l < DEPTH; ++l) {
        const int pb = 1 + l * PH_PER_LAYER;
        if (EN(0) && IN(pb + 0)) { norm1_phase(args, l, l == 0, true); moe_weights_phase(args, l, lds); SEAM(pb + 0); }
        if (EN(1) && IN(pb + 1)) { unsigned char* ws = args.ws + opq(); const int G = (int)gridDim.x, bx = (int)blockIdx.x;
            pg8::Gemm g{(const pg8::bf16_t*)(ws + WS_H), (const pg8::bf16_t*)(ws + WS_WCAT) + (size_t)l * NCAT * 1024, 1024, 1024, 1024}; pg8::StaticOrder S; S.init(T, NCAT, G, bx);
            pg8::EpiZG E{(pg8::bf16_t*)(ws + WS_Z), (pg8::bf16_t*)(ws + WS_G), (const float*)args.in[opq() + I_GATEB] + l * GWD};
            pg8::gemm_phase<pg8::EpiZG, pg8::StaticOrder, true, true>(lds + RING_OFF, g, S, E);
            SEAM(pb + 1);
        }
        if (EN(2) && IN(pb + 2)) { qkprep_phase(args, l); pool_phase(args, lds); ssm_local_phase(args, l); SEAM(pb + 2); }
        if (EN(3) && IN(pb + 3)) { ssm_carry_phase(args, l); attn_naive_phase(args, lds); SEAM(pb + 3); }
        if (EN(4) && IN(pb + 4)) { attn_combine_phase(args, l); ssm_final_phase(args, l, lds); SEAM(pb + 4); }
        if (EN(5) && IN(pb + 5)) { unsigned char* ws = args.ws + opq(); const int G = (int)gridDim.x, bx = (int)blockIdx.x;
            const pg8::bf16_t* am = (const pg8::bf16_t*)(ws + WS_AMIX); pg8::bf16_t* mx = (pg8::bf16_t*)(ws + WS_MIXED); const pg8::bf16_t* gt_ = (const pg8::bf16_t*)(ws + WS_G);
            const pg8::bf16_t* wmix = (const pg8::bf16_t*)(ws + WS_WMIX) + (size_t)l * 1024 * 1024;
            pg8::StaticOrder S; S.init(T, D, G, bx);
#pragma unroll 1
            for (int s = 0; s < 3; ++s) {
                const int koff = s == 0 ? 0 : (s == 1 ? 256 : 768), klen = s == 1 ? 512 : 256;
                pg8::Gemm g{am + koff, wmix + koff, 1024, 1024, klen}; pg8::EpiMix E{mx, gt_, s * 1024, s == 0};
                pg8::gemm_phase<pg8::EpiMix, pg8::StaticOrder, true, true>(lds + RING_OFF, g, S, E);
            }
            SEAM(pb + 5);
        }
        if (EN(6) && IN(pb + 6)) { unsigned char* ws = args.ws + opq(); const int G = (int)gridDim.x, bx = (int)blockIdx.x;
            pg8::Gemm g{(const pg8::bf16_t*)(ws + WS_MIXED), (const pg8::bf16_t*)(ws + WS_WO) + (size_t)l * 1024 * 1024, 1024, 1024, 1024}; pg8::StaticOrder S; S.init(T, D, G, bx);
            pg8::EpiResid E{args.out + opq(), (const float*)(ws + WS_MOD) + (size_t)l * NB * 6144 + 2 * 1024};
            pg8::gemm_phase<pg8::EpiResid, pg8::StaticOrder, true, true>(lds + RING_OFF, g, S, E);
            SEAM(pb + 6);
        }
        if (EN(7) && IN(pb + 7)) { norm2_router_phase(args, l, lds); SEAM(pb + 7); }
        if (EN(8) && IN(pb + 8)) { moe_scatter_phase(args, l, lds); SEAM(pb + 8); }
        if (EN(9) && IN(pb + 9)) { unsigned char* ws = args.ws + opq(); const int G = (int)gridDim.x, bx = (int)blockIdx.x; const int vcu = (G % 8 == 0) ? (bx % 8) * (G / 8) + bx / 8 : bx;
            const int* tile_e = (const int*)(ws + WS_TILEE);
            pg8::GroupedOrder S{tile_e, __builtin_amdgcn_readfirstlane(tile_e[511]), G, vcu};
            pg8::Gemm g{(const pg8::bf16_t*)(ws + WS_AG), (const pg8::bf16_t*)(ws + WS_W13), 1024, 1024, 1024};
            pg8::EpiSwiGLU E{(pg8::bf16_t*)(ws + WS_ACT)};
            pg8::gemm_phase<pg8::EpiSwiGLU, pg8::GroupedOrder, true, true>(lds + RING_OFF, g, S, E);
            SEAM(pb + 9);
        }
        if (EN(10) && IN(pb + 10)) { unsigned char* ws = args.ws + opq(); const int G = (int)gridDim.x, bx = (int)blockIdx.x; const int vcu = (G % 8 == 0) ? (bx % 8) * (G / 8) + bx / 8 : bx;
            const int* tile_e = (const int*)(ws + WS_TILEE);
            pg8::GroupedOrder S{tile_e, __builtin_amdgcn_readfirstlane(tile_e[511]), G, vcu};
            pg8::Gemm g{(const pg8::bf16_t*)(ws + WS_ACT), (const pg8::bf16_t*)(ws + WS_W2), 512, 512, 512};
            pg8::EpiY E{(pg8::bf16_t*)(ws + WS_Y)};
            pg8::gemm_phase<pg8::EpiY, pg8::GroupedOrder, true, true>(lds + RING_OFF, g, S, E);
            SEAM(pb + 10);
        }
    }
    if (EN(12) && IN(N_PHASES - 1)) norm1_phase(args, DEPTH, false, false);
#undef IN
#undef SEAM
}

extern "C" void kernel_launch(void* const* d_in, const int* in_sizes, int n_in, void* d_out, int out_size, void* d_ws, size_t ws_size, hipStream_t stream) {
    static int grid = 0;
    if (grid == 0) {
        if (n_in != 40 || out_size != T * D || ws_size < WS_END) { fprintf(stderr, "kernel_launch: unexpected shapes (n_in %d out %d ws %zu)\n", n_in, out_size, ws_size); grid = -1; return; }
        int dev = 0, cus = 0, per_cu = 0;
        if (hipGetDevice(&dev) != hipSuccess || hipDeviceGetAttribute(&cus, hipDeviceAttributeMultiprocessorCount, dev) != hipSuccess) { grid = -1; return; }
        if (hipFuncSetAttribute((const void*)fwd, hipFuncAttributeMaxDynamicSharedMemorySize, LDS_BYTES) != hipSuccess) { fprintf(stderr, "kernel_launch: hipFuncSetAttribute failed\n"); grid = -1; return; }
        if (hipOccupancyMaxActiveBlocksPerMultiprocessor(&per_cu, (const void*)fwd, NWAVES * 64, LDS_BYTES) != hipSuccess || per_cu < 1) fprintf(stderr, "kernel_launch: occupancy query says %d\n", per_cu);
        (void)hipGetLastError();
        grid = cus;
    }
    if (grid < 0) return;
    if (hipMemsetAsync((char*)d_ws + WS_CTL, 0, CTL_ZERO_BYTES, stream) != hipSuccess) return;
    Args a{};
    for (int i = 0; i < 40; ++i) a.in[i] = d_in[i];
    a.out = (float*)d_out; a.ws = (unsigned char*)d_ws;
#if MK_MULTI
    for (int p = 0; p < N_PHASES; ++p) { a.ph_lo = p; a.ph_hi = p + 1; hipLaunchKernelGGL(fwd, dim3(grid), dim3(NWAVES * 64), LDS_BYTES, stream, a); }
#else
    a.ph_lo = 0; a.ph_hi = N_PHASES;
    hipLaunchKernelGGL(fwd, dim3(grid), dim3(NWAVES * 64), LDS_BYTES, stream, a);
#endif
}
```

```cpp
#include <hip/hip_runtime.h>
#include <cstdio>
#include <cstdint>

#ifndef MK_MULTI
#define MK_MULTI 0
#endif

__device__ __forceinline__ int opqv(int x) { asm volatile("" : "+v"(x)); return x; }
__device__ __forceinline__ int opq() { int z = 0; asm volatile("" : "+s"(z)); return z; }
namespace pg8 {
#define PG8_LAS __attribute__((address_space(3)))
typedef unsigned short bf16_t;
typedef short bf16x8 __attribute__((ext_vector_type(8)));
typedef float f32x4 __attribute__((ext_vector_type(4)));
typedef unsigned u32x4 __attribute__((ext_vector_type(4)));
typedef unsigned u32x2 __attribute__((ext_vector_type(2)));
constexpr int BM = 256, BK = 64, HALF = 128, HTB = HALF * BK * 2  , STAGE_BYTES = 8 * HTB, NXCD = 8, WGM = 8;

__host__ __device__ __forceinline__ int lds_byte(int r, int c) { const int st = (r >> 4) * 2 + (c >> 5), rr = r & 15, cc = c & 31, ob = rr * 64 + cc * 2; return st * 1024 + (ob ^ (((ob >> 9) & 1) << 5)); }
__host__ __device__ __forceinline__ void stage_rc(int b, int& R, int& C) { const int st = b / 1024, sb = b % 1024, swz = sb ^ (((sb >> 9) & 1) << 5); R = (st >> 1) * 16 + swz / 64; C = (st & 1) * 32 + (swz % 64) / 2; }
__host__ __device__ __forceinline__ int perm32(int rho) { const int n = rho >> 4, i = rho & 15; return 8 * (i >> 2) + 4 * n + (i & 3); }

struct Unit { int pm, pn, pb; };
struct Gemm { const bf16_t* A; const bf16_t* Bt; int lda, ldb, K; };

struct StaticOrder {
    int nM, nN, nwg, G, c;
    __host__ __device__ void init(int M, int N, int G_, int c_) { nM = M / BM; nN = N / BM; nwg = nM * nN; G = G_; c = c_; }
    __host__ __device__ bool next(int i, Unit& u) const {
        const long L = (long)i * G + c; if (L >= nwg) return false;
        int wgid = (int)L; { const int q = nwg / NXCD, r = nwg % NXCD, xcd = wgid % NXCD, off = wgid / NXCD; wgid = (xcd < r ? xcd * (q + 1) : r * (q + 1) + (xcd - r) * q) + off; }
        const int nig = WGM * nN, gid = wgid / nig, fm = gid * WGM, gsz = (nM - fm) < WGM ? (nM - fm) : WGM;
        u.pm = fm + ((wgid % nig) % gsz); u.pn = (wgid % nig) / gsz; u.pb = u.pn; return true;
    }
    __device__ __forceinline__ void a_ready(const Unit&) const {}
    __device__ __forceinline__ void done(const Unit&) const {}
};
struct GroupedOrder {
    const int* tile_e; int ntiles, G, c;
    __device__ __forceinline__ bool next(int i, Unit& u) const {
        const long L = (long)i * G + c; if (L >= (long)ntiles * 4) return false;
        const int pm = (int)(L >> 2), pl = (int)(L & 3);
        u.pm = pm; u.pn = pl; u.pb = __builtin_amdgcn_readfirstlane(tile_e[pm]) * 4 + pl; return true;
    }
    __device__ __forceinline__ void a_ready(const Unit&) const {}
    __device__ __forceinline__ void done(const Unit&) const {}
};

__device__ __forceinline__ unsigned cvt_pk_bf16(float lo, float hi) { unsigned r; asm volatile("v_cvt_pk_bf16_f32 %0, %1, %2" : "=v"(r) : "v"(lo), "v"(hi)); return r; }
__device__ __forceinline__ float bflo(unsigned w) { return __uint_as_float(w << 16); }
__device__ __forceinline__ float bfhi(unsigned w) { return __uint_as_float(w & 0xffff0000u); }
__device__ __forceinline__ float sigmoidf_(float x) { return 1.0f / (1.0f + __expf(-x)); }


struct EpiZG {
    static constexpr bool PERM = true, AFTER_DRAIN = false;
    bf16_t* Z; bf16_t* Gt; const float* gbias;
    __device__ __forceinline__ void operator()(const f32x4 (&acc)[2][2][4][2], const Unit& u, int wr, int wc, int fr, int fq) const {
        asm volatile("" : "+v"(fr), "+v"(fq));
        const int row0 = u.pm * BM + wr * 64 + fr;
        const bool gate = u.pn >= 8;
        const int colt = gate ? (u.pn - 8) * BM : u.pn * BM, ldc = gate ? 3072 : 2048;
        bf16_t* base = gate ? Gt : Z;
        const int col0 = colt + wc * 32 + 8 * fq;
        f32x4 bv[2][2];
#pragma unroll
        for (int bj = 0; bj < 2; ++bj)
#pragma unroll
            for (int n = 0; n < 2; ++n) bv[bj][n] = gate ? *(const f32x4*)(gbias + col0 + bj * HALF + 4 * n) : (f32x4){0.f, 0.f, 0.f, 0.f};
#pragma unroll
        for (int ai = 0; ai < 2; ++ai)
#pragma unroll
            for (int m = 0; m < 4; ++m) { bf16_t* rowp = base + (size_t)(row0 + ai * HALF + m * 16) * ldc + col0;
#pragma unroll
                for (int bj = 0; bj < 2; ++bj) { f32x4 v0 = acc[ai][bj][m][0] + bv[bj][0], v1 = acc[ai][bj][m][1] + bv[bj][1];
                    if (gate) {
#pragma unroll
                        for (int j = 0; j < 4; ++j) { v0[j] = sigmoidf_(v0[j]); v1[j] = sigmoidf_(v1[j]); } }
                    u32x4 w; w.x = cvt_pk_bf16(v0[0], v0[1]); w.y = cvt_pk_bf16(v0[2], v0[3]); w.z = cvt_pk_bf16(v1[0], v1[1]); w.w = cvt_pk_bf16(v1[2], v1[3]);
                    *(u32x4*)(rowp + bj * HALF) = w; } }
    }
};
struct EpiMix {
    static constexpr bool PERM = true, AFTER_DRAIN = false;
    bf16_t* O; const bf16_t* Gt; int gcol0; bool first;
    __device__ __forceinline__ void operator()(const f32x4 (&acc)[2][2][4][2], const Unit& u, int wr, int wc, int fr, int fq) const {
        asm volatile("" : "+v"(fr), "+v"(fq));
        const int row0 = u.pm * BM + wr * 64 + fr, col0 = u.pn * BM + wc * 32 + 8 * fq;
#pragma unroll
        for (int ai = 0; ai < 2; ++ai)
#pragma unroll
            for (int m = 0; m < 4; ++m) { const size_t row = (size_t)(row0 + ai * HALF + m * 16);
#pragma unroll
                for (int bj = 0; bj < 2; ++bj) {
                    const u32x4 gw = *(const u32x4*)(Gt + row * 3072 + gcol0 + col0 + bj * HALF);
                    bf16_t* op = O + row * 1024 + col0 + bj * HALF;
                    f32x4 v0 = acc[ai][bj][m][0], v1 = acc[ai][bj][m][1];
                    v0[0] *= bflo(gw.x); v0[1] *= bfhi(gw.x); v0[2] *= bflo(gw.y); v0[3] *= bfhi(gw.y);
                    v1[0] *= bflo(gw.z); v1[1] *= bfhi(gw.z); v1[2] *= bflo(gw.w); v1[3] *= bfhi(gw.w);
                    if (!first) { const u32x4 pw = *(const u32x4*)op;
                        v0[0] += bflo(pw.x); v0[1] += bfhi(pw.x); v0[2] += bflo(pw.y); v0[3] += bfhi(pw.y);
                        v1[0] += bflo(pw.z); v1[1] += bfhi(pw.z); v1[2] += bflo(pw.w); v1[3] += bfhi(pw.w); }
                    u32x4 w; w.x = cvt_pk_bf16(v0[0], v0[1]); w.y = cvt_pk_bf16(v0[2], v0[3]); w.z = cvt_pk_bf16(v1[0], v1[1]); w.w = cvt_pk_bf16(v1[2], v1[3]);
                    *(u32x4*)op = w; }
                asm volatile("" ::: "memory"); }
    }
};
struct EpiResid {
    static constexpr bool PERM = false, AFTER_DRAIN = false;
    float* X; const float* g1;
    __device__ __forceinline__ void operator()(const f32x4 (&acc)[2][2][4][2], const Unit& u, int wr, int wc, int fr, int fq) const {
        asm volatile("" : "+v"(fr), "+v"(fq));
        const int row0 = u.pm * BM + wr * 64 + fr, col0 = u.pn * BM + wc * 32 + 4 * fq;
        const float* gp = g1 + (size_t)((u.pm * BM) >> 12) * 6144 + col0;
        f32x4 gv[2][2];
#pragma unroll
        for (int bj = 0; bj < 2; ++bj)
#pragma unroll
            for (int n = 0; n < 2; ++n) gv[bj][n] = *(const f32x4*)(gp + bj * HALF + n * 16);
#pragma unroll
        for (int ai = 0; ai < 2; ++ai)
#pragma unroll
            for (int m = 0; m < 4; ++m) { float* rowp = X + (size_t)(row0 + ai * HALF + m * 16) * 1024 + col0;
#pragma unroll
                for (int bj = 0; bj < 2; ++bj)
#pragma unroll
                    for (int n = 0; n < 2; ++n) { f32x4* p = (f32x4*)(rowp + bj * HALF + n * 16); *p = *p + gv[bj][n] * acc[ai][bj][m][n]; } }
    }
};
struct EpiSwiGLU {
    static constexpr bool PERM = true, AFTER_DRAIN = false;
    bf16_t* O;
    __device__ __forceinline__ void operator()(const f32x4 (&acc)[2][2][4][2], const Unit& u, int wr, int wc, int fr, int fq) const {
        asm volatile("" : "+v"(fr), "+v"(fq));
        const int row0 = u.pm * BM + wr * 64 + fr, col0 = u.pn * HALF + wc * 32 + 8 * fq;
#pragma unroll
        for (int ai = 0; ai < 2; ++ai)
#pragma unroll
            for (int m = 0; m < 4; ++m) { bf16_t* op = O + (size_t)(row0 + ai * HALF + m * 16) * 512 + col0;
                float r[8];
#pragma unroll
                for (int n = 0; n < 2; ++n)
#pragma unroll
                    for (int j = 0; j < 4; ++j) { const float a = acc[ai][0][m][n][j], b = acc[ai][1][m][n][j]; r[n * 4 + j] = a * sigmoidf_(a) * b; }
                u32x4 w; w.x = cvt_pk_bf16(r[0], r[1]); w.y = cvt_pk_bf16(r[2], r[3]); w.z = cvt_pk_bf16(r[4], r[5]); w.w = cvt_pk_bf16(r[6], r[7]);
                *(u32x4*)op = w; }
    }
};
struct EpiY {
    static constexpr bool PERM = true, AFTER_DRAIN = false;
    bf16_t* O;
    __device__ __forceinline__ void operator()(const f32x4 (&acc)[2][2][4][2], const Unit& u, int wr, int wc, int fr, int fq) const {
        asm volatile("" : "+v"(fr), "+v"(fq));
        const int row0 = u.pm * BM + wr * 64 + fr, col0 = u.pn * BM + wc * 32 + 8 * fq;
#pragma unroll
        for (int ai = 0; ai < 2; ++ai)
#pragma unroll
            for (int m = 0; m < 4; ++m) { bf16_t* rowp = O + (size_t)(row0 + ai * HALF + m * 16) * 1024 + col0;
#pragma unroll
                for (int bj = 0; bj < 2; ++bj) { const f32x4 v0 = acc[ai][bj][m][0], v1 = acc[ai][bj][m][1];
                    u32x4 w; w.x = cvt_pk_bf16(v0[0], v0[1]); w.y = cvt_pk_bf16(v0[2], v0[3]); w.z = cvt_pk_bf16(v1[0], v1[1]); w.w = cvt_pk_bf16(v1[2], v1[3]);
                    *(u32x4*)(rowp + bj * HALF) = w; } }
    }
};

template <class Epi, class Sched, bool ALIGN_EPI = false, bool SP2 = false>
__device__ __forceinline__ void gemm_phase(PG8_LAS unsigned char* lds, const Gemm g, const Sched& S, const Epi& E) {
    const int tid = opqv((int)threadIdx.x), wid = __builtin_amdgcn_readfirstlane(tid >> 6), lane = tid & 63, wr = wid >> 2, wc = wid & 3, fr = lane & 15, fq = lane >> 4;
    const int K = g.K, nt = K / BK, lda = g.lda, ldb = g.ldb;
    unsigned voffA[2], voffB[2];
#pragma unroll
    for (int i = 0; i < 2; ++i) { int R, C; stage_rc(tid * 16 + i * 8192, R, C); const int Rb = Epi::PERM ? ((R & ~31) + perm32(R & 31)) : R;
        voffA[i] = (unsigned)(R * lda + C) * 2u; voffB[i] = (unsigned)(Rb * ldb + C) * 2u; }
    const size_t kstep = (size_t)(BK * 2);
    const size_t hstepA = (size_t)HALF * lda * 2, hstepB = (size_t)HALF * ldb * 2;
    const size_t tstepA = 2 * hstepA, tstepB = 2 * hstepB;
    const unsigned ldsw = (unsigned)wid * 1024u;
    const int aoff = lds_byte(wr * 64 + fr, fq * 8), boff = lds_byte(wc * 32 + fr, fq * 8);
#define PG8_SA(b, h) (((b) * 2 + (h)) * HTB)
#define PG8_SB(b, h) ((4 + (b) * 2 + (h)) * HTB)
#define PG8_STAGE(bufoff, gbase, voff) do { _Pragma("unroll") for (int _i = 0; _i < 2; ++_i) \
        __builtin_amdgcn_global_load_lds((const unsigned*)((const char*)(gbase) + (voff)[_i]), (PG8_LAS unsigned*)(lds + (bufoff) + ldsw + _i * 8192), 16, 0, 0); } while (0)
#define PG8_LDA(dst, b, h) do { _Pragma("unroll") for (int m = 0; m < 4; ++m) _Pragma("unroll") for (int k = 0; k < 2; ++k) dst[m][k] = *(const PG8_LAS bf16x8*)(lds + PG8_SA(b, h) + aoff + m * 2048 + k * 1024); } while (0)
#define PG8_LDB(dst, b, h) do { _Pragma("unroll") for (int n = 0; n < 2; ++n) _Pragma("unroll") for (int k = 0; k < 2; ++k) dst[n][k] = *(const PG8_LAS bf16x8*)(lds + PG8_SB(b, h) + boff + n * 2048 + k * 1024); } while (0)
#define PG8_MMA(ai, bj, At, Bt) do { __builtin_amdgcn_s_setprio(1); _Pragma("unroll") for (int m = 0; m < 4; ++m) _Pragma("unroll") for (int n = 0; n < 2; ++n) _Pragma("unroll") for (int k = 0; k < 2; ++k) \
        acc[ai][bj][m][n] = __builtin_amdgcn_mfma_f32_16x16x32_bf16(Bt[n][k], At[m][k], acc[ai][bj][m][n], 0, 0, 0); __builtin_amdgcn_s_setprio(0); } while (0)
#define PG8_WAIT_V(n) asm volatile("s_waitcnt vmcnt(" #n ")" ::: "memory")
#define PG8_WAIT_L(n) asm volatile("s_waitcnt lgkmcnt(" #n ")" ::: "memory")
#define PG8_BAR __builtin_amdgcn_s_barrier()
#define PG8_SCHED __builtin_amdgcn_sched_barrier(0)
    Unit cur, nxt; int ui = 0;
    if (!S.next(0, cur)) return;
    f32x4 acc[2][2][4][2];
#pragma unroll
    for (int a = 0; a < 2; ++a)
#pragma unroll
        for (int b = 0; b < 2; ++b)
#pragma unroll
            for (int m = 0; m < 4; ++m)
#pragma unroll
                for (int n = 0; n < 2; ++n) acc[a][b][m][n] = (f32x4){0.f, 0.f, 0.f, 0.f};
    bf16x8 At[4][2], B0[2][2], B1[2][2];
    const char* cA = (const char*)g.A + (size_t)cur.pm * tstepA; const char* cB = (const char*)g.Bt + (size_t)cur.pb * tstepB;
    S.a_ready(cur);
    if constexpr (SP2) {
        PG8_STAGE(PG8_SB(0, 0), cB, voffB); PG8_STAGE(PG8_SB(0, 1), cB + hstepB, voffB); PG8_STAGE(PG8_SA(0, 0), cA, voffA); PG8_STAGE(PG8_SA(0, 1), cA + hstepA, voffA);
        if (wr == 1) PG8_BAR;
        PG8_WAIT_V(2); PG8_BAR;
        PG8_STAGE(PG8_SB(1, 0), cB + kstep, voffB); PG8_STAGE(PG8_SA(1, 0), cA + kstep, voffA); PG8_STAGE(PG8_SB(1, 1), cB + hstepB + kstep, voffB);
        PG8_WAIT_V(6); PG8_BAR;
    } else {
        PG8_STAGE(PG8_SB(0, 0), cB, voffB); PG8_STAGE(PG8_SA(0, 0), cA, voffA); PG8_STAGE(PG8_SB(0, 1), cB + hstepB, voffB); PG8_STAGE(PG8_SA(0, 1), cA + hstepA, voffA);
        if (wr == 1) PG8_BAR;
        PG8_WAIT_V(4); PG8_BAR;
        PG8_STAGE(PG8_SB(1, 0), cB + kstep, voffB); PG8_STAGE(PG8_SA(1, 0), cA + kstep, voffA); PG8_STAGE(PG8_SB(1, 1), cB + hstepB + kstep, voffB);
        PG8_WAIT_V(6); PG8_BAR;
    }
    for (;;) {
        const bool has_next = S.next(ui + 1, nxt);
        const char* nA = has_next ? (const char*)g.A + (size_t)nxt.pm * tstepA : cA; const char* nB = has_next ? (const char*)g.Bt + (size_t)nxt.pb * tstepB : cB;
#pragma unroll 1
        for (int t = 0; t < nt; t += 2) {
            const bool last = (t == nt - 2);
            const char* a1 = cA + (size_t)(t + 1) * kstep;
            const char* a2 = last ? nA : cA + (size_t)(t + 2) * kstep; const char* b2 = last ? nB : cB + (size_t)(t + 2) * kstep;
            const char* a3 = a2 + kstep; const char* b3 = b2 + kstep;
            if (last && has_next) S.a_ready(nxt);
            if constexpr (SP2) {
            PG8_LDB(B0, 0, 0); PG8_LDB(B1, 0, 1); PG8_SCHED; PG8_LDA(At, 0, 0); PG8_STAGE(PG8_SA(1, 1), a1 + hstepA, voffA);
            PG8_WAIT_V(8); PG8_WAIT_L(0); PG8_BAR; PG8_MMA(0, 0, At, B0); PG8_MMA(0, 1, At, B1); PG8_BAR; PG8_SCHED;
            PG8_LDA(At, 0, 1); PG8_STAGE(PG8_SB(0, 0), b2, voffB); PG8_STAGE(PG8_SB(0, 1), b2 + hstepB, voffB); PG8_STAGE(PG8_SA(0, 0), a2, voffA);
            PG8_WAIT_V(8); PG8_WAIT_L(0); PG8_BAR; PG8_MMA(1, 0, At, B0); PG8_MMA(1, 1, At, B1); PG8_BAR; PG8_SCHED;
            PG8_LDB(B0, 1, 0); PG8_LDB(B1, 1, 1); PG8_SCHED; PG8_LDA(At, 1, 0); PG8_STAGE(PG8_SA(0, 1), a2 + hstepA, voffA);
            PG8_WAIT_V(8); PG8_WAIT_L(0); PG8_BAR; PG8_MMA(0, 0, At, B0); PG8_MMA(0, 1, At, B1); PG8_BAR; PG8_SCHED;
            PG8_LDA(At, 1, 1); PG8_STAGE(PG8_SB(1, 0), b3, voffB); PG8_STAGE(PG8_SB(1, 1), b3 + hstepB, voffB); PG8_STAGE(PG8_SA(1, 0), a3, voffA);
            PG8_WAIT_V(8); PG8_WAIT_L(0); PG8_BAR; PG8_MMA(1, 0, At, B0); PG8_MMA(1, 1, At, B1); PG8_BAR; PG8_SCHED;
            } else {
            PG8_LDB(B0, 0, 0); PG8_SCHED; PG8_LDA(At, 0, 0); PG8_STAGE(PG8_SA(1, 1), a1 + hstepA, voffA);
            PG8_WAIT_L(8); PG8_BAR; PG8_WAIT_L(0); PG8_MMA(0, 0, At, B0); PG8_BAR; PG8_SCHED;
            PG8_LDB(B1, 0, 1); PG8_STAGE(PG8_SB(0, 0), b2, voffB);
            PG8_BAR; PG8_WAIT_L(0); PG8_MMA(0, 1, At, B1); PG8_BAR;
            PG8_LDA(At, 0, 1); PG8_STAGE(PG8_SA(0, 0), a2, voffA);
            PG8_BAR; PG8_WAIT_L(0); PG8_MMA(1, 0, At, B0); PG8_BAR; PG8_SCHED;
            PG8_STAGE(PG8_SB(0, 1), b2 + hstepB, voffB);
            PG8_WAIT_V(6); PG8_BAR; PG8_MMA(1, 1, At, B1); PG8_BAR;
            PG8_LDB(B0, 1, 0); PG8_SCHED; PG8_LDA(At, 1, 0); PG8_STAGE(PG8_SA(0, 1), a2 + hstepA, voffA);
            PG8_WAIT_L(8); PG8_BAR; PG8_WAIT_L(0); PG8_MMA(0, 0, At, B0); PG8_BAR; PG8_SCHED;
            PG8_LDB(B1, 1, 1); PG8_STAGE(PG8_SB(1, 0), b3, voffB);
            PG8_BAR; PG8_WAIT_L(0); PG8_MMA(0, 1, At, B1); PG8_BAR;
            PG8_LDA(At, 1, 1); PG8_STAGE(PG8_SA(1, 0), a3, voffA);
            PG8_BAR; PG8_WAIT_L(0); PG8_MMA(1, 0, At, B0); PG8_BAR; PG8_SCHED;
            PG8_STAGE(PG8_SB(1, 1), b3 + hstepB, voffB);
            PG8_WAIT_V(6); PG8_BAR; PG8_MMA(1, 1, At, B1); PG8_BAR;
            }
        }
        if constexpr (ALIGN_EPI) { if (wr == 0) PG8_BAR; }
        if constexpr (!Epi::AFTER_DRAIN) { E(acc, cur, wr, wc, fr, fq); S.done(cur); }
        if (!has_next) break;
#pragma unroll
        for (int a = 0; a < 2; ++a)
#pragma unroll
            for (int b = 0; b < 2; ++b)
#pragma unroll
                for (int m = 0; m < 4; ++m)
#pragma unroll
                    for (int n = 0; n < 2; ++n) acc[a][b][m][n] = (f32x4){0.f, 0.f, 0.f, 0.f};
        cur = nxt; cA = nA; cB = nB; ++ui;
        if constexpr (ALIGN_EPI) { if (wr == 1) PG8_BAR; }
    }
    PG8_WAIT_V(0);
    if constexpr (!ALIGN_EPI) { if (wr == 0) PG8_BAR; }
    PG8_BAR;
    if constexpr (Epi::AFTER_DRAIN) { E.fused(acc, cur, wr, wc, fr, fq, lds, wid, lane); S.done(cur); }
#undef PG8_SA
#undef PG8_SB
#undef PG8_STAGE
#undef PG8_LDA
#undef PG8_LDB
#undef PG8_MMA
#undef PG8_WAIT_V
#undef PG8_WAIT_L
#undef PG8_BAR
#undef PG8_SCHED
}
}

#ifndef ATTN_FAST
#define ATTN_FAST 1
#endif
#include <hip/hip_bf16.h>
#include <cmath>
namespace attn_body {
using bf16=__hip_bfloat16;
using bf16x8=__attribute__((ext_vector_type(8)))short;
using s16x4=__attribute__((ext_vector_type(4)))short;
using f32x16=__attribute__((ext_vector_type(16)))float;
using u32x4=__attribute__((ext_vector_type(4)))unsigned;
constexpr int BATCH=8,SEQ=4096,D=64,DM=2048,DMO=512;
constexpr int NW=8,QBLK=32,QB=QBLK*NW,KVBLK=64,NQB=SEQ/QB;
constexpr int ATTN_PITCH=DM, ATTN_UNIT_ROWS=QB;
__device__ __forceinline__ int crow(int r,int hi){return (r&3)+8*(r>>2)+4*hi;}
#define SBAR() __builtin_amdgcn_sched_barrier(0)
__device__ __forceinline__ void cmask(f32x16&p0,f32x16&p1,int jb,int wid){
  if(jb>(wid>>1)){ const float NEG=-INFINITY;
    #pragma unroll
    for(int r=0;r<16;++r){p0[r]=NEG;p1[r]=NEG;} }
}

constexpr int NSLOT=3, SLOTB=8192;
constexpr int LDS_K=0, LDS_V=NSLOT*SLOTB, LDS_WS=2*NSLOT*SLOTB, LDS_OST=LDS_WS+NW*64*4, LDS_BYTES=LDS_OST+NW*4096;
constexpr float C2=0.125f*1.4426950408889634f;
__device__ __forceinline__ void glds16(const void*gsrc,unsigned lds_dst){unsigned keep;
  asm volatile("s_mov_b32 %0, m0\n\ts_mov_b32 m0, %2\n\ts_nop 0\n\tglobal_load_lds_dwordx4 %1, off\n\ts_mov_b32 m0, %0":"=&s"(keep):"v"(gsrc),"s"(lds_dst):"memory");}
__device__ __forceinline__ float max3f(float a,float b,float c){float r;asm("v_max3_f32 %0, %1, %2, %3":"=v"(r):"v"(a),"v"(b),"v"(c));return r;}
__device__ __forceinline__ float max2f(float a,float b){float r;asm("v_max_f32_e32 %0, %1, %2":"=v"(r):"v"(a),"v"(b));return r;}
__device__ __forceinline__ float fadd_s(float a,float b){float r;asm("v_add_f32_e32 %0, %1, %2":"=v"(r):"v"(a),"v"(b));return r;}
__device__ __forceinline__ float fsub_s(float a,float b){float r;asm("v_sub_f32_e32 %0, %1, %2":"=v"(r):"v"(a),"v"(b));return r;}
typedef float f32x2_t __attribute__((ext_vector_type(2))); typedef __bf16 bf16x2_t __attribute__((ext_vector_type(2)));
__device__ __forceinline__ unsigned cvtpk_s(float lo,float hi){f32x2_t v={lo,hi};bf16x2_t b=__builtin_convertvector(v,bf16x2_t);return __builtin_bit_cast(unsigned,b);}
#define WAIT_BAR(N) asm volatile("s_waitcnt vmcnt(" #N ") lgkmcnt(0)\n\ts_barrier":::"memory")

__device__ __forceinline__ void qkt(f32x16&p0,f32x16&p1,const char*Kslot,const bf16x8*qr,const f32x16&negm,int r32,int hi){
  const char*kb=Kslot+hi*1024+r32*16;
  #pragma unroll
  for(int d0=0;d0<4;++d0){
    const bf16x8 b0=*reinterpret_cast<const bf16x8*>(kb+d0*2048);
    const bf16x8 b1=*reinterpret_cast<const bf16x8*>(kb+d0*2048+512);
    if(d0==0){p0=__builtin_amdgcn_mfma_f32_32x32x16_bf16(b0,qr[0],negm,0,0,0);p1=__builtin_amdgcn_mfma_f32_32x32x16_bf16(b1,qr[0],negm,0,0,0);}
    else{p0=__builtin_amdgcn_mfma_f32_32x32x16_bf16(b0,qr[d0],p0,0,0,0);p1=__builtin_amdgcn_mfma_f32_32x32x16_bf16(b1,qr[d0],p1,0,0,0);}}
}
typedef __attribute__((address_space(3))) const char* lds_cptr;
typedef short v4i16_t __attribute__((ext_vector_type(4)));
__device__ __forceinline__ void kload8(bf16x8*kf,lds_cptr kp){
  kf[0]=*(const __attribute__((address_space(3))) bf16x8*)(kp);      kf[1]=*(const __attribute__((address_space(3))) bf16x8*)(kp+512);
  kf[2]=*(const __attribute__((address_space(3))) bf16x8*)(kp+2048); kf[3]=*(const __attribute__((address_space(3))) bf16x8*)(kp+2560);
  kf[4]=*(const __attribute__((address_space(3))) bf16x8*)(kp+4096); kf[5]=*(const __attribute__((address_space(3))) bf16x8*)(kp+4608);
  kf[6]=*(const __attribute__((address_space(3))) bf16x8*)(kp+6144); kf[7]=*(const __attribute__((address_space(3))) bf16x8*)(kp+6656);
}
__device__ __forceinline__ void kload2(bf16x8*kf,lds_cptr kp,int j){ kf[2*j]=*(const __attribute__((address_space(3))) bf16x8*)(kp+j*2048); kf[2*j+1]=*(const __attribute__((address_space(3))) bf16x8*)(kp+j*2048+512); }
__device__ __forceinline__ s16x4 vtr(lds_cptr p){ return __builtin_bit_cast(s16x4,__builtin_amdgcn_ds_read_tr16_b64_v4i16((__attribute__((address_space(3))) v4i16_t*)p)); }
__device__ __forceinline__ float rowmax(const f32x16&p0,const f32x16&p1){
  float a=max3f(p0[0],p0[1],p1[0]),b=max3f(p0[2],p0[3],p1[1]);a=max3f(a,p1[2],p1[3]);
  #pragma unroll
  for(int r=4;r<16;r+=4){a=max3f(a,p0[r],p0[r+1]);b=max3f(b,p0[r+2],p0[r+3]);a=max3f(a,p1[r],p1[r+1]);b=max3f(b,p1[r+2],p1[r+3]);}
  const float m=max2f(a,b);
  auto rr=__builtin_amdgcn_permlane32_swap(__float_as_uint(m),__float_as_uint(m),false,false);
  return max2f(__uint_as_float(rr[0]),__uint_as_float(rr[1]));
}
__device__ __forceinline__ void pv(f32x16*o,int vb,bf16x8 pa0,bf16x8 pa1,bf16x8 pa2,bf16x8 pa3){
  #pragma unroll
  for(int d0=0;d0<2;++d0){s16x4 lo[4],hi[4];
    #pragma unroll
    for(int ks=0;ks<4;++ks){
      asm volatile("ds_read_b64_tr_b16 %0,%1 offset:%c2":"=&v"(lo[ks]):"v"(vb),"i"(d0*4096+ks*1024):"memory");
      asm volatile("ds_read_b64_tr_b16 %0,%1 offset:%c2":"=&v"(hi[ks]):"v"(vb),"i"(d0*4096+ks*1024+512):"memory");}
    asm volatile("s_waitcnt lgkmcnt(0)":::"memory");SBAR();
    #define PK(k) (bf16x8){lo[k][0],lo[k][1],lo[k][2],lo[k][3],hi[k][0],hi[k][1],hi[k][2],hi[k][3]}
    o[d0]=__builtin_amdgcn_mfma_f32_32x32x16_bf16(pa0,PK(0),o[d0],0,0,0);
    o[d0]=__builtin_amdgcn_mfma_f32_32x32x16_bf16(pa1,PK(1),o[d0],0,0,0);
    o[d0]=__builtin_amdgcn_mfma_f32_32x32x16_bf16(pa2,PK(2),o[d0],0,0,0);
    o[d0]=__builtin_amdgcn_mfma_f32_32x32x16_bf16(pa3,PK(3),o[d0],0,0,0);
    #undef PK
  }
}

#ifndef ATTN_STORE16
#define ATTN_STORE16(p,v) (*(u32x4*)(p)=(v))
#endif
template<int THRL> __device__ __forceinline__ void attn_unit(int b,int qb,const bf16*Q,const bf16*__restrict__ K,const bf16*__restrict__ V,bf16*O,char*shm){
  const int tid=opqv((int)threadIdx.x),lane=tid&63,r32=lane&31,hi=lane>>5; const int wid=__builtin_amdgcn_readfirstlane(tid>>6);
  const long rowbase=(long)b*SEQ; const int q0=qb*QB;
  const bf16*Qw=Q+(rowbase+q0+wid*QBLK)*DM;
  const bf16*Kh=K+rowbase*DM,*Vh=V+rowbase*DM;
  const unsigned lds0=(unsigned)(uintptr_t)shm;
  float*wsf=(float*)(shm+LDS_WS)+wid*64;
  const bf16*ksrc=Kh+(long)lane*DM+wid*8;
  const bf16*vsrc=Vh+(long)(16*(wid&3)+(lane>>2))*DM+(wid>>2)*32+(lane&3)*8;
  const unsigned kdst=lds0+LDS_K+wid*1024, vdst=lds0+LDS_V+wid*1024;
  #define DMA_K(t,slot) glds16(ksrc+(long)(t)*KVBLK*DM,(unsigned)__builtin_amdgcn_readfirstlane(kdst+(slot)))
  #define DMA_V(t,slot) glds16(vsrc+(long)(t)*KVBLK*DM,(unsigned)__builtin_amdgcn_readfirstlane(vdst+(slot)))
  const int vb0=(int)(lds0+LDS_V)+((lane>>4)&1)*32+(lane&3)*8+(4*hi+((lane&15)>>2))*64;
  const char*Kbase=shm+LDS_K; bf16x8 kf[8];
  const lds_cptr shm3=(lds_cptr)shm; const lds_cptr kp0=shm3+LDS_K+hi*1024+r32*16; const lds_cptr vp0=shm3+LDS_V+((lane>>4)&1)*32+(lane&3)*8+(4*hi+((lane&15)>>2))*64;
  const int NT=(q0+QB)/KVBLK;
  DMA_K(0,0);DMA_V(0,0);DMA_K(1,SLOTB);
  bf16x8 qr[4];
  #pragma unroll
  for(int d0=0;d0<4;++d0)qr[d0]=*reinterpret_cast<const bf16x8*>(&Qw[(long)r32*DM+d0*16+hi*8]);
  float mhat=0.f,l_reg=0.f;f32x16 o[2];o[0]=f32x16{};o[1]=f32x16{};f32x16 negm=f32x16{};asm volatile("":"+v"(negm));
  #define CMASK(P0,P1,t) do{int jb_=(t)-(NT-4); if(jb_>=0)cmask(P0,P1,jb_,wid);}while(0)
  bool resc=false;
  #define START(P0,P1) do{ const float rm=rowmax(P0,P1); resc=false; \
    { const float dl=rm; mhat=fadd_s(mhat,dl); \
      _Pragma("unroll") for(int r=0;r<16;++r){P0[r]=fsub_s(P0[r],dl);P1[r]=fsub_s(P1[r],dl);} \
      _Pragma("unroll") for(int r=0;r<16;++r)negm[r]=-mhat; asm volatile("":"+v"(negm)); } \
    _Pragma("unroll") for(int r=0;r<16;++r)P0[r]=__builtin_amdgcn_exp2f(P0[r]); }while(0)
  #define RESC() do{ if(resc){ asm volatile("s_waitcnt lgkmcnt(0)":::"memory"); \
      _Pragma("unroll") for(int d_=0;d_<2;++d_) _Pragma("unroll") for(int r=0;r<16;++r)o[d_][r]*=wsf[crow(r,hi)]; } }while(0)
  f32x16 pA0,pA1,pB0,pB1;
  int sl_prev=0,sl_cur=0,sl_next=SLOTB;
  #define ROT() do{sl_prev=sl_cur;sl_cur=sl_next;sl_next=(sl_next==(NSLOT-1)*SLOTB)?0:sl_next+SLOTB;}while(0)
  DMA_K(2,2*SLOTB);
  WAIT_BAR(3);
  qkt(pA0,pA1,Kbase,qr,negm,r32,hi);asm volatile("s_nop 15\n\ts_nop 7":"+v"(pA0),"+v"(pA1));CMASK(pA0,pA1,0);
  START(pA0,pA1);
  _Pragma("unroll") for(int r=0;r<16;++r)pA1[r]=__builtin_amdgcn_exp2f(pA1[r]);
  WAIT_BAR(0);
  DMA_K(3,0);DMA_V(1,SLOTB);
  ROT();
  kload8(kf,kp0+sl_cur);
  WAIT_BAR(2);
  s16x4 vlo[8],vhi[8]; u32x4 pw0,pw1,pw2,pw3;
  #define PKW(P,B) cvtpk_s(P[B],P[B+1])
  #define PAF(k) __builtin_bit_cast(bf16x8,pw##k)
  #define VFR(i) (bf16x8){vlo[i][0],vlo[i][1],vlo[i][2],vlo[i][3],vhi[i][0],vhi[i][1],vhi[i][2],vhi[i][3]}
  #define PIN(x) asm volatile("":"+v"(x))
  #define MX3(a,b,c) __builtin_fmaxf(__builtin_fmaxf((a),(b)),(c))
  #define GAPA(MF,A0,A1,A2,A3,W0,W1,PW) do{ MF; sacc+=A0; sacc+=A1; sacc+=A2; sacc+=A3; PIN(sacc); W0; W1; PIN(PW); SBAR(); }while(0)
  #define EX(v) __builtin_amdgcn_exp2f(v)
  #define GAPB(MF,X,B) do{ MF; X[B]=EX(X[B]); X[B+1]=EX(X[B+1]); X[B+2]=EX(X[B+2]); X[B+3]=EX(X[B+3]); PIN(X); SBAR(); }while(0)
  #define VRD(i) do{ vlo[i]=vtr(vp_+(((i)>>2)*4096+((i)&3)*1024)); vhi[i]=vtr(vp_+(((i)>>2)*4096+((i)&3)*1024+512)); }while(0)
  #define KRD(G,j) do{ if(G){ kload2(kf,kp0+sl_next,j); SBAR(); } }while(0)
  #define STEP(C0,C1,P0,P1,t,GK,GV,GL) do{ SBAR(); \
    const lds_cptr vp_=vp0+sl_prev; \
    VRD(0); SBAR(); float sacc=(P0[0]+P0[1]); \
    GAPA(C0=__builtin_amdgcn_mfma_f32_32x32x16_bf16(kf[0],qr[0],negm,0,0,0), P0[2],P0[3],P0[4],P0[5],     pw0[0]=PKW(P0,0), pw0[1]=PKW(P0,2), pw0); \
    VRD(4); SBAR(); GAPA(C1=__builtin_amdgcn_mfma_f32_32x32x16_bf16(kf[1],qr[0],negm,0,0,0), P0[6],P0[7],P0[8],P0[9],     pw0[2]=PKW(P0,4), pw0[3]=PKW(P0,6), pw0); \
    VRD(1); SBAR(); GAPA(C0=__builtin_amdgcn_mfma_f32_32x32x16_bf16(kf[2],qr[1],C0,0,0,0),   P0[10],P0[11],P0[12],P0[13], pw1[0]=PKW(P0,8), pw1[1]=PKW(P0,10), pw1); \
    VRD(5); SBAR(); GAPA(C1=__builtin_amdgcn_mfma_f32_32x32x16_bf16(kf[3],qr[1],C1,0,0,0),   P0[14],P0[15],P1[0],P1[1],   pw1[2]=PKW(P0,12),pw1[3]=PKW(P0,14), pw1); \
    VRD(2); SBAR(); GAPA(C0=__builtin_amdgcn_mfma_f32_32x32x16_bf16(kf[4],qr[2],C0,0,0,0),   P1[2],P1[3],P1[4],P1[5],     pw2[0]=PKW(P1,0), pw2[1]=PKW(P1,2), pw2); \
    VRD(6); SBAR(); GAPA(C1=__builtin_amdgcn_mfma_f32_32x32x16_bf16(kf[5],qr[2],C1,0,0,0),   P1[6],P1[7],P1[8],P1[9],     pw2[2]=PKW(P1,4), pw2[3]=PKW(P1,6), pw2); \
    VRD(3); SBAR(); GAPA(C0=__builtin_amdgcn_mfma_f32_32x32x16_bf16(kf[6],qr[3],C0,0,0,0),   P1[10],P1[11],P1[12],P1[13], pw3[0]=PKW(P1,8), pw3[1]=PKW(P1,10), pw3); \
    VRD(7); SBAR(); GAPA(C1=__builtin_amdgcn_mfma_f32_32x32x16_bf16(kf[7],qr[3],C1,0,0,0),   P1[14],P1[15],0.f,0.f,       pw3[2]=PKW(P1,12),pw3[3]=PKW(P1,14), pw3); \
    l_reg+=sacc; \
    if(GK){DMA_K((t)+3,sl_cur);} if(GV){DMA_V((t)+1,sl_next);} \
    CMASK(C0,C1,t); \
    { float a=MX3(C0[0],C0[1],C1[0]),b=MX3(C0[2],C0[3],C1[1]); a=MX3(a,C1[2],C1[3]); \
      _Pragma("unroll") for(int r=4;r<16;r+=4){a=MX3(a,C0[r],C0[r+1]);b=MX3(b,C0[r+2],C0[r+3]);a=MX3(a,C1[r],C1[r+1]);b=MX3(b,C1[r+2],C1[r+3]);} \
      float rm=__builtin_fmaxf(a,b); { auto rr=__builtin_amdgcn_permlane32_swap(__float_as_uint(rm),__float_as_uint(rm),false,false); rm=__builtin_fmaxf(__uint_as_float(rr[0]),__uint_as_float(rr[1])); } \
      resc=false; \
      if(__builtin_expect(__any(rm>(float)THRL),0)){ const float dl=__builtin_fmaxf(rm,0.f); mhat+=dl; \
        _Pragma("unroll") for(int r=0;r<16;++r){C0[r]-=dl;C1[r]-=dl;} \
        _Pragma("unroll") for(int r=0;r<16;++r)negm[r]=-mhat; asm volatile("":"+v"(negm)); \
        const float f=__builtin_amdgcn_exp2f(-dl); l_reg*=f; if(hi==0)wsf[r32]=f; resc=true; } } \
    SBAR(); \
    GAPB(o[0]=__builtin_amdgcn_mfma_f32_32x32x16_bf16(PAF(0),VFR(0),o[0],0,0,0), C0,0); \
    GAPB(o[1]=__builtin_amdgcn_mfma_f32_32x32x16_bf16(PAF(0),VFR(4),o[1],0,0,0), C0,4); \
    KRD(GL,0); GAPB(o[0]=__builtin_amdgcn_mfma_f32_32x32x16_bf16(PAF(1),VFR(1),o[0],0,0,0), C0,8); \
    KRD(GL,1); GAPB(o[1]=__builtin_amdgcn_mfma_f32_32x32x16_bf16(PAF(1),VFR(5),o[1],0,0,0), C0,12); \
    KRD(GL,2); GAPB(o[0]=__builtin_amdgcn_mfma_f32_32x32x16_bf16(PAF(2),VFR(2),o[0],0,0,0), C1,0); \
    KRD(GL,3); GAPB(o[1]=__builtin_amdgcn_mfma_f32_32x32x16_bf16(PAF(2),VFR(6),o[1],0,0,0), C1,4); \
    GAPB(o[0]=__builtin_amdgcn_mfma_f32_32x32x16_bf16(PAF(3),VFR(3),o[0],0,0,0), C1,8); \
    GAPB(o[1]=__builtin_amdgcn_mfma_f32_32x32x16_bf16(PAF(3),VFR(7),o[1],0,0,0), C1,12); \
    }while(0)
  int t=1;
  #undef CMASK
  #define CMASK(P0,P1,t) do{}while(0)
  for(;t+5<NT;t+=2){
    STEP(pB0,pB1,pA0,pA1,t,true,true,true);     WAIT_BAR(2); RESC(); ROT();
    STEP(pA0,pA1,pB0,pB1,t+1,true,true,true);   WAIT_BAR(2); RESC(); ROT();
  }
  #undef CMASK
  #define CMASK(P0,P1,t) do{int jb_=(t)-(NT-4); if(jb_>=0)cmask(P0,P1,jb_,wid);}while(0)
  #define ENDW(tt) do{ if((tt)+3<NT){WAIT_BAR(2);} else if((tt)+2<NT){WAIT_BAR(1);} else {WAIT_BAR(0);} }while(0)
  for(;t+1<NT;t+=2){
    STEP(pB0,pB1,pA0,pA1,t,(t+3<NT),(t+1<NT),(t+1<NT));       ENDW(t);   RESC(); ROT();
    STEP(pA0,pA1,pB0,pB1,t+1,(t+4<NT),(t+2<NT),(t+2<NT));     ENDW(t+1); RESC(); ROT();
  }
  STEP(pB0,pB1,pA0,pA1,NT-1,false,false,false); RESC();
  { float sacc=pB0[0]+pB0[1]; _Pragma("unroll") for(int r=2;r<16;++r)sacc+=pB0[r]; _Pragma("unroll") for(int r=0;r<16;++r)sacc+=pB1[r]; l_reg+=sacc;
    pw0=(u32x4){PKW(pB0,0),PKW(pB0,2),PKW(pB0,4),PKW(pB0,6)};pw1=(u32x4){PKW(pB0,8),PKW(pB0,10),PKW(pB0,12),PKW(pB0,14)};pw2=(u32x4){PKW(pB1,0),PKW(pB1,2),PKW(pB1,4),PKW(pB1,6)};pw3=(u32x4){PKW(pB1,8),PKW(pB1,10),PKW(pB1,12),PKW(pB1,14)};
    SBAR(); pv(o,vb0+sl_cur,PAF(0),PAF(1),PAF(2),PAF(3)); }
  #undef PKW
  #undef PAF
  #undef VFR
  #undef PIN
  #undef MX3
  #undef GAPA
  #undef GAPB
  #undef EX
  #undef VRD
  #undef KRD
  #undef STEP
  #undef ENDW
  {auto rr=__builtin_amdgcn_permlane32_swap(__float_as_uint(l_reg),__float_as_uint(l_reg),false,false);l_reg=__uint_as_float(rr[0])+__uint_as_float(rr[1]);}
  if(hi==0)wsf[32+r32]=l_reg;asm volatile("s_waitcnt lgkmcnt(0)":::"memory");
  float rli[16];
  #pragma unroll
  for(int r=0;r<16;++r)rli[r]=__builtin_amdgcn_rcpf(wsf[32+crow(r,hi)]);
  bf16*Ow=O+(rowbase+q0+wid*QBLK)*DMO;
  { bf16*stg=(bf16*)(shm+LDS_OST)+wid*2048;
    #pragma unroll
    for(int r=0;r<16;++r){const int orow=crow(r,hi);
      #pragma unroll
      for(int d0=0;d0<2;++d0)stg[orow*64+d0*32+r32]=__float2bfloat16(o[d0][r]*rli[r]);}
    asm volatile("s_waitcnt lgkmcnt(0)":::"memory");
    #pragma unroll
    for(int i=0;i<4;++i){const int row=i*8+(lane>>3),ch=lane&7; const u32x4 v=*(const u32x4*)(stg+row*64+ch*8); ATTN_STORE16(Ow+(long)row*DMO+ch*8,v);} }
  asm volatile("s_waitcnt lgkmcnt(0)\n\ts_barrier":::"memory");
  #undef DMA_K
  #undef DMA_V
  #undef CMASK
  #undef START
  #undef RESC
  #undef ROT
}
constexpr int ATTN_LDS_BYTES=LDS_BYTES;
#undef SBAR
#undef WAIT_BAR
}

constexpr int NB = 8, SEQ = 4096, T = NB * SEQ, D = 1024, DEPTH = 4;
constexpr int ZW = 2048, GWD = 3072, NCAT = ZW + GWD;
constexpr int ZQ = 256, ZK = 768, ZV = 1280, ZC = 1792;
constexpr int NEXP = 32, FF = 512, MAXSLOT = 2 * T + NEXP * 256;
constexpr float NORM_EPS = 1e-6f;
constexpr int NWAVES = 8;
constexpr int PH_PER_LAYER = 11, N_PHASES = 1 + DEPTH * PH_PER_LAYER + 1;

constexpr size_t MiB = 1u << 20;
constexpr size_t WS_CTL = 0, CTL_ZERO_BYTES = 1 * MiB;
constexpr size_t WS_MOD = 1 * MiB;
constexpr size_t WS_LAM = WS_MOD + (size_t)DEPTH * NB * 6144 * 4;
constexpr size_t WS_ROPE_C = 2 * MiB, WS_ROPE_S = 6 * MiB;
constexpr size_t WS_SSM = 10 * MiB;
constexpr size_t SSM_L_BYTES = 8192 + 8192 + 131072;
constexpr size_t WS_RWT = 11 * MiB;
constexpr size_t WS_TOKE = 12 * MiB, WS_TOKW = WS_TOKE + 256 * 1024, WS_TOKL = WS_TOKW + 256 * 1024, WS_TOKS = WS_TOKL + 256 * 1024;
constexpr size_t WS_WGBASE = 13 * MiB, WS_TILEE = WS_WGBASE + 64 * 1024;
constexpr size_t WS_E = 14 * MiB, WS_CIN = 18 * MiB;
constexpr size_t WS_WCAT = 24 * MiB;
constexpr size_t WS_WMIX = 64 * MiB;
constexpr size_t WS_WO = 72 * MiB;
constexpr size_t WS_WGLU = 80 * MiB;
constexpr size_t WS_W13 = 82 * MiB;
constexpr size_t WS_W2 = 146 * MiB;
constexpr size_t WS_H = 178 * MiB;
constexpr size_t WS_Z = 242 * MiB;
constexpr size_t WS_G = 370 * MiB;
constexpr size_t WS_O0 = 562 * MiB, WS_O1 = 626 * MiB;
constexpr size_t WS_AMIX = 690 * MiB;
constexpr size_t WS_MIXED = 754 * MiB;
constexpr size_t WS_AG = 242 * MiB;
constexpr size_t WS_ACT = 386 * MiB;
constexpr size_t WS_Y = 458 * MiB;
constexpr size_t WS_END = 818 * MiB;
static_assert(WS_AG + (size_t)MAXSLOT * 1024 * 2 <= WS_ACT && WS_ACT + (size_t)MAXSLOT * 512 * 2 <= WS_Y && WS_Y + (size_t)MAXSLOT * 1024 * 2 <= WS_AMIX, "moe overlay map");
constexpr int CW_BAR = 4096;
constexpr int CW_CNT = 16384;

constexpr int RING_OFF = 0, RING_BYTES = 131072;
constexpr int LDSCTL_OFF = RING_BYTES, MISC_OFF = LDSCTL_OFF + 320;
constexpr int LDS_BYTES = 147456;

#define GAS __attribute__((address_space(1)))
#define LAS __attribute__((address_space(3)))
typedef unsigned short bf16;
typedef unsigned v4u __attribute__((ext_vector_type(4)));
typedef unsigned v2u __attribute__((ext_vector_type(2)));
typedef float f32x4 __attribute__((ext_vector_type(4)));
typedef float f32x2 __attribute__((ext_vector_type(2)));
typedef short bf16x8 __attribute__((ext_vector_type(8)));
typedef GAS unsigned gu32;
#define RLX_AGENT __ATOMIC_RELAXED, __HIP_MEMORY_SCOPE_AGENT
#define LDS_WAIT() asm volatile("s_waitcnt lgkmcnt(0)" ::: "memory")
#define VM_WAIT() asm volatile("s_waitcnt vmcnt(0)" ::: "memory")
__device__ __forceinline__ unsigned f2bf(float f) { unsigned u = __builtin_bit_cast(unsigned, f); return (u + 0x7fffu + ((u >> 16) & 1u)) >> 16; }
__device__ __forceinline__ unsigned pk2(float lo, float hi) { return f2bf(lo) | (f2bf(hi) << 16); }
__device__ __forceinline__ float bf2f(unsigned short b) { return __uint_as_float(((unsigned)b) << 16); }
__device__ __forceinline__ float bflo(unsigned w) { return __uint_as_float(w << 16); }
__device__ __forceinline__ float bfhi(unsigned w) { return __uint_as_float(w & 0xffff0000u); }

#define XB_TMO      128
#define XB_XCNT(j)  (256  + 64 * (j))
#define XB_XSUB(j)  (1280 + 64 * (j))
#define XB_XGEN(j)  (2304 + 64 * (j))
#define XB_TOP      3328
#define XB_TOPGEN   3392
#define XCD_BAR_WORDS 3456
#define XB_SPIN_CAP (1u << 18)

__device__ __forceinline__ unsigned xb_ld(unsigned* p)              { return __hip_atomic_load(p, __ATOMIC_RELAXED, __HIP_MEMORY_SCOPE_AGENT); }
__device__ __forceinline__ unsigned xb_add(unsigned* p, unsigned v) { return __hip_atomic_fetch_add(p, v, __ATOMIC_RELAXED, __HIP_MEMORY_SCOPE_AGENT); }
__device__ __forceinline__ unsigned xb_xcc_id() { return (unsigned)__builtin_amdgcn_s_getreg((3 << 11) | 20) & 0xFu; }
#define XB_SPIN(cond, bar) do { unsigned _sp = 0; while (cond) { __builtin_amdgcn_s_sleep(1); \
    if ((++_sp & 255u) == 0u) { if (xb_ld(&(bar)[XB_TMO])) break; if (_sp > XB_SPIN_CAP) { atomicAdd(&(bar)[XB_TMO], 1u); break; } } } } while (0)

struct XcdBarrier {
    unsigned* bar; unsigned x;
    volatile LAS unsigned* st;
};

__device__ __forceinline__ XcdBarrier xcd_barrier_post(unsigned* bar, volatile LAS unsigned* st) {
    XcdBarrier b; b.bar = bar; b.x = xb_xcc_id(); b.st = st;
    if (threadIdx.x == 0) (void)xb_add(&bar[XB_XCNT(b.x)], 1u);
    return b;
}
__device__ __forceinline__ void xcd_barrier_complete(unsigned* bar, unsigned x, unsigned& nloc, unsigned& nx) {
    const unsigned G = gridDim.x * gridDim.y * gridDim.z;
    unsigned sum, cnt, mine, sp = 0u;
    for (;;) {
        sum = 0u; cnt = 0u; mine = 0u;
#pragma unroll
        for (unsigned j = 0; j < 16; ++j) { const unsigned c = xb_ld(&bar[XB_XCNT(j)]); sum += c; cnt += (c > 0u) ? 1u : 0u; mine = (j == x) ? c : mine; }
        if (sum == G) break;
        __builtin_amdgcn_s_sleep(1);
        if ((++sp & 255u) == 0u) { if (xb_ld(&bar[XB_TMO])) break; if (sp > XB_SPIN_CAP) { atomicAdd(&bar[XB_TMO], 1u); break; } }
    }
    nloc = mine > 0u ? mine : 1u; nx = cnt > 0u ? cnt : 1u;
}

__device__ __forceinline__ void xcd_barrier(const XcdBarrier& b) {
    asm volatile("s_waitcnt vmcnt(0)" ::: "memory");
    __syncthreads();
    if (threadIdx.x == 0) {
        unsigned* bar = b.bar;
        __builtin_amdgcn_s_waitcnt(0);
        unsigned nloc = b.st[0], nx = b.st[1];
        if (nloc == 0u) { xcd_barrier_complete(bar, b.x, nloc, nx); b.st[0] = nloc; b.st[1] = nx; }
        const unsigned old = xb_add(&bar[XB_XSUB(b.x)], 1u);
        const unsigned gen = old / nloc;
        if (old + 1u == (gen + 1u) * nloc) {
            __builtin_amdgcn_fence(__ATOMIC_RELEASE, "agent");
            asm volatile("s_waitcnt vmcnt(0)" ::: "memory");
            const unsigned og = xb_add(&bar[XB_TOP], 1u);
            const unsigned tg = og / nx;
            if (og + 1u == (tg + 1u) * nx) xb_add(&bar[XB_TOPGEN], 1u);
            else XB_SPIN(xb_ld(&bar[XB_TOPGEN]) == tg, bar);
            __builtin_amdgcn_fence(__ATOMIC_ACQUIRE, "agent");
            xb_add(&bar[XB_XGEN(b.x)], 1u);
            asm volatile("s_waitcnt vmcnt(0)" ::: "memory");
        } else {
            XB_SPIN(xb_ld(&bar[XB_XGEN(b.x)]) == gen, bar);
            __builtin_amdgcn_fence(__ATOMIC_ACQUIRE, "agent");
            asm volatile("s_waitcnt vmcnt(0)" ::: "memory");
        }
    }
    __syncthreads();
}


__device__ __forceinline__ float wave_sum(float v) {
#pragma unroll
    for (int o = 1; o < 64; o <<= 1) v += __shfl_xor(v, o);
    return v;
}
__device__ __forceinline__ float wave_max(float v) {
#pragma unroll
    for (int o = 1; o < 64; o <<= 1) v = fmaxf(v, __shfl_xor(v, o));
    return v;
}
__device__ __forceinline__ float sigmoidf_(float x) { return 1.0f / (1.0f + __expf(-x)); }
__device__ __forceinline__ float gelu_tanh(float x) { const float u = 0.7978845608028654f * (x + 0.044715f * x * x * x); return 0.5f * x * (1.0f + tanhf(u)); }

__device__ __forceinline__ void tr_item(const float* __restrict__ W, int N, int k0, int n0, bf16* WT, int ldt, int drow0, int dcol0, LAS float* scr, int lane) {
#pragma unroll 8
    for (int i = 0; i < 32; ++i) { const int kk = 2 * i + (lane >> 5); scr[kk * 33 + (lane & 31)] = W[(size_t)(k0 + kk) * N + n0 + (lane & 31)]; }
    LDS_WAIT(); asm volatile("" ::: "memory");
    const int c = lane & 7;
#pragma unroll
    for (int j = 0; j < 4; ++j) { const int n = (lane >> 3) + 8 * j; const LAS float* s = scr + (8 * c) * 33 + n;
        v4u o; o.x = pk2(s[0 * 33], s[1 * 33]); o.y = pk2(s[2 * 33], s[3 * 33]); o.z = pk2(s[4 * 33], s[5 * 33]); o.w = pk2(s[6 * 33], s[7 * 33]);
        *(v4u*)(WT + (size_t)(drow0 + n) * ldt + dcol0 + 8 * c) = o; }
    LDS_WAIT(); asm volatile("" ::: "memory");
}

struct Args { const void* in[40]; float* out; unsigned char* ws; int ph_lo, ph_hi; };

enum { I_X = 0, I_C, I_POS, I_ADAW, I_ADAB, I_N1G, I_WIN, I_POOLW, I_POOLS, I_QNG, I_KNG, I_LQ1, I_LK1, I_LQ2, I_LK2, I_SUBLN,
       I_LAMRE, I_LAMIM, I_LOGDT, I_BRE, I_BIM, I_CRE, I_CIM, I_DSKIP, I_GLUW, I_GLUB, I_PROJA, I_PROJB, I_PROJC, I_GATEW, I_GATEB,
       I_WOUT, I_N2G, I_RGW, I_RGB, I_REW, I_REB, I_W1, I_W3, I_W2 };

__device__ __forceinline__ float lambda_init_of(int l) { return l == 0 ? 0.2f : (l == 1 ? 0.35550906759096926f : (l == 2 ? 0.47071302343358413f : 0.5560582041556841f)); }

__device__ __forceinline__ void prologue_phase(const Args& a, LAS unsigned char* lds) {
    const int z = opq(); (void)z;
    const int tid = opqv((int)threadIdx.x), lane = tid & 63, wave = __builtin_amdgcn_readfirstlane(tid >> 6); const int G = (int)gridDim.x, bx = (int)blockIdx.x;
    const int vcu = (G % 8 == 0) ? (bx % 8) * (G / 8) + bx / 8 : bx; const int gw = vcu * NWAVES + wave, NGW = G * NWAVES, gt = vcu * 512 + tid;
    (void)lane; (void)gw; (void)NGW; (void)gt; (void)bx;
    unsigned char* ws = (a.ws + z);
    const int NGT = G * 512;
    LAS float* scr = (LAS float*)(lds + RING_OFF + wave * 16384);
    {
        constexpr int I_IN = 16 * 64, I_GT = 16 * 96, I_PB = 8 * 32, I_PC = 4 * 32, I_WOI = 16 * 32, I_GL = 4 * 8;
        constexpr int PER_L = I_IN + I_GT + I_PB + I_PC + I_WOI + I_GL;
        for (int it = gw; it < DEPTH * PER_L; it += NGW) {
            const int l = it / PER_L; int r = it - l * PER_L;
            bf16* wcat = (bf16*)(ws + WS_WCAT) + (size_t)l * NCAT * 1024;
            bf16* wmix = (bf16*)(ws + WS_WMIX) + (size_t)l * 1024 * 1024;
            if (r < I_IN) { const int kb = r / 64, nb = r % 64; tr_item((const float*)a.in[z + I_WIN] + (size_t)l * 1024 * ZW, ZW, kb * 64, nb * 32, wcat, 1024, nb * 32, kb * 64, scr, lane); continue; } r -= I_IN;
            if (r < I_GT) { const int kb = r / 96, nb = r % 96; tr_item((const float*)a.in[z + I_GATEW] + (size_t)l * 1024 * GWD, GWD, kb * 64, nb * 32, wcat, 1024, ZW + nb * 32, kb * 64, scr, lane); continue; } r -= I_GT;
            if (r < I_PB) { const int kb = r / 32, nb = r % 32; tr_item((const float*)a.in[z + I_PROJB] + (size_t)l * 512 * 1024, 1024, kb * 64, nb * 32, wmix, 1024, nb * 32, 256 + kb * 64, scr, lane); continue; } r -= I_PB;
            if (r < I_PC) { const int kb = r / 32, nb = r % 32; tr_item((const float*)a.in[z + I_PROJC] + (size_t)l * 256 * 1024, 1024, kb * 64, nb * 32, wmix, 1024, nb * 32, 768 + kb * 64, scr, lane); continue; } r -= I_PC;
            if (r < I_WOI) { const int kb = r / 32, nb = r % 32; tr_item((const float*)a.in[z + I_WOUT] + (size_t)l * 1024 * 1024, 1024, kb * 64, nb * 32, (bf16*)(ws + WS_WO) + (size_t)l * 1024 * 1024, 1024, nb * 32, kb * 64, scr, lane); continue; } r -= I_WOI;
            { const int kb = r / 8, nb = r % 8; tr_item((const float*)a.in[z + I_GLUW] + (size_t)l * 256 * 256, 256, kb * 64, nb * 32, (bf16*)(ws + WS_WGLU) + (size_t)l * 256 * 256, 256, nb * 32, kb * 64, scr, lane); }
        }
    }
    for (int idx = gt; idx < DEPTH * 256 * 1024; idx += NGT) {
        const int l = idx >> 18, k = (idx >> 10) & 255, n = idx & 1023, g = k >> 6, c = k & 63;
        const float* pw = (const float*)a.in[z + I_POOLW] + ((size_t)(l * 4 + g) * 64 + c) * 64;
        const float* ps = (const float*)a.in[z + I_POOLS] + l * 256 + g * 64;
        const float* pa = (const float*)a.in[z + I_PROJA] + ((size_t)l * 256 + g * 64) * 1024 + n;
        float s = 0.f;
        for (int d = 0; d < 64; ++d) s += pw[d] * ps[d] * pa[(size_t)d * 1024];
        ((bf16*)(ws + WS_WMIX))[((size_t)l * 1024 + n) * 1024 + k] = (bf16)f2bf(s);
    }
    for (int idx = gt; idx < T * 32; idx += NGT) {
        const int t = idx >> 5, i = idx & 31;
        const float inv = powf(10000.0f, -(float)(2 * i) / 64.0f);
        const float ang = (float)((const int*)a.in[z + I_POS])[t] * inv;
        ((float*)(ws + WS_ROPE_C))[idx] = cosf(ang); ((float*)(ws + WS_ROPE_S))[idx] = sinf(ang);
    }
    for (int idx = gt; idx < DEPTH * 16 * 64; idx += NGT) {
        const int l = idx >> 10, g = (idx >> 6) & 15, p = idx & 63;
        const float lr = ((const float*)a.in[z + I_LAMRE])[idx], li = ((const float*)a.in[z + I_LAMIM])[idx];
        const float dt = expf(((const float*)a.in[z + I_LOGDT])[l * 16 + g]);
        const float mag = expf(lr * dt), ar = mag * cosf(li * dt), ai = mag * sinf(li * dt);
        const float nr = ar - 1.0f, ni = ai, den = lr * lr + li * li;
        const float kr = (nr * lr + ni * li) / den, ki = (ni * lr - nr * li) / den;
        unsigned char* base = ws + WS_SSM + (size_t)l * SSM_L_BYTES;
        ((f32x2*)base)[g * 64 + p] = (f32x2){ar, ai};
        float pr = ar, pi = ai;
#pragma unroll
        for (int q = 0; q < 6; ++q) { const float tr = pr * pr - pi * pi, ti = 2.0f * pr * pi; pr = tr; pi = ti; }
        ((f32x2*)(base + 8192))[g * 64 + p] = (f32x2){pr, pi};
        const float* br = (const float*)a.in[z + I_BRE] + (size_t)idx * 16; const float* bi = (const float*)a.in[z + I_BIM] + (size_t)idx * 16;
        f32x2* bb = (f32x2*)(base + 16384) + (size_t)(g * 64 + p) * 16;
        for (int ch = 0; ch < 16; ++ch) bb[ch] = (f32x2){kr * br[ch] - ki * bi[ch], kr * bi[ch] + ki * br[ch]};
    }
    if (gt < DEPTH) {
        const int l = gt; float s1 = 0.f, s2 = 0.f;
        for (int d = 0; d < 64; ++d) { s1 += ((const float*)a.in[z + I_LQ1])[l * 64 + d] * ((const float*)a.in[z + I_LK1])[l * 64 + d]; s2 += ((const float*)a.in[z + I_LQ2])[l * 64 + d] * ((const float*)a.in[z + I_LK2])[l * 64 + d]; }
        ((float*)(ws + WS_LAM))[l] = expf(s1) - expf(s2) + lambda_init_of(l);
    }
    for (int idx = gt; idx < DEPTH * 36 * 1024; idx += NGT) {
        const int l = idx / (36 * 1024), r = idx - l * 36 * 1024, j = r >> 10, k = r & 1023;
        ((float*)(ws + WS_RWT))[idx] = j < 4 ? ((const float*)a.in[z + I_RGW])[((size_t)l * 1024 + k) * 4 + j] : ((const float*)a.in[z + I_REW])[((size_t)l * 1024 + k) * 32 + (j - 4)];
    }
    {
        LAS float* cact = (LAS float*)(lds + RING_OFF);
        LAS float* red = (LAS float*)(lds + RING_OFF + 32768);
        __syncthreads();
        for (int i = tid; i < NB * 1024; i += 512) { const float cv = ((const float*)a.in[z + I_C])[i]; cact[i] = cv * sigmoidf_(cv); }
        __syncthreads();
        const int col = tid & 63, kp = tid >> 6;
        for (int u = vcu; u < DEPTH * 96; u += G) {
            const int l = u / 96, cg = u % 96;
            const float* w = (const float*)a.in[z + I_ADAW] + (size_t)l * 1024 * 6144 + cg * 64 + col;
            float acc[NB];
#pragma unroll
            for (int b = 0; b < NB; ++b) acc[b] = 0.f;
            for (int k = kp * 128; k < kp * 128 + 128; ++k) { const float wv = w[(size_t)k * 6144];
#pragma unroll
                for (int b = 0; b < NB; ++b) acc[b] += cact[b * 1024 + k] * wv; }
#pragma unroll
            for (int b = 0; b < NB; ++b) red[(kp * NB + b) * 64 + col] = acc[b];
            __syncthreads();
            { const int b = tid >> 6; float s = 0.f;
#pragma unroll
              for (int q = 0; q < 8; ++q) s += red[(q * NB + b) * 64 + col];
              ((float*)(ws + WS_MOD))[((size_t)l * NB + b) * 6144 + cg * 64 + col] = s + ((const float*)a.in[z + I_ADAB])[l * 6144 + cg * 64 + col]; }
            __syncthreads();
        }
    }
}

__device__ __forceinline__ void moe_weights_phase(const Args& a, int l, LAS unsigned char* lds) {
    const int z = opq(); (void)z;
    const int tid = opqv((int)threadIdx.x), lane = tid & 63, wave = __builtin_amdgcn_readfirstlane(tid >> 6); const int G = (int)gridDim.x, bx = (int)blockIdx.x;
    const int vcu = (G % 8 == 0) ? (bx % 8) * (G / 8) + bx / 8 : bx; const int gw = vcu * NWAVES + wave, NGW = G * NWAVES, gt = vcu * 512 + tid;
    (void)lane; (void)gw; (void)NGW; (void)gt; (void)bx;
    LAS float* scr = (LAS float*)(lds + RING_OFF + wave * 16384);
    bf16* w13 = (bf16*)((a.ws + z) + WS_W13); bf16* w2t = (bf16*)((a.ws + z) + WS_W2);
    for (int it = gw; it < NEXP * 768; it += NGW) {
        const int e = it / 768; int r = it - e * 768;
        if (r < 512) { const int which = r >> 8; r &= 255; const int kb = r >> 4, nb = r & 15, n0 = nb * 32;
            const float* W = (const float*)a.in[which ? I_W3 : I_W1] + ((size_t)l * NEXP + e) * 1024 * 512;
            tr_item(W, 512, kb * 64, n0, w13, 1024, e * 1024 + (n0 >> 7) * 256 + which * 128 + (n0 & 127), kb * 64, scr, lane); }
        else { r -= 512; const int kb = r >> 5, nb = r & 31;
            const float* W = (const float*)a.in[z + I_W2] + ((size_t)l * NEXP + e) * 512 * 1024;
            tr_item(W, 1024, kb * 64, nb * 32, w2t, 512, e * 1024 + nb * 32, kb * 64, scr, lane); }
    }
}

__device__ __forceinline__ void norm1_phase(const Args& a, int l, bool first, bool do_norm) {
    const int z = opq(); (void)z;
    const int tid = opqv((int)threadIdx.x), lane = tid & 63, wave = __builtin_amdgcn_readfirstlane(tid >> 6); const int G = (int)gridDim.x, bx = (int)blockIdx.x;
    const int vcu = (G % 8 == 0) ? (bx % 8) * (G / 8) + bx / 8 : bx; const int gw = vcu * NWAVES + wave, NGW = G * NWAVES, gt = vcu * 512 + tid;
    (void)lane; (void)gw; (void)NGW; (void)gt; (void)bx;
    unsigned char* ws = (a.ws + z);
    const float* mod = (const float*)(ws + WS_MOD);
    const bf16* Y = (const bf16*)(ws + WS_Y);
    const int* tok_slot = (const int*)(ws + WS_TOKS); const float* tok_w = (const float*)(ws + WS_TOKW);
    bf16* H = (bf16*)(ws + WS_H);
    for (int m = gw; m < T; m += NGW) {
        const int b = m >> 12;
        const f32x4* xr = (const f32x4*)((first ? (const float*)a.in[z + I_X] : (const float*)(a.out + z)) + (size_t)m * D) + lane;
        f32x4 v[4];
#pragma unroll
        for (int j = 0; j < 4; ++j) v[j] = xr[64 * j];
        if (!first) {
            const int s0 = tok_slot[2 * m], s1 = tok_slot[2 * m + 1]; const float w0 = tok_w[2 * m], w1 = tok_w[2 * m + 1];
            const float* g2 = mod + ((size_t)(l - 1) * NB + b) * 6144 + 5 * 1024;
            const v2u* y0 = (const v2u*)(Y + (size_t)s0 * D) + lane; const v2u* y1 = (const v2u*)(Y + (size_t)s1 * D) + lane;
#pragma unroll
            for (int j = 0; j < 4; ++j) { const v2u p = y0[64 * j], q = y1[64 * j]; const f32x4 g = *((const f32x4*)g2 + lane + 64 * j);
                v[j].x += g.x * (w0 * bflo(p.x) + w1 * bflo(q.x)); v[j].y += g.y * (w0 * bfhi(p.x) + w1 * bfhi(q.x));
                v[j].z += g.z * (w0 * bflo(p.y) + w1 * bflo(q.y)); v[j].w += g.w * (w0 * bfhi(p.y) + w1 * bfhi(q.y)); }
        }
        f32x4* xo = (f32x4*)((a.out + z) + (size_t)m * D) + lane;
#pragma unroll
        for (int j = 0; j < 4; ++j) xo[64 * j] = v[j];
        if (do_norm) {
            float ss = 0.f;
#pragma unroll
            for (int j = 0; j < 4; ++j) ss += (v[j].x * v[j].x + v[j].y * v[j].y) + (v[j].z * v[j].z + v[j].w * v[j].w);
            const float r = rsqrtf(wave_sum(ss) * (1.0f / D) + NORM_EPS);
            const float* mrow = mod + ((size_t)l * NB + b) * 6144;
            const f32x4* gn = (const f32x4*)((const float*)a.in[z + I_N1G] + l * D) + lane;
            v2u* ho = (v2u*)(H + (size_t)m * D) + lane;
#pragma unroll
            for (int j = 0; j < 4; ++j) { const f32x4 g = gn[64 * j], sh = *((const f32x4*)mrow + lane + 64 * j), sc = *((const f32x4*)(mrow + 1024) + lane + 64 * j);
                const f32x4 hh = (v[j] * r * g) * (sc + 1.0f) + sh;
                v2u o; o.x = pk2(hh.x, hh.y); o.y = pk2(hh.z, hh.w); ho[64 * j] = o; }
        }
    }
}

__device__ __forceinline__ void qkprep_phase(const Args& a, int l) {
    const int z = opq(); (void)z;
    const int tid = opqv((int)threadIdx.x), lane = tid & 63, wave = __builtin_amdgcn_readfirstlane(tid >> 6); const int G = (int)gridDim.x, bx = (int)blockIdx.x;
    const int vcu = (G % 8 == 0) ? (bx % 8) * (G / 8) + bx / 8 : bx; const int gw = vcu * NWAVES + wave, NGW = G * NWAVES, gt = vcu * 512 + tid;
    (void)lane; (void)gw; (void)NGW; (void)gt; (void)bx;
    unsigned char* ws = (a.ws + z); bf16* Z = (bf16*)(ws + WS_Z);
    const float qg = ((const float*)a.in[z + I_QNG])[l * 64 + lane], kg = ((const float*)a.in[z + I_KNG])[l * 64 + lane];
    for (int m = gw; m < T; m += NGW) {
        bf16* zr = Z + (size_t)m * ZW + ZQ + lane;
        const float c = ((const float*)(ws + WS_ROPE_C))[m * 32 + (lane & 31)], s = ((const float*)(ws + WS_ROPE_S))[m * 32 + (lane & 31)];
        float xv[16];
#pragma unroll
        for (int v = 0; v < 16; ++v) xv[v] = bf2f(zr[v * 64]);
#pragma unroll
        for (int v = 0; v < 16; ++v) {
            const float x = xv[v];
            const float r = rsqrtf(wave_sum(x * x) * (1.0f / 64.0f) + NORM_EPS);
            const float y = x * r * (v < 8 ? qg : kg);
            const float p = __shfl_xor(y, 32);
            float o = lane < 32 ? y * c - p * s : y * c + p * s;
            if (v < 8) o *= (ATTN_FAST ? 0.125f * 1.4426950408889634f : 0.125f);
            zr[v * 64] = (bf16)f2bf(o);
        }
    }
}

__device__ __forceinline__ void pool_phase(const Args& a, LAS unsigned char* lds) {
    const int z = opq(); (void)z;
    const int tid = opqv((int)threadIdx.x), lane = tid & 63, wave = __builtin_amdgcn_readfirstlane(tid >> 6); const int G = (int)gridDim.x, bx = (int)blockIdx.x;
    const int vcu = (G % 8 == 0) ? (bx % 8) * (G / 8) + bx / 8 : bx; const int gw = vcu * NWAVES + wave, NGW = G * NWAVES, gt = vcu * 512 + tid;
    (void)lane; (void)gw; (void)NGW; (void)gt; (void)bx;
    const bf16* Z = (const bf16*)((a.ws + z) + WS_Z); bf16* AM = (bf16*)((a.ws + z) + WS_AMIX);
    LAS float* U = (LAS float*)(lds + RING_OFF);
    for (int tl = vcu; tl < T / 64; tl += G) {
        const int m0 = tl * 64, s0 = m0 & (SEQ - 1);
        __syncthreads();
        for (int idx = tid; idx < 80 * 32; idx += 512) { const int r = idx >> 5, c8 = (idx & 31) * 8; const int sp = s0 - 16 + r;
            v4u w = (v4u){0u, 0u, 0u, 0u};
            if (sp >= 0) w = *(const v4u*)(Z + (size_t)(m0 - 16 + r) * ZW + c8);
            LAS float* u = U + r * 256 + c8;
            u[0] = bflo(w.x); u[1] = bfhi(w.x); u[2] = bflo(w.y); u[3] = bfhi(w.y); u[4] = bflo(w.z); u[5] = bfhi(w.z); u[6] = bflo(w.w); u[7] = bfhi(w.w); }
        __syncthreads();
        const int ch = tid & 255, th = tid >> 8, g = ch >> 6, w = 2 << g;
        for (int i = 0; i < 32; ++i) { const int t = th * 32 + i; float s = 0.f;
            for (int q = 0; q < w; ++q) s += U[(16 + t - q) * 256 + ch];
            const int cnt = (s0 + t + 1) < w ? (s0 + t + 1) : w;
            const float o = s / (float)cnt - U[(16 + t) * 256 + ch];
            AM[(size_t)(m0 + t) * D + ch] = (bf16)f2bf(o); }
    }
}

__device__ __forceinline__ void load_u16(const bf16* up, float (&u)[16]) {
    const v4u w0 = *(const v4u*)up, w1 = *(const v4u*)(up + 8);
    u[0] = bflo(w0.x); u[1] = bfhi(w0.x); u[2] = bflo(w0.y); u[3] = bfhi(w0.y); u[4] = bflo(w0.z); u[5] = bfhi(w0.z); u[6] = bflo(w0.w); u[7] = bfhi(w0.w);
    u[8] = bflo(w1.x); u[9] = bfhi(w1.x); u[10] = bflo(w1.y); u[11] = bfhi(w1.y); u[12] = bflo(w1.z); u[13] = bfhi(w1.z); u[14] = bflo(w1.w); u[15] = bfhi(w1.w);
}
__device__ __forceinline__ void ssm_local_phase(const Args& a, int l) {
    const int z = opq(); (void)z;
    const int tid = opqv((int)threadIdx.x), lane = tid & 63, wave = __builtin_amdgcn_readfirstlane(tid >> 6); const int G = (int)gridDim.x, bx = (int)blockIdx.x;
    const int vcu = (G % 8 == 0) ? (bx % 8) * (G / 8) + bx / 8 : bx; const int gw = vcu * NWAVES + wave, NGW = G * NWAVES, gt = vcu * 512 + tid;
    (void)lane; (void)gw; (void)NGW; (void)gt; (void)bx;
    unsigned char* ws = (a.ws + z); const bf16* Z = (const bf16*)(ws + WS_Z);
    const unsigned char* sb = ws + WS_SSM + (size_t)l * SSM_L_BYTES;
    f32x2* E = (f32x2*)(ws + WS_E);
    for (int uidx = gw; uidx < NB * 64 * 16; uidx += NGW) {
        const int g = uidx & 15, c = (uidx >> 4) & 63, b = uidx >> 10;
        const f32x2 av = ((const f32x2*)sb)[g * 64 + lane];
        float bbr[16], bbi[16];
        { const f32x4* bp = (const f32x4*)(sb + 16384) + (size_t)(g * 64 + lane) * 8;
#pragma unroll
          for (int q = 0; q < 8; ++q) { const f32x4 t4 = bp[q]; bbr[2 * q] = t4.x; bbi[2 * q] = t4.y; bbr[2 * q + 1] = t4.z; bbi[2 * q + 1] = t4.w; } }
        float xr = 0.f, xi = 0.f;
        const bf16* up = Z + (size_t)(b * SEQ + c * 64) * ZW + ZC + g * 16;
        for (int t = 0; t < 64; ++t) {
            float u[16]; load_u16(up + (size_t)t * ZW, u);
            float br = 0.f, bi = 0.f;
#pragma unroll
            for (int ch = 0; ch < 16; ++ch) { br += bbr[ch] * u[ch]; bi += bbi[ch] * u[ch]; }
            const float nr = av.x * xr - av.y * xi + br, ni = av.x * xi + av.y * xr + bi; xr = nr; xi = ni;
        }
        E[(size_t)uidx * 64 + lane] = (f32x2){xr, xi};
    }
}
__device__ __forceinline__ void ssm_carry_phase(const Args& a, int l) {
    const int z = opq(); (void)z;
    const int tid = opqv((int)threadIdx.x), lane = tid & 63, wave = __builtin_amdgcn_readfirstlane(tid >> 6); const int G = (int)gridDim.x, bx = (int)blockIdx.x;
    const int vcu = (G % 8 == 0) ? (bx % 8) * (G / 8) + bx / 8 : bx; const int gw = vcu * NWAVES + wave, NGW = G * NWAVES, gt = vcu * 512 + tid;
    (void)lane; (void)gw; (void)NGW; (void)gt; (void)bx;
    if (gt >= NB * 16 * 64) return;
    unsigned char* ws = (a.ws + z); const unsigned char* sb = ws + WS_SSM + (size_t)l * SSM_L_BYTES;
    const int p = gt & 63, g = (gt >> 6) & 15, b = gt >> 10;
    const f32x2 a64 = ((const f32x2*)(sb + 8192))[g * 64 + p];
    const f32x2* E = (const f32x2*)(ws + WS_E); f32x2* CI = (f32x2*)(ws + WS_CIN);
    float sr = 0.f, si = 0.f;
    for (int c = 0; c < 64; ++c) { const size_t o = ((size_t)((b * 64 + c) * 16 + g)) * 64 + p;
        CI[o] = (f32x2){sr, si}; const f32x2 e = E[o];
        const float nr = a64.x * sr - a64.y * si + e.x, ni = a64.x * si + a64.y * sr + e.y; sr = nr; si = ni; }
}

__device__ __forceinline__ void ssm_final_phase(const Args& a, int l, LAS unsigned char* lds) {
    const int z = opq(); (void)z;
    const int tid = opqv((int)threadIdx.x), lane = tid & 63, wave = __builtin_amdgcn_readfirstlane(tid >> 6); const int G = (int)gridDim.x, bx = (int)blockIdx.x;
    const int vcu = (G % 8 == 0) ? (bx % 8) * (G / 8) + bx / 8 : bx; const int gw = vcu * NWAVES + wave, NGW = G * NWAVES, gt = vcu * 512 + tid;
    (void)lane; (void)gw; (void)NGW; (void)gt; (void)bx;
    unsigned char* ws = (a.ws + z); const bf16* Z = (const bf16*)(ws + WS_Z); bf16* AM = (bf16*)(ws + WS_AMIX);
    const unsigned char* sb = ws + WS_SSM + (size_t)l * SSM_L_BYTES;
    const f32x2* CI = (const f32x2*)(ws + WS_CIN);
    constexpr int YP = 264, XP = 136;
    LAS bf16* Ypre = (LAS bf16*)(lds + RING_OFF);
    LAS bf16* Xb = (LAS bf16*)(lds + RING_OFF + 65536) + wave * (16 * XP);
    const int fr = lane & 15, fq = lane >> 4;
    for (int uu = vcu; uu < NB * 64; uu += G) {
        const int b = uu >> 6, c = uu & 63; const size_t m0 = (size_t)b * SEQ + c * 64;
        __syncthreads();
#pragma unroll 1
        for (int gi = 0; gi < 2; ++gi) {
            const int g = wave * 2 + gi;
            const f32x2 av = ((const f32x2*)sb)[g * 64 + lane];
            float bbr[16], bbi[16];
            { const f32x4* bp = (const f32x4*)(sb + 16384) + (size_t)(g * 64 + lane) * 8;
#pragma unroll
              for (int q = 0; q < 8; ++q) { const f32x4 t4 = bp[q]; bbr[2 * q] = t4.x; bbi[2 * q] = t4.y; bbr[2 * q + 1] = t4.z; bbi[2 * q + 1] = t4.w; } }
            bf16x8 Bf[4];
            { const float* cre = (const float*)a.in[z + I_CRE] + ((size_t)(l * 16 + g) * 16 + fr) * 64; const float* cim = (const float*)a.in[z + I_CIM] + ((size_t)(l * 16 + g) * 16 + fr) * 64;
#pragma unroll
              for (int ks = 0; ks < 4; ++ks) { const float* src = (ks < 2 ? cre : cim) + (ks & 1) * 32 + fq * 8; const float sg = ks < 2 ? 1.0f : -1.0f;
#pragma unroll
                  for (int j = 0; j < 8; ++j) Bf[ks][j] = (short)f2bf(sg * src[j]); } }
            const float dsk = ((const float*)a.in[z + I_DSKIP])[l * 256 + g * 16 + fr];
            const f32x2 st = CI[((size_t)((b * 64 + c) * 16 + g)) * 64 + lane];
            float xr = st.x, xi = st.y;
            const bf16* up = Z + m0 * ZW + ZC + g * 16;
#pragma unroll 1
            for (int tb = 0; tb < 4; ++tb) {
#pragma unroll 1
                for (int tt = 0; tt < 16; ++tt) {
                    float u[16]; load_u16(up + (size_t)(tb * 16 + tt) * ZW, u);
                    float br = 0.f, bi = 0.f;
#pragma unroll
                    for (int ch = 0; ch < 16; ++ch) { br += bbr[ch] * u[ch]; bi += bbi[ch] * u[ch]; }
                    const float nr = av.x * xr - av.y * xi + br, ni = av.x * xi + av.y * xr + bi; xr = nr; xi = ni;
                    Xb[tt * XP + lane] = (bf16)f2bf(xr); Xb[tt * XP + 64 + lane] = (bf16)f2bf(xi);
                }
                LDS_WAIT(); asm volatile("" ::: "memory");
                pg8::f32x4 acc = {0.f, 0.f, 0.f, 0.f};
#pragma unroll
                for (int ks = 0; ks < 4; ++ks) { const bf16x8 Af = *(const LAS bf16x8*)(Xb + fr * XP + ks * 32 + fq * 8);
                    acc = __builtin_amdgcn_mfma_f32_16x16x32_bf16(Af, Bf[ks], acc, 0, 0, 0); }
#pragma unroll
                for (int j = 0; j < 4; ++j) { const int t = tb * 16 + fq * 4 + j;
                    const float uu2 = bf2f(up[(size_t)t * ZW + fr]);
                    Ypre[t * YP + g * 16 + fr] = (bf16)f2bf(gelu_tanh(acc[j] + dsk * uu2)); }
                LDS_WAIT(); asm volatile("" ::: "memory");
            }
        }
        __syncthreads();
        { pg8::f32x4 acc[4][2];
#pragma unroll
          for (int rb = 0; rb < 4; ++rb)
#pragma unroll
              for (int nb = 0; nb < 2; ++nb) acc[rb][nb] = (pg8::f32x4){0.f, 0.f, 0.f, 0.f};
          const bf16* wg = (const bf16*)(ws + WS_WGLU) + (size_t)l * 256 * 256;
#pragma unroll 2
          for (int ks = 0; ks < 8; ++ks) {
              bf16x8 Bw[2], Aw[4];
#pragma unroll
              for (int nb = 0; nb < 2; ++nb) Bw[nb] = *(const bf16x8*)(wg + (size_t)(wave * 32 + nb * 16 + fr) * 256 + ks * 32 + fq * 8);
#pragma unroll
              for (int rb = 0; rb < 4; ++rb) Aw[rb] = *(const LAS bf16x8*)(Ypre + (rb * 16 + fr) * YP + ks * 32 + fq * 8);
#pragma unroll
              for (int rb = 0; rb < 4; ++rb)
#pragma unroll
                  for (int nb = 0; nb < 2; ++nb) acc[rb][nb] = __builtin_amdgcn_mfma_f32_16x16x32_bf16(Aw[rb], Bw[nb], acc[rb][nb], 0, 0, 0);
          }
#pragma unroll
          for (int nb = 0; nb < 2; ++nb) { const int n = wave * 32 + nb * 16 + fr; const float gb = ((const float*)a.in[z + I_GLUB])[l * 256 + n];
#pragma unroll
              for (int rb = 0; rb < 4; ++rb)
#pragma unroll
                  for (int j = 0; j < 4; ++j) { const int t = rb * 16 + fq * 4 + j;
                      const float yv = bf2f(Ypre[t * YP + n]);
                      AM[(m0 + t) * D + 768 + n] = (bf16)f2bf(yv * sigmoidf_(acc[rb][nb][j] + gb)); } }
        }
    }
}

__device__ __forceinline__ void attn_naive_unit(const Args& a, int b, int h, int mp, int cc, LAS unsigned char* lds, int tid, int lane, int wave) {
    const int z = opq();
    const bf16* Z = (const bf16*)((a.ws + z) + WS_Z);
    float* O = (float*)((a.ws + z) + (mp ? WS_O1 : WS_O0));
    const size_t m0 = (size_t)b * SEQ + cc * 64;
    const int qcol = ZQ + h * 128 + mp * 64, kcol = ZK + h * 128 + mp * 64, vcol = ZV + h * 128;
    LAS float* Qs = (LAS float*)(lds + RING_OFF);
    LAS unsigned* Vs = (LAS unsigned*)(lds + RING_OFF + 16384);
    LAS float* Ps = (LAS float*)(lds + RING_OFF + 32768) + wave * 512;
    __syncthreads();
    { const int r = tid >> 3, c8 = (tid & 7) * 8; const v4u w = *(const v4u*)(Z + (m0 + r) * ZW + qcol + c8); LAS float* q = Qs + r * 64 + c8;
      q[0] = bflo(w.x); q[1] = bfhi(w.x); q[2] = bflo(w.y); q[3] = bfhi(w.y); q[4] = bflo(w.z); q[5] = bfhi(w.z); q[6] = bflo(w.w); q[7] = bfhi(w.w); }
    float mrun[8], lrun[8], o0[8], o1[8];
#pragma unroll
    for (int i = 0; i < 8; ++i) { mrun[i] = -1e30f; lrun[i] = 0.f; o0[i] = 0.f; o1[i] = 0.f; }
    const size_t kb0 = (size_t)b * SEQ;
#pragma unroll 1
    for (int kt = 0; kt <= cc; ++kt) {
        __syncthreads();
        { const int key = tid >> 3, part = tid & 7; const bf16* vp = Z + (kb0 + kt * 64 + key) * ZW + vcol + part * 16;
          const v4u w0 = *(const v4u*)vp, w1 = *(const v4u*)(vp + 8); LAS v4u* d = (LAS v4u*)(Vs + key * 64 + part * 8); d[0] = w0; d[1] = w1; }
        float kf[64];
        { const bf16* kp = Z + (kb0 + kt * 64 + lane) * ZW + kcol;
#pragma unroll
          for (int q = 0; q < 8; ++q) { const v4u w = *(const v4u*)(kp + q * 8);
              kf[q * 8 + 0] = bflo(w.x); kf[q * 8 + 1] = bfhi(w.x); kf[q * 8 + 2] = bflo(w.y); kf[q * 8 + 3] = bfhi(w.y);
              kf[q * 8 + 4] = bflo(w.z); kf[q * 8 + 5] = bfhi(w.z); kf[q * 8 + 6] = bflo(w.w); kf[q * 8 + 7] = bfhi(w.w); } }
        __syncthreads();
#pragma unroll
        for (int i = 0; i < 8; ++i) {
            const LAS f32x4* qr = (const LAS f32x4*)(Qs + (wave * 8 + i) * 64);
            float s = 0.f;
#pragma unroll
            for (int d4 = 0; d4 < 16; ++d4) { const f32x4 q4 = qr[d4]; s += q4.x * kf[d4 * 4] + q4.y * kf[d4 * 4 + 1] + q4.z * kf[d4 * 4 + 2] + q4.w * kf[d4 * 4 + 3]; }
            const float mt = wave_max(s), mn = fmaxf(mrun[i], mt), al = __expf(mrun[i] - mn), p = __expf(s - mn);
            lrun[i] = lrun[i] * al + wave_sum(p); o0[i] *= al; o1[i] *= al; mrun[i] = mn;
            Ps[i * 64 + lane] = p;
        }
        LDS_WAIT(); asm volatile("" ::: "memory");
#pragma unroll 4
        for (int j4 = 0; j4 < 16; ++j4) {
            unsigned vw[4];
#pragma unroll
            for (int jj = 0; jj < 4; ++jj) vw[jj] = Vs[(j4 * 4 + jj) * 64 + lane];
#pragma unroll
            for (int i = 0; i < 8; ++i) { const f32x4 p4 = *(const LAS f32x4*)(Ps + i * 64 + j4 * 4);
                o0[i] += p4.x * bflo(vw[0]) + p4.y * bflo(vw[1]) + p4.z * bflo(vw[2]) + p4.w * bflo(vw[3]);
                o1[i] += p4.x * bfhi(vw[0]) + p4.y * bfhi(vw[1]) + p4.z * bfhi(vw[2]) + p4.w * bfhi(vw[3]); }
        }
    }
#pragma unroll
    for (int i = 0; i < 8; ++i) { const float rl = 1.0f / lrun[i];
        *(f32x2*)(O + (m0 + wave * 8 + i) * 512 + h * 128 + lane * 2) = (f32x2){o0[i] * rl, o1[i] * rl}; }
}
__device__ __forceinline__ void attn_naive_phase(const Args& a, LAS unsigned char* lds) {
    const int z = opq(); (void)z;
    const int tid = opqv((int)threadIdx.x), lane = tid & 63, wave = __builtin_amdgcn_readfirstlane(tid >> 6); const int G = (int)gridDim.x, bx = (int)blockIdx.x;
    const int vcu = (G % 8 == 0) ? (bx % 8) * (G / 8) + bx / 8 : bx; const int gw = vcu * NWAVES + wave, NGW = G * NWAVES, gt = vcu * 512 + tid;
    (void)lane; (void)gw; (void)NGW; (void)gt; (void)bx;
    for (int u = vcu; u < 2048; u += G) {
        const int bhm = u >> 5, j = u & 31, b = bhm >> 3, h = (bhm >> 1) & 3, mp = bhm & 1;
        attn_naive_unit(a, b, h, mp, j, lds, tid, lane, wave);
        attn_naive_unit(a, b, h, mp, 63 - j, lds, tid, lane, wave);
    }
}

__device__ __forceinline__ void attn_fast_phase(const Args& a, char* lds_generic) {
    const int z = opq();
    const int G = (int)gridDim.x, bx = (int)blockIdx.x; const int vcu = (G % 8 == 0) ? (bx % 8) * (G / 8) + bx / 8 : bx;
    const attn_body::bf16* Z = (const attn_body::bf16*)((a.ws + z) + WS_Z);
#pragma unroll 1
    for (int p = vcu; p < 1024; p += G) {
        const int stream = (p >> 8) * 32 + ((p & 255) >> 3), j = p & 7;
        const int b = stream >> 4, vh = stream & 15, h = vh >> 2, mp = (vh >> 1) & 1, vhalf = vh & 1;
        const attn_body::bf16* Q = Z + ZQ + h * 128 + mp * 64; const attn_body::bf16* K = Z + ZK + h * 128 + mp * 64; const attn_body::bf16* V = Z + ZV + h * 128 + vhalf * 64;
        attn_body::bf16* O = (attn_body::bf16*)((a.ws + z) + (mp ? WS_O1 : WS_O0)) + h * 128 + vhalf * 64;
#pragma unroll 1
        for (int k2 = 0; k2 < 2; ++k2) attn_body::attn_unit<8>(b, k2 ? 15 - j : j, Q, K, V, O, lds_generic);
    }
}

__device__ __forceinline__ void attn_combine_phase(const Args& a, int l) {
    const int z = opq(); (void)z;
    const int tid = opqv((int)threadIdx.x), lane = tid & 63, wave = __builtin_amdgcn_readfirstlane(tid >> 6); const int G = (int)gridDim.x, bx = (int)blockIdx.x;
    const int vcu = (G % 8 == 0) ? (bx % 8) * (G / 8) + bx / 8 : bx; const int gw = vcu * NWAVES + wave, NGW = G * NWAVES, gt = vcu * 512 + tid;
    (void)lane; (void)gw; (void)NGW; (void)gt; (void)bx;
    unsigned char* ws = (a.ws + z); const float* O0 = (const float*)(ws + WS_O0); const float* O1 = (const float*)(ws + WS_O1); bf16* AM = (bf16*)(ws + WS_AMIX);
    const float lam = ((const float*)(ws + WS_LAM))[l], post = 1.0f - lambda_init_of(l);
    const f32x2 sg = *((const f32x2*)((const float*)a.in[z + I_SUBLN] + l * 128) + lane);
    for (int m = gw; m < T; m += NGW) {
#pragma unroll
        for (int h = 0; h < 4; ++h) {
#if ATTN_FAST
            const unsigned pw = *((const unsigned*)((const bf16*)O0 + (size_t)m * 512 + h * 128) + lane), qw = *((const unsigned*)((const bf16*)O1 + (size_t)m * 512 + h * 128) + lane);
            const float d0 = bflo(pw) - lam * bflo(qw), d1 = bfhi(pw) - lam * bfhi(qw);
#else
            const f32x2 p = *((const f32x2*)(O0 + (size_t)m * 512 + h * 128) + lane), q = *((const f32x2*)(O1 + (size_t)m * 512 + h * 128) + lane);
            const float d0 = p.x - lam * q.x, d1 = p.y - lam * q.y;
#endif
            const float r = rsqrtf(wave_sum(d0 * d0 + d1 * d1) * (1.0f / 128.0f) + NORM_EPS);
            *((unsigned*)(AM + (size_t)m * D + 256 + h * 128) + lane) = pk2(d0 * r * sg.x * post, d1 * r * sg.y * post);
        }
    }
}

__device__ __forceinline__ void norm2_router_phase(const Args& a, int l, LAS unsigned char* lds) {
    const int z = opq(); (void)z;
    const int tid = opqv((int)threadIdx.x), lane = tid & 63, wave = __builtin_amdgcn_readfirstlane(tid >> 6); const int G = (int)gridDim.x, bx = (int)blockIdx.x;
    const int vcu = (G % 8 == 0) ? (bx % 8) * (G / 8) + bx / 8 : bx; const int gw = vcu * NWAVES + wave, NGW = G * NWAVES, gt = vcu * 512 + tid;
    (void)lane; (void)gw; (void)NGW; (void)gt; (void)bx;
    unsigned char* ws = (a.ws + z);
    const float* mod = (const float*)(ws + WS_MOD); bf16* H = (bf16*)(ws + WS_H);
    const float* rwt = (const float*)(ws + WS_RWT) + (size_t)l * 36 * 1024;
    int* tok_e = (int*)(ws + WS_TOKE); float* tok_w = (float*)(ws + WS_TOKW); int* tok_l = (int*)(ws + WS_TOKL);
    LAS int* lcnt = (LAS int*)(lds + RING_OFF);
    __syncthreads();
    if (tid < 32) lcnt[tid] = 0;
    __syncthreads();
    const float rgb = lane < 4 ? ((const float*)a.in[z + I_RGB])[l * 4 + lane] : (lane < 36 ? ((const float*)a.in[z + I_REB])[l * 32 + lane - 4] : 0.f);
    for (int m4 = gw; m4 < T / 4; m4 += NGW) {
        const int mb = m4 * 4, b = mb >> 12;
        const float* mrow = mod + ((size_t)l * NB + b) * 6144;
        f32x4 hv[4][4];
#pragma unroll
        for (int r = 0; r < 4; ++r) {
            const f32x4* xr = (const f32x4*)((a.out + z) + (size_t)(mb + r) * D) + lane;
            float ss = 0.f;
#pragma unroll
            for (int j = 0; j < 4; ++j) { hv[r][j] = xr[64 * j]; ss += (hv[r][j].x * hv[r][j].x + hv[r][j].y * hv[r][j].y) + (hv[r][j].z * hv[r][j].z + hv[r][j].w * hv[r][j].w); }
            const float rr = rsqrtf(wave_sum(ss) * (1.0f / D) + NORM_EPS);
            v2u* ho = (v2u*)(H + (size_t)(mb + r) * D) + lane;
#pragma unroll
            for (int j = 0; j < 4; ++j) { const f32x4 g = *((const f32x4*)((const float*)a.in[z + I_N2G] + l * D) + lane + 64 * j), sh = *((const f32x4*)(mrow + 3 * 1024) + lane + 64 * j), sc = *((const f32x4*)(mrow + 4 * 1024) + lane + 64 * j);
                hv[r][j] = (hv[r][j] * rr * g) * (sc + 1.0f) + sh;
                v2u o; o.x = pk2(hv[r][j].x, hv[r][j].y); o.y = pk2(hv[r][j].z, hv[r][j].w); ho[64 * j] = o; }
        }
        float lg[4] = {0.f, 0.f, 0.f, 0.f};
#pragma unroll 1
        for (int e = 0; e < 36; ++e) {
            const f32x4* wr = (const f32x4*)(rwt + (size_t)e * 1024) + lane;
            f32x4 w4[4];
#pragma unroll
            for (int j = 0; j < 4; ++j) w4[j] = wr[64 * j];
#pragma unroll
            for (int r = 0; r < 4; ++r) { float s = 0.f;
#pragma unroll
                for (int j = 0; j < 4; ++j) s += (hv[r][j].x * w4[j].x + hv[r][j].y * w4[j].y) + (hv[r][j].z * w4[j].z + hv[r][j].w * w4[j].w);
                s = wave_sum(s); if (lane == e) lg[r] = s; }
        }
#pragma unroll
        for (int r = 0; r < 4; ++r) {
            const float v = lg[r] + rgb;
            float gl[4];
#pragma unroll
            for (int j = 0; j < 4; ++j) gl[j] = __shfl(v, j);
            int gi = 0; float gm = gl[0];
#pragma unroll
            for (int j = 1; j < 4; ++j) if (gl[j] > gm) { gm = gl[j]; gi = j; }
            float gs = 0.f;
#pragma unroll
            for (int j = 0; j < 4; ++j) gs += __expf(gl[j] - gm);
            const float pg = 1.0f / gs;
            float el[8];
#pragma unroll
            for (int j = 0; j < 8; ++j) el[j] = __shfl(v, 4 + gi * 8 + j);
            int e0 = 0; float m0v = el[0];
#pragma unroll
            for (int j = 1; j < 8; ++j) if (el[j] > m0v) { m0v = el[j]; e0 = j; }
            int e1 = -1; float m1v = -3.0e38f;
#pragma unroll
            for (int j = 0; j < 8; ++j) if (j != e0 && el[j] > m1v) { m1v = el[j]; e1 = j; }
            const float x1 = __expf(m1v - m0v), w0 = pg / (1.0f + x1), w1 = pg * x1 / (1.0f + x1);
            if (lane == 0) {
                const int m = mb + r, ea = gi * 8 + e0, eb = gi * 8 + e1;
                tok_e[2 * m] = ea; tok_e[2 * m + 1] = eb; tok_w[2 * m] = w0; tok_w[2 * m + 1] = w1;
                tok_l[2 * m] = __hip_atomic_fetch_add(&lcnt[ea], 1, __ATOMIC_RELAXED, __HIP_MEMORY_SCOPE_WORKGROUP); tok_l[2 * m + 1] = __hip_atomic_fetch_add(&lcnt[eb], 1, __ATOMIC_RELAXED, __HIP_MEMORY_SCOPE_WORKGROUP);
            }
        }
    }
    __syncthreads();
    if (tid < 32) { const int c = lcnt[tid];
        const unsigned old = __hip_atomic_fetch_add((unsigned*)(ws + WS_CTL) + CW_CNT + l * 64 + tid, (unsigned)c, RLX_AGENT);
        ((int*)(ws + WS_WGBASE))[bx * 32 + tid] = (int)old; }
}

__device__ __forceinline__ void moe_scatter_phase(const Args& a, int l, LAS unsigned char* lds) {
    const int z = opq(); (void)z;
    const int tid = opqv((int)threadIdx.x), lane = tid & 63, wave = __builtin_amdgcn_readfirstlane(tid >> 6); const int G = (int)gridDim.x, bx = (int)blockIdx.x;
    const int vcu = (G % 8 == 0) ? (bx % 8) * (G / 8) + bx / 8 : bx; const int gw = vcu * NWAVES + wave, NGW = G * NWAVES, gt = vcu * 512 + tid;
    (void)lane; (void)gw; (void)NGW; (void)gt; (void)bx;
    unsigned char* ws = (a.ws + z);
    LAS int* pst = (LAS int*)(lds + RING_OFF);
    __syncthreads();
    if (tid == 0) {
        int run = 0; int* tile_e = (int*)(ws + WS_TILEE);
        for (int e = 0; e < NEXP; ++e) { const int c = (int)__hip_atomic_load((unsigned*)(ws + WS_CTL) + CW_CNT + l * 64 + e, RLX_AGENT); const int pad = (c + 255) & ~255;
            pst[e] = run + ((const int*)(ws + WS_WGBASE))[bx * 32 + e];
            if (bx == 0) for (int q = 0; q < (pad >> 8); ++q) tile_e[(run >> 8) + q] = e;
            run += pad; }
        if (bx == 0) tile_e[511] = run >> 8;
    }
    __syncthreads();
    const int* tok_e = (const int*)(ws + WS_TOKE); const int* tok_l = (const int*)(ws + WS_TOKL); int* tok_s = (int*)(ws + WS_TOKS);
    const bf16* H = (const bf16*)(ws + WS_H); bf16* AG = (bf16*)(ws + WS_AG);
    for (int m4 = gw; m4 < T / 4; m4 += NGW) {
#pragma unroll
        for (int r = 0; r < 4; ++r) { const int m = m4 * 4 + r;
            const int s0 = pst[tok_e[2 * m]] + tok_l[2 * m], s1 = pst[tok_e[2 * m + 1]] + tok_l[2 * m + 1];
            if (lane == 0) { tok_s[2 * m] = s0; tok_s[2 * m + 1] = s1; }
            const v4u* src = (const v4u*)(H + (size_t)m * D) + lane; const v4u x0 = src[0], x1 = src[64];
            v4u* d0 = (v4u*)(AG + (size_t)s0 * D) + lane; v4u* d1 = (v4u*)(AG + (size_t)s1 * D) + lane;
            d0[0] = x0; d0[64] = x1; d1[0] = x0; d1[64] = x1; }
    }
}

__global__ void __launch_bounds__(NWAVES * 64, 2) fwd(Args args) {
    extern __shared__ __attribute__((aligned(16))) unsigned char lds_raw[];
    LAS unsigned char* lds = (LAS unsigned char*)lds_raw;
    for (int u = threadIdx.x; u < (LDS_BYTES - LDSCTL_OFF) / 4; u += NWAVES * 64) ((LAS unsigned*)(lds + LDSCTL_OFF))[u] = 0u;
    __syncthreads();
#if MK_MULTI
#define GRID_BAR() do { } while (0)
#else
    XcdBarrier bar = xcd_barrier_post((unsigned*)(args.ws + WS_CTL) + CW_BAR, (volatile LAS unsigned*)(lds + MISC_OFF) + 8);
#define GRID_BAR() xcd_barrier(bar)
#endif
    const int lo = args.ph_lo, hi = args.ph_hi;
#ifndef PHMASK
#define PHMASK 0xFFFF
#endif
#define EN(p) (((PHMASK) >> (p)) & 1)
#define IN(k) (lo <= (k) && (k) < hi)
#define SEAM(k) do { if (IN(k) && IN((k) + 1)) GRID_BAR(); } while (0)

    if (EN(11) && IN(0)) { prologue_phase(args, lds); SEAM(0); }

#pragma unroll 1
    for (int l = 0; l < DEPTH; ++l) {
        const int pb = 1 + l * PH_PER_LAYER;
        if (EN(0) && IN(pb + 0)) { norm1_phase(args, l, l == 0, true); moe_weights_phase(args, l, lds); SEAM(pb + 0); }
        if (EN(1) && IN(pb + 1)) { unsigned char* ws = args.ws + opq(); const int G = (int)gridDim.x, bx = (int)blockIdx.x;
            pg8::Gemm g{(const pg8::bf16_t*)(ws + WS_H), (const pg8::bf16_t*)(ws + WS_WCAT) + (size_t)l * NCAT * 1024, 1024, 1024, 1024}; pg8::StaticOrder S; S.init(T, NCAT, G, bx);
            pg8::EpiZG E{(pg8::bf16_t*)(ws + WS_Z), (pg8::bf16_t*)(ws + WS_G), (const float*)args.in[opq() + I_GATEB] + l * GWD};
            pg8::gemm_phase<pg8::EpiZG, pg8::StaticOrder, true, true>(lds + RING_OFF, g, S, E);
            SEAM(pb + 1);
        }
        if (EN(2) && IN(pb + 2)) { qkprep_phase(args, l); pool_phase(args, lds); ssm_local_phase(args, l); SEAM(pb + 2); }
        if (EN(3) && IN(pb + 3)) { ssm_carry_phase(args, l);
#if ATTN_FAST
            attn_fast_phase(args, (char*)lds_raw + RING_OFF);
#else
            attn_naive_phase(args, lds);
#endif
            SEAM(pb + 3); }
        if (EN(4) && IN(pb + 4)) { attn_combine_phase(args, l); ssm_final_phase(args, l, lds); SEAM(pb + 4); }
        if (EN(5) && IN(pb + 5)) { unsigned char* ws = args.ws + opq(); const int G = (int)gridDim.x, bx = (int)blockIdx.x;
            const pg8::bf16_t* am = (const pg8::bf16_t*)(ws + WS_AMIX); pg8::bf16_t* mx = (pg8::bf16_t*)(ws + WS_MIXED); const pg8::bf16_t* gt_ = (const pg8::bf16_t*)(ws + WS_G);
            const pg8::bf16_t* wmix = (const pg8::bf16_t*)(ws + WS_WMIX) + (size_t)l * 1024 * 1024;
            pg8::StaticOrder S; S.init(T, D, G, bx);
#pragma unroll 1
            for (int s = 0; s < 3; ++s) {
                const int koff = s == 0 ? 0 : (s == 1 ? 256 : 768), klen = s == 1 ? 512 : 256;
                pg8::Gemm g{am + koff, wmix + koff, 1024, 1024, klen}; pg8::EpiMix E{mx, gt_, s * 1024, s == 0};
                pg8::gemm_phase<pg8::EpiMix, pg8::StaticOrder, true, true>(lds + RING_OFF, g, S, E);
            }
            SEAM(pb + 5);
        }
        if (EN(6) && IN(pb + 6)) { unsigned char* ws = args.ws + opq(); const int G = (int)gridDim.x, bx = (int)blockIdx.x;
            pg8::Gemm g{(const pg8::bf16_t*)(ws + WS_MIXED), (const pg8::bf16_t*)(ws + WS_WO) + (size_t)l * 1024 * 1024, 1024, 1024, 1024}; pg8::StaticOrder S; S.init(T, D, G, bx);
            pg8::EpiResid E{args.out + opq(), (const float*)(ws + WS_MOD) + (size_t)l * NB * 6144 + 2 * 1024};
            pg8::gemm_phase<pg8::EpiResid, pg8::StaticOrder, true, true>(lds + RING_OFF, g, S, E);
            SEAM(pb + 6);
        }
        if (EN(7) && IN(pb + 7)) { norm2_router_phase(args, l, lds); SEAM(pb + 7); }
        if (EN(8) && IN(pb + 8)) { moe_scatter_phase(args, l, lds); SEAM(pb + 8); }
        if (EN(9) && IN(pb + 9)) { unsigned char* ws = args.ws + opq(); const int G = (int)gridDim.x, bx = (int)blockIdx.x; const int vcu = (G % 8 == 0) ? (bx % 8) * (G / 8) + bx / 8 : bx;
            const int* tile_e = (const int*)(ws + WS_TILEE);
            pg8::GroupedOrder S{tile_e, __builtin_amdgcn_readfirstlane(tile_e[511]), G, vcu};
            pg8::Gemm g{(const pg8::bf16_t*)(ws + WS_AG), (const pg8::bf16_t*)(ws + WS_W13), 1024, 1024, 1024};
            pg8::EpiSwiGLU E{(pg8::bf16_t*)(ws + WS_ACT)};
            pg8::gemm_phase<pg8::EpiSwiGLU, pg8::GroupedOrder, true, true>(lds + RING_OFF, g, S, E);
            SEAM(pb + 9);
        }
        if (EN(10) && IN(pb + 10)) { unsigned char* ws = args.ws + opq(); const int G = (int)gridDim.x, bx = (int)blockIdx.x; const int vcu = (G % 8 == 0) ? (bx % 8) * (G / 8) + bx / 8 : bx;
            const int* tile_e = (const int*)(ws + WS_TILEE);
            pg8::GroupedOrder S{tile_e, __builtin_amdgcn_readfirstlane(tile_e[511]), G, vcu};
            pg8::Gemm g{(const pg8::bf16_t*)(ws + WS_ACT), (const pg8::bf16_t*)(ws + WS_W2), 512, 512, 512};
            pg8::EpiY E{(pg8::bf16_t*)(ws + WS_Y)};
            pg8::gemm_phase<pg8::EpiY, pg8::GroupedOrder, true, true>(lds + RING_OFF, g, S, E);
            SEAM(pb + 10);
        }
    }
    if (EN(12) && IN(N_PHASES - 1)) norm1_phase(args, DEPTH, false, false);
#undef IN
#undef SEAM
}

extern "C" void kernel_launch(void* const* d_in, const int* in_sizes, int n_in, void* d_out, int out_size, void* d_ws, size_t ws_size, hipStream_t stream) {
    static int grid = 0;
    if (grid == 0) {
        if (n_in != 40 || out_size != T * D || ws_size < WS_END) { fprintf(stderr, "kernel_launch: unexpected shapes (n_in %d out %d ws %zu)\n", n_in, out_size, ws_size); grid = -1; return; }
        int dev = 0, cus = 0, per_cu = 0;
        if (hipGetDevice(&dev) != hipSuccess || hipDeviceGetAttribute(&cus, hipDeviceAttributeMultiprocessorCount, dev) != hipSuccess) { grid = -1; return; }
        if (hipFuncSetAttribute((const void*)fwd, hipFuncAttributeMaxDynamicSharedMemorySize, LDS_BYTES) != hipSuccess) { fprintf(stderr, "kernel_launch: hipFuncSetAttribute failed\n"); grid = -1; return; }
        if (hipOccupancyMaxActiveBlocksPerMultiprocessor(&per_cu, (const void*)fwd, NWAVES * 64, LDS_BYTES) != hipSuccess || per_cu < 1) fprintf(stderr, "kernel_launch: occupancy query says %d\n", per_cu);
        (void)hipGetLastError();
        grid = cus;
    }
    if (grid < 0) return;
    if (hipMemsetAsync((char*)d_ws + WS_CTL, 0, CTL_ZERO_BYTES, stream) != hipSuccess) return;
    Args a{};
    for (int i = 0; i < 40; ++i) a.in[i] = d_in[i];
    a.out = (float*)d_out; a.ws = (unsigned char*)d_ws;
#if MK_MULTI
    for (int p = 0; p < N_PHASES; ++p) { a.ph_lo = p; a.ph_hi = p + 1; hipLaunchKernelGGL(fwd, dim3(grid), dim3(NWAVES * 64), LDS_BYTES, stream, a); }
#else
    a.ph_lo = 0; a.ph_hi = N_PHASES;
    hipLaunchKernelGGL(fwd, dim3(grid), dim3(NWAVES * 64), LDS_BYTES, stream, a);
#endif
}
```

```cpp
#include <hip/hip_runtime.h>
#include <cstdio>
#include <cstdint>

#ifndef MK_MULTI
#define MK_MULTI 0
#endif

__device__ __forceinline__ int opqv(int x) { asm volatile("" : "+v"(x)); return x; }
__device__ __forceinline__ int opq() { int z = 0; asm volatile("" : "+s"(z)); return z; }
namespace pg8 {
#define PG8_LAS __attribute__((address_space(3)))
typedef unsigned short bf16_t;
typedef short bf16x8 __attribute__((ext_vector_type(8)));
typedef float f32x4 __attribute__((ext_vector_type(4)));
typedef unsigned u32x4 __attribute__((ext_vector_type(4)));
typedef unsigned u32x2 __attribute__((ext_vector_type(2)));
constexpr int BM = 256, BK = 64, HALF = 128, HTB = HALF * BK * 2  , STAGE_BYTES = 8 * HTB, NXCD = 8, WGM = 8;

__host__ __device__ __forceinline__ int lds_byte(int r, int c) { const int st = (r >> 4) * 2 + (c >> 5), rr = r & 15, cc = c & 31, ob = rr * 64 + cc * 2; return st * 1024 + (ob ^ (((ob >> 9) & 1) << 5)); }
__host__ __device__ __forceinline__ void stage_rc(int b, int& R, int& C) { const int st = b / 1024, sb = b % 1024, swz = sb ^ (((sb >> 9) & 1) << 5); R = (st >> 1) * 16 + swz / 64; C = (st & 1) * 32 + (swz % 64) / 2; }
__host__ __device__ __forceinline__ int perm32(int rho) { const int n = rho >> 4, i = rho & 15; return 8 * (i >> 2) + 4 * n + (i & 3); }

struct Unit { int pm, pn, pb; };
struct Gemm { const bf16_t* A; const bf16_t* Bt; int lda, ldb, K; };

struct StaticOrder {
    int nM, nN, nwg, G, c;
    __host__ __device__ void init(int M, int N, int G_, int c_) { nM = M / BM; nN = N / BM; nwg = nM * nN; G = G_; c = c_; }
    __host__ __device__ bool next(int i, Unit& u) const {
        const long L = (long)i * G + c; if (L >= nwg) return false;
        int wgid = (int)L; { const int q = nwg / NXCD, r = nwg % NXCD, xcd = wgid % NXCD, off = wgid / NXCD; wgid = (xcd < r ? xcd * (q + 1) : r * (q + 1) + (xcd - r) * q) + off; }
        const int nig = WGM * nN, gid = wgid / nig, fm = gid * WGM, gsz = (nM - fm) < WGM ? (nM - fm) : WGM;
        u.pm = fm + ((wgid % nig) % gsz); u.pn = (wgid % nig) / gsz; u.pb = u.pn; return true;
    }
    __device__ __forceinline__ void a_ready(const Unit&) const {}
    __device__ __forceinline__ void done(const Unit&) const {}
};
struct GroupedOrder {
    const int* tile_e; int ntiles, G, c;
    __device__ __forceinline__ bool next(int i, Unit& u) const {
        const long L = (long)i * G + c; if (L >= (long)ntiles * 4) return false;
        const int pm = (int)(L >> 2), pl = (int)(L & 3);
        u.pm = pm; u.pn = pl; u.pb = __builtin_amdgcn_readfirstlane(tile_e[pm]) * 4 + pl; return true;
    }
    __device__ __forceinline__ void a_ready(const Unit&) const {}
    __device__ __forceinline__ void done(const Unit&) const {}
};

__device__ __forceinline__ unsigned cvt_pk_bf16(float lo, float hi) { unsigned r; asm volatile("v_cvt_pk_bf16_f32 %0, %1, %2" : "=v"(r) : "v"(lo), "v"(hi)); return r; }
__device__ __forceinline__ float bflo(unsigned w) { return __uint_as_float(w << 16); }
__device__ __forceinline__ float bfhi(unsigned w) { return __uint_as_float(w & 0xffff0000u); }
__device__ __forceinline__ float sigmoidf_(float x) { return 1.0f / (1.0f + __expf(-x)); }


struct EpiZG {
    static constexpr bool PERM = true, AFTER_DRAIN = false;
    bf16_t* Z; bf16_t* Gt; const float* gbias;
    __device__ __forceinline__ void operator()(const f32x4 (&acc)[2][2][4][2], const Unit& u, int wr, int wc, int fr, int fq) const {
        asm volatile("" : "+v"(fr), "+v"(fq));
        const int row0 = u.pm * BM + wr * 64 + fr;
        const bool gate = u.pn >= 8;
        const int colt = gate ? (u.pn - 8) * BM : u.pn * BM, ldc = gate ? 3072 : 2048;
        bf16_t* base = gate ? Gt : Z;
        const int col0 = colt + wc * 32 + 8 * fq;
        f32x4 bv[2][2];
#pragma unroll
        for (int bj = 0; bj < 2; ++bj)
#pragma unroll
            for (int n = 0; n < 2; ++n) bv[bj][n] = gate ? *(const f32x4*)(gbias + col0 + bj * HALF + 4 * n) : (f32x4){0.f, 0.f, 0.f, 0.f};
#pragma unroll
        for (int ai = 0; ai < 2; ++ai)
#pragma unroll
            for (int m = 0; m < 4; ++m) { bf16_t* rowp = base + (size_t)(row0 + ai * HALF + m * 16) * ldc + col0;
#pragma unroll
                for (int bj = 0; bj < 2; ++bj) { f32x4 v0 = acc[ai][bj][m][0] + bv[bj][0], v1 = acc[ai][bj][m][1] + bv[bj][1];
                    if (gate) {
#pragma unroll
                        for (int j = 0; j < 4; ++j) { v0[j] = sigmoidf_(v0[j]); v1[j] = sigmoidf_(v1[j]); } }
                    u32x4 w; w.x = cvt_pk_bf16(v0[0], v0[1]); w.y = cvt_pk_bf16(v0[2], v0[3]); w.z = cvt_pk_bf16(v1[0], v1[1]); w.w = cvt_pk_bf16(v1[2], v1[3]);
                    *(u32x4*)(rowp + bj * HALF) = w; } }
    }
};
struct EpiMix {
    static constexpr bool PERM = true, AFTER_DRAIN = false;
    bf16_t* O; const bf16_t* Gt; int gcol0; bool first;
    __device__ __forceinline__ void operator()(const f32x4 (&acc)[2][2][4][2], const Unit& u, int wr, int wc, int fr, int fq) const {
        asm volatile("" : "+v"(fr), "+v"(fq));
        const int row0 = u.pm * BM + wr * 64 + fr, col0 = u.pn * BM + wc * 32 + 8 * fq;
#pragma unroll
        for (int ai = 0; ai < 2; ++ai)
#pragma unroll
            for (int m = 0; m < 4; ++m) { const size_t row = (size_t)(row0 + ai * HALF + m * 16);
#pragma unroll
                for (int bj = 0; bj < 2; ++bj) {
                    const u32x4 gw = *(const u32x4*)(Gt + row * 3072 + gcol0 + col0 + bj * HALF);
                    bf16_t* op = O + row * 1024 + col0 + bj * HALF;
                    f32x4 v0 = acc[ai][bj][m][0], v1 = acc[ai][bj][m][1];
                    v0[0] *= bflo(gw.x); v0[1] *= bfhi(gw.x); v0[2] *= bflo(gw.y); v0[3] *= bfhi(gw.y);
                    v1[0] *= bflo(gw.z); v1[1] *= bfhi(gw.z); v1[2] *= bflo(gw.w); v1[3] *= bfhi(gw.w);
                    if (!first) { const u32x4 pw = *(const u32x4*)op;
                        v0[0] += bflo(pw.x); v0[1] += bfhi(pw.x); v0[2] += bflo(pw.y); v0[3] += bfhi(pw.y);
                        v1[0] += bflo(pw.z); v1[1] += bfhi(pw.z); v1[2] += bflo(pw.w); v1[3] += bfhi(pw.w); }
                    u32x4 w; w.x = cvt_pk_bf16(v0[0], v0[1]); w.y = cvt_pk_bf16(v0[2], v0[3]); w.z = cvt_pk_bf16(v1[0], v1[1]); w.w = cvt_pk_bf16(v1[2], v1[3]);
                    *(u32x4*)op = w; }
                asm volatile("" ::: "memory"); }
    }
};
struct EpiResid {
    static constexpr bool PERM = false, AFTER_DRAIN = false;
    float* X; const float* g1;
    __device__ __forceinline__ void operator()(const f32x4 (&acc)[2][2][4][2], const Unit& u, int wr, int wc, int fr, int fq) const {
        asm volatile("" : "+v"(fr), "+v"(fq));
        const int row0 = u.pm * BM + wr * 64 + fr, col0 = u.pn * BM + wc * 32 + 4 * fq;
        const float* gp = g1 + (size_t)((u.pm * BM) >> 12) * 6144 + col0;
        f32x4 gv[2][2];
#pragma unroll
        for (int bj = 0; bj < 2; ++bj)
#pragma unroll
            for (int n = 0; n < 2; ++n) gv[bj][n] = *(const f32x4*)(gp + bj * HALF + n * 16);
#pragma unroll
        for (int ai = 0; ai < 2; ++ai)
#pragma unroll
            for (int m = 0; m < 4; ++m) { float* rowp = X + (size_t)(row0 + ai * HALF + m * 16) * 1024 + col0;
#pragma unroll
                for (int bj = 0; bj < 2; ++bj)
#pragma unroll
                    for (int n = 0; n < 2; ++n) { f32x4* p = (f32x4*)(rowp + bj * HALF + n * 16); *p = *p + gv[bj][n] * acc[ai][bj][m][n]; } }
    }
};
struct EpiSwiGLU {
    static constexpr bool PERM = true, AFTER_DRAIN = false;
    bf16_t* O;
    __device__ __forceinline__ void operator()(const f32x4 (&acc)[2][2][4][2], const Unit& u, int wr, int wc, int fr, int fq) const {
        asm volatile("" : "+v"(fr), "+v"(fq));
        const int row0 = u.pm * BM + wr * 64 + fr, col0 = u.pn * HALF + wc * 32 + 8 * fq;
#pragma unroll
        for (int ai = 0; ai < 2; ++ai)
#pragma unroll
            for (int m = 0; m < 4; ++m) { bf16_t* op = O + (size_t)(row0 + ai * HALF + m * 16) * 512 + col0;
                float r[8];
#pragma unroll
                for (int n = 0; n < 2; ++n)
#pragma unroll
                    for (int j = 0; j < 4; ++j) { const float a = acc[ai][0][m][n][j], b = acc[ai][1][m][n][j]; r[n * 4 + j] = a * sigmoidf_(a) * b; }
                u32x4 w; w.x = cvt_pk_bf16(r[0], r[1]); w.y = cvt_pk_bf16(r[2], r[3]); w.z = cvt_pk_bf16(r[4], r[5]); w.w = cvt_pk_bf16(r[6], r[7]);
                *(u32x4*)op = w; }
    }
};
struct EpiY {
    static constexpr bool PERM = true, AFTER_DRAIN = false;
    bf16_t* O;
    __device__ __forceinline__ void operator()(const f32x4 (&acc)[2][2][4][2], const Unit& u, int wr, int wc, int fr, int fq) const {
        asm volatile("" : "+v"(fr), "+v"(fq));
        const int row0 = u.pm * BM + wr * 64 + fr, col0 = u.pn * BM + wc * 32 + 8 * fq;
#pragma unroll
        for (int ai = 0; ai < 2; ++ai)
#pragma unroll
            for (int m = 0; m < 4; ++m) { bf16_t* rowp = O + (size_t)(row0 + ai * HALF + m * 16) * 1024 + col0;
#pragma unroll
                for (int bj = 0; bj < 2; ++bj) { const f32x4 v0 = acc[ai][bj][m][0], v1 = acc[ai][bj][m][1];
                    u32x4 w; w.x = cvt_pk_bf16(v0[0], v0[1]); w.y = cvt_pk_bf16(v0[2], v0[3]); w.z = cvt_pk_bf16(v1[0], v1[1]); w.w = cvt_pk_bf16(v1[2], v1[3]);
                    *(u32x4*)(rowp + bj * HALF) = w; } }
    }
};

template <class Epi, class Sched, bool ALIGN_EPI = false, bool SP2 = false>
__device__ __forceinline__ void gemm_phase(PG8_LAS unsigned char* lds, const Gemm g, const Sched& S, const Epi& E) {
    const int tid = opqv((int)threadIdx.x), wid = __builtin_amdgcn_readfirstlane(tid >> 6), lane = tid & 63, wr = wid >> 2, wc = wid & 3, fr = lane & 15, fq = lane >> 4;
    const int K = g.K, nt = K / BK, lda = g.lda, ldb = g.ldb;
    unsigned voffA[2], voffB[2];
#pragma unroll
    for (int i = 0; i < 2; ++i) { int R, C; stage_rc(tid * 16 + i * 8192, R, C); const int Rb = Epi::PERM ? ((R & ~31) + perm32(R & 31)) : R;
        voffA[i] = (unsigned)(R * lda + C) * 2u; voffB[i] = (unsigned)(Rb * ldb + C) * 2u; }
    const size_t kstep = (size_t)(BK * 2);
    const size_t hstepA = (size_t)HALF * lda * 2, hstepB = (size_t)HALF * ldb * 2;
    const size_t tstepA = 2 * hstepA, tstepB = 2 * hstepB;
    const unsigned ldsw = (unsigned)wid * 1024u;
    const int aoff = lds_byte(wr * 64 + fr, fq * 8), boff = lds_byte(wc * 32 + fr, fq * 8);
#define PG8_SA(b, h) (((b) * 2 + (h)) * HTB)
#define PG8_SB(b, h) ((4 + (b) * 2 + (h)) * HTB)
#define PG8_STAGE(bufoff, gbase, voff) do { _Pragma("unroll") for (int _i = 0; _i < 2; ++_i) \
        __builtin_amdgcn_global_load_lds((const unsigned*)((const char*)(gbase) + (voff)[_i]), (PG8_LAS unsigned*)(lds + (bufoff) + ldsw + _i * 8192), 16, 0, 0); } while (0)
#define PG8_LDA(dst, b, h) do { _Pragma("unroll") for (int m = 0; m < 4; ++m) _Pragma("unroll") for (int k = 0; k < 2; ++k) dst[m][k] = *(const PG8_LAS bf16x8*)(lds + PG8_SA(b, h) + aoff + m * 2048 + k * 1024); } while (0)
#define PG8_LDB(dst, b, h) do { _Pragma("unroll") for (int n = 0; n < 2; ++n) _Pragma("unroll") for (int k = 0; k < 2; ++k) dst[n][k] = *(const PG8_LAS bf16x8*)(lds + PG8_SB(b, h) + boff + n * 2048 + k * 1024); } while (0)
#define PG8_MMA(ai, bj, At, Bt) do { __builtin_amdgcn_s_setprio(1); _Pragma("unroll") for (int m = 0; m < 4; ++m) _Pragma("unroll") for (int n = 0; n < 2; ++n) _Pragma("unroll") for (int k = 0; k < 2; ++k) \
        acc[ai][bj][m][n] = __builtin_amdgcn_mfma_f32_16x16x32_bf16(Bt[n][k], At[m][k], acc[ai][bj][m][n], 0, 0, 0); __builtin_amdgcn_s_setprio(0); } while (0)
#define PG8_WAIT_V(n) asm volatile("s_waitcnt vmcnt(" #n ")" ::: "memory")
#define PG8_WAIT_L(n) asm volatile("s_waitcnt lgkmcnt(" #n ")" ::: "memory")
#define PG8_BAR __builtin_amdgcn_s_barrier()
#define PG8_SCHED __builtin_amdgcn_sched_barrier(0)
    Unit cur, nxt; int ui = 0;
    if (!S.next(0, cur)) return;
    f32x4 acc[2][2][4][2];
#pragma unroll
    for (int a = 0; a < 2; ++a)
#pragma unroll
        for (int b = 0; b < 2; ++b)
#pragma unroll
            for (int m = 0; m < 4; ++m)
#pragma unroll
                for (int n = 0; n < 2; ++n) acc[a][b][m][n] = (f32x4){0.f, 0.f, 0.f, 0.f};
    bf16x8 At[4][2], B0[2][2], B1[2][2];
    const char* cA = (const char*)g.A + (size_t)cur.pm * tstepA; const char* cB = (const char*)g.Bt + (size_t)cur.pb * tstepB;
    S.a_ready(cur);
    if constexpr (SP2) {
        PG8_STAGE(PG8_SB(0, 0), cB, voffB); PG8_STAGE(PG8_SB(0, 1), cB + hstepB, voffB); PG8_STAGE(PG8_SA(0, 0), cA, voffA); PG8_STAGE(PG8_SA(0, 1), cA + hstepA, voffA);
        if (wr == 1) PG8_BAR;
        PG8_WAIT_V(2); PG8_BAR;
        PG8_STAGE(PG8_SB(1, 0), cB + kstep, voffB); PG8_STAGE(PG8_SA(1, 0), cA + kstep, voffA); PG8_STAGE(PG8_SB(1, 1), cB + hstepB + kstep, voffB);
        PG8_WAIT_V(6); PG8_BAR;
    } else {
        PG8_STAGE(PG8_SB(0, 0), cB, voffB); PG8_STAGE(PG8_SA(0, 0), cA, voffA); PG8_STAGE(PG8_SB(0, 1), cB + hstepB, voffB); PG8_STAGE(PG8_SA(0, 1), cA + hstepA, voffA);
        if (wr == 1) PG8_BAR;
        PG8_WAIT_V(4); PG8_BAR;
        PG8_STAGE(PG8_SB(1, 0), cB + kstep, voffB); PG8_STAGE(PG8_SA(1, 0), cA + kstep, voffA); PG8_STAGE(PG8_SB(1, 1), cB + hstepB + kstep, voffB);
        PG8_WAIT_V(6); PG8_BAR;
    }
    for (;;) {
        const bool has_next = S.next(ui + 1, nxt);
        const char* nA = has_next ? (const char*)g.A + (size_t)nxt.pm * tstepA : cA; const char* nB = has_next ? (const char*)g.Bt + (size_t)nxt.pb * tstepB : cB;
#pragma unroll 1
        for (int t = 0; t < nt; t += 2) {
            const bool last = (t == nt - 2);
            const char* a1 = cA + (size_t)(t + 1) * kstep;
            const char* a2 = last ? nA : cA + (size_t)(t + 2) * kstep; const char* b2 = last ? nB : cB + (size_t)(t + 2) * kstep;
            const char* a3 = a2 + kstep; const char* b3 = b2 + kstep;
            if (last && has_next) S.a_ready(nxt);
            if constexpr (SP2) {
            PG8_LDB(B0, 0, 0); PG8_LDB(B1, 0, 1); PG8_SCHED; PG8_LDA(At, 0, 0); PG8_STAGE(PG8_SA(1, 1), a1 + hstepA, voffA);
            PG8_WAIT_V(8); PG8_WAIT_L(0); PG8_BAR; PG8_MMA(0, 0, At, B0); PG8_MMA(0, 1, At, B1); PG8_BAR; PG8_SCHED;
            PG8_LDA(At, 0, 1); PG8_STAGE(PG8_SB(0, 0), b2, voffB); PG8_STAGE(PG8_SB(0, 1), b2 + hstepB, voffB); PG8_STAGE(PG8_SA(0, 0), a2, voffA);
            PG8_WAIT_V(8); PG8_WAIT_L(0); PG8_BAR; PG8_MMA(1, 0, At, B0); PG8_MMA(1, 1, At, B1); PG8_BAR; PG8_SCHED;
            PG8_LDB(B0, 1, 0); PG8_LDB(B1, 1, 1); PG8_SCHED; PG8_LDA(At, 1, 0); PG8_STAGE(PG8_SA(0, 1), a2 + hstepA, voffA);
            PG8_WAIT_V(8); PG8_WAIT_L(0); PG8_BAR; PG8_MMA(0, 0, At, B0); PG8_MMA(0, 1, At, B1); PG8_BAR; PG8_SCHED;
            PG8_LDA(At, 1, 1); PG8_STAGE(PG8_SB(1, 0), b3, voffB); PG8_STAGE(PG8_SB(1, 1), b3 + hstepB, voffB); PG8_STAGE(PG8_SA(1, 0), a3, voffA);
            PG8_WAIT_V(8); PG8_WAIT_L(0); PG8_BAR; PG8_MMA(1, 0, At, B0); PG8_MMA(1, 1, At, B1); PG8_BAR; PG8_SCHED;
            } else {
            PG8_LDB(B0, 0, 0); PG8_SCHED; PG8_LDA(At, 0, 0); PG8_STAGE(PG8_SA(1, 1), a1 + hstepA, voffA);
            PG8_WAIT_L(8); PG8_BAR; PG8_WAIT_L(0); PG8_MMA(0, 0, At, B0); PG8_BAR; PG8_SCHED;
            PG8_LDB(B1, 0, 1); PG8_STAGE(PG8_SB(0, 0), b2, voffB);
            PG8_BAR; PG8_WAIT_L(0); PG8_MMA(0, 1, At, B1); PG8_BAR;
            PG8_LDA(At, 0, 1); PG8_STAGE(PG8_SA(0, 0), a2, voffA);
            PG8_BAR; PG8_WAIT_L(0); PG8_MMA(1, 0, At, B0); PG8_BAR; PG8_SCHED;
            PG8_STAGE(PG8_SB(0, 1), b2 + hstepB, voffB);
            PG8_WAIT_V(6); PG8_BAR; PG8_MMA(1, 1, At, B1); PG8_BAR;
            PG8_LDB(B0, 1, 0); PG8_SCHED; PG8_LDA(At, 1, 0); PG8_STAGE(PG8_SA(0, 1), a2 + hstepA, voffA);
            PG8_WAIT_L(8); PG8_BAR; PG8_WAIT_L(0); PG8_MMA(0, 0, At, B0); PG8_BAR; PG8_SCHED;
            PG8_LDB(B1, 1, 1); PG8_STAGE(PG8_SB(1, 0), b3, voffB);
            PG8_BAR; PG8_WAIT_L(0); PG8_MMA(0, 1, At, B1); PG8_BAR;
            PG8_LDA(At, 1, 1); PG8_STAGE(PG8_SA(1, 0), a3, voffA);
            PG8_BAR; PG8_WAIT_L(0); PG8_MMA(1, 0, At, B0); PG8_BAR; PG8_SCHED;
            PG8_STAGE(PG8_SB(1, 1), b3 + hstepB, voffB);
            PG8_WAIT_V(6); PG8_BAR; PG8_MMA(1, 1, At, B1); PG8_BAR;
            }
        }
        if constexpr (ALIGN_EPI) { if (wr == 0) PG8_BAR; }
        if constexpr (!Epi::AFTER_DRAIN) { E(acc, cur, wr, wc, fr, fq); S.done(cur); }
        if (!has_next) break;
#pragma unroll
        for (int a = 0; a < 2; ++a)
#pragma unroll
            for (int b = 0; b < 2; ++b)
#pragma unroll
                for (int m = 0; m < 4; ++m)
#pragma unroll
                    for (int n = 0; n < 2; ++n) acc[a][b][m][n] = (f32x4){0.f, 0.f, 0.f, 0.f};
        cur = nxt; cA = nA; cB = nB; ++ui;
        if constexpr (ALIGN_EPI) { if (wr == 1) PG8_BAR; }
    }
    PG8_WAIT_V(0);
    if constexpr (!ALIGN_EPI) { if (wr == 0) PG8_BAR; }
    PG8_BAR;
    if constexpr (Epi::AFTER_DRAIN) { E.fused(acc, cur, wr, wc, fr, fq, lds, wid, lane); S.done(cur); }
#undef PG8_SA
#undef PG8_SB
#undef PG8_STAGE
#undef PG8_LDA
#undef PG8_LDB
#undef PG8_MMA
#undef PG8_WAIT_V
#undef PG8_WAIT_L
#undef PG8_BAR
#undef PG8_SCHED
}
}

#ifndef ATTN_FAST
#define ATTN_FAST 1
#endif
#include <hip/hip_bf16.h>
#include <cmath>
namespace attn_body {
using bf16=__hip_bfloat16;
using bf16x8=__attribute__((ext_vector_type(8)))short;
using s16x4=__attribute__((ext_vector_type(4)))short;
using f32x16=__attribute__((ext_vector_type(16)))float;
using u32x4=__attribute__((ext_vector_type(4)))unsigned;
constexpr int BATCH=8,SEQ=4096,D=64,DM=2048,DMO=512;
constexpr int NW=8,QBLK=32,QB=QBLK*NW,KVBLK=64,NQB=SEQ/QB;
constexpr int ATTN_PITCH=DM, ATTN_UNIT_ROWS=QB;
__device__ __forceinline__ int crow(int r,int hi){return (r&3)+8*(r>>2)+4*hi;}
#define SBAR() __builtin_amdgcn_sched_barrier(0)
__device__ __forceinline__ void cmask(f32x16&p0,f32x16&p1,int jb,int wid){
  if(jb>(wid>>1)){ const float NEG=-INFINITY;
    #pragma unroll
    for(int r=0;r<16;++r){p0[r]=NEG;p1[r]=NEG;} }
}

constexpr int NSLOT=3, SLOTB=8192;
constexpr int LDS_K=0, LDS_V=NSLOT*SLOTB, LDS_WS=2*NSLOT*SLOTB, LDS_OST=LDS_WS+NW*64*4, LDS_BYTES=LDS_OST+NW*4096;
constexpr float C2=0.125f*1.4426950408889634f;
__device__ __forceinline__ void glds16(const void*gsrc,unsigned lds_dst){unsigned keep;
  asm volatile("s_mov_b32 %0, m0\n\ts_mov_b32 m0, %2\n\ts_nop 0\n\tglobal_load_lds_dwordx4 %1, off\n\ts_mov_b32 m0, %0":"=&s"(keep):"v"(gsrc),"s"(lds_dst):"memory");}
__device__ __forceinline__ float max3f(float a,float b,float c){float r;asm("v_max3_f32 %0, %1, %2, %3":"=v"(r):"v"(a),"v"(b),"v"(c));return r;}
__device__ __forceinline__ float max2f(float a,float b){float r;asm("v_max_f32_e32 %0, %1, %2":"=v"(r):"v"(a),"v"(b));return r;}
__device__ __forceinline__ float fadd_s(float a,float b){float r;asm("v_add_f32_e32 %0, %1, %2":"=v"(r):"v"(a),"v"(b));return r;}
__device__ __forceinline__ float fsub_s(float a,float b){float r;asm("v_sub_f32_e32 %0, %1, %2":"=v"(r):"v"(a),"v"(b));return r;}
typedef float f32x2_t __attribute__((ext_vector_type(2))); typedef __bf16 bf16x2_t __attribute__((ext_vector_type(2)));
__device__ __forceinline__ unsigned cvtpk_s(float lo,float hi){f32x2_t v={lo,hi};bf16x2_t b=__builtin_convertvector(v,bf16x2_t);return __builtin_bit_cast(unsigned,b);}
#define WAIT_BAR(N) asm volatile("s_waitcnt vmcnt(" #N ") lgkmcnt(0)\n\ts_barrier":::"memory")

__device__ __forceinline__ void qkt(f32x16&p0,f32x16&p1,const char*Kslot,const bf16x8*qr,const f32x16&negm,int r32,int hi){
  const char*kb=Kslot+hi*1024+r32*16;
  #pragma unroll
  for(int d0=0;d0<4;++d0){
    const bf16x8 b0=*reinterpret_cast<const bf16x8*>(kb+d0*2048);
    const bf16x8 b1=*reinterpret_cast<const bf16x8*>(kb+d0*2048+512);
    if(d0==0){p0=__builtin_amdgcn_mfma_f32_32x32x16_bf16(b0,qr[0],negm,0,0,0);p1=__builtin_amdgcn_mfma_f32_32x32x16_bf16(b1,qr[0],negm,0,0,0);}
    else{p0=__builtin_amdgcn_mfma_f32_32x32x16_bf16(b0,qr[d0],p0,0,0,0);p1=__builtin_amdgcn_mfma_f32_32x32x16_bf16(b1,qr[d0],p1,0,0,0);}}
}
typedef __attribute__((address_space(3))) const char* lds_cptr;
typedef short v4i16_t __attribute__((ext_vector_type(4)));
__device__ __forceinline__ void kload8(bf16x8*kf,lds_cptr kp){
  kf[0]=*(const __attribute__((address_space(3))) bf16x8*)(kp);      kf[1]=*(const __attribute__((address_space(3))) bf16x8*)(kp+512);
  kf[2]=*(const __attribute__((address_space(3))) bf16x8*)(kp+2048); kf[3]=*(const __attribute__((address_space(3))) bf16x8*)(kp+2560);
  kf[4]=*(const __attribute__((address_space(3))) bf16x8*)(kp+4096); kf[5]=*(const __attribute__((address_space(3))) bf16x8*)(kp+4608);
  kf[6]=*(const __attribute__((address_space(3))) bf16x8*)(kp+6144); kf[7]=*(const __attribute__((address_space(3))) bf16x8*)(kp+6656);
}
__device__ __forceinline__ void kload2(bf16x8*kf,lds_cptr kp,int j){ kf[2*j]=*(const __attribute__((address_space(3))) bf16x8*)(kp+j*2048); kf[2*j+1]=*(const __attribute__((address_space(3))) bf16x8*)(kp+j*2048+512); }
__device__ __forceinline__ s16x4 vtr(lds_cptr p){ return __builtin_bit_cast(s16x4,__builtin_amdgcn_ds_read_tr16_b64_v4i16((__attribute__((address_space(3))) v4i16_t*)p)); }
__device__ __forceinline__ float rowmax(const f32x16&p0,const f32x16&p1){
  float a=max3f(p0[0],p0[1],p1[0]),b=max3f(p0[2],p0[3],p1[1]);a=max3f(a,p1[2],p1[3]);
  #pragma unroll
  for(int r=4;r<16;r+=4){a=max3f(a,p0[r],p0[r+1]);b=max3f(b,p0[r+2],p0[r+3]);a=max3f(a,p1[r],p1[r+1]);b=max3f(b,p1[r+2],p1[r+3]);}
  const float m=max2f(a,b);
  auto rr=__builtin_amdgcn_permlane32_swap(__float_as_uint(m),__float_as_uint(m),false,false);
  return max2f(__uint_as_float(rr[0]),__uint_as_float(rr[1]));
}
__device__ __forceinline__ void pv(f32x16*o,int vb,bf16x8 pa0,bf16x8 pa1,bf16x8 pa2,bf16x8 pa3){
  #pragma unroll
  for(int d0=0;d0<2;++d0){s16x4 lo[4],hi[4];
    #pragma unroll
    for(int ks=0;ks<4;++ks){
      asm volatile("ds_read_b64_tr_b16 %0,%1 offset:%c2":"=&v"(lo[ks]):"v"(vb),"i"(d0*4096+ks*1024):"memory");
      asm volatile("ds_read_b64_tr_b16 %0,%1 offset:%c2":"=&v"(hi[ks]):"v"(vb),"i"(d0*4096+ks*1024+512):"memory");}
    asm volatile("s_waitcnt lgkmcnt(0)":::"memory");SBAR();
    #define PK(k) (bf16x8){lo[k][0],lo[k][1],lo[k][2],lo[k][3],hi[k][0],hi[k][1],hi[k][2],hi[k][3]}
    o[d0]=__builtin_amdgcn_mfma_f32_32x32x16_bf16(pa0,PK(0),o[d0],0,0,0);
    o[d0]=__builtin_amdgcn_mfma_f32_32x32x16_bf16(pa1,PK(1),o[d0],0,0,0);
    o[d0]=__builtin_amdgcn_mfma_f32_32x32x16_bf16(pa2,PK(2),o[d0],0,0,0);
    o[d0]=__builtin_amdgcn_mfma_f32_32x32x16_bf16(pa3,PK(3),o[d0],0,0,0);
    #undef PK
  }
}

#ifndef ATTN_STORE16
#define ATTN_STORE16(p,v) (*(u32x4*)(p)=(v))
#endif
template<int THRL> __device__ __forceinline__ void attn_unit(int b,int qb,const bf16*Q,const bf16*__restrict__ K,const bf16*__restrict__ V,bf16*O,char*shm){
  const int tid=opqv((int)threadIdx.x),lane=tid&63,r32=lane&31,hi=lane>>5; const int wid=__builtin_amdgcn_readfirstlane(tid>>6);
  const long rowbase=(long)b*SEQ; const int q0=qb*QB;
  const bf16*Qw=Q+(rowbase+q0+wid*QBLK)*DM;
  const bf16*Kh=K+rowbase*DM,*Vh=V+rowbase*DM;
  const unsigned lds0=(unsigned)(uintptr_t)shm;
  float*wsf=(float*)(shm+LDS_WS)+wid*64;
  const bf16*ksrc=Kh+(long)lane*DM+wid*8;
  const bf16*vsrc=Vh+(long)(16*(wid&3)+(lane>>2))*DM+(wid>>2)*32+(lane&3)*8;
  const unsigned kdst=lds0+LDS_K+wid*1024, vdst=lds0+LDS_V+wid*1024;
  #define DMA_K(t,slot) glds16(ksrc+(long)(t)*KVBLK*DM,(unsigned)__builtin_amdgcn_readfirstlane(kdst+(slot)))
  #define DMA_V(t,slot) glds16(vsrc+(long)(t)*KVBLK*DM,(unsigned)__builtin_amdgcn_readfirstlane(vdst+(slot)))
  const int vb0=(int)(lds0+LDS_V)+((lane>>4)&1)*32+(lane&3)*8+(4*hi+((lane&15)>>2))*64;
  const char*Kbase=shm+LDS_K; bf16x8 kf[8];
  const lds_cptr shm3=(lds_cptr)shm; const lds_cptr kp0=shm3+LDS_K+hi*1024+r32*16; const lds_cptr vp0=shm3+LDS_V+((lane>>4)&1)*32+(lane&3)*8+(4*hi+((lane&15)>>2))*64;
  const int NT=(q0+QB)/KVBLK;
  DMA_K(0,0);DMA_V(0,0);DMA_K(1,SLOTB);
  bf16x8 qr[4];
  #pragma unroll
  for(int d0=0;d0<4;++d0)qr[d0]=*reinterpret_cast<const bf16x8*>(&Qw[(long)r32*DM+d0*16+hi*8]);
  float mhat=0.f,l_reg=0.f;f32x16 o[2];o[0]=f32x16{};o[1]=f32x16{};f32x16 negm=f32x16{};asm volatile("":"+v"(negm));
  #define CMASK(P0,P1,t) do{int jb_=(t)-(NT-4); if(jb_>=0)cmask(P0,P1,jb_,wid);}while(0)
  bool resc=false;
  #define START(P0,P1) do{ const float rm=rowmax(P0,P1); resc=false; \
    { const float dl=rm; mhat=fadd_s(mhat,dl); \
      _Pragma("unroll") for(int r=0;r<16;++r){P0[r]=fsub_s(P0[r],dl);P1[r]=fsub_s(P1[r],dl);} \
      _Pragma("unroll") for(int r=0;r<16;++r)negm[r]=-mhat; asm volatile("":"+v"(negm)); } \
    _Pragma("unroll") for(int r=0;r<16;++r)P0[r]=__builtin_amdgcn_exp2f(P0[r]); }while(0)
  #define RESC() do{ if(resc){ asm volatile("s_waitcnt lgkmcnt(0)":::"memory"); \
      _Pragma("unroll") for(int d_=0;d_<2;++d_) _Pragma("unroll") for(int r=0;r<16;++r)o[d_][r]*=wsf[crow(r,hi)]; } }while(0)
  f32x16 pA0,pA1,pB0,pB1;
  int sl_prev=0,sl_cur=0,sl_next=SLOTB;
  #define ROT() do{sl_prev=sl_cur;sl_cur=sl_next;sl_next=(sl_next==(NSLOT-1)*SLOTB)?0:sl_next+SLOTB;}while(0)
  DMA_K(2,2*SLOTB);
  WAIT_BAR(3);
  qkt(pA0,pA1,Kbase,qr,negm,r32,hi);asm volatile("s_nop 15\n\ts_nop 7":"+v"(pA0),"+v"(pA1));CMASK(pA0,pA1,0);
  START(pA0,pA1);
  _Pragma("unroll") for(int r=0;r<16;++r)pA1[r]=__builtin_amdgcn_exp2f(pA1[r]);
  WAIT_BAR(0);
  DMA_K(3,0);DMA_V(1,SLOTB);
  ROT();
  kload8(kf,kp0+sl_cur);
  WAIT_BAR(2);
  s16x4 vlo[8],vhi[8]; u32x4 pw0,pw1,pw2,pw3;
  #define PKW(P,B) cvtpk_s(P[B],P[B+1])
  #define PAF(k) __builtin_bit_cast(bf16x8,pw##k)
  #define VFR(i) (bf16x8){vlo[i][0],vlo[i][1],vlo[i][2],vlo[i][3],vhi[i][0],vhi[i][1],vhi[i][2],vhi[i][3]}
  #define PIN(x) asm volatile("":"+v"(x))
  #define MX3(a,b,c) __builtin_fmaxf(__builtin_fmaxf((a),(b)),(c))
  #define GAPA(MF,A0,A1,A2,A3,W0,W1,PW) do{ MF; sacc+=A0; sacc+=A1; sacc+=A2; sacc+=A3; PIN(sacc); W0; W1; PIN(PW); SBAR(); }while(0)
  #define EX(v) __builtin_amdgcn_exp2f(v)
  #define GAPB(MF,X,B) do{ MF; X[B]=EX(X[B]); X[B+1]=EX(X[B+1]); X[B+2]=EX(X[B+2]); X[B+3]=EX(X[B+3]); PIN(X); SBAR(); }while(0)
  #define VRD(i) do{ vlo[i]=vtr(vp_+(((i)>>2)*4096+((i)&3)*1024)); vhi[i]=vtr(vp_+(((i)>>2)*4096+((i)&3)*1024+512)); }while(0)
  #define KRD(G,j) do{ if(G){ kload2(kf,kp0+sl_next,j); SBAR(); } }while(0)
  #define STEP(C0,C1,P0,P1,t,GK,GV,GL) do{ SBAR(); \
    const lds_cptr vp_=vp0+sl_prev; \
    VRD(0); SBAR(); float sacc=(P0[0]+P0[1]); \
    GAPA(C0=__builtin_amdgcn_mfma_f32_32x32x16_bf16(kf[0],qr[0],negm,0,0,0), P0[2],P0[3],P0[4],P0[5],     pw0[0]=PKW(P0,0), pw0[1]=PKW(P0,2), pw0); \
    VRD(4); SBAR(); GAPA(C1=__builtin_amdgcn_mfma_f32_32x32x16_bf16(kf[1],qr[0],negm,0,0,0), P0[6],P0[7],P0[8],P0[9],     pw0[2]=PKW(P0,4), pw0[3]=PKW(P0,6), pw0); \
    VRD(1); SBAR(); GAPA(C0=__builtin_amdgcn_mfma_f32_32x32x16_bf16(kf[2],qr[1],C0,0,0,0),   P0[10],P0[11],P0[12],P0[13], pw1[0]=PKW(P0,8), pw1[1]=PKW(P0,10), pw1); \
    VRD(5); SBAR(); GAPA(C1=__builtin_amdgcn_mfma_f32_32x32x16_bf16(kf[3],qr[1],C1,0,0,0),   P0[14],P0[15],P1[0],P1[1],   pw1[2]=PKW(P0,12),pw1[3]=PKW(P0,14), pw1); \
    VRD(2); SBAR(); GAPA(C0=__builtin_amdgcn_mfma_f32_32x32x16_bf16(kf[4],qr[2],C0,0,0,0),   P1[2],P1[3],P1[4],P1[5],     pw2[0]=PKW(P1,0), pw2[1]=PKW(P1,2), pw2); \
    VRD(6); SBAR(); GAPA(C1=__builtin_amdgcn_mfma_f32_32x32x16_bf16(kf[5],qr[2],C1,0,0,0),   P1[6],P1[7],P1[8],P1[9],     pw2[2]=PKW(P1,4), pw2[3]=PKW(P1,6), pw2); \
    VRD(3); SBAR(); GAPA(C0=__builtin_amdgcn_mfma_f32_32x32x16_bf16(kf[6],qr[3],C0,0,0,0),   P1[10],P1[11],P1[12],P1[13], pw3[0]=PKW(P1,8), pw3[1]=PKW(P1,10), pw3); \
    VRD(7); SBAR(); GAPA(C1=__builtin_amdgcn_mfma_f32_32x32x16_bf16(kf[7],qr[3],C1,0,0,0),   P1[14],P1[15],0.f,0.f,       pw3[2]=PKW(P1,12),pw3[3]=PKW(P1,14), pw3); \
    l_reg+=sacc; \
    if(GK){DMA_K((t)+3,sl_cur);} if(GV){DMA_V((t)+1,sl_next);} \
    CMASK(C0,C1,t); \
    { float a=MX3(C0[0],C0[1],C1[0]),b=MX3(C0[2],C0[3],C1[1]); a=MX3(a,C1[2],C1[3]); \
      _Pragma("unroll") for(int r=4;r<16;r+=4){a=MX3(a,C0[r],C0[r+1]);b=MX3(b,C0[r+2],C0[r+3]);a=MX3(a,C1[r],C1[r+1]);b=MX3(b,C1[r+2],C1[r+3]);} \
      float rm=__builtin_fmaxf(a,b); { auto rr=__builtin_amdgcn_permlane32_swap(__float_as_uint(rm),__float_as_uint(rm),false,false); rm=__builtin_fmaxf(__uint_as_float(rr[0]),__uint_as_float(rr[1])); } \
      resc=false; \
      if(__builtin_expect(__any(rm>(float)THRL),0)){ const float dl=__builtin_fmaxf(rm,0.f); mhat+=dl; \
        _Pragma("unroll") for(int r=0;r<16;++r){C0[r]-=dl;C1[r]-=dl;} \
        _Pragma("unroll") for(int r=0;r<16;++r)negm[r]=-mhat; asm volatile("":"+v"(negm)); \
        const float f=__builtin_amdgcn_exp2f(-dl); l_reg*=f; if(hi==0)wsf[r32]=f; resc=true; } } \
    SBAR(); \
    GAPB(o[0]=__builtin_amdgcn_mfma_f32_32x32x16_bf16(PAF(0),VFR(0),o[0],0,0,0), C0,0); \
    GAPB(o[1]=__builtin_amdgcn_mfma_f32_32x32x16_bf16(PAF(0),VFR(4),o[1],0,0,0), C0,4); \
    KRD(GL,0); GAPB(o[0]=__builtin_amdgcn_mfma_f32_32x32x16_bf16(PAF(1),VFR(1),o[0],0,0,0), C0,8); \
    KRD(GL,1); GAPB(o[1]=__builtin_amdgcn_mfma_f32_32x32x16_bf16(PAF(1),VFR(5),o[1],0,0,0), C0,12); \
    KRD(GL,2); GAPB(o[0]=__builtin_amdgcn_mfma_f32_32x32x16_bf16(PAF(2),VFR(2),o[0],0,0,0), C1,0); \
    KRD(GL,3); GAPB(o[1]=__builtin_amdgcn_mfma_f32_32x32x16_bf16(PAF(2),VFR(6),o[1],0,0,0), C1,4); \
    GAPB(o[0]=__builtin_amdgcn_mfma_f32_32x32x16_bf16(PAF(3),VFR(3),o[0],0,0,0), C1,8); \
    GAPB(o[1]=__builtin_amdgcn_mfma_f32_32x32x16_bf16(PAF(3),VFR(7),o[1],0,0,0), C1,12); \
    }while(0)
  int t=1;
  #undef CMASK
  #define CMASK(P0,P1,t) do{}while(0)
  for(;t+5<NT;t+=2){
    STEP(pB0,pB1,pA0,pA1,t,true,true,true);     WAIT_BAR(2); RESC(); ROT();
    STEP(pA0,pA1,pB0,pB1,t+1,true,true,true);   WAIT_BAR(2); RESC(); ROT();
  }
  #undef CMASK
  #define CMASK(P0,P1,t) do{int jb_=(t)-(NT-4); if(jb_>=0)cmask(P0,P1,jb_,wid);}while(0)
  #define ENDW(tt) do{ if((tt)+3<NT){WAIT_BAR(2);} else if((tt)+2<NT){WAIT_BAR(1);} else {WAIT_BAR(0);} }while(0)
  for(;t+1<NT;t+=2){
    STEP(pB0,pB1,pA0,pA1,t,(t+3<NT),(t+1<NT),(t+1<NT));       ENDW(t);   RESC(); ROT();
    STEP(pA0,pA1,pB0,pB1,t+1,(t+4<NT),(t+2<NT),(t+2<NT));     ENDW(t+1); RESC(); ROT();
  }
  STEP(pB0,pB1,pA0,pA1,NT-1,false,false,false); RESC();
  { float sacc=pB0[0]+pB0[1]; _Pragma("unroll") for(int r=2;r<16;++r)sacc+=pB0[r]; _Pragma("unroll") for(int r=0;r<16;++r)sacc+=pB1[r]; l_reg+=sacc;
    pw0=(u32x4){PKW(pB0,0),PKW(pB0,2),PKW(pB0,4),PKW(pB0,6)};pw1=(u32x4){PKW(pB0,8),PKW(pB0,10),PKW(pB0,12),PKW(pB0,14)};pw2=(u32x4){PKW(pB1,0),PKW(pB1,2),PKW(pB1,4),PKW(pB1,6)};pw3=(u32x4){PKW(pB1,8),PKW(pB1,10),PKW(pB1,12),PKW(pB1,14)};
    SBAR(); pv(o,vb0+sl_cur,PAF(0),PAF(1),PAF(2),PAF(3)); }
  #undef PKW
  #undef PAF
  #undef VFR
  #undef PIN
  #undef MX3
  #undef GAPA
  #undef GAPB
  #undef EX
  #undef VRD
  #undef KRD
  #undef STEP
  #undef ENDW
  {auto rr=__builtin_amdgcn_permlane32_swap(__float_as_uint(l_reg),__float_as_uint(l_reg),false,false);l_reg=__uint_as_float(rr[0])+__uint_as_float(rr[1]);}
  if(hi==0)wsf[32+r32]=l_reg;asm volatile("s_waitcnt lgkmcnt(0)":::"memory");
  float rli[16];
  #pragma unroll
  for(int r=0;r<16;++r)rli[r]=__builtin_amdgcn_rcpf(wsf[32+crow(r,hi)]);
  bf16*Ow=O+(rowbase+q0+wid*QBLK)*DMO;
  { bf16*stg=(bf16*)(shm+LDS_OST)+wid*2048;
    #pragma unroll
    for(int r=0;r<16;++r){const int orow=crow(r,hi);
      #pragma unroll
      for(int d0=0;d0<2;++d0)stg[orow*64+d0*32+r32]=__float2bfloat16(o[d0][r]*rli[r]);}
    asm volatile("s_waitcnt lgkmcnt(0)":::"memory");
    #pragma unroll
    for(int i=0;i<4;++i){const int row=i*8+(lane>>3),ch=lane&7; const u32x4 v=*(const u32x4*)(stg+row*64+ch*8); ATTN_STORE16(Ow+(long)row*DMO+ch*8,v);} }
  asm volatile("s_waitcnt lgkmcnt(0)\n\ts_barrier":::"memory");
  #undef DMA_K
  #undef DMA_V
  #undef CMASK
  #undef START
  #undef RESC
  #undef ROT
}
constexpr int ATTN_LDS_BYTES=LDS_BYTES;
#undef SBAR
#undef WAIT_BAR
}

constexpr int NB = 8, SEQ = 4096, T = NB * SEQ, D = 1024, DEPTH = 4;
constexpr int ZW = 2048, GWD = 3072, NCAT = ZW + GWD;
constexpr int ZQ = 256, ZK = 768, ZV = 1280, ZC = 1792;
constexpr int NEXP = 32, FF = 512, MAXSLOT = 2 * T + NEXP * 256;
constexpr float NORM_EPS = 1e-6f;
constexpr int NWAVES = 8;
constexpr int PH_PER_LAYER = 11, N_PHASES = 1 + DEPTH * PH_PER_LAYER + 1;

constexpr size_t MiB = 1u << 20;
constexpr size_t WS_CTL = 0, CTL_ZERO_BYTES = 1 * MiB;
constexpr size_t WS_MOD = 1 * MiB;
constexpr size_t WS_LAM = WS_MOD + (size_t)DEPTH * NB * 6144 * 4;
constexpr size_t WS_ROPE_C = 2 * MiB, WS_ROPE_S = 6 * MiB;
constexpr size_t WS_SSM = 10 * MiB;
constexpr size_t SSM_L_BYTES = 8192 + 8192 + 65536;
constexpr size_t WS_RWT = 11 * MiB;
constexpr size_t WS_TOKE = 12 * MiB, WS_TOKW = WS_TOKE + 256 * 1024, WS_TOKL = WS_TOKW + 256 * 1024, WS_TOKS = WS_TOKL + 256 * 1024;
constexpr size_t WS_WGBASE = 13 * MiB, WS_TILEE = WS_WGBASE + 64 * 1024;
constexpr size_t WS_E = 14 * MiB, WS_CIN = 18 * MiB;
constexpr size_t WS_WCAT = 24 * MiB;
constexpr size_t WS_WMIX = 64 * MiB;
constexpr size_t WS_WO = 72 * MiB;
constexpr size_t WS_WGLU = 80 * MiB;
constexpr size_t WS_W13 = 82 * MiB;
constexpr size_t WS_W2 = 146 * MiB;
constexpr size_t WS_H = 178 * MiB;
constexpr size_t WS_Z = 242 * MiB;
constexpr size_t WS_G = 370 * MiB;
constexpr size_t WS_O0 = 562 * MiB, WS_O1 = 626 * MiB;
constexpr size_t WS_AMIX = 690 * MiB;
constexpr size_t WS_MIXED = 754 * MiB;
constexpr size_t WS_AG = 242 * MiB;
constexpr size_t WS_ACT = 386 * MiB;
constexpr size_t WS_Y = 458 * MiB;
constexpr size_t WS_END = 818 * MiB;
static_assert(WS_AG + (size_t)MAXSLOT * 1024 * 2 <= WS_ACT && WS_ACT + (size_t)MAXSLOT * 512 * 2 <= WS_Y && WS_Y + (size_t)MAXSLOT * 1024 * 2 <= WS_AMIX, "moe overlay map");
constexpr int CW_BAR = 4096;
constexpr int CW_CNT = 16384;

constexpr int RING_OFF = 0, RING_BYTES = 143360;
constexpr int LDSCTL_OFF = RING_BYTES, MISC_OFF = LDSCTL_OFF + 320;
constexpr int LDS_BYTES = 147456;

#define GAS __attribute__((address_space(1)))
#define LAS __attribute__((address_space(3)))
typedef unsigned short bf16;
typedef unsigned v4u __attribute__((ext_vector_type(4)));
typedef unsigned v2u __attribute__((ext_vector_type(2)));
typedef float f32x4 __attribute__((ext_vector_type(4)));
typedef float f32x2 __attribute__((ext_vector_type(2)));
typedef short bf16x8 __attribute__((ext_vector_type(8)));
typedef GAS unsigned gu32;
#define RLX_AGENT __ATOMIC_RELAXED, __HIP_MEMORY_SCOPE_AGENT
#define LDS_WAIT() asm volatile("s_waitcnt lgkmcnt(0)" ::: "memory")
#define VM_WAIT() asm volatile("s_waitcnt vmcnt(0)" ::: "memory")
__device__ __forceinline__ unsigned f2bf(float f) { unsigned u = __builtin_bit_cast(unsigned, f); return (u + 0x7fffu + ((u >> 16) & 1u)) >> 16; }
__device__ __forceinline__ unsigned pk2(float lo, float hi) { return f2bf(lo) | (f2bf(hi) << 16); }
__device__ __forceinline__ float bf2f(unsigned short b) { return __uint_as_float(((unsigned)b) << 16); }
__device__ __forceinline__ float bflo(unsigned w) { return __uint_as_float(w << 16); }
__device__ __forceinline__ float bfhi(unsigned w) { return __uint_as_float(w & 0xffff0000u); }

#define XB_TMO      128
#define XB_XCNT(j)  (256  + 64 * (j))
#define XB_XSUB(j)  (1280 + 64 * (j))
#define XB_XGEN(j)  (2304 + 64 * (j))
#define XB_TOP      3328
#define XB_TOPGEN   3392
#define XCD_BAR_WORDS 3456
#define XB_SPIN_CAP (1u << 18)

__device__ __forceinline__ unsigned xb_ld(unsigned* p)              { return __hip_atomic_load(p, __ATOMIC_RELAXED, __HIP_MEMORY_SCOPE_AGENT); }
__device__ __forceinline__ unsigned xb_add(unsigned* p, unsigned v) { return __hip_atomic_fetch_add(p, v, __ATOMIC_RELAXED, __HIP_MEMORY_SCOPE_AGENT); }
__device__ __forceinline__ unsigned xb_xcc_id() { return (unsigned)__builtin_amdgcn_s_getreg((3 << 11) | 20) & 0xFu; }
#define XB_SPIN(cond, bar) do { unsigned _sp = 0; while (cond) { __builtin_amdgcn_s_sleep(1); \
    if ((++_sp & 255u) == 0u) { if (xb_ld(&(bar)[XB_TMO])) break; if (_sp > XB_SPIN_CAP) { atomicAdd(&(bar)[XB_TMO], 1u); break; } } } } while (0)

struct XcdBarrier {
    unsigned* bar; unsigned x;
    volatile LAS unsigned* st;
};

__device__ __forceinline__ XcdBarrier xcd_barrier_post(unsigned* bar, volatile LAS unsigned* st) {
    XcdBarrier b; b.bar = bar; b.x = xb_xcc_id(); b.st = st;
    if (threadIdx.x == 0) (void)xb_add(&bar[XB_XCNT(b.x)], 1u);
    return b;
}
__device__ __forceinline__ void xcd_barrier_complete(unsigned* bar, unsigned x, unsigned& nloc, unsigned& nx) {
    const unsigned G = gridDim.x * gridDim.y * gridDim.z;
    unsigned sum, cnt, mine, sp = 0u;
    for (;;) {
        sum = 0u; cnt = 0u; mine = 0u;
#pragma unroll
        for (unsigned j = 0; j < 16; ++j) { const unsigned c = xb_ld(&bar[XB_XCNT(j)]); sum += c; cnt += (c > 0u) ? 1u : 0u; mine = (j == x) ? c : mine; }
        if (sum == G) break;
        __builtin_amdgcn_s_sleep(1);
        if ((++sp & 255u) == 0u) { if (xb_ld(&bar[XB_TMO])) break; if (sp > XB_SPIN_CAP) { atomicAdd(&bar[XB_TMO], 1u); break; } }
    }
    nloc = mine > 0u ? mine : 1u; nx = cnt > 0u ? cnt : 1u;
}

__device__ __forceinline__ void xcd_barrier(const XcdBarrier& b) {
    asm volatile("s_waitcnt vmcnt(0)" ::: "memory");
    __syncthreads();
    if (threadIdx.x == 0) {
        unsigned* bar = b.bar;
        __builtin_amdgcn_s_waitcnt(0);
        unsigned nloc = b.st[0], nx = b.st[1];
        if (nloc == 0u) { xcd_barrier_complete(bar, b.x, nloc, nx); b.st[0] = nloc; b.st[1] = nx; }
        const unsigned old = xb_add(&bar[XB_XSUB(b.x)], 1u);
        const unsigned gen = old / nloc;
        if (old + 1u == (gen + 1u) * nloc) {
            __builtin_amdgcn_fence(__ATOMIC_RELEASE, "agent");
            asm volatile("s_waitcnt vmcnt(0)" ::: "memory");
            const unsigned og = xb_add(&bar[XB_TOP], 1u);
            const unsigned tg = og / nx;
            if (og + 1u == (tg + 1u) * nx) xb_add(&bar[XB_TOPGEN], 1u);
            else XB_SPIN(xb_ld(&bar[XB_TOPGEN]) == tg, bar);
            __builtin_amdgcn_fence(__ATOMIC_ACQUIRE, "agent");
            xb_add(&bar[XB_XGEN(b.x)], 1u);
            asm volatile("s_waitcnt vmcnt(0)" ::: "memory");
        } else {
            XB_SPIN(xb_ld(&bar[XB_XGEN(b.x)]) == gen, bar);
            __builtin_amdgcn_fence(__ATOMIC_ACQUIRE, "agent");
            asm volatile("s_waitcnt vmcnt(0)" ::: "memory");
        }
    }
    __syncthreads();
}


#define DPPF(v, ctrl) __builtin_bit_cast(float, __builtin_amdgcn_update_dpp(0, __builtin_bit_cast(int, (v)), (ctrl), 0xF, 0xF, false))
__device__ __forceinline__ float wave_sum(float v) {
    v += DPPF(v, 0xB1);
    v += DPPF(v, 0x4E);
    v += DPPF(v, 0x141);
    v += DPPF(v, 0x140);
    { auto rr = __builtin_amdgcn_permlane16_swap(__float_as_uint(v), __float_as_uint(v), false, false); v = __uint_as_float(rr[0]) + __uint_as_float(rr[1]); }
    { auto rr = __builtin_amdgcn_permlane32_swap(__float_as_uint(v), __float_as_uint(v), false, false); v = __uint_as_float(rr[0]) + __uint_as_float(rr[1]); }
    return v;
}
__device__ __forceinline__ float wave_max(float v) {
#pragma unroll
    for (int o = 1; o < 64; o <<= 1) v = fmaxf(v, __shfl_xor(v, o));
    return v;
}
__device__ __forceinline__ float sigmoidf_(float x) { return 1.0f / (1.0f + __expf(-x)); }
__device__ __forceinline__ float gelu_tanh(float x) { const float u = 0.7978845608028654f * (x + 0.044715f * x * x * x); return x / (1.0f + __expf(-2.0f * u)); }

__device__ __forceinline__ void tr_item(const float* __restrict__ W, int N, int k0, int n0, bf16* WT, int ldt, int drow0, int dcol0, LAS float* scr, int lane) {
#pragma unroll 8
    for (int i = 0; i < 32; ++i) { const int kk = 2 * i + (lane >> 5); scr[kk * 33 + (lane & 31)] = W[(size_t)(k0 + kk) * N + n0 + (lane & 31)]; }
    LDS_WAIT(); asm volatile("" ::: "memory");
    const int c = lane & 7;
#pragma unroll
    for (int j = 0; j < 4; ++j) { const int n = (lane >> 3) + 8 * j; const LAS float* s = scr + (8 * c) * 33 + n;
        v4u o; o.x = pk2(s[0 * 33], s[1 * 33]); o.y = pk2(s[2 * 33], s[3 * 33]); o.z = pk2(s[4 * 33], s[5 * 33]); o.w = pk2(s[6 * 33], s[7 * 33]);
        *(v4u*)(WT + (size_t)(drow0 + n) * ldt + dcol0 + 8 * c) = o; }
    LDS_WAIT(); asm volatile("" ::: "memory");
}

struct Args { const void* in[40]; float* out; unsigned char* ws; int ph_lo, ph_hi; };

enum { I_X = 0, I_C, I_POS, I_ADAW, I_ADAB, I_N1G, I_WIN, I_POOLW, I_POOLS, I_QNG, I_KNG, I_LQ1, I_LK1, I_LQ2, I_LK2, I_SUBLN,
       I_LAMRE, I_LAMIM, I_LOGDT, I_BRE, I_BIM, I_CRE, I_CIM, I_DSKIP, I_GLUW, I_GLUB, I_PROJA, I_PROJB, I_PROJC, I_GATEW, I_GATEB,
       I_WOUT, I_N2G, I_RGW, I_RGB, I_REW, I_REB, I_W1, I_W3, I_W2 };

__device__ __forceinline__ float lambda_init_of(int l) { return l == 0 ? 0.2f : (l == 1 ? 0.35550906759096926f : (l == 2 ? 0.47071302343358413f : 0.5560582041556841f)); }

__device__ __forceinline__ void prologue_phase(const Args& a, LAS unsigned char* lds) {
    const int z = opq(); (void)z;
    const int tid = opqv((int)threadIdx.x), lane = tid & 63, wave = __builtin_amdgcn_readfirstlane(tid >> 6); const int G = (int)gridDim.x, bx = (int)blockIdx.x;
    const int vcu = (G % 8 == 0) ? (bx % 8) * (G / 8) + bx / 8 : bx; const int gw = vcu * NWAVES + wave, NGW = G * NWAVES, gt = vcu * 512 + tid;
    (void)lane; (void)gw; (void)NGW; (void)gt; (void)bx;
    unsigned char* ws = (a.ws + z);
    const int NGT = G * 512;
    LAS float* scr = (LAS float*)(lds + RING_OFF + wave * 16384);
    {
        constexpr int I_IN = 16 * 64, I_GT = 16 * 96, I_PB = 8 * 32, I_PC = 4 * 32, I_WOI = 16 * 32, I_GL = 4 * 8;
        constexpr int PER_L = I_IN + I_GT + I_PB + I_PC + I_WOI + I_GL;
        for (int it = gw; it < DEPTH * PER_L; it += NGW) {
            const int l = it / PER_L; int r = it - l * PER_L;
            bf16* wcat = (bf16*)(ws + WS_WCAT) + (size_t)l * NCAT * 1024;
            bf16* wmix = (bf16*)(ws + WS_WMIX) + (size_t)l * 1024 * 1024;
            if (r < I_IN) { const int kb = r / 64, nb = r % 64; tr_item((const float*)a.in[z + I_WIN] + (size_t)l * 1024 * ZW, ZW, kb * 64, nb * 32, wcat, 1024, nb * 32, kb * 64, scr, lane); continue; } r -= I_IN;
            if (r < I_GT) { const int kb = r / 96, nb = r % 96; tr_item((const float*)a.in[z + I_GATEW] + (size_t)l * 1024 * GWD, GWD, kb * 64, nb * 32, wcat, 1024, ZW + nb * 32, kb * 64, scr, lane); continue; } r -= I_GT;
            if (r < I_PB) { const int kb = r / 32, nb = r % 32; tr_item((const float*)a.in[z + I_PROJB] + (size_t)l * 512 * 1024, 1024, kb * 64, nb * 32, wmix, 1024, nb * 32, 256 + kb * 64, scr, lane); continue; } r -= I_PB;
            if (r < I_PC) { const int kb = r / 32, nb = r % 32; tr_item((const float*)a.in[z + I_PROJC] + (size_t)l * 256 * 1024, 1024, kb * 64, nb * 32, wmix, 1024, nb * 32, 768 + kb * 64, scr, lane); continue; } r -= I_PC;
            if (r < I_WOI) { const int kb = r / 32, nb = r % 32; tr_item((const float*)a.in[z + I_WOUT] + (size_t)l * 1024 * 1024, 1024, kb * 64, nb * 32, (bf16*)(ws + WS_WO) + (size_t)l * 1024 * 1024, 1024, nb * 32, kb * 64, scr, lane); continue; } r -= I_WOI;
            { const int kb = r / 8, nb = r % 8; tr_item((const float*)a.in[z + I_GLUW] + (size_t)l * 256 * 256, 256, kb * 64, nb * 32, (bf16*)(ws + WS_WGLU) + (size_t)l * 256 * 256, 256, nb * 32, kb * 64, scr, lane); }
        }
    }
    for (int idx = gt; idx < DEPTH * 256 * 1024; idx += NGT) {
        const int l = idx >> 18, k = (idx >> 10) & 255, n = idx & 1023, g = k >> 6, c = k & 63;
        const float* pw = (const float*)a.in[z + I_POOLW] + ((size_t)(l * 4 + g) * 64 + c) * 64;
        const float* ps = (const float*)a.in[z + I_POOLS] + l * 256 + g * 64;
        const float* pa = (const float*)a.in[z + I_PROJA] + ((size_t)l * 256 + g * 64) * 1024 + n;
        float s = 0.f;
        for (int d = 0; d < 64; ++d) s += pw[d] * ps[d] * pa[(size_t)d * 1024];
        ((bf16*)(ws + WS_WMIX))[((size_t)l * 1024 + n) * 1024 + k] = (bf16)f2bf(s);
    }
    for (int idx = gt; idx < T * 32; idx += NGT) {
        const int t = idx >> 5, i = idx & 31;
        const float inv = powf(10000.0f, -(float)(2 * i) / 64.0f);
        const float ang = (float)((const int*)a.in[z + I_POS])[t] * inv;
        ((float*)(ws + WS_ROPE_C))[idx] = cosf(ang); ((float*)(ws + WS_ROPE_S))[idx] = sinf(ang);
    }
    for (int idx = gt; idx < DEPTH * 16 * 64; idx += NGT) {
        const int l = idx >> 10, g = (idx >> 6) & 15, p = idx & 63;
        const float lr = ((const float*)a.in[z + I_LAMRE])[idx], li = ((const float*)a.in[z + I_LAMIM])[idx];
        const float dt = expf(((const float*)a.in[z + I_LOGDT])[l * 16 + g]);
        const float mag = expf(lr * dt), ar = mag * cosf(li * dt), ai = mag * sinf(li * dt);
        const float nr = ar - 1.0f, ni = ai, den = lr * lr + li * li;
        const float kr = (nr * lr + ni * li) / den, ki = (ni * lr - nr * li) / den;
        unsigned char* base = ws + WS_SSM + (size_t)l * SSM_L_BYTES;
        ((f32x2*)base)[g * 64 + p] = (f32x2){ar, ai};
        float pr = ar, pi = ai;
#pragma unroll
        for (int q = 0; q < 6; ++q) { const float tr = pr * pr - pi * pi, ti = 2.0f * pr * pi; pr = tr; pi = ti; }
        ((f32x2*)(base + 8192))[g * 64 + p] = (f32x2){pr, pi};
        const float* br = (const float*)a.in[z + I_BRE] + (size_t)idx * 16; const float* bi = (const float*)a.in[z + I_BIM] + (size_t)idx * 16;
        bf16* bbh = (bf16*)(base + 16384) + (size_t)g * 128 * 16;
        for (int ch = 0; ch < 16; ++ch) { bbh[p * 16 + ch] = (bf16)f2bf(kr * br[ch] - ki * bi[ch]); bbh[(64 + p) * 16 + ch] = (bf16)f2bf(kr * bi[ch] + ki * br[ch]); }
    }
    if (gt < DEPTH) {
        const int l = gt; float s1 = 0.f, s2 = 0.f;
        for (int d = 0; d < 64; ++d) { s1 += ((const float*)a.in[z + I_LQ1])[l * 64 + d] * ((const float*)a.in[z + I_LK1])[l * 64 + d]; s2 += ((const float*)a.in[z + I_LQ2])[l * 64 + d] * ((const float*)a.in[z + I_LK2])[l * 64 + d]; }
        ((float*)(ws + WS_LAM))[l] = expf(s1) - expf(s2) + lambda_init_of(l);
    }
    for (int idx = gt; idx < DEPTH * 36 * 1024; idx += NGT) {
        const int l = idx / (36 * 1024), r = idx - l * 36 * 1024, j = r >> 10, k = r & 1023;
        ((float*)(ws + WS_RWT))[idx] = j < 4 ? ((const float*)a.in[z + I_RGW])[((size_t)l * 1024 + k) * 4 + j] : ((const float*)a.in[z + I_REW])[((size_t)l * 1024 + k) * 32 + (j - 4)];
    }
    {
        LAS float* cact = (LAS float*)(lds + RING_OFF);
        LAS float* red = (LAS float*)(lds + RING_OFF + 32768);
        __syncthreads();
        for (int i = tid; i < NB * 1024; i += 512) { const float cv = ((const float*)a.in[z + I_C])[i]; cact[i] = cv * sigmoidf_(cv); }
        __syncthreads();
        const int col = tid & 63, kp = tid >> 6;
        for (int u = vcu; u < DEPTH * 96; u += G) {
            const int l = u / 96, cg = u % 96;
            const float* w = (const float*)a.in[z + I_ADAW] + (size_t)l * 1024 * 6144 + cg * 64 + col;
            float acc[NB];
#pragma unroll
            for (int b = 0; b < NB; ++b) acc[b] = 0.f;
            for (int k = kp * 128; k < kp * 128 + 128; ++k) { const float wv = w[(size_t)k * 6144];
#pragma unroll
                for (int b = 0; b < NB; ++b) acc[b] += cact[b * 1024 + k] * wv; }
#pragma unroll
            for (int b = 0; b < NB; ++b) red[(kp * NB + b) * 64 + col] = acc[b];
            __syncthreads();
            { const int b = tid >> 6; float s = 0.f;
#pragma unroll
              for (int q = 0; q < 8; ++q) s += red[(q * NB + b) * 64 + col];
              ((float*)(ws + WS_MOD))[((size_t)l * NB + b) * 6144 + cg * 64 + col] = s + ((const float*)a.in[z + I_ADAB])[l * 6144 + cg * 64 + col]; }
            __syncthreads();
        }
    }
}

__device__ __forceinline__ void moe_weights_phase(const Args& a, int l, LAS unsigned char* lds) {
    const int z = opq(); (void)z;
    const int tid = opqv((int)threadIdx.x), lane = tid & 63, wave = __builtin_amdgcn_readfirstlane(tid >> 6); const int G = (int)gridDim.x, bx = (int)blockIdx.x;
    const int vcu = (G % 8 == 0) ? (bx % 8) * (G / 8) + bx / 8 : bx; const int gw = vcu * NWAVES + wave, NGW = G * NWAVES, gt = vcu * 512 + tid;
    (void)lane; (void)gw; (void)NGW; (void)gt; (void)bx;
    LAS float* scr = (LAS float*)(lds + RING_OFF + wave * 16384);
    bf16* w13 = (bf16*)((a.ws + z) + WS_W13); bf16* w2t = (bf16*)((a.ws + z) + WS_W2);
    for (int it = gw; it < NEXP * 768; it += NGW) {
        const int e = it / 768; int r = it - e * 768;
        if (r < 512) { const int which = r >> 8; r &= 255; const int kb = r >> 4, nb = r & 15, n0 = nb * 32;
            const float* W = (const float*)a.in[which ? I_W3 : I_W1] + ((size_t)l * NEXP + e) * 1024 * 512;
            tr_item(W, 512, kb * 64, n0, w13, 1024, e * 1024 + (n0 >> 7) * 256 + which * 128 + (n0 & 127), kb * 64, scr, lane); }
        else { r -= 512; const int kb = r >> 5, nb = r & 31;
            const float* W = (const float*)a.in[z + I_W2] + ((size_t)l * NEXP + e) * 512 * 1024;
            tr_item(W, 1024, kb * 64, nb * 32, w2t, 512, e * 1024 + nb * 32, kb * 64, scr, lane); }
    }
}

__device__ __forceinline__ void norm1_phase(const Args& a, int l, bool first, bool do_norm) {
    const int z = opq(); (void)z;
    const int tid = opqv((int)threadIdx.x), lane = tid & 63, wave = __builtin_amdgcn_readfirstlane(tid >> 6); const int G = (int)gridDim.x, bx = (int)blockIdx.x;
    const int vcu = (G % 8 == 0) ? (bx % 8) * (G / 8) + bx / 8 : bx; const int gw = vcu * NWAVES + wave, NGW = G * NWAVES, gt = vcu * 512 + tid;
    (void)lane; (void)gw; (void)NGW; (void)gt; (void)bx;
    unsigned char* ws = (a.ws + z);
    const float* mod = (const float*)(ws + WS_MOD);
    const bf16* Y = (const bf16*)(ws + WS_Y);
    const int* tok_slot = (const int*)(ws + WS_TOKS); const float* tok_w = (const float*)(ws + WS_TOKW);
    bf16* H = (bf16*)(ws + WS_H);
    for (int m = gw; m < T; m += NGW) {
        const int b = m >> 12;
        const f32x4* xr = (const f32x4*)((first ? (const float*)a.in[z + I_X] : (const float*)(a.out + z)) + (size_t)m * D) + lane;
        f32x4 v[4];
#pragma unroll
        for (int j = 0; j < 4; ++j) v[j] = xr[64 * j];
        if (!first) {
            const int s0 = tok_slot[2 * m], s1 = tok_slot[2 * m + 1]; const float w0 = tok_w[2 * m], w1 = tok_w[2 * m + 1];
            const float* g2 = mod + ((size_t)(l - 1) * NB + b) * 6144 + 5 * 1024;
            const v2u* y0 = (const v2u*)(Y + (size_t)s0 * D) + lane; const v2u* y1 = (const v2u*)(Y + (size_t)s1 * D) + lane;
#pragma unroll
            for (int j = 0; j < 4; ++j) { const v2u p = y0[64 * j], q = y1[64 * j]; const f32x4 g = *((const f32x4*)g2 + lane + 64 * j);
                v[j].x += g.x * (w0 * bflo(p.x) + w1 * bflo(q.x)); v[j].y += g.y * (w0 * bfhi(p.x) + w1 * bfhi(q.x));
                v[j].z += g.z * (w0 * bflo(p.y) + w1 * bflo(q.y)); v[j].w += g.w * (w0 * bfhi(p.y) + w1 * bfhi(q.y)); }
        }
        f32x4* xo = (f32x4*)((a.out + z) + (size_t)m * D) + lane;
#pragma unroll
        for (int j = 0; j < 4; ++j) xo[64 * j] = v[j];
        if (do_norm) {
            float ss = 0.f;
#pragma unroll
            for (int j = 0; j < 4; ++j) ss += (v[j].x * v[j].x + v[j].y * v[j].y) + (v[j].z * v[j].z + v[j].w * v[j].w);
            const float r = rsqrtf(wave_sum(ss) * (1.0f / D) + NORM_EPS);
            const float* mrow = mod + ((size_t)l * NB + b) * 6144;
            const f32x4* gn = (const f32x4*)((const float*)a.in[z + I_N1G] + l * D) + lane;
            v2u* ho = (v2u*)(H + (size_t)m * D) + lane;
#pragma unroll
            for (int j = 0; j < 4; ++j) { const f32x4 g = gn[64 * j], sh = *((const f32x4*)mrow + lane + 64 * j), sc = *((const f32x4*)(mrow + 1024) + lane + 64 * j);
                const f32x4 hh = (v[j] * r * g) * (sc + 1.0f) + sh;
                v2u o; o.x = pk2(hh.x, hh.y); o.y = pk2(hh.z, hh.w); ho[64 * j] = o; }
        }
    }
}

__device__ __forceinline__ void qkprep_phase(const Args& a, int l) {
    const int z = opq(); (void)z;
    const int tid = opqv((int)threadIdx.x), lane = tid & 63, wave = __builtin_amdgcn_readfirstlane(tid >> 6); const int G = (int)gridDim.x, bx = (int)blockIdx.x;
    const int vcu = (G % 8 == 0) ? (bx % 8) * (G / 8) + bx / 8 : bx; const int gw = vcu * NWAVES + wave, NGW = G * NWAVES, gt = vcu * 512 + tid;
    (void)lane; (void)gw; (void)NGW; (void)gt; (void)bx;
    unsigned char* ws = (a.ws + z); bf16* Z = (bf16*)(ws + WS_Z);
    const float qg = ((const float*)a.in[z + I_QNG])[l * 64 + lane], kg = ((const float*)a.in[z + I_KNG])[l * 64 + lane];
    for (int m = gw; m < T; m += NGW) {
        bf16* zr = Z + (size_t)m * ZW + ZQ + lane;
        const float c = ((const float*)(ws + WS_ROPE_C))[m * 32 + (lane & 31)], s = ((const float*)(ws + WS_ROPE_S))[m * 32 + (lane & 31)];
        float xv[16];
#pragma unroll
        for (int v = 0; v < 16; ++v) xv[v] = bf2f(zr[v * 64]);
#pragma unroll
        for (int v = 0; v < 16; ++v) {
            const float x = xv[v];
            const float r = rsqrtf(wave_sum(x * x) * (1.0f / 64.0f) + NORM_EPS);
            const float y = x * r * (v < 8 ? qg : kg);
            const float p = __shfl_xor(y, 32);
            float o = lane < 32 ? y * c - p * s : y * c + p * s;
            if (v < 8) o *= (ATTN_FAST ? 0.125f * 1.4426950408889634f : 0.125f);
            zr[v * 64] = (bf16)f2bf(o);
        }
    }
}

__device__ __forceinline__ void pool_phase(const Args& a, LAS unsigned char* lds) {
    const int z = opq(); (void)z;
    const int tid = opqv((int)threadIdx.x), lane = tid & 63, wave = __builtin_amdgcn_readfirstlane(tid >> 6); const int G = (int)gridDim.x, bx = (int)blockIdx.x;
    const int vcu = (G % 8 == 0) ? (bx % 8) * (G / 8) + bx / 8 : bx; const int gw = vcu * NWAVES + wave, NGW = G * NWAVES, gt = vcu * 512 + tid;
    (void)lane; (void)gw; (void)NGW; (void)gt; (void)bx;
    const bf16* Z = (const bf16*)((a.ws + z) + WS_Z); bf16* AM = (bf16*)((a.ws + z) + WS_AMIX);
    LAS float* U = (LAS float*)(lds + RING_OFF);
    for (int tl = vcu; tl < T / 64; tl += G) {
        const int m0 = tl * 64, s0 = m0 & (SEQ - 1);
        __syncthreads();
        for (int idx = tid; idx < 80 * 32; idx += 512) { const int r = idx >> 5, c8 = (idx & 31) * 8; const int sp = s0 - 16 + r;
            v4u w = (v4u){0u, 0u, 0u, 0u};
            if (sp >= 0) w = *(const v4u*)(Z + (size_t)(m0 - 16 + r) * ZW + c8);
            LAS float* u = U + r * 256 + c8;
            u[0] = bflo(w.x); u[1] = bfhi(w.x); u[2] = bflo(w.y); u[3] = bfhi(w.y); u[4] = bflo(w.z); u[5] = bfhi(w.z); u[6] = bflo(w.w); u[7] = bfhi(w.w); }
        __syncthreads();
        const int ch = tid & 255, th = tid >> 8, g = ch >> 6, w = 2 << g;
        for (int i = 0; i < 32; ++i) { const int t = th * 32 + i; float s = 0.f;
            for (int q = 0; q < w; ++q) s += U[(16 + t - q) * 256 + ch];
            const int cnt = (s0 + t + 1) < w ? (s0 + t + 1) : w;
            const float o = s / (float)cnt - U[(16 + t) * 256 + ch];
            AM[(size_t)(m0 + t) * D + ch] = (bf16)f2bf(o); }
    }
}

__device__ __forceinline__ void load_u16(const bf16* up, float (&u)[16]) {
    const v4u w0 = *(const v4u*)up, w1 = *(const v4u*)(up + 8);
    u[0] = bflo(w0.x); u[1] = bfhi(w0.x); u[2] = bflo(w0.y); u[3] = bfhi(w0.y); u[4] = bflo(w0.z); u[5] = bfhi(w0.z); u[6] = bflo(w0.w); u[7] = bfhi(w0.w);
    u[8] = bflo(w1.x); u[9] = bfhi(w1.x); u[10] = bflo(w1.y); u[11] = bfhi(w1.y); u[12] = bflo(w1.z); u[13] = bfhi(w1.z); u[14] = bflo(w1.w); u[15] = bfhi(w1.w);
}
constexpr int BUP = 132;
typedef short bf16x4_t __attribute__((ext_vector_type(4)));
struct BqT { bf16x4_t v[8]; };
__device__ __forceinline__ void ssm_bu16(const bf16* zrow0  , const bf16x4_t (&Bq)[8], LAS float* BU, int fr, int fq) {
    const bf16x4_t Af = *(const bf16x4_t*)(zrow0 + (size_t)fr * ZW + fq * 4);
#pragma unroll
    for (int cb = 0; cb < 8; ++cb) { const pg8::f32x4 acc = __builtin_amdgcn_mfma_f32_16x16x16bf16_1k(Af, Bq[cb], (pg8::f32x4){0.f, 0.f, 0.f, 0.f}, 0, 0, 0);
#pragma unroll
        for (int j = 0; j < 4; ++j) BU[(fq * 4 + j) * BUP + cb * 16 + fr] = acc[j]; }
}
__device__ __forceinline__ void ssm_load_bq(const unsigned char* sb, int g, bf16x4_t (&Bq)[8], int fr, int fq) {
    const bf16* bbh = (const bf16*)(sb + 16384) + (size_t)g * 128 * 16;
#pragma unroll
    for (int cb = 0; cb < 8; ++cb) Bq[cb] = *(const bf16x4_t*)(bbh + (cb * 16 + fr) * 16 + fq * 4);
}
__device__ __forceinline__ void ssm_local_phase(const Args& a, int l, LAS unsigned char* lds) {
    const int z = opq(); (void)z;
    const int tid = opqv((int)threadIdx.x), lane = tid & 63, wave = __builtin_amdgcn_readfirstlane(tid >> 6); const int G = (int)gridDim.x, bx = (int)blockIdx.x;
    const int vcu = (G % 8 == 0) ? (bx % 8) * (G / 8) + bx / 8 : bx; const int gw = vcu * NWAVES + wave, NGW = G * NWAVES;
    unsigned char* ws = (a.ws + z); const bf16* Z = (const bf16*)(ws + WS_Z);
    const unsigned char* sb = ws + WS_SSM + (size_t)l * SSM_L_BYTES;
    f32x2* E = (f32x2*)(ws + WS_E);
    LAS float* BU = (LAS float*)(lds + RING_OFF) + wave * (16 * BUP);
    const int fr = lane & 15, fq = lane >> 4;
    __syncthreads();
    for (int uidx = gw; uidx < NB * 64 * 16; uidx += NGW) {
        const int g = uidx & 15, c = (uidx >> 4) & 63, b = uidx >> 10;
        const f32x2 av = ((const f32x2*)sb)[g * 64 + lane];
        bf16x4_t Bq[8]; ssm_load_bq(sb, g, Bq, fr, fq);
        float xr = 0.f, xi = 0.f;
        const bf16* up = Z + (size_t)(b * SEQ + c * 64) * ZW + ZC + g * 16;
#pragma unroll 1
        for (int tb = 0; tb < 4; ++tb) {
            ssm_bu16(up + (size_t)(tb * 16) * ZW, Bq, BU, fr, fq);
            LDS_WAIT(); asm volatile("" ::: "memory");
#pragma unroll
            for (int tt = 0; tt < 16; ++tt) { const float br = BU[tt * BUP + lane], bi = BU[tt * BUP + 64 + lane];
                const float nr = av.x * xr - av.y * xi + br, ni = av.x * xi + av.y * xr + bi; xr = nr; xi = ni; }
            LDS_WAIT(); asm volatile("" ::: "memory");
        }
        E[(size_t)uidx * 64 + lane] = (f32x2){xr, xi};
    }
}
__device__ __forceinline__ void ssm_carry_phase(const Args& a, int l) {
    const int z = opq(); (void)z;
    const int tid = opqv((int)threadIdx.x), lane = tid & 63, wave = __builtin_amdgcn_readfirstlane(tid >> 6); const int G = (int)gridDim.x, bx = (int)blockIdx.x;
    const int vcu = (G % 8 == 0) ? (bx % 8) * (G / 8) + bx / 8 : bx; const int gw = vcu * NWAVES + wave, NGW = G * NWAVES, gt = vcu * 512 + tid;
    (void)lane; (void)gw; (void)NGW; (void)gt; (void)bx;
    if (gt >= NB * 16 * 64) return;
    unsigned char* ws = (a.ws + z); const unsigned char* sb = ws + WS_SSM + (size_t)l * SSM_L_BYTES;
    const int p = gt & 63, g = (gt >> 6) & 15, b = gt >> 10;
    const f32x2 a64 = ((const f32x2*)(sb + 8192))[g * 64 + p];
    const f32x2* E = (const f32x2*)(ws + WS_E); f32x2* CI = (f32x2*)(ws + WS_CIN);
    float sr = 0.f, si = 0.f;
    for (int c = 0; c < 64; ++c) { const size_t o = ((size_t)((b * 64 + c) * 16 + g)) * 64 + p;
        CI[o] = (f32x2){sr, si}; const f32x2 e = E[o];
        const float nr = a64.x * sr - a64.y * si + e.x, ni = a64.x * si + a64.y * sr + e.y; sr = nr; si = ni; }
}

__device__ __forceinline__ void ssm_final_phase(const Args& a, int l, LAS unsigned char* lds) {
    const int z = opq(); (void)z;
    const int tid = opqv((int)threadIdx.x), lane = tid & 63, wave = __builtin_amdgcn_readfirstlane(tid >> 6); const int G = (int)gridDim.x, bx = (int)blockIdx.x;
    const int vcu = (G % 8 == 0) ? (bx % 8) * (G / 8) + bx / 8 : bx; const int gw = vcu * NWAVES + wave, NGW = G * NWAVES, gt = vcu * 512 + tid;
    (void)lane; (void)gw; (void)NGW; (void)gt; (void)bx;
    unsigned char* ws = (a.ws + z); const bf16* Z = (const bf16*)(ws + WS_Z); bf16* AM = (bf16*)(ws + WS_AMIX);
    const unsigned char* sb = ws + WS_SSM + (size_t)l * SSM_L_BYTES;
    const f32x2* CI = (const f32x2*)(ws + WS_CIN);
    constexpr int YP = 264, XP = 136;
    LAS bf16* Ypre = (LAS bf16*)(lds + RING_OFF);
    LAS bf16* Xb = (LAS bf16*)(lds + RING_OFF + 34816) + wave * (16 * XP);
    LAS float* BU = (LAS float*)(lds + RING_OFF + 69632) + wave * (16 * BUP);
    const int fr = lane & 15, fq = lane >> 4;
    for (int uu = vcu; uu < NB * 64; uu += G) {
        const int b = uu >> 6, c = uu & 63; const size_t m0 = (size_t)b * SEQ + c * 64;
        __syncthreads();
#pragma unroll 1
        for (int gi = 0; gi < 2; ++gi) {
            const int g = wave * 2 + gi;
            const f32x2 av = ((const f32x2*)sb)[g * 64 + lane];
            bf16x4_t Bq[8]; ssm_load_bq(sb, g, Bq, fr, fq);
            bf16x8 Bf[4];
            { const float* cre = (const float*)a.in[z + I_CRE] + ((size_t)(l * 16 + g) * 16 + fr) * 64; const float* cim = (const float*)a.in[z + I_CIM] + ((size_t)(l * 16 + g) * 16 + fr) * 64;
#pragma unroll
              for (int ks = 0; ks < 4; ++ks) { const float* src = (ks < 2 ? cre : cim) + (ks & 1) * 32 + fq * 8; const float sg = ks < 2 ? 1.0f : -1.0f;
#pragma unroll
                  for (int j = 0; j < 8; ++j) Bf[ks][j] = (short)f2bf(sg * src[j]); } }
            const float dsk = ((const float*)a.in[z + I_DSKIP])[l * 256 + g * 16 + fr];
            const f32x2 st = CI[((size_t)((b * 64 + c) * 16 + g)) * 64 + lane];
            float xr = st.x, xi = st.y;
            const bf16* up = Z + m0 * ZW + ZC + g * 16;
#pragma unroll 1
            for (int tb = 0; tb < 4; ++tb) {
                ssm_bu16(up + (size_t)(tb * 16) * ZW, Bq, BU, fr, fq);
                LDS_WAIT(); asm volatile("" ::: "memory");
#pragma unroll
                for (int tt = 0; tt < 16; ++tt) { const float br = BU[tt * BUP + lane], bi = BU[tt * BUP + 64 + lane];
                    const float nr = av.x * xr - av.y * xi + br, ni = av.x * xi + av.y * xr + bi; xr = nr; xi = ni;
                    Xb[tt * XP + lane] = (bf16)f2bf(xr); Xb[tt * XP + 64 + lane] = (bf16)f2bf(xi); }
                LDS_WAIT(); asm volatile("" ::: "memory");
                pg8::f32x4 acc = {0.f, 0.f, 0.f, 0.f};
#pragma unroll
                for (int ks = 0; ks < 4; ++ks) { const bf16x8 Af = *(const LAS bf16x8*)(Xb + fr * XP + ks * 32 + fq * 8);
                    acc = __builtin_amdgcn_mfma_f32_16x16x32_bf16(Af, Bf[ks], acc, 0, 0, 0); }
#pragma unroll
                for (int j = 0; j < 4; ++j) { const int t = tb * 16 + fq * 4 + j;
                    const float uu2 = bf2f(up[(size_t)t * ZW + fr]);
                    Ypre[t * YP + g * 16 + fr] = (bf16)f2bf(gelu_tanh(acc[j] + dsk * uu2)); }
                LDS_WAIT(); asm volatile("" ::: "memory");
            }
        }
        __syncthreads();
        { pg8::f32x4 acc[4][2];
#pragma unroll
          for (int rb = 0; rb < 4; ++rb)
#pragma unroll
              for (int nb = 0; nb < 2; ++nb) acc[rb][nb] = (pg8::f32x4){0.f, 0.f, 0.f, 0.f};
          const bf16* wg = (const bf16*)(ws + WS_WGLU) + (size_t)l * 256 * 256;
#pragma unroll 2
          for (int ks = 0; ks < 8; ++ks) {
              bf16x8 Bw[2], Aw[4];
#pragma unroll
              for (int nb = 0; nb < 2; ++nb) Bw[nb] = *(const bf16x8*)(wg + (size_t)(wave * 32 + nb * 16 + fr) * 256 + ks * 32 + fq * 8);
#pragma unroll
              for (int rb = 0; rb < 4; ++rb) Aw[rb] = *(const LAS bf16x8*)(Ypre + (rb * 16 + fr) * YP + ks * 32 + fq * 8);
#pragma unroll
              for (int rb = 0; rb < 4; ++rb)
#pragma unroll
                  for (int nb = 0; nb < 2; ++nb) acc[rb][nb] = __builtin_amdgcn_mfma_f32_16x16x32_bf16(Aw[rb], Bw[nb], acc[rb][nb], 0, 0, 0);
          }
#pragma unroll
          for (int nb = 0; nb < 2; ++nb) { const int n = wave * 32 + nb * 16 + fr; const float gb = ((const float*)a.in[z + I_GLUB])[l * 256 + n];
#pragma unroll
              for (int rb = 0; rb < 4; ++rb)
#pragma unroll
                  for (int j = 0; j < 4; ++j) { const int t = rb * 16 + fq * 4 + j;
                      const float yv = bf2f(Ypre[t * YP + n]);
                      AM[(m0 + t) * D + 768 + n] = (bf16)f2bf(yv * sigmoidf_(acc[rb][nb][j] + gb)); } }
        }
    }
}

__device__ __forceinline__ void attn_naive_unit(const Args& a, int b, int h, int mp, int cc, LAS unsigned char* lds, int tid, int lane, int wave) {
    const int z = opq();
    const bf16* Z = (const bf16*)((a.ws + z) + WS_Z);
    float* O = (float*)((a.ws + z) + (mp ? WS_O1 : WS_O0));
    const size_t m0 = (size_t)b * SEQ + cc * 64;
    const int qcol = ZQ + h * 128 + mp * 64, kcol = ZK + h * 128 + mp * 64, vcol = ZV + h * 128;
    LAS float* Qs = (LAS float*)(lds + RING_OFF);
    LAS unsigned* Vs = (LAS unsigned*)(lds + RING_OFF + 16384);
    LAS float* Ps = (LAS float*)(lds + RING_OFF + 32768) + wave * 512;
    __syncthreads();
    { const int r = tid >> 3, c8 = (tid & 7) * 8; const v4u w = *(const v4u*)(Z + (m0 + r) * ZW + qcol + c8); LAS float* q = Qs + r * 64 + c8;
      q[0] = bflo(w.x); q[1] = bfhi(w.x); q[2] = bflo(w.y); q[3] = bfhi(w.y); q[4] = bflo(w.z); q[5] = bfhi(w.z); q[6] = bflo(w.w); q[7] = bfhi(w.w); }
    float mrun[8], lrun[8], o0[8], o1[8];
#pragma unroll
    for (int i = 0; i < 8; ++i) { mrun[i] = -1e30f; lrun[i] = 0.f; o0[i] = 0.f; o1[i] = 0.f; }
    const size_t kb0 = (size_t)b * SEQ;
#pragma unroll 1
    for (int kt = 0; kt <= cc; ++kt) {
        __syncthreads();
        { const int key = tid >> 3, part = tid & 7; const bf16* vp = Z + (kb0 + kt * 64 + key) * ZW + vcol + part * 16;
          const v4u w0 = *(const v4u*)vp, w1 = *(const v4u*)(vp + 8); LAS v4u* d = (LAS v4u*)(Vs + key * 64 + part * 8); d[0] = w0; d[1] = w1; }
        float kf[64];
        { const bf16* kp = Z + (kb0 + kt * 64 + lane) * ZW + kcol;
#pragma unroll
          for (int q = 0; q < 8; ++q) { const v4u w = *(const v4u*)(kp + q * 8);
              kf[q * 8 + 0] = bflo(w.x); kf[q * 8 + 1] = bfhi(w.x); kf[q * 8 + 2] = bflo(w.y); kf[q * 8 + 3] = bfhi(w.y);
              kf[q * 8 + 4] = bflo(w.z); kf[q * 8 + 5] = bfhi(w.z); kf[q * 8 + 6] = bflo(w.w); kf[q * 8 + 7] = bfhi(w.w); } }
        __syncthreads();
#pragma unroll
        for (int i = 0; i < 8; ++i) {
            const LAS f32x4* qr = (const LAS f32x4*)(Qs + (wave * 8 + i) * 64);
            float s = 0.f;
#pragma unroll
            for (int d4 = 0; d4 < 16; ++d4) { const f32x4 q4 = qr[d4]; s += q4.x * kf[d4 * 4] + q4.y * kf[d4 * 4 + 1] + q4.z * kf[d4 * 4 + 2] + q4.w * kf[d4 * 4 + 3]; }
            const float mt = wave_max(s), mn = fmaxf(mrun[i], mt), al = __expf(mrun[i] - mn), p = __expf(s - mn);
            lrun[i] = lrun[i] * al + wave_sum(p); o0[i] *= al; o1[i] *= al; mrun[i] = mn;
            Ps[i * 64 + lane] = p;
        }
        LDS_WAIT(); asm volatile("" ::: "memory");
#pragma unroll 4
        for (int j4 = 0; j4 < 16; ++j4) {
            unsigned vw[4];
#pragma unroll
            for (int jj = 0; jj < 4; ++jj) vw[jj] = Vs[(j4 * 4 + jj) * 64 + lane];
#pragma unroll
            for (int i = 0; i < 8; ++i) { const f32x4 p4 = *(const LAS f32x4*)(Ps + i * 64 + j4 * 4);
                o0[i] += p4.x * bflo(vw[0]) + p4.y * bflo(vw[1]) + p4.z * bflo(vw[2]) + p4.w * bflo(vw[3]);
                o1[i] += p4.x * bfhi(vw[0]) + p4.y * bfhi(vw[1]) + p4.z * bfhi(vw[2]) + p4.w * bfhi(vw[3]); }
        }
    }
#pragma unroll
    for (int i = 0; i < 8; ++i) { const float rl = 1.0f / lrun[i];
        *(f32x2*)(O + (m0 + wave * 8 + i) * 512 + h * 128 + lane * 2) = (f32x2){o0[i] * rl, o1[i] * rl}; }
}
__device__ __forceinline__ void attn_naive_phase(const Args& a, LAS unsigned char* lds) {
    const int z = opq(); (void)z;
    const int tid = opqv((int)threadIdx.x), lane = tid & 63, wave = __builtin_amdgcn_readfirstlane(tid >> 6); const int G = (int)gridDim.x, bx = (int)blockIdx.x;
    const int vcu = (G % 8 == 0) ? (bx % 8) * (G / 8) + bx / 8 : bx; const int gw = vcu * NWAVES + wave, NGW = G * NWAVES, gt = vcu * 512 + tid;
    (void)lane; (void)gw; (void)NGW; (void)gt; (void)bx;
    for (int u = vcu; u < 2048; u += G) {
        const int bhm = u >> 5, j = u & 31, b = bhm >> 3, h = (bhm >> 1) & 3, mp = bhm & 1;
        attn_naive_unit(a, b, h, mp, j, lds, tid, lane, wave);
        attn_naive_unit(a, b, h, mp, 63 - j, lds, tid, lane, wave);
    }
}

__device__ __forceinline__ void attn_fast_phase(const Args& a, char* lds_generic) {
    const int z = opq();
    const int G = (int)gridDim.x, bx = (int)blockIdx.x; const int vcu = (G % 8 == 0) ? (bx % 8) * (G / 8) + bx / 8 : bx;
    const attn_body::bf16* Z = (const attn_body::bf16*)((a.ws + z) + WS_Z);
#pragma unroll 1
    for (int p = vcu; p < 1024; p += G) {
        const int stream = (p >> 8) * 32 + ((p & 255) >> 3), j = p & 7;
        const int b = stream >> 4, vh = stream & 15, h = vh >> 2, mp = (vh >> 1) & 1, vhalf = vh & 1;
        const attn_body::bf16* Q = Z + ZQ + h * 128 + mp * 64; const attn_body::bf16* K = Z + ZK + h * 128 + mp * 64; const attn_body::bf16* V = Z + ZV + h * 128 + vhalf * 64;
        attn_body::bf16* O = (attn_body::bf16*)((a.ws + z) + (mp ? WS_O1 : WS_O0)) + h * 128 + vhalf * 64;
#pragma unroll 1
        for (int k2 = 0; k2 < 2; ++k2) attn_body::attn_unit<8>(b, k2 ? 15 - j : j, Q, K, V, O, lds_generic);
    }
}

__device__ __forceinline__ void attn_combine_phase(const Args& a, int l) {
    const int z = opq(); (void)z;
    const int tid = opqv((int)threadIdx.x), lane = tid & 63, wave = __builtin_amdgcn_readfirstlane(tid >> 6); const int G = (int)gridDim.x, bx = (int)blockIdx.x;
    const int vcu = (G % 8 == 0) ? (bx % 8) * (G / 8) + bx / 8 : bx; const int gw = vcu * NWAVES + wave, NGW = G * NWAVES, gt = vcu * 512 + tid;
    (void)lane; (void)gw; (void)NGW; (void)gt; (void)bx;
    unsigned char* ws = (a.ws + z); const float* O0 = (const float*)(ws + WS_O0); const float* O1 = (const float*)(ws + WS_O1); bf16* AM = (bf16*)(ws + WS_AMIX);
    const float lam = ((const float*)(ws + WS_LAM))[l], post = 1.0f - lambda_init_of(l);
    const f32x2 sg = *((const f32x2*)((const float*)a.in[z + I_SUBLN] + l * 128) + lane);
    for (int m = gw; m < T; m += NGW) {
#pragma unroll
        for (int h = 0; h < 4; ++h) {
#if ATTN_FAST
            const unsigned pw = *((const unsigned*)((const bf16*)O0 + (size_t)m * 512 + h * 128) + lane), qw = *((const unsigned*)((const bf16*)O1 + (size_t)m * 512 + h * 128) + lane);
            const float d0 = bflo(pw) - lam * bflo(qw), d1 = bfhi(pw) - lam * bfhi(qw);
#else
            const f32x2 p = *((const f32x2*)(O0 + (size_t)m * 512 + h * 128) + lane), q = *((const f32x2*)(O1 + (size_t)m * 512 + h * 128) + lane);
            const float d0 = p.x - lam * q.x, d1 = p.y - lam * q.y;
#endif
            const float r = rsqrtf(wave_sum(d0 * d0 + d1 * d1) * (1.0f / 128.0f) + NORM_EPS);
            *((unsigned*)(AM + (size_t)m * D + 256 + h * 128) + lane) = pk2(d0 * r * sg.x * post, d1 * r * sg.y * post);
        }
    }
}

__device__ __forceinline__ void norm2_router_phase(const Args& a, int l, LAS unsigned char* lds, bool do_cnt) {
    const int z = opq(); (void)z;
    const int tid = opqv((int)threadIdx.x), lane = tid & 63, wave = __builtin_amdgcn_readfirstlane(tid >> 6); const int G = (int)gridDim.x, bx = (int)blockIdx.x;
    const int vcu = (G % 8 == 0) ? (bx % 8) * (G / 8) + bx / 8 : bx; const int gw = vcu * NWAVES + wave, NGW = G * NWAVES, gt = vcu * 512 + tid;
    (void)lane; (void)gw; (void)NGW; (void)gt; (void)bx;
    unsigned char* ws = (a.ws + z);
    const float* mod = (const float*)(ws + WS_MOD); bf16* H = (bf16*)(ws + WS_H);
    const float* rwt = (const float*)(ws + WS_RWT) + (size_t)l * 36 * 1024;
    int* tok_e = (int*)(ws + WS_TOKE); float* tok_w = (float*)(ws + WS_TOKW); int* tok_l = (int*)(ws + WS_TOKL);
    LAS int* lcnt = (LAS int*)(lds + RING_OFF);
    __syncthreads();
    if (tid < 32) lcnt[tid] = 0;
    __syncthreads();
    const float rgb = lane < 4 ? ((const float*)a.in[z + I_RGB])[l * 4 + lane] : (lane < 36 ? ((const float*)a.in[z + I_REB])[l * 32 + lane - 4] : 0.f);
    for (int m4 = gw; m4 < T / 4; m4 += NGW) {
        const int mb = m4 * 4, b = mb >> 12;
        const float* mrow = mod + ((size_t)l * NB + b) * 6144;
        f32x4 hv[4][4];
#pragma unroll
        for (int r = 0; r < 4; ++r) {
            const f32x4* xr = (const f32x4*)((a.out + z) + (size_t)(mb + r) * D) + lane;
            float ss = 0.f;
#pragma unroll
            for (int j = 0; j < 4; ++j) { hv[r][j] = xr[64 * j]; ss += (hv[r][j].x * hv[r][j].x + hv[r][j].y * hv[r][j].y) + (hv[r][j].z * hv[r][j].z + hv[r][j].w * hv[r][j].w); }
            const float rr = rsqrtf(wave_sum(ss) * (1.0f / D) + NORM_EPS);
            v2u* ho = (v2u*)(H + (size_t)(mb + r) * D) + lane;
#pragma unroll
            for (int j = 0; j < 4; ++j) { const f32x4 g = *((const f32x4*)((const float*)a.in[z + I_N2G] + l * D) + lane + 64 * j), sh = *((const f32x4*)(mrow + 3 * 1024) + lane + 64 * j), sc = *((const f32x4*)(mrow + 4 * 1024) + lane + 64 * j);
                hv[r][j] = (hv[r][j] * rr * g) * (sc + 1.0f) + sh;
                v2u o; o.x = pk2(hv[r][j].x, hv[r][j].y); o.y = pk2(hv[r][j].z, hv[r][j].w); ho[64 * j] = o; }
        }
        float lg[4] = {0.f, 0.f, 0.f, 0.f};
#pragma unroll 1
        for (int e = 0; e < 36; ++e) {
            const f32x4* wr = (const f32x4*)(rwt + (size_t)e * 1024) + lane;
            f32x4 w4[4];
#pragma unroll
            for (int j = 0; j < 4; ++j) w4[j] = wr[64 * j];
#pragma unroll
            for (int r = 0; r < 4; ++r) { float s = 0.f;
#pragma unroll
                for (int j = 0; j < 4; ++j) s += (hv[r][j].x * w4[j].x + hv[r][j].y * w4[j].y) + (hv[r][j].z * w4[j].z + hv[r][j].w * w4[j].w);
                s = wave_sum(s); if (lane == e) lg[r] = s; }
        }
#pragma unroll
        for (int r = 0; r < 4; ++r) {
            const float v = lg[r] + rgb;
            float gl[4];
#pragma unroll
            for (int j = 0; j < 4; ++j) gl[j] = __shfl(v, j);
            int gi = 0; float gm = gl[0];
#pragma unroll
            for (int j = 1; j < 4; ++j) if (gl[j] > gm) { gm = gl[j]; gi = j; }
            float gs = 0.f;
#pragma unroll
            for (int j = 0; j < 4; ++j) gs += __expf(gl[j] - gm);
            const float pg = 1.0f / gs;
            float el[8];
#pragma unroll
            for (int j = 0; j < 8; ++j) el[j] = __shfl(v, 4 + gi * 8 + j);
            int e0 = 0; float m0v = el[0];
#pragma unroll
            for (int j = 1; j < 8; ++j) if (el[j] > m0v) { m0v = el[j]; e0 = j; }
            int e1 = -1; float m1v = -3.0e38f;
#pragma unroll
            for (int j = 0; j < 8; ++j) if (j != e0 && el[j] > m1v) { m1v = el[j]; e1 = j; }
            const float x1 = __expf(m1v - m0v), w0 = pg / (1.0f + x1), w1 = pg * x1 / (1.0f + x1);
            if (lane == 0) {
                const int m = mb + r, ea = gi * 8 + e0, eb = gi * 8 + e1;
                tok_e[2 * m] = ea; tok_e[2 * m + 1] = eb; tok_w[2 * m] = w0; tok_w[2 * m + 1] = w1;
                tok_l[2 * m] = __hip_atomic_fetch_add(&lcnt[ea], 1, __ATOMIC_RELAXED, __HIP_MEMORY_SCOPE_WORKGROUP); tok_l[2 * m + 1] = __hip_atomic_fetch_add(&lcnt[eb], 1, __ATOMIC_RELAXED, __HIP_MEMORY_SCOPE_WORKGROUP);
            }
        }
    }
    __syncthreads();
    if (tid < 32 && do_cnt) { const int c = lcnt[tid];
        const unsigned old = __hip_atomic_fetch_add((unsigned*)(ws + WS_CTL) + CW_CNT + l * 64 + tid, (unsigned)c, RLX_AGENT);
        ((int*)(ws + WS_WGBASE))[bx * 32 + tid] = (int)old; }
}

__device__ __forceinline__ void moe_scatter_phase(const Args& a, int l, LAS unsigned char* lds) {
    const int z = opq(); (void)z;
    const int tid = opqv((int)threadIdx.x), lane = tid & 63, wave = __builtin_amdgcn_readfirstlane(tid >> 6); const int G = (int)gridDim.x, bx = (int)blockIdx.x;
    const int vcu = (G % 8 == 0) ? (bx % 8) * (G / 8) + bx / 8 : bx; const int gw = vcu * NWAVES + wave, NGW = G * NWAVES, gt = vcu * 512 + tid;
    (void)lane; (void)gw; (void)NGW; (void)gt; (void)bx;
    unsigned char* ws = (a.ws + z);
    LAS int* pst = (LAS int*)(lds + RING_OFF);
    __syncthreads();
    if (tid == 0) {
        int run = 0; int* tile_e = (int*)(ws + WS_TILEE);
        for (int e = 0; e < NEXP; ++e) { const int c = (int)__hip_atomic_load((unsigned*)(ws + WS_CTL) + CW_CNT + l * 64 + e, RLX_AGENT); const int pad = (c + 255) & ~255;
            pst[e] = run + ((const int*)(ws + WS_WGBASE))[bx * 32 + e];
            if (bx == 0) for (int q = 0; q < (pad >> 8); ++q) tile_e[(run >> 8) + q] = e;
            run += pad; }
        if (bx == 0) tile_e[511] = run >> 8;
    }
    __syncthreads();
    const int* tok_e = (const int*)(ws + WS_TOKE); const int* tok_l = (const int*)(ws + WS_TOKL); int* tok_s = (int*)(ws + WS_TOKS);
    const bf16* H = (const bf16*)(ws + WS_H); bf16* AG = (bf16*)(ws + WS_AG);
    for (int m4 = gw; m4 < T / 4; m4 += NGW) {
#pragma unroll
        for (int r = 0; r < 4; ++r) { const int m = m4 * 4 + r;
            const int s0 = pst[tok_e[2 * m]] + tok_l[2 * m], s1 = pst[tok_e[2 * m + 1]] + tok_l[2 * m + 1];
            if (lane == 0) { tok_s[2 * m] = s0; tok_s[2 * m + 1] = s1; }
            const v4u* src = (const v4u*)(H + (size_t)m * D) + lane; const v4u x0 = src[0], x1 = src[64];
            v4u* d0 = (v4u*)(AG + (size_t)s0 * D) + lane; v4u* d1 = (v4u*)(AG + (size_t)s1 * D) + lane;
            d0[0] = x0; d0[64] = x1; d1[0] = x0; d1[64] = x1; }
    }
}

__global__ void __launch_bounds__(NWAVES * 64, 2) fwd(Args args) {
    extern __shared__ __attribute__((aligned(16))) unsigned char lds_raw[];
    LAS unsigned char* lds = (LAS unsigned char*)lds_raw;
    for (int u = threadIdx.x; u < (LDS_BYTES - LDSCTL_OFF) / 4; u += NWAVES * 64) ((LAS unsigned*)(lds + LDSCTL_OFF))[u] = 0u;
    __syncthreads();
#if MK_MULTI
#define GRID_BAR() do { } while (0)
#else
    XcdBarrier bar = xcd_barrier_post((unsigned*)(args.ws + WS_CTL) + CW_BAR, (volatile LAS unsigned*)(lds + MISC_OFF) + 8);
#define GRID_BAR() xcd_barrier(bar)
#endif
    const int lo = args.ph_lo, hi = args.ph_hi;
#ifndef PHMASK
#define PHMASK 0xFFFF
#endif
#define EN(p) (((PHMASK) >> (p)) & 1)
#ifndef REPMASK
#define REPMASK 0
#endif
#define REPEAT(b) _Pragma("unroll 1") for (int rep_ = 0; rep_ < ((((REPMASK) >> (b)) & 1) ? 2 : 1); ++rep_)
#define IN(k) (lo <= (k) && (k) < hi)
#define SEAM(k) do { if (IN(k) && IN((k) + 1)) GRID_BAR(); } while (0)

    if (EN(11) && IN(0)) { REPEAT(11) prologue_phase(args, lds); SEAM(0); }

#pragma unroll 1
    for (int l = 0; l < DEPTH; ++l) {
        const int pb = 1 + l * PH_PER_LAYER;
        if (EN(0) && IN(pb + 0)) { norm1_phase(args, l, l == 0, true); REPEAT(0) moe_weights_phase(args, l, lds); SEAM(pb + 0); }
        if (EN(1) && IN(pb + 1)) { unsigned char* ws = args.ws + opq(); const int G = (int)gridDim.x, bx = (int)blockIdx.x;
            pg8::Gemm g{(const pg8::bf16_t*)(ws + WS_H), (const pg8::bf16_t*)(ws + WS_WCAT) + (size_t)l * NCAT * 1024, 1024, 1024, 1024}; pg8::StaticOrder S; S.init(T, NCAT, G, bx);
            pg8::EpiZG E{(pg8::bf16_t*)(ws + WS_Z), (pg8::bf16_t*)(ws + WS_G), (const float*)args.in[opq() + I_GATEB] + l * GWD};
            REPEAT(1) pg8::gemm_phase<pg8::EpiZG, pg8::StaticOrder, true, true>(lds + RING_OFF, g, S, E);
            SEAM(pb + 1);
        }
        if (EN(2) && IN(pb + 2)) { qkprep_phase(args, l); REPEAT(2) { pool_phase(args, lds); ssm_local_phase(args, l, lds); } SEAM(pb + 2); }
        if (EN(3) && IN(pb + 3)) { REPEAT(13) ssm_carry_phase(args, l);
#if ATTN_FAST
            REPEAT(3) attn_fast_phase(args, (char*)lds_raw + RING_OFF);
#else
            attn_naive_phase(args, lds);
#endif
            SEAM(pb + 3); }
        if (EN(4) && IN(pb + 4)) { REPEAT(12) attn_combine_phase(args, l); REPEAT(4) ssm_final_phase(args, l, lds); SEAM(pb + 4); }
        if (EN(5) && IN(pb + 5)) { unsigned char* ws = args.ws + opq(); const int G = (int)gridDim.x, bx = (int)blockIdx.x;
            const pg8::bf16_t* am = (const pg8::bf16_t*)(ws + WS_AMIX); pg8::bf16_t* mx = (pg8::bf16_t*)(ws + WS_MIXED); const pg8::bf16_t* gt_ = (const pg8::bf16_t*)(ws + WS_G);
            const pg8::bf16_t* wmix = (const pg8::bf16_t*)(ws + WS_WMIX) + (size_t)l * 1024 * 1024;
            pg8::StaticOrder S; S.init(T, D, G, bx);
            REPEAT(5)
#pragma unroll 1
            for (int s = 0; s < 3; ++s) {
                const int koff = s == 0 ? 0 : (s == 1 ? 256 : 768), klen = s == 1 ? 512 : 256;
                pg8::Gemm g{am + koff, wmix + koff, 1024, 1024, klen}; pg8::EpiMix E{mx, gt_, s * 1024, s == 0};
                pg8::gemm_phase<pg8::EpiMix, pg8::StaticOrder, true, true>(lds + RING_OFF, g, S, E);
            }
            SEAM(pb + 5);
        }
        if (EN(6) && IN(pb + 6)) { unsigned char* ws = args.ws + opq(); const int G = (int)gridDim.x, bx = (int)blockIdx.x;
            pg8::Gemm g{(const pg8::bf16_t*)(ws + WS_MIXED), (const pg8::bf16_t*)(ws + WS_WO) + (size_t)l * 1024 * 1024, 1024, 1024, 1024}; pg8::StaticOrder S; S.init(T, D, G, bx);
            pg8::EpiResid E{args.out + opq(), (const float*)(ws + WS_MOD) + (size_t)l * NB * 6144 + 2 * 1024};
            pg8::gemm_phase<pg8::EpiResid, pg8::StaticOrder, true, true>(lds + RING_OFF, g, S, E);
            SEAM(pb + 6);
        }
        if (EN(7) && IN(pb + 7)) { REPEAT(7) norm2_router_phase(args, l, lds, rep_ == ((((REPMASK) >> 7) & 1) ? 1 : 0)); SEAM(pb + 7); }
        if (EN(8) && IN(pb + 8)) { REPEAT(8) moe_scatter_phase(args, l, lds); SEAM(pb + 8); }
        if (EN(9) && IN(pb + 9)) { unsigned char* ws = args.ws + opq(); const int G = (int)gridDim.x, bx = (int)blockIdx.x; const int vcu = (G % 8 == 0) ? (bx % 8) * (G / 8) + bx / 8 : bx;
            const int* tile_e = (const int*)(ws + WS_TILEE);
            pg8::GroupedOrder S{tile_e, __builtin_amdgcn_readfirstlane(tile_e[511]), G, vcu};
            pg8::Gemm g{(const pg8::bf16_t*)(ws + WS_AG), (const pg8::bf16_t*)(ws + WS_W13), 1024, 1024, 1024};
            pg8::EpiSwiGLU E{(pg8::bf16_t*)(ws + WS_ACT)};
            REPEAT(9) pg8::gemm_phase<pg8::EpiSwiGLU, pg8::GroupedOrder, true, true>(lds + RING_OFF, g, S, E);
            SEAM(pb + 9);
        }
        if (EN(10) && IN(pb + 10)) { unsigned char* ws = args.ws + opq(); const int G = (int)gridDim.x, bx = (int)blockIdx.x; const int vcu = (G % 8 == 0) ? (bx % 8) * (G / 8) + bx / 8 : bx;
            const int* tile_e = (const int*)(ws + WS_TILEE);
            pg8::GroupedOrder S{tile_e, __builtin_amdgcn_readfirstlane(tile_e[511]), G, vcu};
            pg8::Gemm g{(const pg8::bf16_t*)(ws + WS_ACT), (const pg8::bf16_t*)(ws + WS_W2), 512, 512, 512};
            pg8::EpiY E{(pg8::bf16_t*)(ws + WS_Y)};
            REPEAT(10) pg8::gemm_phase<pg8::EpiY, pg8::GroupedOrder, true, true>(lds + RING_OFF, g, S, E);
            SEAM(pb + 10);
        }
    }
    if (EN(12) && IN(N_PHASES - 1)) norm1_phase(args, DEPTH, false, false);
#undef IN
#undef SEAM
}

extern "C" void kernel_launch(void* const* d_in, const int* in_sizes, int n_in, void* d_out, int out_size, void* d_ws, size_t ws_size, hipStream_t stream) {
    static int grid = 0;
    if (grid == 0) {
        if (n_in != 40 || out_size != T * D || ws_size < WS_END) { fprintf(stderr, "kernel_launch: unexpected shapes (n_in %d out %d ws %zu)\n", n_in, out_size, ws_size); grid = -1; return; }
        int dev = 0, cus = 0, per_cu = 0;
        if (hipGetDevice(&dev) != hipSuccess || hipDeviceGetAttribute(&cus, hipDeviceAttributeMultiprocessorCount, dev) != hipSuccess) { grid = -1; return; }
        if (hipFuncSetAttribute((const void*)fwd, hipFuncAttributeMaxDynamicSharedMemorySize, LDS_BYTES) != hipSuccess) { fprintf(stderr, "kernel_launch: hipFuncSetAttribute failed\n"); grid = -1; return; }
        if (hipOccupancyMaxActiveBlocksPerMultiprocessor(&per_cu, (const void*)fwd, NWAVES * 64, LDS_BYTES) != hipSuccess || per_cu < 1) fprintf(stderr, "kernel_launch: occupancy query says %d\n", per_cu);
        (void)hipGetLastError();
        grid = cus;
    }
    if (grid < 0) return;
    if (hipMemsetAsync((char*)d_ws + WS_CTL, 0, CTL_ZERO_BYTES, stream) != hipSuccess) return;
    Args a{};
    for (int i = 0; i < 40; ++i) a.in[i] = d_in[i];
    a.out = (float*)d_out; a.ws = (unsigned char*)d_ws;
#if MK_MULTI
    for (int p = 0; p < N_PHASES; ++p) { a.ph_lo = p; a.ph_hi = p + 1; hipLaunchKernelGGL(fwd, dim3(grid), dim3(NWAVES * 64), LDS_BYTES, stream, a); }
#else
    a.ph_lo = 0; a.ph_hi = N_PHASES;
    hipLaunchKernelGGL(fwd, dim3(grid), dim3(NWAVES * 64), LDS_BYTES, stream, a);
#endif
}
```

```cpp
#include <hip/hip_runtime.h>
#include <cstdio>
#include <cstdint>

#ifndef REPMASK
#define REPMASK 0x80
#endif
#define REPN(b) ((((REPMASK) >> (b)) & 1) ? 2 : 1)
#ifndef MK_MULTI
#define MK_MULTI 0
#endif

__device__ __forceinline__ int opqv(int x) { asm volatile("" : "+v"(x)); return x; }
__device__ __forceinline__ int opq() { int z = 0; asm volatile("" : "+s"(z)); return z; }
namespace pg8 {
#define PG8_LAS __attribute__((address_space(3)))
typedef unsigned short bf16_t;
typedef short bf16x8 __attribute__((ext_vector_type(8)));
typedef float f32x4 __attribute__((ext_vector_type(4)));
typedef unsigned u32x4 __attribute__((ext_vector_type(4)));
typedef unsigned u32x2 __attribute__((ext_vector_type(2)));
constexpr int BM = 256, BK = 64, HALF = 128, HTB = HALF * BK * 2  , STAGE_BYTES = 8 * HTB, NXCD = 8, WGM = 8;

__host__ __device__ __forceinline__ int lds_byte(int r, int c) { const int st = (r >> 4) * 2 + (c >> 5), rr = r & 15, cc = c & 31, ob = rr * 64 + cc * 2; return st * 1024 + (ob ^ (((ob >> 9) & 1) << 5)); }
__host__ __device__ __forceinline__ void stage_rc(int b, int& R, int& C) { const int st = b / 1024, sb = b % 1024, swz = sb ^ (((sb >> 9) & 1) << 5); R = (st >> 1) * 16 + swz / 64; C = (st & 1) * 32 + (swz % 64) / 2; }
__host__ __device__ __forceinline__ int perm32(int rho) { const int n = rho >> 4, i = rho & 15; return 8 * (i >> 2) + 4 * n + (i & 3); }

struct Unit { int pm, pn, pb, seg, koff, nt, zero; };
struct Gemm { const bf16_t* A; const bf16_t* Bt; int lda, ldb, K; };

struct StaticOrder {
    static constexpr bool VARK = false, GATHER = false;
    int nM, nN, nwg, G, c;
    __host__ __device__ void init(int M, int N, int G_, int c_) { nM = M / BM; nN = N / BM; nwg = nM * nN; G = G_; c = c_; }
    __host__ __device__ bool next(int i, Unit& u) const {
        const long L = (long)i * G + c; if (L >= nwg) return false;
        int wgid = (int)L; { const int q = nwg / NXCD, r = nwg % NXCD, xcd = wgid % NXCD, off = wgid / NXCD; wgid = (xcd < r ? xcd * (q + 1) : r * (q + 1) + (xcd - r) * q) + off; }
        const int nig = WGM * nN, gid = wgid / nig, fm = gid * WGM, gsz = (nM - fm) < WGM ? (nM - fm) : WGM;
        u.pm = fm + ((wgid % nig) % gsz); u.pn = (wgid % nig) / gsz; u.pb = u.pn; return true;
    }
    __device__ __forceinline__ void a_ready(const Unit&) const {}
    __device__ __forceinline__ void done(const Unit&) const {}
};
struct GroupedOrder {
    static constexpr bool VARK = false, GATHER = false;
    const int* tile_e; int ntiles, G, c;
    __device__ __forceinline__ bool next(int i, Unit& u) const {
        const long L = (long)i * G + c; if (L >= (long)ntiles * 4) return false;
        const int pm = (int)(L >> 2), pl = (int)(L & 3);
        u.pm = pm; u.pn = pl; u.pb = __builtin_amdgcn_readfirstlane(tile_e[pm]) * 4 + pl; return true;
    }
    __device__ __forceinline__ void a_ready(const Unit&) const {}
    __device__ __forceinline__ void done(const Unit&) const {}
};

struct GatherOrder {
    static constexpr bool VARK = false, GATHER = true;
    const int* tile_e; const int* rowmap; int ntiles, G, c;
    __device__ __forceinline__ bool next(int i, Unit& u) const {
        const long L = (long)i * G + c; if (L >= (long)ntiles * 4) return false;
        const int pm = (int)(L >> 2), pl = (int)(L & 3);
        u.pm = pm; u.pn = pl; u.pb = __builtin_amdgcn_readfirstlane(tile_e[pm]) * 4 + pl; return true;
    }
    __device__ __forceinline__ void a_ready(const Unit&) const {}
    __device__ __forceinline__ void done(const Unit&) const {}
};
struct MixOrder {
    static constexpr bool VARK = true, GATHER = false;
    StaticOrder so;
    __device__ __forceinline__ bool next(int i, Unit& u) const { const int bi = i / 3, seg = i - bi * 3; if (!so.next(bi, u)) return false;
        u.seg = seg; u.koff = seg == 0 ? 0 : (seg == 1 ? 256 : 768); u.nt = seg == 1 ? 8 : 4; u.zero = seg == 2; return true; }
    __device__ __forceinline__ void a_ready(const Unit&) const {}
    __device__ __forceinline__ void done(const Unit&) const {}
};

__device__ __forceinline__ unsigned cvt_pk_bf16(float lo, float hi) { unsigned r; asm volatile("v_cvt_pk_bf16_f32 %0, %1, %2" : "=v"(r) : "v"(lo), "v"(hi)); return r; }
__device__ __forceinline__ float bflo(unsigned w) { return __uint_as_float(w << 16); }
__device__ __forceinline__ float bfhi(unsigned w) { return __uint_as_float(w & 0xffff0000u); }
__device__ __forceinline__ float sigmoidf_(float x) { return __builtin_amdgcn_rcpf(1.0f + __builtin_amdgcn_exp2f(-1.4426950408889634f * x)); }


struct EpiZG {
    static constexpr bool PERM = true, AFTER_DRAIN = false, MIDHOOK = false;
    bf16_t* Z; unsigned char* G8; const float* gbias;
    const float* qg; const float* kg; const float* ropec; const float* ropes;
    __device__ __forceinline__ void operator()(const f32x4 (&acc)[2][2][4][2], const Unit& u, int wr, int wc, int fr, int fq) const {
        asm volatile("" : "+v"(fr), "+v"(fq));
        const int row0 = u.pm * BM + wr * 64 + fr;
        if (u.pn >= 1 && u.pn <= 4) {
            const int vec = (u.pn - 1) * 4 + wc; const bool isq = vec < 8;
            const float* gsrc = isq ? qg : kg; const float sc = isq ? 0.125f * 1.4426950408889634f : 1.0f;
            f32x4 gv[2][2];
#pragma unroll
            for (int bj = 0; bj < 2; ++bj)
#pragma unroll
                for (int n = 0; n < 2; ++n) gv[bj][n] = *(const f32x4*)(gsrc + 32 * bj + 8 * fq + 4 * n) * sc;
#pragma unroll
            for (int ai = 0; ai < 2; ++ai)
#pragma unroll
                for (int m = 0; m < 4; ++m) { const size_t row = (size_t)(row0 + ai * HALF + m * 16);
                    float ss = 0.f;
#pragma unroll
                    for (int bj = 0; bj < 2; ++bj)
#pragma unroll
                        for (int n = 0; n < 2; ++n) { const f32x4 x = acc[ai][bj][m][n]; ss += (x[0] * x[0] + x[1] * x[1]) + (x[2] * x[2] + x[3] * x[3]); }
                    { auto rr = __builtin_amdgcn_permlane16_swap(__float_as_uint(ss), __float_as_uint(ss), false, false); ss = __uint_as_float(rr[0]) + __uint_as_float(rr[1]); }
                    { auto rr = __builtin_amdgcn_permlane32_swap(__float_as_uint(ss), __float_as_uint(ss), false, false); ss = __uint_as_float(rr[0]) + __uint_as_float(rr[1]); }
                    const float rs = __builtin_amdgcn_rsqf(ss * (1.0f / 64.0f) + 1e-6f);
                    f32x4 o[2][2];
#pragma unroll
                    for (int n = 0; n < 2; ++n) { const f32x4 c = *(const f32x4*)(ropec + row * 32 + 8 * fq + 4 * n), s = *(const f32x4*)(ropes + row * 32 + 8 * fq + 4 * n);
                        const f32x4 y0 = acc[ai][0][m][n] * rs * gv[0][n], y1 = acc[ai][1][m][n] * rs * gv[1][n];
                        o[0][n] = y0 * c - y1 * s; o[1][n] = y1 * c + y0 * s; }
                    bf16_t* rowp = Z + row * 2048 + 256 + vec * 64 + 8 * fq;
#pragma unroll
                    for (int bj = 0; bj < 2; ++bj) { u32x4 w; w.x = cvt_pk_bf16(o[bj][0][0], o[bj][0][1]); w.y = cvt_pk_bf16(o[bj][0][2], o[bj][0][3]); w.z = cvt_pk_bf16(o[bj][1][0], o[bj][1][1]); w.w = cvt_pk_bf16(o[bj][1][2], o[bj][1][3]);
                        *(u32x4*)(rowp + 32 * bj) = w; }
                    if (m == 3) asm volatile("" ::: "memory"); }
            return;
        }
        if (u.pn >= 8) {
            const int col0 = (u.pn - 8) * BM + wc * 64 + 16 * fq;
            f32x4 bc[2][2];
#pragma unroll
            for (int bj = 0; bj < 2; ++bj)
#pragma unroll
                for (int n = 0; n < 2; ++n) bc[bj][n] = *(const f32x4*)(gbias + col0 + 8 * bj + 4 * n) * (-1.4426950408889634f) - 7.994353436858858f;
#pragma unroll
            for (int ai = 0; ai < 2; ++ai)
#pragma unroll
                for (int m = 0; m < 4; ++m) { u32x4 w;
#pragma unroll
                    for (int bj = 0; bj < 2; ++bj)
#pragma unroll
                        for (int n = 0; n < 2; ++n) { const f32x4 v = acc[ai][bj][m][n] * (-1.4426950408889634f) + bc[bj][n]; unsigned pw = 0u;
#pragma unroll
                            for (int j = 0; j < 4; ++j) pw = __builtin_amdgcn_cvt_pk_u8_f32(fmaxf(__builtin_rintf(__builtin_amdgcn_rcpf(__builtin_amdgcn_exp2f(v[j]) + (1.0f / 255.0f))), 1.0f), j, pw);
                            w[bj * 2 + n] = pw; }
                    *(u32x4*)(G8 + (size_t)(row0 + ai * HALF + m * 16) * 3072 + col0) = w; }
            return;
        }
        const int colt = u.pn * BM;
        const int col0 = colt + wc * 64 + 8 * fq;
#pragma unroll
        for (int ai = 0; ai < 2; ++ai)
#pragma unroll
            for (int m = 0; m < 4; ++m) { bf16_t* rowp = Z + (size_t)(row0 + ai * HALF + m * 16) * 2048 + col0;
#pragma unroll
                for (int bj = 0; bj < 2; ++bj) { const f32x4 v0 = acc[ai][bj][m][0], v1 = acc[ai][bj][m][1];
                    u32x4 w; w.x = cvt_pk_bf16(v0[0], v0[1]); w.y = cvt_pk_bf16(v0[2], v0[3]); w.z = cvt_pk_bf16(v1[0], v1[1]); w.w = cvt_pk_bf16(v1[2], v1[3]);
                    *(u32x4*)(rowp + bj * 32) = w; } }
    }
};
struct EpiMix {
    static constexpr bool PERM = true, AFTER_DRAIN = false, MIDHOOK = false;
    bf16_t* O; const bf16_t* Gt; int gcol0; bool first;
    __device__ __forceinline__ void operator()(const f32x4 (&acc)[2][2][4][2], const Unit& u, int wr, int wc, int fr, int fq) const {
        asm volatile("" : "+v"(fr), "+v"(fq));
        const int row0 = u.pm * BM + wr * 64 + fr, col0 = u.pn * BM + wc * 32 + 8 * fq;
#pragma unroll
        for (int ai = 0; ai < 2; ++ai)
#pragma unroll
            for (int m = 0; m < 4; ++m) { const size_t row = (size_t)(row0 + ai * HALF + m * 16);
#pragma unroll
                for (int bj = 0; bj < 2; ++bj) {
                    const u32x4 gw = *(const u32x4*)(Gt + row * 3072 + gcol0 + col0 + bj * HALF);
                    bf16_t* op = O + row * 1024 + col0 + bj * HALF;
                    f32x4 v0 = acc[ai][bj][m][0], v1 = acc[ai][bj][m][1];
                    v0[0] *= bflo(gw.x); v0[1] *= bfhi(gw.x); v0[2] *= bflo(gw.y); v0[3] *= bfhi(gw.y);
                    v1[0] *= bflo(gw.z); v1[1] *= bfhi(gw.z); v1[2] *= bflo(gw.w); v1[3] *= bfhi(gw.w);
                    if (!first) { const u32x4 pw = *(const u32x4*)op;
                        v0[0] += bflo(pw.x); v0[1] += bfhi(pw.x); v0[2] += bflo(pw.y); v0[3] += bfhi(pw.y);
                        v1[0] += bflo(pw.z); v1[1] += bfhi(pw.z); v1[2] += bflo(pw.w); v1[3] += bfhi(pw.w); }
                    u32x4 w; w.x = cvt_pk_bf16(v0[0], v0[1]); w.y = cvt_pk_bf16(v0[2], v0[3]); w.z = cvt_pk_bf16(v1[0], v1[1]); w.w = cvt_pk_bf16(v1[2], v1[3]);
                    *(u32x4*)op = w; }
                asm volatile("" ::: "memory"); }
    }
};
struct EpiMixFused {
    static constexpr bool PERM = true, AFTER_DRAIN = false, MIDHOOK = false;
    bf16_t* O; const unsigned char* G8;
    __device__ __forceinline__ static void gld(const unsigned char* p, float (&g)[2][2][4]) { const u32x4 w = *(const u32x4*)p;
#pragma unroll
        for (int q = 0; q < 4; ++q) { const unsigned d = w[q]; g[q >> 1][q & 1][0] = (float)(d & 0xffu); g[q >> 1][q & 1][1] = (float)((d >> 8) & 0xffu); g[q >> 1][q & 1][2] = (float)((d >> 16) & 0xffu); g[q >> 1][q & 1][3] = (float)(d >> 24); } }
    __device__ __forceinline__ void operator()(f32x4 (&acc)[2][2][4][2], const Unit& u, int wr, int wc, int fr, int fq) const {
        asm volatile("" : "+v"(fr), "+v"(fq));
        const int row0 = u.pm * BM + wr * 64 + fr, col0 = u.pn * BM + wc * 64 + 16 * fq;
        if (u.seg < 2) {
#pragma unroll
            for (int ai = 0; ai < 2; ++ai)
#pragma unroll
                for (int m = 0; m < 4; ++m) { const unsigned char* gp = G8 + (size_t)(row0 + ai * HALF + m * 16) * 3072 + u.seg * 1024 + col0;
                    float gn[2][2][4], gd[2][2][4]; gld(gp, gn); gld(gp + 1024, gd);
#pragma unroll
                    for (int bj = 0; bj < 2; ++bj)
#pragma unroll
                        for (int n = 0; n < 2; ++n)
#pragma unroll
                            for (int j = 0; j < 4; ++j) acc[ai][bj][m][n][j] *= gn[bj][n][j] * __builtin_amdgcn_rcpf(gd[bj][n][j]);
                    if (m == 3) asm volatile("" ::: "memory"); }
        } else {
#pragma unroll
            for (int ai = 0; ai < 2; ++ai)
#pragma unroll
                for (int m = 0; m < 4; ++m) { const size_t row = (size_t)(row0 + ai * HALF + m * 16);
                    float g[2][2][4]; gld(G8 + row * 3072 + 2048 + col0, g);
#pragma unroll
                    for (int bj = 0; bj < 2; ++bj) { const f32x4 v0 = acc[ai][bj][m][0] * (1.0f / 255.0f), v1 = acc[ai][bj][m][1] * (1.0f / 255.0f);
                        u32x4 w; w.x = cvt_pk_bf16(v0[0] * g[bj][0][0], v0[1] * g[bj][0][1]); w.y = cvt_pk_bf16(v0[2] * g[bj][0][2], v0[3] * g[bj][0][3]);
                        w.z = cvt_pk_bf16(v1[0] * g[bj][1][0], v1[1] * g[bj][1][1]); w.w = cvt_pk_bf16(v1[2] * g[bj][1][2], v1[3] * g[bj][1][3]);
                        *(u32x4*)(O + row * 1024 + col0 + 8 * bj) = w; }
                    if (m == 3) asm volatile("" ::: "memory"); }
        }
    }
};
template <bool FIRST>
struct EpiResid {
    static constexpr bool PERM = true, AFTER_DRAIN = false, MIDHOOK = false;
    const float* Xf; const bf16_t* X; const float* g1; bf16_t* Xo;
    __device__ __forceinline__ void operator()(const f32x4 (&acc)[2][2][4][2], const Unit& u, int wr, int wc, int fr, int fq) const {
        asm volatile("" : "+v"(fr), "+v"(fq));
        const int row0 = u.pm * BM + wr * 64 + fr, col0 = u.pn * BM + wc * 32 + 8 * fq;
        const float* gp = g1 + (size_t)((u.pm * BM) >> 12) * 6144 + col0;
        f32x4 gv[2][2];
#pragma unroll
        for (int bj = 0; bj < 2; ++bj)
#pragma unroll
            for (int n = 0; n < 2; ++n) gv[bj][n] = *(const f32x4*)(gp + bj * HALF + n * 4);
#pragma unroll
        for (int ai = 0; ai < 2; ++ai)
#pragma unroll
            for (int m = 0; m < 4; ++m) { const size_t ro = (size_t)(row0 + ai * HALF + m * 16) * 1024 + col0;
#pragma unroll
                for (int bj = 0; bj < 2; ++bj) { f32x4 x0, x1;
                    if (FIRST) { x0 = *(const f32x4*)(Xf + ro + bj * HALF); x1 = *(const f32x4*)(Xf + ro + bj * HALF + 4); }
                    else { const u32x4 xb = *(const u32x4*)(X + ro + bj * HALF); x0 = (f32x4){bflo(xb.x), bfhi(xb.x), bflo(xb.y), bfhi(xb.y)}; x1 = (f32x4){bflo(xb.z), bfhi(xb.z), bflo(xb.w), bfhi(xb.w)}; }
                    const f32x4 r0 = x0 + gv[bj][0] * acc[ai][bj][m][0], r1 = x1 + gv[bj][1] * acc[ai][bj][m][1];
                    u32x4 w; w.x = cvt_pk_bf16(r0[0], r0[1]); w.y = cvt_pk_bf16(r0[2], r0[3]); w.z = cvt_pk_bf16(r1[0], r1[1]); w.w = cvt_pk_bf16(r1[2], r1[3]);
                    *(u32x4*)(Xo + ro + bj * HALF) = w; } }
    }
};
struct EpiSwiGLU {
    static constexpr bool PERM = true, AFTER_DRAIN = false, MIDHOOK = false;
    bf16_t* O;
    __device__ __forceinline__ void operator()(const f32x4 (&acc)[2][2][4][2], const Unit& u, int wr, int wc, int fr, int fq) const {
        asm volatile("" : "+v"(fr), "+v"(fq));
        const int row0 = u.pm * BM + wr * 64 + fr, col0 = u.pn * HALF + wc * 32 + 8 * fq;
#pragma unroll
        for (int ai = 0; ai < 2; ++ai)
#pragma unroll
            for (int m = 0; m < 4; ++m) { bf16_t* op = O + (size_t)(row0 + ai * HALF + m * 16) * 512 + col0;
                float r[8];
#pragma unroll
                for (int n = 0; n < 2; ++n)
#pragma unroll
                    for (int j = 0; j < 4; ++j) { const float a = acc[ai][0][m][n][j], b = acc[ai][1][m][n][j]; r[n * 4 + j] = a * sigmoidf_(a) * b; }
                u32x4 w; w.x = cvt_pk_bf16(r[0], r[1]); w.y = cvt_pk_bf16(r[2], r[3]); w.z = cvt_pk_bf16(r[4], r[5]); w.w = cvt_pk_bf16(r[6], r[7]);
                *(u32x4*)op = w; }
    }
};
struct EpiY {
    static constexpr bool PERM = true, AFTER_DRAIN = false, MIDHOOK = false;
    bf16_t* O;
    __device__ __forceinline__ void operator()(const f32x4 (&acc)[2][2][4][2], const Unit& u, int wr, int wc, int fr, int fq) const {
        asm volatile("" : "+v"(fr), "+v"(fq));
        const int row0 = u.pm * BM + wr * 64 + fr, col0 = u.pn * BM + wc * 32 + 8 * fq;
#pragma unroll
        for (int ai = 0; ai < 2; ++ai)
#pragma unroll
            for (int m = 0; m < 4; ++m) { bf16_t* rowp = O + (size_t)(row0 + ai * HALF + m * 16) * 1024 + col0;
#pragma unroll
                for (int bj = 0; bj < 2; ++bj) { const f32x4 v0 = acc[ai][bj][m][0], v1 = acc[ai][bj][m][1];
                    u32x4 w; w.x = cvt_pk_bf16(v0[0], v0[1]); w.y = cvt_pk_bf16(v0[2], v0[3]); w.z = cvt_pk_bf16(v1[0], v1[1]); w.w = cvt_pk_bf16(v1[2], v1[3]);
                    *(u32x4*)(rowp + bj * HALF) = w; } }
    }
};

template <class Epi, class Sched, bool ALIGN_EPI = false, bool SP2 = false>
__device__ __forceinline__ void gemm_phase(PG8_LAS unsigned char* lds, const Gemm g, const Sched& S, const Epi& E) {
    const int tid = opqv((int)threadIdx.x), wid = __builtin_amdgcn_readfirstlane(tid >> 6), lane = tid & 63, wr = wid >> 2, wc = wid & 3, fr = lane & 15, fq = lane >> 4;
    const int K = g.K, nt = K / BK, lda = g.lda, ldb = g.ldb;
    unsigned voffA[2], voffB[2];
#pragma unroll
    for (int i = 0; i < 2; ++i) { int R, C; stage_rc(tid * 16 + i * 8192, R, C); const int Rb = Epi::PERM ? ((R & ~31) + perm32(R & 31)) : R;
        voffA[i] = (unsigned)(R * lda + C) * 2u; voffB[i] = (unsigned)(Rb * ldb + C) * 2u; }
    const size_t kstep = (size_t)(BK * 2);
    const size_t hstepA = (size_t)HALF * lda * 2, hstepB = (size_t)HALF * ldb * 2;
    const size_t tstepA = 2 * hstepA, tstepB = 2 * hstepB;
    const unsigned ldsw = (unsigned)wid * 1024u;
    const int aoff = lds_byte(wr * 64 + fr, fq * 8), boff = lds_byte(wc * 32 + fr, fq * 8);
#define PG8_SA(b, h) (((b) * 2 + (h)) * HTB)
#define PG8_SB(b, h) ((4 + (b) * 2 + (h)) * HTB)
#define PG8_STAGE(bufoff, gbase, voff) do { _Pragma("unroll") for (int _i = 0; _i < 2; ++_i) \
        __builtin_amdgcn_global_load_lds((const unsigned*)((const char*)(gbase) + (voff)[_i]), (PG8_LAS unsigned*)(lds + (bufoff) + ldsw + _i * 8192), 16, 0, 0); } while (0)
#define PG8_LDA(dst, b, h) do { _Pragma("unroll") for (int m = 0; m < 4; ++m) _Pragma("unroll") for (int k = 0; k < 2; ++k) dst[m][k] = *(const PG8_LAS bf16x8*)(lds + PG8_SA(b, h) + aoff + m * 2048 + k * 1024); } while (0)
#define PG8_LDB(dst, b, h) do { _Pragma("unroll") for (int n = 0; n < 2; ++n) _Pragma("unroll") for (int k = 0; k < 2; ++k) dst[n][k] = *(const PG8_LAS bf16x8*)(lds + PG8_SB(b, h) + boff + n * 2048 + k * 1024); } while (0)
#define PG8_MMA(ai, bj, At, Bt) do { __builtin_amdgcn_s_setprio(1); _Pragma("unroll") for (int m = 0; m < 4; ++m) _Pragma("unroll") for (int n = 0; n < 2; ++n) _Pragma("unroll") for (int k = 0; k < 2; ++k) \
        acc[ai][bj][m][n] = __builtin_amdgcn_mfma_f32_16x16x32_bf16(Bt[n][k], At[m][k], acc[ai][bj][m][n], 0, 0, 0); __builtin_amdgcn_s_setprio(0); } while (0)
#define PG8_WAIT_V(n) asm volatile("s_waitcnt vmcnt(" #n ")" ::: "memory")
#define PG8_WAIT_L(n) asm volatile("s_waitcnt lgkmcnt(" #n ")" ::: "memory")
#define PG8_BAR __builtin_amdgcn_s_barrier()
#define PG8_SCHED __builtin_amdgcn_sched_barrier(0)
    Unit cur, nxt; int ui = 0;
    if (!S.next(0, cur)) return;
    unsigned gC[2][2], gN[2][2];
#define PG8_GOFF(dst, U) do { if constexpr (Sched::GATHER) { _Pragma("unroll") for (int _h = 0; _h < 2; ++_h) _Pragma("unroll") for (int _i = 0; _i < 2; ++_i) { int _R, _C; stage_rc(tid * 16 + _i * 8192, _R, _C); \
        dst[_h][_i] = (unsigned)S.rowmap[(U).pm * 256 + _h * 128 + _R] * (unsigned)(lda * 2) + (unsigned)_C * 2u; } } } while (0)
#define PG8_STAGEA(bufoff, ptr, gptr, goff) do { if constexpr (Sched::GATHER) PG8_STAGE(bufoff, gptr, goff); else PG8_STAGE(bufoff, ptr, voffA); } while (0)
#define PG8_STAGEA_SEL(bufoff, ptr, gptr, h) do { if constexpr (Sched::GATHER) { if (last) PG8_STAGE(bufoff, gptr, gN[h]); else PG8_STAGE(bufoff, gptr, gC[h]); } else PG8_STAGE(bufoff, ptr, voffA); } while (0)
    PG8_GOFF(gC, cur);
    f32x4 acc[2][2][4][2];
#pragma unroll
    for (int a = 0; a < 2; ++a)
#pragma unroll
        for (int b = 0; b < 2; ++b)
#pragma unroll
            for (int m = 0; m < 4; ++m)
#pragma unroll
                for (int n = 0; n < 2; ++n) acc[a][b][m][n] = (f32x4){0.f, 0.f, 0.f, 0.f};
    bf16x8 At[4][2], B0[2][2], B1[2][2];
    const char* cA = (const char*)g.A + (size_t)cur.pm * tstepA + (Sched::VARK ? (size_t)cur.koff * 2 : 0); const char* cB = (const char*)g.Bt + (size_t)cur.pb * tstepB + (Sched::VARK ? (size_t)cur.koff * 2 : 0);
    S.a_ready(cur);
    if constexpr (SP2) {
        PG8_STAGE(PG8_SB(0, 0), cB, voffB); PG8_STAGE(PG8_SB(0, 1), cB + hstepB, voffB); PG8_STAGEA(PG8_SA(0, 0), cA, (const char*)g.A, gC[0]); PG8_STAGEA(PG8_SA(0, 1), cA + hstepA, (const char*)g.A, gC[1]);
        if (wr == 1) PG8_BAR;
        PG8_WAIT_V(2); PG8_BAR;
        PG8_STAGE(PG8_SB(1, 0), cB + kstep, voffB); PG8_STAGEA(PG8_SA(1, 0), cA + kstep, (const char*)g.A + kstep, gC[0]); PG8_STAGE(PG8_SB(1, 1), cB + hstepB + kstep, voffB);
        PG8_WAIT_V(6); PG8_BAR;
    } else {
        PG8_STAGE(PG8_SB(0, 0), cB, voffB); PG8_STAGE(PG8_SA(0, 0), cA, voffA); PG8_STAGE(PG8_SB(0, 1), cB + hstepB, voffB); PG8_STAGE(PG8_SA(0, 1), cA + hstepA, voffA);
        if (wr == 1) PG8_BAR;
        PG8_WAIT_V(4); PG8_BAR;
        PG8_STAGE(PG8_SB(1, 0), cB + kstep, voffB); PG8_STAGE(PG8_SA(1, 0), cA + kstep, voffA); PG8_STAGE(PG8_SB(1, 1), cB + hstepB + kstep, voffB);
        PG8_WAIT_V(6); PG8_BAR;
    }
    for (;;) {
        const bool has_next = S.next(ui + 1, nxt);
        const char* nA = has_next ? (const char*)g.A + (size_t)nxt.pm * tstepA + (Sched::VARK ? (size_t)nxt.koff * 2 : 0) : cA; const char* nB = has_next ? (const char*)g.Bt + (size_t)nxt.pb * tstepB + (Sched::VARK ? (size_t)nxt.koff * 2 : 0) : cB;
        const int ntc = Sched::VARK ? cur.nt : nt;
        if constexpr (Sched::GATHER) { if (has_next) PG8_GOFF(gN, nxt); else { gN[0][0] = gC[0][0]; gN[0][1] = gC[0][1]; gN[1][0] = gC[1][0]; gN[1][1] = gC[1][1]; } }
#pragma unroll 1
        for (int t = 0; t < ntc; t += 2) {
            const bool last = (t == ntc - 2);
            const char* a1 = cA + (size_t)(t + 1) * kstep;
            const char* a2 = last ? nA : cA + (size_t)(t + 2) * kstep; const char* b2 = last ? nB : cB + (size_t)(t + 2) * kstep;
            const char* a3 = a2 + kstep; const char* b3 = b2 + kstep;
            if (last && has_next) S.a_ready(nxt);
            const char* gk1 = (const char*)g.A + (size_t)(t + 1) * kstep; const char* gk2 = (const char*)g.A + (size_t)(last ? 0 : t + 2) * kstep; const char* gk3 = gk2 + kstep;
            if constexpr (SP2) {
            PG8_LDB(B0, 0, 0); PG8_LDB(B1, 0, 1); PG8_SCHED; PG8_LDA(At, 0, 0); PG8_STAGEA(PG8_SA(1, 1), a1 + hstepA, gk1, gC[1]);
            PG8_WAIT_V(8); PG8_WAIT_L(0); PG8_BAR; PG8_MMA(0, 0, At, B0); PG8_MMA(0, 1, At, B1); PG8_BAR; PG8_SCHED;
            PG8_LDA(At, 0, 1); PG8_STAGE(PG8_SB(0, 0), b2, voffB); PG8_STAGE(PG8_SB(0, 1), b2 + hstepB, voffB); PG8_STAGEA_SEL(PG8_SA(0, 0), a2, gk2, 0);
            PG8_WAIT_V(8); PG8_WAIT_L(0); PG8_BAR; PG8_MMA(1, 0, At, B0); PG8_MMA(1, 1, At, B1); PG8_BAR; PG8_SCHED;
            PG8_LDB(B0, 1, 0); PG8_LDB(B1, 1, 1); PG8_SCHED; PG8_LDA(At, 1, 0); PG8_STAGEA_SEL(PG8_SA(0, 1), a2 + hstepA, gk2, 1);
            PG8_WAIT_V(8); PG8_WAIT_L(0); PG8_BAR; PG8_MMA(0, 0, At, B0); PG8_MMA(0, 1, At, B1); PG8_BAR; PG8_SCHED;
            PG8_LDA(At, 1, 1); PG8_STAGE(PG8_SB(1, 0), b3, voffB); PG8_STAGE(PG8_SB(1, 1), b3 + hstepB, voffB); PG8_STAGEA_SEL(PG8_SA(1, 0), a3, gk3, 0);
            PG8_WAIT_V(8); PG8_WAIT_L(0); PG8_BAR; PG8_MMA(1, 0, At, B0); PG8_MMA(1, 1, At, B1); PG8_BAR; PG8_SCHED;
            } else {
            PG8_LDB(B0, 0, 0); PG8_SCHED; PG8_LDA(At, 0, 0); PG8_STAGE(PG8_SA(1, 1), a1 + hstepA, voffA);
            PG8_WAIT_L(8); PG8_BAR; PG8_WAIT_L(0); PG8_MMA(0, 0, At, B0); PG8_BAR; PG8_SCHED;
            PG8_LDB(B1, 0, 1); PG8_STAGE(PG8_SB(0, 0), b2, voffB);
            PG8_BAR; PG8_WAIT_L(0); PG8_MMA(0, 1, At, B1); PG8_BAR;
            PG8_LDA(At, 0, 1); PG8_STAGE(PG8_SA(0, 0), a2, voffA);
            PG8_BAR; PG8_WAIT_L(0); PG8_MMA(1, 0, At, B0); PG8_BAR; PG8_SCHED;
            PG8_STAGE(PG8_SB(0, 1), b2 + hstepB, voffB);
            PG8_WAIT_V(6); PG8_BAR; PG8_MMA(1, 1, At, B1); PG8_BAR;
            PG8_LDB(B0, 1, 0); PG8_SCHED; PG8_LDA(At, 1, 0); PG8_STAGE(PG8_SA(0, 1), a2 + hstepA, voffA);
            PG8_WAIT_L(8); PG8_BAR; PG8_WAIT_L(0); PG8_MMA(0, 0, At, B0); PG8_BAR; PG8_SCHED;
            PG8_LDB(B1, 1, 1); PG8_STAGE(PG8_SB(1, 0), b3, voffB);
            PG8_BAR; PG8_WAIT_L(0); PG8_MMA(0, 1, At, B1); PG8_BAR;
            PG8_LDA(At, 1, 1); PG8_STAGE(PG8_SA(1, 0), a3, voffA);
            PG8_BAR; PG8_WAIT_L(0); PG8_MMA(1, 0, At, B0); PG8_BAR; PG8_SCHED;
            PG8_STAGE(PG8_SB(1, 1), b3 + hstepB, voffB);
            PG8_WAIT_V(6); PG8_BAR; PG8_MMA(1, 1, At, B1); PG8_BAR;
            }
        }
        if constexpr (ALIGN_EPI) { if (wr == 0) PG8_BAR; }
        if constexpr (!Epi::AFTER_DRAIN) { E(acc, cur, wr, wc, fr, fq); S.done(cur); }
        if (!has_next) break;
        if (!Sched::VARK || cur.zero) {
#pragma unroll
        for (int a = 0; a < 2; ++a)
#pragma unroll
            for (int b = 0; b < 2; ++b)
#pragma unroll
                for (int m = 0; m < 4; ++m)
#pragma unroll
                    for (int n = 0; n < 2; ++n) acc[a][b][m][n] = (f32x4){0.f, 0.f, 0.f, 0.f};
        }
        cur = nxt; cA = nA; cB = nB; ++ui;
        if constexpr (Sched::GATHER) { gC[0][0] = gN[0][0]; gC[0][1] = gN[0][1]; gC[1][0] = gN[1][0]; gC[1][1] = gN[1][1]; }
        if constexpr (ALIGN_EPI) { if (wr == 1) PG8_BAR; }
    }
    PG8_WAIT_V(0);
    if constexpr (!ALIGN_EPI) { if (wr == 0) PG8_BAR; }
    PG8_BAR;
    if constexpr (Epi::AFTER_DRAIN) { E.fused(acc, cur, wr, wc, fr, fq, lds, wid, lane); S.done(cur); }
#undef PG8_GOFF
#undef PG8_STAGEA
#undef PG8_STAGEA_SEL
#undef PG8_SA
#undef PG8_SB
#undef PG8_STAGE
#undef PG8_LDA
#undef PG8_LDB
#undef PG8_MMA
#undef PG8_WAIT_V
#undef PG8_WAIT_L
#undef PG8_BAR
#undef PG8_SCHED
}
}

#ifndef ATTN_FAST
#define ATTN_FAST 1
#endif
#include <hip/hip_bf16.h>
#include <cmath>
namespace attn_body {
using bf16=__hip_bfloat16;
using bf16x8=__attribute__((ext_vector_type(8)))short;
using s16x4=__attribute__((ext_vector_type(4)))short;
using f32x16=__attribute__((ext_vector_type(16)))float;
using u32x4=__attribute__((ext_vector_type(4)))unsigned;
constexpr int BATCH=8,SEQ=4096,D=64,DM=2048,DMO=512;
constexpr int NW=8,QBLK=32,QB=QBLK*NW,KVBLK=64,NQB=SEQ/QB;
constexpr int ATTN_PITCH=DM, ATTN_UNIT_ROWS=QB;
__device__ __forceinline__ int crow(int r,int hi){return (r&3)+8*(r>>2)+4*hi;}
#define SBAR() __builtin_amdgcn_sched_barrier(0)
__device__ __forceinline__ void cmask(f32x16&p0,f32x16&p1,int jb,int wid){
  if(jb>(wid>>1)){ const float NEG=-INFINITY;
    #pragma unroll
    for(int r=0;r<16;++r){p0[r]=NEG;p1[r]=NEG;} }
}

constexpr int NSLOT=3, SLOTB=8192;
constexpr int LDS_K=0, LDS_V=NSLOT*SLOTB, LDS_WS=2*NSLOT*SLOTB, LDS_OST=LDS_WS+NW*64*4, LDS_BYTES=LDS_OST+NW*4096;
constexpr float C2=0.125f*1.4426950408889634f;
__device__ __forceinline__ void glds16(const void*gsrc,unsigned lds_dst){unsigned keep;
  asm volatile("s_mov_b32 %0, m0\n\ts_mov_b32 m0, %2\n\ts_nop 0\n\tglobal_load_lds_dwordx4 %1, off\n\ts_mov_b32 m0, %0":"=&s"(keep):"v"(gsrc),"s"(lds_dst):"memory");}
__device__ __forceinline__ float max3f(float a,float b,float c){float r;asm("v_max3_f32 %0, %1, %2, %3":"=v"(r):"v"(a),"v"(b),"v"(c));return r;}
__device__ __forceinline__ float max2f(float a,float b){float r;asm("v_max_f32_e32 %0, %1, %2":"=v"(r):"v"(a),"v"(b));return r;}
__device__ __forceinline__ float fadd_s(float a,float b){float r;asm("v_add_f32_e32 %0, %1, %2":"=v"(r):"v"(a),"v"(b));return r;}
__device__ __forceinline__ float fsub_s(float a,float b){float r;asm("v_sub_f32_e32 %0, %1, %2":"=v"(r):"v"(a),"v"(b));return r;}
typedef float f32x2_t __attribute__((ext_vector_type(2))); typedef __bf16 bf16x2_t __attribute__((ext_vector_type(2)));
__device__ __forceinline__ unsigned cvtpk_s(float lo,float hi){f32x2_t v={lo,hi};bf16x2_t b=__builtin_convertvector(v,bf16x2_t);return __builtin_bit_cast(unsigned,b);}
#define WAIT_BAR(N) asm volatile("s_waitcnt vmcnt(" #N ") lgkmcnt(0)\n\ts_barrier":::"memory")

__device__ __forceinline__ void qkt(f32x16&p0,f32x16&p1,const char*Kslot,const bf16x8*qr,const f32x16&negm,int r32,int hi){
  const char*kb=Kslot+hi*1024+r32*16;
  #pragma unroll
  for(int d0=0;d0<4;++d0){
    const bf16x8 b0=*reinterpret_cast<const bf16x8*>(kb+d0*2048);
    const bf16x8 b1=*reinterpret_cast<const bf16x8*>(kb+d0*2048+512);
    if(d0==0){p0=__builtin_amdgcn_mfma_f32_32x32x16_bf16(b0,qr[0],negm,0,0,0);p1=__builtin_amdgcn_mfma_f32_32x32x16_bf16(b1,qr[0],negm,0,0,0);}
    else{p0=__builtin_amdgcn_mfma_f32_32x32x16_bf16(b0,qr[d0],p0,0,0,0);p1=__builtin_amdgcn_mfma_f32_32x32x16_bf16(b1,qr[d0],p1,0,0,0);}}
}
typedef __attribute__((address_space(3))) const char* lds_cptr;
typedef short v4i16_t __attribute__((ext_vector_type(4)));
__device__ __forceinline__ void kload8(bf16x8*kf,lds_cptr kp){
  kf[0]=*(const __attribute__((address_space(3))) bf16x8*)(kp);      kf[1]=*(const __attribute__((address_space(3))) bf16x8*)(kp+512);
  kf[2]=*(const __attribute__((address_space(3))) bf16x8*)(kp+2048); kf[3]=*(const __attribute__((address_space(3))) bf16x8*)(kp+2560);
  kf[4]=*(const __attribute__((address_space(3))) bf16x8*)(kp+4096); kf[5]=*(const __attribute__((address_space(3))) bf16x8*)(kp+4608);
  kf[6]=*(const __attribute__((address_space(3))) bf16x8*)(kp+6144); kf[7]=*(const __attribute__((address_space(3))) bf16x8*)(kp+6656);
}
__device__ __forceinline__ void kload2(bf16x8*kf,lds_cptr kp,int j){ kf[2*j]=*(const __attribute__((address_space(3))) bf16x8*)(kp+j*2048); kf[2*j+1]=*(const __attribute__((address_space(3))) bf16x8*)(kp+j*2048+512); }
__device__ __forceinline__ s16x4 vtr(lds_cptr p){ return __builtin_bit_cast(s16x4,__builtin_amdgcn_ds_read_tr16_b64_v4i16((__attribute__((address_space(3))) v4i16_t*)p)); }
__device__ __forceinline__ float rowmax(const f32x16&p0,const f32x16&p1){
  float a=max3f(p0[0],p0[1],p1[0]),b=max3f(p0[2],p0[3],p1[1]);a=max3f(a,p1[2],p1[3]);
  #pragma unroll
  for(int r=4;r<16;r+=4){a=max3f(a,p0[r],p0[r+1]);b=max3f(b,p0[r+2],p0[r+3]);a=max3f(a,p1[r],p1[r+1]);b=max3f(b,p1[r+2],p1[r+3]);}
  const float m=max2f(a,b);
  auto rr=__builtin_amdgcn_permlane32_swap(__float_as_uint(m),__float_as_uint(m),false,false);
  return max2f(__uint_as_float(rr[0]),__uint_as_float(rr[1]));
}
__device__ __forceinline__ void pv(f32x16*o,int vb,bf16x8 pa0,bf16x8 pa1,bf16x8 pa2,bf16x8 pa3){
  #pragma unroll
  for(int d0=0;d0<2;++d0){s16x4 lo[4],hi[4];
    #pragma unroll
    for(int ks=0;ks<4;++ks){
      asm volatile("ds_read_b64_tr_b16 %0,%1 offset:%c2":"=&v"(lo[ks]):"v"(vb),"i"(d0*4096+ks*1024):"memory");
      asm volatile("ds_read_b64_tr_b16 %0,%1 offset:%c2":"=&v"(hi[ks]):"v"(vb),"i"(d0*4096+ks*1024+512):"memory");}
    asm volatile("s_waitcnt lgkmcnt(0)":::"memory");SBAR();
    #define PK(k) (bf16x8){lo[k][0],lo[k][1],lo[k][2],lo[k][3],hi[k][0],hi[k][1],hi[k][2],hi[k][3]}
    o[d0]=__builtin_amdgcn_mfma_f32_32x32x16_bf16(pa0,PK(0),o[d0],0,0,0);
    o[d0]=__builtin_amdgcn_mfma_f32_32x32x16_bf16(pa1,PK(1),o[d0],0,0,0);
    o[d0]=__builtin_amdgcn_mfma_f32_32x32x16_bf16(pa2,PK(2),o[d0],0,0,0);
    o[d0]=__builtin_amdgcn_mfma_f32_32x32x16_bf16(pa3,PK(3),o[d0],0,0,0);
    #undef PK
  }
}

#ifndef ATTN_STORE16
#define ATTN_STORE16(p,v) (*(u32x4*)(p)=(v))
#endif
template<int THRL> __device__ __forceinline__ void attn_unit(int b,int qb,const bf16*Q,const bf16*__restrict__ K,const bf16*__restrict__ V,bf16*O,char*shm){
  const int tid=opqv((int)threadIdx.x),lane=tid&63,r32=lane&31,hi=lane>>5; const int wid=__builtin_amdgcn_readfirstlane(tid>>6);
  const long rowbase=(long)b*SEQ; const int q0=qb*QB;
  const bf16*Qw=Q+(rowbase+q0+wid*QBLK)*DM;
  const bf16*Kh=K+rowbase*DM,*Vh=V+rowbase*DM;
  const unsigned lds0=(unsigned)(uintptr_t)shm;
  float*wsf=(float*)(shm+LDS_WS)+wid*64;
  const bf16*ksrc=Kh+(long)lane*DM+wid*8;
  const bf16*vsrc=Vh+(long)(16*(wid&3)+(lane>>2))*DM+(wid>>2)*32+(lane&3)*8;
  const unsigned kdst=lds0+LDS_K+wid*1024, vdst=lds0+LDS_V+wid*1024;
  #define DMA_K(t,slot) glds16(ksrc+(long)(t)*KVBLK*DM,(unsigned)__builtin_amdgcn_readfirstlane(kdst+(slot)))
  #define DMA_V(t,slot) glds16(vsrc+(long)(t)*KVBLK*DM,(unsigned)__builtin_amdgcn_readfirstlane(vdst+(slot)))
  const int vb0=(int)(lds0+LDS_V)+((lane>>4)&1)*32+(lane&3)*8+(4*hi+((lane&15)>>2))*64;
  const char*Kbase=shm+LDS_K; bf16x8 kf[8];
  const lds_cptr shm3=(lds_cptr)shm; const lds_cptr kp0=shm3+LDS_K+hi*1024+r32*16; const lds_cptr vp0=shm3+LDS_V+((lane>>4)&1)*32+(lane&3)*8+(4*hi+((lane&15)>>2))*64;
  const int NT=(q0+QB)/KVBLK;
  DMA_K(0,0);DMA_V(0,0);DMA_K(1,SLOTB);
  bf16x8 qr[4];
  #pragma unroll
  for(int d0=0;d0<4;++d0)qr[d0]=*reinterpret_cast<const bf16x8*>(&Qw[(long)r32*DM+d0*16+hi*8]);
  float mhat=0.f,l_reg=0.f;f32x16 o[2];o[0]=f32x16{};o[1]=f32x16{};f32x16 negm=f32x16{};asm volatile("":"+v"(negm));
  #define CMASK(P0,P1,t) do{int jb_=(t)-(NT-4); if(jb_>=0)cmask(P0,P1,jb_,wid);}while(0)
  bool resc=false;
  #define START(P0,P1) do{ const float rm=rowmax(P0,P1); resc=false; \
    { const float dl=rm; mhat=fadd_s(mhat,dl); \
      _Pragma("unroll") for(int r=0;r<16;++r){P0[r]=fsub_s(P0[r],dl);P1[r]=fsub_s(P1[r],dl);} \
      _Pragma("unroll") for(int r=0;r<16;++r)negm[r]=-mhat; asm volatile("":"+v"(negm)); } \
    _Pragma("unroll") for(int r=0;r<16;++r)P0[r]=__builtin_amdgcn_exp2f(P0[r]); }while(0)
  #define RESC() do{ if(resc){ asm volatile("s_waitcnt lgkmcnt(0)":::"memory"); \
      _Pragma("unroll") for(int d_=0;d_<2;++d_) _Pragma("unroll") for(int r=0;r<16;++r)o[d_][r]*=wsf[crow(r,hi)]; } }while(0)
  f32x16 pA0,pA1,pB0,pB1;
  int sl_prev=0,sl_cur=0,sl_next=SLOTB;
  #define ROT() do{sl_prev=sl_cur;sl_cur=sl_next;sl_next=(sl_next==(NSLOT-1)*SLOTB)?0:sl_next+SLOTB;}while(0)
  DMA_K(2,2*SLOTB);
  WAIT_BAR(3);
  qkt(pA0,pA1,Kbase,qr,negm,r32,hi);asm volatile("s_nop 15\n\ts_nop 7":"+v"(pA0),"+v"(pA1));CMASK(pA0,pA1,0);
  START(pA0,pA1);
  _Pragma("unroll") for(int r=0;r<16;++r)pA1[r]=__builtin_amdgcn_exp2f(pA1[r]);
  WAIT_BAR(0);
  DMA_K(3,0);DMA_V(1,SLOTB);
  ROT();
  kload8(kf,kp0+sl_cur);
  WAIT_BAR(2);
  s16x4 vlo[8],vhi[8]; u32x4 pw0,pw1,pw2,pw3;
  #define PKW(P,B) cvtpk_s(P[B],P[B+1])
  #define PAF(k) __builtin_bit_cast(bf16x8,pw##k)
  #define VFR(i) (bf16x8){vlo[i][0],vlo[i][1],vlo[i][2],vlo[i][3],vhi[i][0],vhi[i][1],vhi[i][2],vhi[i][3]}
  #define PIN(x) asm volatile("":"+v"(x))
  #define MX3(a,b,c) __builtin_fmaxf(__builtin_fmaxf((a),(b)),(c))
  #define GAPA(MF,A0,A1,A2,A3,W0,W1,PW) do{ MF; sacc+=A0; sacc+=A1; sacc+=A2; sacc+=A3; PIN(sacc); W0; W1; PIN(PW); SBAR(); }while(0)
  #define EX(v) __builtin_amdgcn_exp2f(v)
  #define GAPB(MF,X,B) do{ MF; X[B]=EX(X[B]); X[B+1]=EX(X[B+1]); X[B+2]=EX(X[B+2]); X[B+3]=EX(X[B+3]); PIN(X); SBAR(); }while(0)
  #define VRD(i) do{ vlo[i]=vtr(vp_+(((i)>>2)*4096+((i)&3)*1024)); vhi[i]=vtr(vp_+(((i)>>2)*4096+((i)&3)*1024+512)); }while(0)
  #define KRD(G,j) do{ if(G){ kload2(kf,kp0+sl_next,j); SBAR(); } }while(0)
  #define STEP(C0,C1,P0,P1,t,GK,GV,GL) do{ SBAR(); \
    const lds_cptr vp_=vp0+sl_prev; \
    VRD(0); SBAR(); float sacc=(P0[0]+P0[1]); \
    GAPA(C0=__builtin_amdgcn_mfma_f32_32x32x16_bf16(kf[0],qr[0],negm,0,0,0), P0[2],P0[3],P0[4],P0[5],     pw0[0]=PKW(P0,0), pw0[1]=PKW(P0,2), pw0); \
    VRD(4); SBAR(); GAPA(C1=__builtin_amdgcn_mfma_f32_32x32x16_bf16(kf[1],qr[0],negm,0,0,0), P0[6],P0[7],P0[8],P0[9],     pw0[2]=PKW(P0,4), pw0[3]=PKW(P0,6), pw0); \
    VRD(1); SBAR(); GAPA(C0=__builtin_amdgcn_mfma_f32_32x32x16_bf16(kf[2],qr[1],C0,0,0,0),   P0[10],P0[11],P0[12],P0[13], pw1[0]=PKW(P0,8), pw1[1]=PKW(P0,10), pw1); \
    VRD(5); SBAR(); GAPA(C1=__builtin_amdgcn_mfma_f32_32x32x16_bf16(kf[3],qr[1],C1,0,0,0),   P0[14],P0[15],P1[0],P1[1],   pw1[2]=PKW(P0,12),pw1[3]=PKW(P0,14), pw1); \
    VRD(2); SBAR(); GAPA(C0=__builtin_amdgcn_mfma_f32_32x32x16_bf16(kf[4],qr[2],C0,0,0,0),   P1[2],P1[3],P1[4],P1[5],     pw2[0]=PKW(P1,0), pw2[1]=PKW(P1,2), pw2); \
    VRD(6); SBAR(); GAPA(C1=__builtin_amdgcn_mfma_f32_32x32x16_bf16(kf[5],qr[2],C1,0,0,0),   P1[6],P1[7],P1[8],P1[9],     pw2[2]=PKW(P1,4), pw2[3]=PKW(P1,6), pw2); \
    VRD(3); SBAR(); GAPA(C0=__builtin_amdgcn_mfma_f32_32x32x16_bf16(kf[6],qr[3],C0,0,0,0),   P1[10],P1[11],P1[12],P1[13], pw3[0]=PKW(P1,8), pw3[1]=PKW(P1,10), pw3); \
    VRD(7); SBAR(); GAPA(C1=__builtin_amdgcn_mfma_f32_32x32x16_bf16(kf[7],qr[3],C1,0,0,0),   P1[14],P1[15],0.f,0.f,       pw3[2]=PKW(P1,12),pw3[3]=PKW(P1,14), pw3); \
    l_reg+=sacc; \
    if(GK){DMA_K((t)+3,sl_cur);} if(GV){DMA_V((t)+1,sl_next);} \
    CMASK(C0,C1,t); \
    { float a=MX3(C0[0],C0[1],C1[0]),b=MX3(C0[2],C0[3],C1[1]); a=MX3(a,C1[2],C1[3]); \
      _Pragma("unroll") for(int r=4;r<16;r+=4){a=MX3(a,C0[r],C0[r+1]);b=MX3(b,C0[r+2],C0[r+3]);a=MX3(a,C1[r],C1[r+1]);b=MX3(b,C1[r+2],C1[r+3]);} \
      float rm=__builtin_fmaxf(a,b); { auto rr=__builtin_amdgcn_permlane32_swap(__float_as_uint(rm),__float_as_uint(rm),false,false); rm=__builtin_fmaxf(__uint_as_float(rr[0]),__uint_as_float(rr[1])); } \
      resc=false; \
      if(__builtin_expect(__any(rm>(float)THRL),0)){ const float dl=__builtin_fmaxf(rm,0.f); mhat+=dl; \
        _Pragma("unroll") for(int r=0;r<16;++r){C0[r]-=dl;C1[r]-=dl;} \
        _Pragma("unroll") for(int r=0;r<16;++r)negm[r]=-mhat; asm volatile("":"+v"(negm)); \
        const float f=__builtin_amdgcn_exp2f(-dl); l_reg*=f; if(hi==0)wsf[r32]=f; resc=true; } } \
    SBAR(); \
    GAPB(o[0]=__builtin_amdgcn_mfma_f32_32x32x16_bf16(PAF(0),VFR(0),o[0],0,0,0), C0,0); \
    GAPB(o[1]=__builtin_amdgcn_mfma_f32_32x32x16_bf16(PAF(0),VFR(4),o[1],0,0,0), C0,4); \
    KRD(GL,0); GAPB(o[0]=__builtin_amdgcn_mfma_f32_32x32x16_bf16(PAF(1),VFR(1),o[0],0,0,0), C0,8); \
    KRD(GL,1); GAPB(o[1]=__builtin_amdgcn_mfma_f32_32x32x16_bf16(PAF(1),VFR(5),o[1],0,0,0), C0,12); \
    KRD(GL,2); GAPB(o[0]=__builtin_amdgcn_mfma_f32_32x32x16_bf16(PAF(2),VFR(2),o[0],0,0,0), C1,0); \
    KRD(GL,3); GAPB(o[1]=__builtin_amdgcn_mfma_f32_32x32x16_bf16(PAF(2),VFR(6),o[1],0,0,0), C1,4); \
    GAPB(o[0]=__builtin_amdgcn_mfma_f32_32x32x16_bf16(PAF(3),VFR(3),o[0],0,0,0), C1,8); \
    GAPB(o[1]=__builtin_amdgcn_mfma_f32_32x32x16_bf16(PAF(3),VFR(7),o[1],0,0,0), C1,12); \
    }while(0)
  int t=1;
  #undef CMASK
  #define CMASK(P0,P1,t) do{}while(0)
  for(;t+5<NT;t+=2){
    STEP(pB0,pB1,pA0,pA1,t,true,true,true);     WAIT_BAR(2); RESC(); ROT();
    STEP(pA0,pA1,pB0,pB1,t+1,true,true,true);   WAIT_BAR(2); RESC(); ROT();
  }
  #undef CMASK
  #define CMASK(P0,P1,t) do{int jb_=(t)-(NT-4); if(jb_>=0)cmask(P0,P1,jb_,wid);}while(0)
  #define ENDW(tt) do{ if((tt)+3<NT){WAIT_BAR(2);} else if((tt)+2<NT){WAIT_BAR(1);} else {WAIT_BAR(0);} }while(0)
  for(;t+1<NT;t+=2){
    STEP(pB0,pB1,pA0,pA1,t,(t+3<NT),(t+1<NT),(t+1<NT));       ENDW(t);   RESC(); ROT();
    STEP(pA0,pA1,pB0,pB1,t+1,(t+4<NT),(t+2<NT),(t+2<NT));     ENDW(t+1); RESC(); ROT();
  }
  STEP(pB0,pB1,pA0,pA1,NT-1,false,false,false); RESC();
  { float sacc=pB0[0]+pB0[1]; _Pragma("unroll") for(int r=2;r<16;++r)sacc+=pB0[r]; _Pragma("unroll") for(int r=0;r<16;++r)sacc+=pB1[r]; l_reg+=sacc;
    pw0=(u32x4){PKW(pB0,0),PKW(pB0,2),PKW(pB0,4),PKW(pB0,6)};pw1=(u32x4){PKW(pB0,8),PKW(pB0,10),PKW(pB0,12),PKW(pB0,14)};pw2=(u32x4){PKW(pB1,0),PKW(pB1,2),PKW(pB1,4),PKW(pB1,6)};pw3=(u32x4){PKW(pB1,8),PKW(pB1,10),PKW(pB1,12),PKW(pB1,14)};
    SBAR(); pv(o,vb0+sl_cur,PAF(0),PAF(1),PAF(2),PAF(3)); }
  #undef PKW
  #undef PAF
  #undef VFR
  #undef PIN
  #undef MX3
  #undef GAPA
  #undef GAPB
  #undef EX
  #undef VRD
  #undef KRD
  #undef STEP
  #undef ENDW
  {auto rr=__builtin_amdgcn_permlane32_swap(__float_as_uint(l_reg),__float_as_uint(l_reg),false,false);l_reg=__uint_as_float(rr[0])+__uint_as_float(rr[1]);}
  if(hi==0)wsf[32+r32]=l_reg;asm volatile("s_waitcnt lgkmcnt(0)":::"memory");
  float rli[16];
  #pragma unroll
  for(int r=0;r<16;++r)rli[r]=__builtin_amdgcn_rcpf(wsf[32+crow(r,hi)]);
  bf16*Ow=O+(rowbase+q0+wid*QBLK)*DMO;
  { bf16*stg=(bf16*)(shm+LDS_OST)+wid*2048;
    #pragma unroll
    for(int r=0;r<16;++r){const int orow=crow(r,hi);
      #pragma unroll
      for(int d0=0;d0<2;++d0)stg[orow*64+d0*32+r32]=__float2bfloat16(o[d0][r]*rli[r]);}
    asm volatile("s_waitcnt lgkmcnt(0)":::"memory");
    #pragma unroll
    for(int i=0;i<4;++i){const int row=i*8+(lane>>3),ch=lane&7; const u32x4 v=*(const u32x4*)(stg+row*64+ch*8); ATTN_STORE16(Ow+(long)row*DMO+ch*8,v);} }
  asm volatile("s_waitcnt lgkmcnt(0)\n\ts_barrier":::"memory");
  #undef DMA_K
  #undef DMA_V
  #undef CMASK
  #undef START
  #undef RESC
  #undef ROT
}
constexpr int ATTN_LDS_BYTES=LDS_BYTES;
#undef SBAR
#undef WAIT_BAR
}
#ifndef ATTN_V128
#define ATTN_V128 1
#endif
namespace attn128 {
using bf16=__hip_bfloat16;
using bf16x8=__attribute__((ext_vector_type(8)))short;
using s16x4=__attribute__((ext_vector_type(4)))short;
using f32x16=__attribute__((ext_vector_type(16)))float;
using u32x4=__attribute__((ext_vector_type(4)))unsigned;
constexpr int BATCH=8,SEQ=4096,D=64,DM=2048,DMO=512;
constexpr int NW=8,QBLK=32,QB=QBLK*NW,KVBLK=64,NQB=SEQ/QB;
constexpr int ATTN_PITCH=DM, ATTN_UNIT_ROWS=QB;
__device__ __forceinline__ int crow(int r,int hi){return (r&3)+8*(r>>2)+4*hi;}
#define SBAR() __builtin_amdgcn_sched_barrier(0)
__device__ __forceinline__ void cmask(f32x16&p0,f32x16&p1,int jb,int wid){
  if(jb>(wid>>1)){ const float NEG=-INFINITY;
    #pragma unroll
    for(int r=0;r<16;++r){p0[r]=NEG;p1[r]=NEG;} }
}

constexpr int NSLOT=3, SLOTB=8192;
constexpr int VSLOTB=2*SLOTB;
constexpr int LDS_K=0, LDS_V=NSLOT*SLOTB, LDS_WS=LDS_V+NSLOT*VSLOTB, LDS_OST=LDS_WS+NW*64*4, LDS_BYTES=LDS_OST+NW*8192;
constexpr float C2=0.125f*1.4426950408889634f;
__device__ __forceinline__ void glds16(const void*gsrc,unsigned lds_dst){unsigned keep;
  asm volatile("s_mov_b32 %0, m0\n\ts_mov_b32 m0, %2\n\ts_nop 0\n\tglobal_load_lds_dwordx4 %1, off\n\ts_mov_b32 m0, %0":"=&s"(keep):"v"(gsrc),"s"(lds_dst):"memory");}
__device__ __forceinline__ float max3f(float a,float b,float c){float r;asm("v_max3_f32 %0, %1, %2, %3":"=v"(r):"v"(a),"v"(b),"v"(c));return r;}
__device__ __forceinline__ float max2f(float a,float b){float r;asm("v_max_f32_e32 %0, %1, %2":"=v"(r):"v"(a),"v"(b));return r;}
__device__ __forceinline__ float fadd_s(float a,float b){float r;asm("v_add_f32_e32 %0, %1, %2":"=v"(r):"v"(a),"v"(b));return r;}
__device__ __forceinline__ float fsub_s(float a,float b){float r;asm("v_sub_f32_e32 %0, %1, %2":"=v"(r):"v"(a),"v"(b));return r;}
typedef float f32x2_t __attribute__((ext_vector_type(2))); typedef __bf16 bf16x2_t __attribute__((ext_vector_type(2)));
__device__ __forceinline__ unsigned cvtpk_s(float lo,float hi){f32x2_t v={lo,hi};bf16x2_t b=__builtin_convertvector(v,bf16x2_t);return __builtin_bit_cast(unsigned,b);}
#define WAIT_BAR(N) asm volatile("s_waitcnt vmcnt(" #N ") lgkmcnt(0)\n\ts_barrier":::"memory")

__device__ __forceinline__ void qkt(f32x16&p0,f32x16&p1,const char*Kslot,const bf16x8*qr,int r32,int hi){
  const char*kb=Kslot+hi*1024+r32*16;
  #pragma unroll
  for(int d0=0;d0<4;++d0){
    const bf16x8 b0=*reinterpret_cast<const bf16x8*>(kb+d0*2048);
    const bf16x8 b1=*reinterpret_cast<const bf16x8*>(kb+d0*2048+512);
    if(d0==0){p0=__builtin_amdgcn_mfma_f32_32x32x16_bf16(b0,qr[0],f32x16{},0,0,0);p1=__builtin_amdgcn_mfma_f32_32x32x16_bf16(b1,qr[0],f32x16{},0,0,0);}
    else{p0=__builtin_amdgcn_mfma_f32_32x32x16_bf16(b0,qr[d0],p0,0,0,0);p1=__builtin_amdgcn_mfma_f32_32x32x16_bf16(b1,qr[d0],p1,0,0,0);}}
}
typedef __attribute__((address_space(3))) const char* lds_cptr;
typedef short v4i16_t __attribute__((ext_vector_type(4)));
__device__ __forceinline__ void kload8(bf16x8*kf,lds_cptr kp){
  kf[0]=*(const __attribute__((address_space(3))) bf16x8*)(kp);      kf[1]=*(const __attribute__((address_space(3))) bf16x8*)(kp+512);
  kf[2]=*(const __attribute__((address_space(3))) bf16x8*)(kp+2048); kf[3]=*(const __attribute__((address_space(3))) bf16x8*)(kp+2560);
  kf[4]=*(const __attribute__((address_space(3))) bf16x8*)(kp+4096); kf[5]=*(const __attribute__((address_space(3))) bf16x8*)(kp+4608);
  kf[6]=*(const __attribute__((address_space(3))) bf16x8*)(kp+6144); kf[7]=*(const __attribute__((address_space(3))) bf16x8*)(kp+6656);
}
__device__ __forceinline__ void kload2(bf16x8*kf,lds_cptr kp,int j){ kf[2*j]=*(const __attribute__((address_space(3))) bf16x8*)(kp+j*2048); kf[2*j+1]=*(const __attribute__((address_space(3))) bf16x8*)(kp+j*2048+512); }
__device__ __forceinline__ s16x4 vtr(lds_cptr p){ return __builtin_bit_cast(s16x4,__builtin_amdgcn_ds_read_tr16_b64_v4i16((__attribute__((address_space(3))) v4i16_t*)p)); }
__device__ __forceinline__ float rowmax(const f32x16&p0,const f32x16&p1){
  float a=max3f(p0[0],p0[1],p1[0]),b=max3f(p0[2],p0[3],p1[1]);a=max3f(a,p1[2],p1[3]);
  #pragma unroll
  for(int r=4;r<16;r+=4){a=max3f(a,p0[r],p0[r+1]);b=max3f(b,p0[r+2],p0[r+3]);a=max3f(a,p1[r],p1[r+1]);b=max3f(b,p1[r+2],p1[r+3]);}
  const float m=max2f(a,b);
  auto rr=__builtin_amdgcn_permlane32_swap(__float_as_uint(m),__float_as_uint(m),false,false);
  return max2f(__uint_as_float(rr[0]),__uint_as_float(rr[1]));
}
__device__ __forceinline__ void pv(f32x16*o,int vb,bf16x8 pa0,bf16x8 pa1,bf16x8 pa2,bf16x8 pa3){
  #pragma unroll
  for(int d0=0;d0<4;++d0){s16x4 lo[4],hi[4];
    #pragma unroll
    for(int ks=0;ks<4;++ks){
      asm volatile("ds_read_b64_tr_b16 %0,%1 offset:%c2":"=&v"(lo[ks]):"v"(vb),"i"(d0*4096+ks*1024):"memory");
      asm volatile("ds_read_b64_tr_b16 %0,%1 offset:%c2":"=&v"(hi[ks]):"v"(vb),"i"(d0*4096+ks*1024+512):"memory");}
    asm volatile("s_waitcnt lgkmcnt(0)":::"memory");SBAR();
    #define PK(k) (bf16x8){lo[k][0],lo[k][1],lo[k][2],lo[k][3],hi[k][0],hi[k][1],hi[k][2],hi[k][3]}
    o[d0]=__builtin_amdgcn_mfma_f32_32x32x16_bf16(pa0,PK(0),o[d0],0,0,0);
    o[d0]=__builtin_amdgcn_mfma_f32_32x32x16_bf16(pa1,PK(1),o[d0],0,0,0);
    o[d0]=__builtin_amdgcn_mfma_f32_32x32x16_bf16(pa2,PK(2),o[d0],0,0,0);
    o[d0]=__builtin_amdgcn_mfma_f32_32x32x16_bf16(pa3,PK(3),o[d0],0,0,0);
    #undef PK
  }
}

#ifndef ATTN_STORE16
#define ATTN_STORE16(p,v) (*(u32x4*)(p)=(v))
#endif
template<int THRL> __device__ __forceinline__ void attn_unit(int b,int qb,const bf16*Q,const bf16*__restrict__ K,const bf16*__restrict__ V,bf16*O,char*shm){
  const int tid=opqv((int)threadIdx.x),lane=tid&63,r32=lane&31,hi=lane>>5; const int wid=__builtin_amdgcn_readfirstlane(tid>>6);
  const long rowbase=(long)b*SEQ; const int q0=qb*QB;
  const bf16*Qw=Q+(rowbase+q0+wid*QBLK)*DM;
  const bf16*Kh=K+rowbase*DM,*Vh=V+rowbase*DM;
  const unsigned lds0=(unsigned)(uintptr_t)shm;
  float*wsf=(float*)(shm+LDS_WS)+wid*64;
  const bf16*ksrc=Kh+(long)lane*DM+wid*8;
  const bf16*vsrc=Vh+(long)(16*(wid&3)+(lane>>2))*DM+(wid>>2)*32+(lane&3)*8;
  const unsigned kdst=lds0+LDS_K+wid*1024, vdst=lds0+LDS_V+wid*1024;
  #define DMA_K(t,slot) glds16(ksrc+(long)(t)*KVBLK*DM,(unsigned)__builtin_amdgcn_readfirstlane(kdst+(slot)))
  #define DMA_V(t,slot) do{ glds16(vsrc+(long)(t)*KVBLK*DM,(unsigned)__builtin_amdgcn_readfirstlane(vdst+2*(slot))); glds16(vsrc+(long)(t)*KVBLK*DM+64,(unsigned)__builtin_amdgcn_readfirstlane(vdst+2*(slot)+8192)); }while(0)
  const int vb0=(int)(lds0+LDS_V)+((lane>>4)&1)*32+(lane&3)*8+(4*hi+((lane&15)>>2))*64;
  const char*Kbase=shm+LDS_K; bf16x8 kf[8];
  const lds_cptr shm3=(lds_cptr)shm; const lds_cptr kp0=shm3+LDS_K+hi*1024+r32*16; const lds_cptr vp0=shm3+LDS_V+((lane>>4)&1)*32+(lane&3)*8+(4*hi+((lane&15)>>2))*64;
  const int NT=(q0+QB)/KVBLK;
  DMA_K(0,0);DMA_V(0,0);DMA_K(1,SLOTB);
  bf16x8 qr[4];
  #pragma unroll
  for(int d0=0;d0<4;++d0)qr[d0]=*reinterpret_cast<const bf16x8*>(&Qw[(long)r32*DM+d0*16+hi*8]);
  float mhat=0.f,l_reg=0.f;f32x16 o[4];o[0]=f32x16{};o[1]=f32x16{};o[2]=f32x16{};o[3]=f32x16{};
  #define CMASK(P0,P1,t) do{int jb_=(t)-(NT-4); if(jb_>=0)cmask(P0,P1,jb_,wid);}while(0)
  bool resc=false;
  #define START(P0,P1) do{ mhat=rowmax(P0,P1); resc=false; \
    _Pragma("unroll") for(int r=0;r<16;++r)P0[r]=__builtin_amdgcn_exp2f(P0[r]-mhat); }while(0)
  #define RESC() do{ if(resc){ asm volatile("s_waitcnt lgkmcnt(0)":::"memory"); \
      _Pragma("unroll") for(int d_=0;d_<4;++d_) _Pragma("unroll") for(int r=0;r<16;++r)o[d_][r]*=wsf[crow(r,hi)]; } }while(0)
  f32x16 pA0,pA1,pB0,pB1;
  int sl_prev=0,sl_cur=0,sl_next=SLOTB;
  #define ROT() do{sl_prev=sl_cur;sl_cur=sl_next;sl_next=(sl_next==(NSLOT-1)*SLOTB)?0:sl_next+SLOTB;}while(0)
  DMA_K(2,2*SLOTB);
  WAIT_BAR(4);
  qkt(pA0,pA1,Kbase,qr,r32,hi);asm volatile("s_nop 15\n\ts_nop 7":"+v"(pA0),"+v"(pA1));CMASK(pA0,pA1,0);
  START(pA0,pA1);
  _Pragma("unroll") for(int r=0;r<16;++r)pA1[r]=__builtin_amdgcn_exp2f(pA1[r]-mhat);
  WAIT_BAR(0);
  DMA_K(3,0);DMA_V(1,SLOTB);
  ROT();
  kload8(kf,kp0+sl_cur);
  WAIT_BAR(3);
  s16x4 vlo[8],vhi[8]; u32x4 pw0,pw1,pw2,pw3;
  #define PKW(P,B) cvtpk_s(P[B],P[B+1])
  #define PAF(k) __builtin_bit_cast(bf16x8,pw##k)
  #define VFR(i) (bf16x8){vlo[i][0],vlo[i][1],vlo[i][2],vlo[i][3],vhi[i][0],vhi[i][1],vhi[i][2],vhi[i][3]}
  #define PIN(x) asm volatile("":"+v"(x))
  #define MX3(a,b,c) __builtin_fmaxf(__builtin_fmaxf((a),(b)),(c))
  #define GAPA(MF,A0,A1,A2,A3,W0,W1,PW) do{ MF; sacc+=A0; sacc+=A1; sacc+=A2; sacc+=A3; PIN(sacc); W0; W1; PIN(PW); SBAR(); }while(0)
  #define EX(v) __builtin_amdgcn_exp2f((v)-mhat)
  #define GAPB(MF,X,B) do{ MF; X[B]=EX(X[B]); X[B+1]=EX(X[B+1]); X[B+2]=EX(X[B+2]); X[B+3]=EX(X[B+3]); PIN(X); SBAR(); }while(0)
  #define VRD(i) do{ vlo[i]=vtr(vp_+(((i)>>2)*4096+((i)&3)*1024)); vhi[i]=vtr(vp_+(((i)>>2)*4096+((i)&3)*1024+512)); }while(0)
  #define VRD2(i) do{ vlo[i]=vtr(vp_+((((i)>>2)+2)*4096+((i)&3)*1024)); vhi[i]=vtr(vp_+((((i)>>2)+2)*4096+((i)&3)*1024+512)); SBAR(); }while(0)
  #define GAPC(MF) do{ MF; SBAR(); }while(0)
  #define KRD(G,j) do{ if(G){ kload2(kf,kp0+sl_next,j); SBAR(); } }while(0)
  #define STEP(C0,C1,P0,P1,t,GK,GV,GL) do{ SBAR(); \
    const lds_cptr vp_=vp0+2*sl_prev; \
    VRD(0); SBAR(); float sacc=(P0[0]+P0[1]); \
    GAPA(C0=__builtin_amdgcn_mfma_f32_32x32x16_bf16(kf[0],qr[0],f32x16{},0,0,0), P0[2],P0[3],P0[4],P0[5],     pw0[0]=PKW(P0,0), pw0[1]=PKW(P0,2), pw0); \
    VRD(4); SBAR(); GAPA(C1=__builtin_amdgcn_mfma_f32_32x32x16_bf16(kf[1],qr[0],f32x16{},0,0,0), P0[6],P0[7],P0[8],P0[9],     pw0[2]=PKW(P0,4), pw0[3]=PKW(P0,6), pw0); \
    VRD(1); SBAR(); GAPA(C0=__builtin_amdgcn_mfma_f32_32x32x16_bf16(kf[2],qr[1],C0,0,0,0),   P0[10],P0[11],P0[12],P0[13], pw1[0]=PKW(P0,8), pw1[1]=PKW(P0,10), pw1); \
    VRD(5); SBAR(); GAPA(C1=__builtin_amdgcn_mfma_f32_32x32x16_bf16(kf[3],qr[1],C1,0,0,0),   P0[14],P0[15],P1[0],P1[1],   pw1[2]=PKW(P0,12),pw1[3]=PKW(P0,14), pw1); \
    VRD(2); SBAR(); GAPA(C0=__builtin_amdgcn_mfma_f32_32x32x16_bf16(kf[4],qr[2],C0,0,0,0),   P1[2],P1[3],P1[4],P1[5],     pw2[0]=PKW(P1,0), pw2[1]=PKW(P1,2), pw2); \
    VRD(6); SBAR(); GAPA(C1=__builtin_amdgcn_mfma_f32_32x32x16_bf16(kf[5],qr[2],C1,0,0,0),   P1[6],P1[7],P1[8],P1[9],     pw2[2]=PKW(P1,4), pw2[3]=PKW(P1,6), pw2); \
    VRD(3); SBAR(); GAPA(C0=__builtin_amdgcn_mfma_f32_32x32x16_bf16(kf[6],qr[3],C0,0,0,0),   P1[10],P1[11],P1[12],P1[13], pw3[0]=PKW(P1,8), pw3[1]=PKW(P1,10), pw3); \
    VRD(7); SBAR(); GAPA(C1=__builtin_amdgcn_mfma_f32_32x32x16_bf16(kf[7],qr[3],C1,0,0,0),   P1[14],P1[15],0.f,0.f,       pw3[2]=PKW(P1,12),pw3[3]=PKW(P1,14), pw3); \
    l_reg+=sacc; \
    if(GK){DMA_K((t)+3,sl_cur);} if(GV){DMA_V((t)+1,sl_next);} \
    CMASK(C0,C1,t); \
    { float a=MX3(C0[0],C0[1],C1[0]),b=MX3(C0[2],C0[3],C1[1]); a=MX3(a,C1[2],C1[3]); \
      _Pragma("unroll") for(int r=4;r<16;r+=4){a=MX3(a,C0[r],C0[r+1]);b=MX3(b,C0[r+2],C0[r+3]);a=MX3(a,C1[r],C1[r+1]);b=MX3(b,C1[r+2],C1[r+3]);} \
      float rm=__builtin_fmaxf(a,b); { auto rr=__builtin_amdgcn_permlane32_swap(__float_as_uint(rm),__float_as_uint(rm),false,false); rm=__builtin_fmaxf(__uint_as_float(rr[0]),__uint_as_float(rr[1])); } \
      resc=false; rm-=mhat;                                                            \
      if(__builtin_expect(__any(rm>(float)THRL),0)){ const float dl=__builtin_fmaxf(rm,0.f); mhat+=dl; \
        const float f=__builtin_amdgcn_exp2f(-dl); l_reg*=f; if(hi==0)wsf[r32]=f; resc=true; } } \
    SBAR(); \
    GAPB(o[0]=__builtin_amdgcn_mfma_f32_32x32x16_bf16(PAF(0),VFR(0),o[0],0,0,0), C0,0);  VRD2(0); \
    GAPB(o[1]=__builtin_amdgcn_mfma_f32_32x32x16_bf16(PAF(0),VFR(4),o[1],0,0,0), C0,4);  VRD2(4); \
    GAPB(o[0]=__builtin_amdgcn_mfma_f32_32x32x16_bf16(PAF(1),VFR(1),o[0],0,0,0), C0,8);  VRD2(1); \
    GAPB(o[1]=__builtin_amdgcn_mfma_f32_32x32x16_bf16(PAF(1),VFR(5),o[1],0,0,0), C0,12); VRD2(5); \
    GAPB(o[0]=__builtin_amdgcn_mfma_f32_32x32x16_bf16(PAF(2),VFR(2),o[0],0,0,0), C1,0);  VRD2(2); \
    GAPB(o[1]=__builtin_amdgcn_mfma_f32_32x32x16_bf16(PAF(2),VFR(6),o[1],0,0,0), C1,4);  VRD2(6); \
    GAPB(o[0]=__builtin_amdgcn_mfma_f32_32x32x16_bf16(PAF(3),VFR(3),o[0],0,0,0), C1,8);  VRD2(3); \
    GAPB(o[1]=__builtin_amdgcn_mfma_f32_32x32x16_bf16(PAF(3),VFR(7),o[1],0,0,0), C1,12); VRD2(7); \
      \
    GAPC(o[2]=__builtin_amdgcn_mfma_f32_32x32x16_bf16(PAF(0),VFR(0),o[2],0,0,0)); \
    GAPC(o[3]=__builtin_amdgcn_mfma_f32_32x32x16_bf16(PAF(0),VFR(4),o[3],0,0,0)); \
    KRD(GL,0); GAPC(o[2]=__builtin_amdgcn_mfma_f32_32x32x16_bf16(PAF(1),VFR(1),o[2],0,0,0)); \
    KRD(GL,1); GAPC(o[3]=__builtin_amdgcn_mfma_f32_32x32x16_bf16(PAF(1),VFR(5),o[3],0,0,0)); \
    KRD(GL,2); GAPC(o[2]=__builtin_amdgcn_mfma_f32_32x32x16_bf16(PAF(2),VFR(2),o[2],0,0,0)); \
    KRD(GL,3); GAPC(o[3]=__builtin_amdgcn_mfma_f32_32x32x16_bf16(PAF(2),VFR(6),o[3],0,0,0)); \
    GAPC(o[2]=__builtin_amdgcn_mfma_f32_32x32x16_bf16(PAF(3),VFR(3),o[2],0,0,0)); \
    GAPC(o[3]=__builtin_amdgcn_mfma_f32_32x32x16_bf16(PAF(3),VFR(7),o[3],0,0,0)); \
    }while(0)
  int t=1;
  #undef CMASK
  #define CMASK(P0,P1,t) do{}while(0)
  for(;t+5<NT;t+=2){
    STEP(pB0,pB1,pA0,pA1,t,true,true,true);     WAIT_BAR(3); RESC(); ROT();
    STEP(pA0,pA1,pB0,pB1,t+1,true,true,true);   WAIT_BAR(3); RESC(); ROT();
  }
  #undef CMASK
  #define CMASK(P0,P1,t) do{int jb_=(t)-(NT-4); if(jb_>=0)cmask(P0,P1,jb_,wid);}while(0)
  #define ENDW(tt) do{ if((tt)+3<NT){WAIT_BAR(3);} else if((tt)+2<NT){WAIT_BAR(2);} else {WAIT_BAR(0);} }while(0)
  for(;t+1<NT;t+=2){
    STEP(pB0,pB1,pA0,pA1,t,(t+3<NT),(t+1<NT),(t+1<NT));       ENDW(t);   RESC(); ROT();
    STEP(pA0,pA1,pB0,pB1,t+1,(t+4<NT),(t+2<NT),(t+2<NT));     ENDW(t+1); RESC(); ROT();
  }
  STEP(pB0,pB1,pA0,pA1,NT-1,false,false,false); RESC();
  { float sacc=pB0[0]+pB0[1]; _Pragma("unroll") for(int r=2;r<16;++r)sacc+=pB0[r]; _Pragma("unroll") for(int r=0;r<16;++r)sacc+=pB1[r]; l_reg+=sacc;
    pw0=(u32x4){PKW(pB0,0),PKW(pB0,2),PKW(pB0,4),PKW(pB0,6)};pw1=(u32x4){PKW(pB0,8),PKW(pB0,10),PKW(pB0,12),PKW(pB0,14)};pw2=(u32x4){PKW(pB1,0),PKW(pB1,2),PKW(pB1,4),PKW(pB1,6)};pw3=(u32x4){PKW(pB1,8),PKW(pB1,10),PKW(pB1,12),PKW(pB1,14)};
    SBAR(); pv(o,vb0+2*sl_cur,PAF(0),PAF(1),PAF(2),PAF(3)); }
  #undef PKW
  #undef PAF
  #undef VFR
  #undef PIN
  #undef MX3
  #undef GAPA
  #undef GAPB
  #undef EX
  #undef VRD
  #undef VRD2
  #undef GAPC
  #undef KRD
  #undef STEP
  #undef ENDW
  {auto rr=__builtin_amdgcn_permlane32_swap(__float_as_uint(l_reg),__float_as_uint(l_reg),false,false);l_reg=__uint_as_float(rr[0])+__uint_as_float(rr[1]);}
  if(hi==0)wsf[32+r32]=l_reg;asm volatile("s_waitcnt lgkmcnt(0)":::"memory");
  float rli[16];
  #pragma unroll
  for(int r=0;r<16;++r)rli[r]=__builtin_amdgcn_rcpf(wsf[32+crow(r,hi)]);
  bf16*Ow=O+(rowbase+q0+wid*QBLK)*DMO;
  { bf16*stg=(bf16*)(shm+LDS_OST)+wid*4096;
    #pragma unroll
    for(int r=0;r<16;++r){const int orow=crow(r,hi);
      #pragma unroll
      for(int d0=0;d0<4;++d0)stg[orow*128+d0*32+r32]=__float2bfloat16(o[d0][r]*rli[r]);}
    asm volatile("s_waitcnt lgkmcnt(0)":::"memory");
    #pragma unroll
    for(int i=0;i<8;++i){const int row=i*4+(lane>>4),ch=lane&15; const u32x4 v=*(const u32x4*)(stg+row*128+ch*8); ATTN_STORE16(Ow+(long)row*DMO+ch*8,v);} }
  asm volatile("s_waitcnt lgkmcnt(0)\n\ts_barrier":::"memory");
  #undef DMA_K
  #undef DMA_V
  #undef CMASK
  #undef START
  #undef RESC
  #undef ROT
}
constexpr int ATTN_LDS_BYTES=LDS_BYTES;
#undef SBAR
#undef WAIT_BAR
}


constexpr int NB = 8, SEQ = 4096, T = NB * SEQ, D = 1024, DEPTH = 4;
constexpr int ZW = 2048, GWD = 3072, NCAT = ZW + GWD;
constexpr int ZQ = 256, ZK = 768, ZV = 1280, ZC = 1792;
constexpr int NEXP = 32, FF = 512, MAXSLOT = 2 * T + NEXP * 256;
constexpr float NORM_EPS = 1e-6f;
constexpr int NWAVES = 8;
constexpr int PH_PER_LAYER = 11, N_PHASES = 1 + DEPTH * PH_PER_LAYER + 1;

constexpr size_t MiB = 1u << 20;
constexpr size_t WS_CTL = 0, CTL_ZERO_BYTES = 1 * MiB;
constexpr size_t WS_MOD = 1 * MiB;
constexpr size_t WS_LAM = WS_MOD + (size_t)DEPTH * NB * 6144 * 4;
constexpr size_t WS_ROPE_C = 2 * MiB, WS_ROPE_S = 6 * MiB;
constexpr size_t WS_SSM = 10 * MiB;
constexpr size_t SSM_L_BYTES = 8192 + 8192 + 65536;
constexpr size_t WS_RWT = 11 * MiB;
constexpr size_t WS_TOKE = 12 * MiB, WS_TOKW = WS_TOKE + 256 * 1024, WS_TOKL = WS_TOKW + 256 * 1024, WS_TOKS = WS_TOKL + 256 * 1024;
constexpr size_t WS_WGBASE = 13 * MiB, WS_TILEE = WS_WGBASE + 64 * 1024;
constexpr size_t WS_ROWMAP = WS_WGBASE + 128 * 1024;
constexpr size_t WS_E = 14 * MiB, WS_CIN = 18 * MiB;
constexpr size_t WS_WCAT = 24 * MiB;
constexpr size_t WS_WMIX = 64 * MiB;
constexpr size_t WS_WO = 72 * MiB;
constexpr size_t WS_WGLU = 80 * MiB;
constexpr size_t WS_W13 = 82 * MiB;
constexpr size_t WS_W2 = 146 * MiB;
constexpr size_t WS_H = 178 * MiB;
constexpr size_t WS_Z = 242 * MiB;
constexpr size_t WS_G = 370 * MiB;
constexpr size_t WS_O0 = 562 * MiB, WS_O1 = 626 * MiB;
constexpr size_t WS_AMIX = 690 * MiB;
constexpr size_t WS_MIXED = 754 * MiB;
constexpr size_t WS_AG = 242 * MiB;
constexpr size_t WS_ACT = 386 * MiB;
constexpr size_t WS_Y = 458 * MiB;
constexpr size_t WS_XB = 818 * MiB;
constexpr size_t WS_END = 882 * MiB;
static_assert(WS_AG + (size_t)MAXSLOT * 1024 * 2 <= WS_ACT && WS_ACT + (size_t)MAXSLOT * 512 * 2 <= WS_Y && WS_Y + (size_t)MAXSLOT * 1024 * 2 <= WS_AMIX, "moe overlay map");
constexpr int CW_BAR = 4096;
constexpr int CW_CNT = 16384;

constexpr int RING_OFF = 0, RING_BYTES = 159744;
constexpr int LDSCTL_OFF = RING_BYTES, MISC_OFF = LDSCTL_OFF + 320;
constexpr int LDS_BYTES = 163840;

#define GAS __attribute__((address_space(1)))
#define LAS __attribute__((address_space(3)))
typedef unsigned short bf16;
typedef unsigned v4u __attribute__((ext_vector_type(4)));
typedef unsigned v2u __attribute__((ext_vector_type(2)));
typedef float f32x4 __attribute__((ext_vector_type(4)));
typedef float f32x2 __attribute__((ext_vector_type(2)));
typedef short bf16x8 __attribute__((ext_vector_type(8)));
typedef GAS unsigned gu32;
#define RLX_AGENT __ATOMIC_RELAXED, __HIP_MEMORY_SCOPE_AGENT
#define LDS_WAIT() asm volatile("s_waitcnt lgkmcnt(0)" ::: "memory")
#define VM_WAIT() asm volatile("s_waitcnt vmcnt(0)" ::: "memory")
__device__ __forceinline__ unsigned f2bf(float f) { unsigned u = __builtin_bit_cast(unsigned, f); return (u + 0x7fffu + ((u >> 16) & 1u)) >> 16; }
__device__ __forceinline__ unsigned pk2(float lo, float hi) { return f2bf(lo) | (f2bf(hi) << 16); }
__device__ __forceinline__ float bf2f(unsigned short b) { return __uint_as_float(((unsigned)b) << 16); }
__device__ __forceinline__ float bflo(unsigned w) { return __uint_as_float(w << 16); }
__device__ __forceinline__ float bfhi(unsigned w) { return __uint_as_float(w & 0xffff0000u); }

#define XB_TMO      128
#define XB_XCNT(j)  (256  + 64 * (j))
#define XB_XSUB(j)  (1280 + 64 * (j))
#define XB_XGEN(j)  (2304 + 64 * (j))
#define XB_TOP      3328
#define XB_TOPGEN   3392
#define XCD_BAR_WORDS 3456
#define XB_SPIN_CAP (1u << 18)

__device__ __forceinline__ unsigned xb_ld(unsigned* p)              { return __hip_atomic_load(p, __ATOMIC_RELAXED, __HIP_MEMORY_SCOPE_AGENT); }
__device__ __forceinline__ unsigned xb_add(unsigned* p, unsigned v) { return __hip_atomic_fetch_add(p, v, __ATOMIC_RELAXED, __HIP_MEMORY_SCOPE_AGENT); }
__device__ __forceinline__ unsigned xb_xcc_id() { return (unsigned)__builtin_amdgcn_s_getreg((3 << 11) | 20) & 0xFu; }
#define XB_SPIN(cond, bar) do { unsigned _sp = 0; while (cond) { __builtin_amdgcn_s_sleep(1); \
    if ((++_sp & 255u) == 0u) { if (xb_ld(&(bar)[XB_TMO])) break; if (_sp > XB_SPIN_CAP) { atomicAdd(&(bar)[XB_TMO], 1u); break; } } } } while (0)

struct XcdBarrier {
    unsigned* bar; unsigned x;
    volatile LAS unsigned* st;
};

__device__ __forceinline__ XcdBarrier xcd_barrier_post(unsigned* bar, volatile LAS unsigned* st) {
    XcdBarrier b; b.bar = bar; b.x = xb_xcc_id(); b.st = st;
    if (threadIdx.x == 0) (void)xb_add(&bar[XB_XCNT(b.x)], 1u);
    return b;
}
__device__ __forceinline__ void xcd_barrier_complete(unsigned* bar, unsigned x, unsigned& nloc, unsigned& nx) {
    const unsigned G = gridDim.x * gridDim.y * gridDim.z;
    unsigned sum, cnt, mine, sp = 0u;
    for (;;) {
        sum = 0u; cnt = 0u; mine = 0u;
#pragma unroll
        for (unsigned j = 0; j < 16; ++j) { const unsigned c = xb_ld(&bar[XB_XCNT(j)]); sum += c; cnt += (c > 0u) ? 1u : 0u; mine = (j == x) ? c : mine; }
        if (sum == G) break;
        __builtin_amdgcn_s_sleep(1);
        if ((++sp & 255u) == 0u) { if (xb_ld(&bar[XB_TMO])) break; if (sp > XB_SPIN_CAP) { atomicAdd(&bar[XB_TMO], 1u); break; } }
    }
    nloc = mine > 0u ? mine : 1u; nx = cnt > 0u ? cnt : 1u;
}

__device__ __forceinline__ void xcd_barrier(const XcdBarrier& b) {
    asm volatile("s_waitcnt vmcnt(0)" ::: "memory");
    __syncthreads();
    if (threadIdx.x == 0) {
        unsigned* bar = b.bar;
        __builtin_amdgcn_s_waitcnt(0);
        unsigned nloc = b.st[0], nx = b.st[1];
        if (nloc == 0u) { xcd_barrier_complete(bar, b.x, nloc, nx); b.st[0] = nloc; b.st[1] = nx; }
        const unsigned old = xb_add(&bar[XB_XSUB(b.x)], 1u);
        const unsigned gen = old / nloc;
        if (old + 1u == (gen + 1u) * nloc) {
            __builtin_amdgcn_fence(__ATOMIC_RELEASE, "agent");
            asm volatile("s_waitcnt vmcnt(0)" ::: "memory");
            const unsigned og = xb_add(&bar[XB_TOP], 1u);
            const unsigned tg = og / nx;
            if (og + 1u == (tg + 1u) * nx) xb_add(&bar[XB_TOPGEN], 1u);
            else XB_SPIN(xb_ld(&bar[XB_TOPGEN]) == tg, bar);
            __builtin_amdgcn_fence(__ATOMIC_ACQUIRE, "agent");
            xb_add(&bar[XB_XGEN(b.x)], 1u);
            asm volatile("s_waitcnt vmcnt(0)" ::: "memory");
        } else {
            XB_SPIN(xb_ld(&bar[XB_XGEN(b.x)]) == gen, bar);
            __builtin_amdgcn_fence(__ATOMIC_ACQUIRE, "agent");
            asm volatile("s_waitcnt vmcnt(0)" ::: "memory");
        }
    }
    __syncthreads();
}


typedef float f32x2_cv __attribute__((ext_vector_type(2))); typedef __bf16 bf16x2_cv __attribute__((ext_vector_type(2)));
__device__ __forceinline__ unsigned cvtpk(float lo, float hi) { f32x2_cv v = {lo, hi}; bf16x2_cv b = __builtin_convertvector(v, bf16x2_cv); return __builtin_bit_cast(unsigned, b); }
#define DPPF(v, ctrl) __builtin_bit_cast(float, __builtin_amdgcn_update_dpp(0, __builtin_bit_cast(int, (v)), (ctrl), 0xF, 0xF, false))
__device__ __forceinline__ float wave_sum(float v) {
    v += DPPF(v, 0xB1);
    v += DPPF(v, 0x4E);
    v += DPPF(v, 0x141);
    v += DPPF(v, 0x140);
    { auto rr = __builtin_amdgcn_permlane16_swap(__float_as_uint(v), __float_as_uint(v), false, false); v = __uint_as_float(rr[0]) + __uint_as_float(rr[1]); }
    { auto rr = __builtin_amdgcn_permlane32_swap(__float_as_uint(v), __float_as_uint(v), false, false); v = __uint_as_float(rr[0]) + __uint_as_float(rr[1]); }
    return v;
}
__device__ __forceinline__ void wave_sum4(float& a0, float& a1, float& a2, float& a3, int lane) {
    const bool o1 = (lane & 1) != 0, o2 = (lane & 2) != 0;
    float u = o1 ? a1 : a0; const float us = o1 ? a0 : a1; u += DPPF(us, 0xB1);
    float w = o1 ? a3 : a2; const float wsn = o1 ? a2 : a3; w += DPPF(wsn, 0xB1);
    float p = o2 ? w : u; const float ps = o2 ? u : w; p += DPPF(ps, 0x4E);
    p += DPPF(p, 0x124);
    p += DPPF(p, 0x128);
    { auto rr = __builtin_amdgcn_permlane16_swap(__float_as_uint(p), __float_as_uint(p), false, false); p = __uint_as_float(rr[0]) + __uint_as_float(rr[1]); }
    { auto rr = __builtin_amdgcn_permlane32_swap(__float_as_uint(p), __float_as_uint(p), false, false); p = __uint_as_float(rr[0]) + __uint_as_float(rr[1]); }
    a0 = DPPF(p, 0x00); a1 = DPPF(p, 0x55); a2 = DPPF(p, 0xAA); a3 = DPPF(p, 0xFF);
}
__device__ __forceinline__ float wave_max(float v) {
#pragma unroll
    for (int o = 1; o < 64; o <<= 1) v = fmaxf(v, __shfl_xor(v, o));
    return v;
}
__device__ __forceinline__ float sigmoidf_(float x) { return __builtin_amdgcn_rcpf(1.0f + __builtin_amdgcn_exp2f(-1.4426950408889634f * x)); }
__device__ __forceinline__ float gelu_tanh(float x) { const float u = 0.7978845608028654f * (x + 0.044715f * x * x * x); return x * __builtin_amdgcn_rcpf(1.0f + __builtin_amdgcn_exp2f(-2.8853900817779268f * u)); }

__device__ __forceinline__ void tr_item(const float* __restrict__ W, int N, int k0, int n0, bf16* WT, int ldt, int drow0, int dcol0, LAS float* scr, int lane, bool mode16 = false) {
#pragma unroll 1
    for (int hb = 0; hb < 2; ++hb) { f32x4 v[4];
#pragma unroll
      for (int i = 0; i < 4; ++i) v[i] = __builtin_nontemporal_load((const f32x4*)(W + (size_t)(k0 + 8 * (4 * hb + i) + (lane >> 3)) * N + n0 + 4 * (lane & 7)));
#pragma unroll
      for (int i = 0; i < 4; ++i) { LAS float* d = scr + (8 * (4 * hb + i) + (lane >> 3)) * 33 + 4 * (lane & 7); d[0] = v[i].x; d[1] = v[i].y; d[2] = v[i].z; d[3] = v[i].w; } }
    LDS_WAIT(); asm volatile("" ::: "memory");
    const int c = lane & 7;
#pragma unroll
    for (int j = 0; j < 4; ++j) { const int n = (lane >> 3) + 8 * j; const LAS float* s = scr + (8 * c) * 33 + n;
        v4u o; o.x = pk2(s[0 * 33], s[1 * 33]); o.y = pk2(s[2 * 33], s[3 * 33]); o.z = pk2(s[4 * 33], s[5 * 33]); o.w = pk2(s[6 * 33], s[7 * 33]);
        const int c0 = n0 & 255, drow = mode16 ? drow0 + 128 * (j & 1) + 32 * (c0 >> 6) + 16 * ((c0 >> 5) & 1) + 8 * (j >> 1) + (lane >> 3) : drow0 + n;
        *(v4u*)(WT + (size_t)drow * ldt + dcol0 + 8 * c) = o; }
    LDS_WAIT(); asm volatile("" ::: "memory");
}

struct Args { const void* in[40]; float* out; unsigned char* ws; int ph_lo, ph_hi; };

enum { I_X = 0, I_C, I_POS, I_ADAW, I_ADAB, I_N1G, I_WIN, I_POOLW, I_POOLS, I_QNG, I_KNG, I_LQ1, I_LK1, I_LQ2, I_LK2, I_SUBLN,
       I_LAMRE, I_LAMIM, I_LOGDT, I_BRE, I_BIM, I_CRE, I_CIM, I_DSKIP, I_GLUW, I_GLUB, I_PROJA, I_PROJB, I_PROJC, I_GATEW, I_GATEB,
       I_WOUT, I_N2G, I_RGW, I_RGB, I_REW, I_REB, I_W1, I_W3, I_W2 };

__device__ __forceinline__ float lambda_init_of(int l) { return l == 0 ? 0.2f : (l == 1 ? 0.35550906759096926f : (l == 2 ? 0.47071302343358413f : 0.5560582041556841f)); }

__device__ __forceinline__ void prologue_phase(const Args& a, LAS unsigned char* lds) {
    const int z = opq(); (void)z;
    const int tid = opqv((int)threadIdx.x), lane = tid & 63, wave = __builtin_amdgcn_readfirstlane(tid >> 6); const int G = (int)gridDim.x, bx = (int)blockIdx.x;
    const int vcu = (G % 8 == 0) ? (bx % 8) * (G / 8) + bx / 8 : bx; const int gw = vcu * NWAVES + wave, NGW = G * NWAVES, gt = vcu * 512 + tid;
    (void)lane; (void)gw; (void)NGW; (void)gt; (void)bx;
    unsigned char* ws = (a.ws + z);
    const int NGT = G * 512;
    LAS float* scr = (LAS float*)(lds + RING_OFF + wave * 16384);
    {
        constexpr int I_IN = 16 * 64, I_GT = 16 * 96, I_PB = 8 * 32, I_PC = 4 * 32, I_WOI = 16 * 32, I_GL = 4 * 8;
        constexpr int PER_L = I_IN + I_GT + I_PB + I_PC + I_WOI + I_GL;
        for (int it = gw; it < DEPTH * PER_L; it += NGW) {
            const int l = it / PER_L; int r = it - l * PER_L;
            bf16* wcat = (bf16*)(ws + WS_WCAT) + (size_t)l * NCAT * 1024;
            bf16* wmix = (bf16*)(ws + WS_WMIX) + (size_t)l * 1024 * 1024;
            if (r < I_IN) { const int kb = r / 64, nb = r % 64; int drow = nb * 32;
                { const int lg = nb & 7, p = 4 * (lg & 1) + (lg >> 1); drow = (nb & ~7) * 32 + 32 * p; }
                tr_item((const float*)a.in[z + I_WIN] + (size_t)l * 1024 * ZW, ZW, kb * 64, nb * 32, wcat, 1024, drow, kb * 64, scr, lane); continue; } r -= I_IN;
            if (r < I_GT) { const int kb = r / 96, nb = r % 96;
                tr_item((const float*)a.in[z + I_GATEW] + (size_t)l * 1024 * GWD, GWD, kb * 64, nb * 32, wcat, 1024, ZW + (nb & ~7) * 32, kb * 64, scr, lane, true); continue; } r -= I_GT;
            if (r < I_PB) { const int kb = r / 32, nb = r % 32; tr_item((const float*)a.in[z + I_PROJB] + (size_t)l * 512 * 1024, 1024, kb * 64, nb * 32, wmix, 1024, (nb & ~7) * 32, 256 + kb * 64, scr, lane, true); continue; } r -= I_PB;
            if (r < I_PC) { const int kb = r / 32, nb = r % 32; tr_item((const float*)a.in[z + I_PROJC] + (size_t)l * 256 * 1024, 1024, kb * 64, nb * 32, wmix, 1024, (nb & ~7) * 32, 768 + kb * 64, scr, lane, true); continue; } r -= I_PC;
            if (r < I_WOI) { const int kb = r / 32, nb = r % 32; tr_item((const float*)a.in[z + I_WOUT] + (size_t)l * 1024 * 1024, 1024, kb * 64, nb * 32, (bf16*)(ws + WS_WO) + (size_t)l * 1024 * 1024, 1024, nb * 32, kb * 64, scr, lane); continue; } r -= I_WOI;
            { const int kb = r / 8, nb = r % 8; tr_item((const float*)a.in[z + I_GLUW] + (size_t)l * 256 * 256, 256, kb * 64, nb * 32, (bf16*)(ws + WS_WGLU) + (size_t)l * 256 * 256, 256, nb * 32, kb * 64, scr, lane); }
        }
    }
    for (int idx = gt; idx < DEPTH * 256 * 1024; idx += NGT) {
        const int l = idx >> 18, k = (idx >> 10) & 255, n = idx & 1023, g = k >> 6, c = k & 63;
        const float* pw = (const float*)a.in[z + I_POOLW] + ((size_t)(l * 4 + g) * 64 + c) * 64;
        const float* ps = (const float*)a.in[z + I_POOLS] + l * 256 + g * 64;
        const float* pa = (const float*)a.in[z + I_PROJA] + ((size_t)l * 256 + g * 64) * 1024 + n;
        float s = 0.f;
        for (int d = 0; d < 64; ++d) s += pw[d] * ps[d] * pa[(size_t)d * 1024];
        const int cc = n & 255, prow = (n & ~255) + 128 * ((cc >> 3) & 1) + 32 * (cc >> 6) + 8 * ((cc >> 4) & 3) + (cc & 7);
        ((bf16*)(ws + WS_WMIX))[((size_t)l * 1024 + prow) * 1024 + k] = (bf16)f2bf(s);
    }
    for (int idx = gt; idx < T * 32; idx += NGT) {
        const int t = idx >> 5, i = idx & 31;
        const float inv = powf(10000.0f, -(float)(2 * i) / 64.0f);
        const float ang = (float)((const int*)a.in[z + I_POS])[t] * inv;
        ((float*)(ws + WS_ROPE_C))[idx] = cosf(ang); ((float*)(ws + WS_ROPE_S))[idx] = sinf(ang);
    }
    for (int idx = gt; idx < DEPTH * 16 * 64; idx += NGT) {
        const int l = idx >> 10, g = (idx >> 6) & 15, p = idx & 63;
        const float lr = ((const float*)a.in[z + I_LAMRE])[idx], li = ((const float*)a.in[z + I_LAMIM])[idx];
        const float dt = expf(((const float*)a.in[z + I_LOGDT])[l * 16 + g]);
        const float mag = expf(lr * dt), ar = mag * cosf(li * dt), ai = mag * sinf(li * dt);
        const float nr = ar - 1.0f, ni = ai, den = lr * lr + li * li;
        const float kr = (nr * lr + ni * li) / den, ki = (ni * lr - nr * li) / den;
        unsigned char* base = ws + WS_SSM + (size_t)l * SSM_L_BYTES;
        ((f32x2*)base)[g * 64 + p] = (f32x2){ar, ai};
        float pr = ar, pi = ai;
#pragma unroll
        for (int q = 0; q < 6; ++q) { const float tr = pr * pr - pi * pi, ti = 2.0f * pr * pi; pr = tr; pi = ti; }
        ((f32x2*)(base + 8192))[g * 64 + p] = (f32x2){pr, pi};
        const float* br = (const float*)a.in[z + I_BRE] + (size_t)idx * 16; const float* bi = (const float*)a.in[z + I_BIM] + (size_t)idx * 16;
        bf16* bbh = (bf16*)(base + 16384) + (size_t)g * 128 * 16;
        for (int ch = 0; ch < 16; ++ch) { bbh[p * 16 + ch] = (bf16)f2bf(kr * br[ch] - ki * bi[ch]); bbh[(64 + p) * 16 + ch] = (bf16)f2bf(kr * bi[ch] + ki * br[ch]); }
    }
    if (gt < DEPTH) {
        const int l = gt; float s1 = 0.f, s2 = 0.f;
        for (int d = 0; d < 64; ++d) { s1 += ((const float*)a.in[z + I_LQ1])[l * 64 + d] * ((const float*)a.in[z + I_LK1])[l * 64 + d]; s2 += ((const float*)a.in[z + I_LQ2])[l * 64 + d] * ((const float*)a.in[z + I_LK2])[l * 64 + d]; }
        ((float*)(ws + WS_LAM))[l] = expf(s1) - expf(s2) + lambda_init_of(l);
    }
    for (int idx = gt; idx < DEPTH * 36 * 1024; idx += NGT) {
        const int l = idx / (36 * 1024), r = idx - l * 36 * 1024, j = r >> 10, k = r & 1023;
        ((float*)(ws + WS_RWT))[idx] = j < 4 ? ((const float*)a.in[z + I_RGW])[((size_t)l * 1024 + k) * 4 + j] : ((const float*)a.in[z + I_REW])[((size_t)l * 1024 + k) * 32 + (j - 4)];
    }
    {
        LAS float* cact = (LAS float*)(lds + RING_OFF);
        __syncthreads();
        for (int i = tid; i < NB * 1024; i += 512) { const float cv = ((const float*)a.in[z + I_C])[i]; cact[i] = cv * sigmoidf_(cv); }
        __syncthreads();
        const int c4 = tid & 15, kp = tid >> 4;
        for (int u = vcu; u < DEPTH * 96; u += G) {
            const int l = u / 96, cg = u % 96;
            const float* w = (const float*)a.in[z + I_ADAW] + (size_t)l * 1024 * 6144 + cg * 64 + 4 * c4;
            f32x4 acc[NB];
#pragma unroll
            for (int b = 0; b < NB; ++b) acc[b] = (f32x4){0.f, 0.f, 0.f, 0.f};
#pragma unroll 4
            for (int k = kp * 32; k < kp * 32 + 32; ++k) { const f32x4 wv = __builtin_nontemporal_load((const f32x4*)(w + (size_t)k * 6144));
#pragma unroll
                for (int b = 0; b < NB; ++b) acc[b] = acc[b] + wv * cact[b * 1024 + k]; }
            LAS float* red = (LAS float*)(lds + RING_OFF + 32768);
#pragma unroll
            for (int b = 0; b < NB; ++b) *(LAS f32x4*)(red + (kp * NB + b) * 64 + 4 * c4) = acc[b];
            __syncthreads();
            { const int b = tid >> 6, col = tid & 63; float s = 0.f;
#pragma unroll
              for (int q = 0; q < 32; ++q) s += red[(q * NB + b) * 64 + col];
              ((float*)(ws + WS_MOD))[((size_t)l * NB + b) * 6144 + cg * 64 + col] = s + ((const float*)a.in[z + I_ADAB])[l * 6144 + cg * 64 + col]; }
            __syncthreads();
        }
    }
}

__device__ __forceinline__ void moe_weights_phase(const Args& a, int l, LAS unsigned char* lds) {
    const int z = opq(); (void)z;
    const int tid = opqv((int)threadIdx.x), lane = tid & 63, wave = __builtin_amdgcn_readfirstlane(tid >> 6); const int G = (int)gridDim.x, bx = (int)blockIdx.x;
    const int vcu = (G % 8 == 0) ? (bx % 8) * (G / 8) + bx / 8 : bx; const int gw = vcu * NWAVES + wave, NGW = G * NWAVES, gt = vcu * 512 + tid;
    (void)lane; (void)gw; (void)NGW; (void)gt; (void)bx;
    LAS float* scr = (LAS float*)(lds + RING_OFF + wave * 16384);
    bf16* w13 = (bf16*)((a.ws + z) + WS_W13); bf16* w2t = (bf16*)((a.ws + z) + WS_W2);
    for (int it = gw; it < NEXP * 768; it += NGW) {
        const int e = it / 768; int r = it - e * 768;
        if (r < 512) { const int which = r >> 8; r &= 255; const int kb = r >> 4, nb = r & 15, n0 = nb * 32;
            const float* W = (const float*)a.in[which ? I_W3 : I_W1] + ((size_t)l * NEXP + e) * 1024 * 512;
            tr_item(W, 512, kb * 64, n0, w13, 1024, e * 1024 + (n0 >> 7) * 256 + which * 128 + (n0 & 127), kb * 64, scr, lane); }
        else { r -= 512; const int kb = r >> 5, nb = r & 31;
            const float* W = (const float*)a.in[z + I_W2] + ((size_t)l * NEXP + e) * 512 * 1024;
            tr_item(W, 1024, kb * 64, nb * 32, w2t, 512, e * 1024 + nb * 32, kb * 64, scr, lane); }
    }
}

__device__ __forceinline__ void norm1_phase(const Args& a, int l, bool first, bool do_norm) {
    const int z = opq(); (void)z;
    const int tid = opqv((int)threadIdx.x), lane = tid & 63, wave = __builtin_amdgcn_readfirstlane(tid >> 6); const int G = (int)gridDim.x, bx = (int)blockIdx.x;
    const int vcu = (G % 8 == 0) ? (bx % 8) * (G / 8) + bx / 8 : bx; const int gw = vcu * NWAVES + wave, NGW = G * NWAVES;
    unsigned char* ws = (a.ws + z);
    const float* mod = (const float*)(ws + WS_MOD);
    const bf16* Y = (const bf16*)(ws + WS_Y);
    const int* tok_slot = (const int*)(ws + WS_TOKS); const float* tok_w = (const float*)(ws + WS_TOKW);
    bf16* H = (bf16*)(ws + WS_H);
    const float* xin = (const float*)a.in[z + I_X]; bf16* XB = (bf16*)(ws + WS_XB);
#pragma unroll 1
    for (int blk = gw; blk < T / 16; blk += NGW) {
        const int mB = blk * 16, b = mB >> 12;
        f32x4 g2v[4], gnv[4], shv[4], scv[4];
        if (!first) { const float* g2 = mod + ((size_t)(l - 1) * NB + b) * 6144 + 5 * 1024;
#pragma unroll
            for (int q = 0; q < 4; ++q) g2v[q] = *(const f32x4*)(g2 + 512 * (q >> 1) + 8 * lane + 4 * (q & 1)); }
        if (do_norm) { const float* mrow = mod + ((size_t)l * NB + b) * 6144; const float* gn = (const float*)a.in[z + I_N1G] + l * D;
#pragma unroll
            for (int q = 0; q < 4; ++q) { const int co = 512 * (q >> 1) + 8 * lane + 4 * (q & 1); gnv[q] = *(const f32x4*)(gn + co); shv[q] = *(const f32x4*)(mrow + co); scv[q] = *(const f32x4*)(mrow + 1024 + co) + 1.0f; } }
#pragma unroll 1
        for (int r2 = 0; r2 < 16; r2 += 2) {
            f32x4 v[2][4]; v4u yp[2][2], yq[2][2]; float w0[2], w1[2];
            if (first) {
#pragma unroll
            for (int r = 0; r < 2; ++r) { const float* xr = xin + (size_t)(mB + r2 + r) * D;
#pragma unroll
                for (int q = 0; q < 4; ++q) v[r][q] = __builtin_nontemporal_load((const f32x4*)(xr + 512 * (q >> 1) + 8 * lane + 4 * (q & 1))); }
            } else {
#pragma unroll
            for (int r = 0; r < 2; ++r)
#pragma unroll
                for (int hq = 0; hq < 2; ++hq) { const v4u xw = __builtin_nontemporal_load((const v4u*)(XB + (size_t)(mB + r2 + r) * D + 512 * hq + 8 * lane));
                    v[r][2 * hq] = (f32x4){bflo(xw.x), bfhi(xw.x), bflo(xw.y), bfhi(xw.y)}; v[r][2 * hq + 1] = (f32x4){bflo(xw.z), bfhi(xw.z), bflo(xw.w), bfhi(xw.w)}; }
            }
            if (!first) {
#pragma unroll
                for (int r = 0; r < 2; ++r) { const int m = mB + r2 + r; const int s0 = tok_slot[2 * m], s1 = tok_slot[2 * m + 1]; w0[r] = tok_w[2 * m]; w1[r] = tok_w[2 * m + 1];
#pragma unroll
                    for (int hq = 0; hq < 2; ++hq) { yp[r][hq] = __builtin_nontemporal_load((const v4u*)(Y + (size_t)s0 * D + 512 * hq + 8 * lane)); yq[r][hq] = __builtin_nontemporal_load((const v4u*)(Y + (size_t)s1 * D + 512 * hq + 8 * lane)); } }
#pragma unroll
                for (int r = 0; r < 2; ++r)
#pragma unroll
                    for (int hq = 0; hq < 2; ++hq) { const v4u p = yp[r][hq], q = yq[r][hq]; f32x4& va = v[r][2 * hq]; f32x4& vb = v[r][2 * hq + 1]; const f32x4 ga = g2v[2 * hq], gb = g2v[2 * hq + 1];
                        va.x += ga.x * (w0[r] * bflo(p.x) + w1[r] * bflo(q.x)); va.y += ga.y * (w0[r] * bfhi(p.x) + w1[r] * bfhi(q.x));
                        va.z += ga.z * (w0[r] * bflo(p.y) + w1[r] * bflo(q.y)); va.w += ga.w * (w0[r] * bfhi(p.y) + w1[r] * bfhi(q.y));
                        vb.x += gb.x * (w0[r] * bflo(p.z) + w1[r] * bflo(q.z)); vb.y += gb.y * (w0[r] * bfhi(p.z) + w1[r] * bfhi(q.z));
                        vb.z += gb.z * (w0[r] * bflo(p.w) + w1[r] * bflo(q.w)); vb.w += gb.w * (w0[r] * bfhi(p.w) + w1[r] * bfhi(q.w)); }
            }
            if (!first && do_norm) {
#pragma unroll
            for (int r = 0; r < 2; ++r)
#pragma unroll
                for (int hq = 0; hq < 2; ++hq) { const f32x4 xa = v[r][2 * hq], xb = v[r][2 * hq + 1];
                    v4u o; o.x = pk2(xa.x, xa.y); o.y = pk2(xa.z, xa.w); o.z = pk2(xb.x, xb.y); o.w = pk2(xb.z, xb.w);
                    *(v4u*)(XB + (size_t)(mB + r2 + r) * D + 512 * hq + 8 * lane) = o; } }
            if (!do_norm) {
#pragma unroll
            for (int r = 0; r < 2; ++r) { float* xo = (a.out + z) + (size_t)(mB + r2 + r) * D;
#pragma unroll
                for (int q = 0; q < 4; ++q) __builtin_nontemporal_store(v[r][q], (f32x4*)(xo + 512 * (q >> 1) + 8 * lane + 4 * (q & 1))); } }
            if (do_norm) {
#pragma unroll
                for (int r = 0; r < 2; ++r) {
                    float ss = 0.f;
#pragma unroll
                    for (int q = 0; q < 4; ++q) ss += (v[r][q].x * v[r][q].x + v[r][q].y * v[r][q].y) + (v[r][q].z * v[r][q].z + v[r][q].w * v[r][q].w);
                    const float rr = rsqrtf(wave_sum(ss) * (1.0f / D) + NORM_EPS);
#pragma unroll
                    for (int hq = 0; hq < 2; ++hq) { const f32x4 ha = (v[r][2 * hq] * rr * gnv[2 * hq]) * scv[2 * hq] + shv[2 * hq], hb = (v[r][2 * hq + 1] * rr * gnv[2 * hq + 1]) * scv[2 * hq + 1] + shv[2 * hq + 1];
                        v4u o; o.x = pk2(ha.x, ha.y); o.y = pk2(ha.z, ha.w); o.z = pk2(hb.x, hb.y); o.w = pk2(hb.z, hb.w);
                        *(v4u*)(H + (size_t)(mB + r2 + r) * D + 512 * hq + 8 * lane) = o; }
                }
            }
        }
    }
}

__device__ __forceinline__ void qkprep_phase(const Args& a, int l) {
    const int z = opq(); (void)z;
    const int tid = opqv((int)threadIdx.x), lane = tid & 63, wave = __builtin_amdgcn_readfirstlane(tid >> 6); const int G = (int)gridDim.x, bx = (int)blockIdx.x;
    const int vcu = (G % 8 == 0) ? (bx % 8) * (G / 8) + bx / 8 : bx; const int gw = vcu * NWAVES + wave, NGW = G * NWAVES;
    unsigned char* ws = (a.ws + z); bf16* Z = (bf16*)(ws + WS_Z);
    const int sq = lane & 3; const bool isq = lane < 32, lowhalf = sq < 2;
    float gn[16];
    { const float* gp = (const float*)a.in[z + (isq ? I_QNG : I_KNG)] + l * 64 + 16 * sq;
#pragma unroll
      for (int i = 0; i < 16; ++i) gn[i] = gp[i] * (isq ? (ATTN_FAST ? 0.125f * 1.4426950408889634f : 0.125f) : 1.0f); }
    const float* RC = (const float*)(ws + WS_ROPE_C) + 16 * (sq & 1); const float* RS = (const float*)(ws + WS_ROPE_S) + 16 * (sq & 1);
#pragma unroll 1
    for (int m2 = gw; m2 < T / 2; m2 += NGW) {
        v4u w[2][2]; f32x4 cs[2][4], sn[2][4];
#pragma unroll
        for (int r = 0; r < 2; ++r) { const int m = m2 * 2 + r; const v4u* zp = (const v4u*)(Z + (size_t)m * ZW + ZQ) + 2 * lane; w[r][0] = zp[0]; w[r][1] = zp[1];
#pragma unroll
            for (int q = 0; q < 4; ++q) { cs[r][q] = *((const f32x4*)(RC + (size_t)m * 32) + q); sn[r][q] = *((const f32x4*)(RS + (size_t)m * 32) + q); } }
#pragma unroll
        for (int r = 0; r < 2; ++r) { const int m = m2 * 2 + r;
            float x[16];
#pragma unroll
            for (int q = 0; q < 2; ++q) { x[8 * q + 0] = bflo(w[r][q].x); x[8 * q + 1] = bfhi(w[r][q].x); x[8 * q + 2] = bflo(w[r][q].y); x[8 * q + 3] = bfhi(w[r][q].y);
                x[8 * q + 4] = bflo(w[r][q].z); x[8 * q + 5] = bfhi(w[r][q].z); x[8 * q + 6] = bflo(w[r][q].w); x[8 * q + 7] = bfhi(w[r][q].w); }
            float ss = 0.f;
#pragma unroll
            for (int i = 0; i < 16; ++i) ss += x[i] * x[i];
            ss += DPPF(ss, 0xB1); ss += DPPF(ss, 0x4E);
            const float rr = rsqrtf(ss * (1.0f / 64.0f) + NORM_EPS);
            unsigned ow[8];
#pragma unroll
            for (int i = 0; i < 16; i += 2) {
                const float y0 = x[i] * rr * gn[i], y1 = x[i + 1] * rr * gn[i + 1];
                const float p0 = DPPF(y0, 0x4E), p1 = DPPF(y1, 0x4E);
                const float c0 = cs[r][i >> 2][i & 3], c1 = cs[r][i >> 2][(i & 3) + 1], s0 = sn[r][i >> 2][i & 3], s1 = sn[r][i >> 2][(i & 3) + 1];
                const float o0 = lowhalf ? y0 * c0 - p0 * s0 : y0 * c0 + p0 * s0, o1 = lowhalf ? y1 * c1 - p1 * s1 : y1 * c1 + p1 * s1;
                ow[i >> 1] = pk2(o0, o1); }
            v4u* zo = (v4u*)(Z + (size_t)m * ZW + ZQ) + 2 * lane;
            zo[0] = (v4u){ow[0], ow[1], ow[2], ow[3]}; zo[1] = (v4u){ow[4], ow[5], ow[6], ow[7]}; }
    }
}

__device__ __forceinline__ void pool_phase(const Args& a, LAS unsigned char* lds) {
    const int z = opq(); (void)z;
    const int tid = opqv((int)threadIdx.x), lane = tid & 63, wave = __builtin_amdgcn_readfirstlane(tid >> 6); const int G = (int)gridDim.x, bx = (int)blockIdx.x;
    const int vcu = (G % 8 == 0) ? (bx % 8) * (G / 8) + bx / 8 : bx; const int gw = vcu * NWAVES + wave, NGW = G * NWAVES, gt = vcu * 512 + tid;
    (void)lane; (void)gw; (void)NGW; (void)gt; (void)bx;
    const bf16* Z = (const bf16*)((a.ws + z) + WS_Z); bf16* AM = (bf16*)((a.ws + z) + WS_AMIX);
    LAS float* U = (LAS float*)(lds + RING_OFF);
    for (int tl = vcu; tl < T / 64; tl += G) {
        const int m0 = tl * 64, s0 = m0 & (SEQ - 1);
        __syncthreads();
        for (int idx = tid; idx < 80 * 32; idx += 512) { const int r = idx >> 5, c8 = (idx & 31) * 8; const int sp = s0 - 16 + r;
            v4u w = (v4u){0u, 0u, 0u, 0u};
            if (sp >= 0) w = *(const v4u*)(Z + (size_t)(m0 - 16 + r) * ZW + c8);
            LAS float* u = U + r * 256 + c8;
            u[0] = bflo(w.x); u[1] = bfhi(w.x); u[2] = bflo(w.y); u[3] = bfhi(w.y); u[4] = bflo(w.z); u[5] = bfhi(w.z); u[6] = bflo(w.w); u[7] = bfhi(w.w); }
        __syncthreads();
        const int cc = tid & 31, tg = tid >> 5, g = cc >> 3, w = 2 << g;
        const LAS f32x4* U4 = (const LAS f32x4*)U + cc * 2;
        f32x4 sa = (f32x4){0.f, 0.f, 0.f, 0.f}, sb = sa; const int t0 = tg * 4;
        for (int q = 0; q < w; ++q) { sa = sa + U4[(16 + t0 - q) * 64]; sb = sb + U4[(16 + t0 - q) * 64 + 1]; }
#pragma unroll
        for (int i = 0; i < 4; ++i) { const int t = t0 + i;
            if (i > 0) { sa = sa + U4[(16 + t) * 64] - U4[(16 + t - w) * 64]; sb = sb + U4[(16 + t) * 64 + 1] - U4[(16 + t - w) * 64 + 1]; }
            const int cnt = (s0 + t + 1) < w ? (s0 + t + 1) : w; const float rc = 1.0f / (float)cnt;
            const f32x4 ua = U4[(16 + t) * 64], ub = U4[(16 + t) * 64 + 1], oa = sa * rc - ua, ob = sb * rc - ub;
            v4u o; o.x = pk2(oa.x, oa.y); o.y = pk2(oa.z, oa.w); o.z = pk2(ob.x, ob.y); o.w = pk2(ob.z, ob.w);
            *(v4u*)(AM + (size_t)(m0 + t) * D + cc * 8) = o; }
    }
}

__device__ __forceinline__ void load_u16(const bf16* up, float (&u)[16]) {
    const v4u w0 = *(const v4u*)up, w1 = *(const v4u*)(up + 8);
    u[0] = bflo(w0.x); u[1] = bfhi(w0.x); u[2] = bflo(w0.y); u[3] = bfhi(w0.y); u[4] = bflo(w0.z); u[5] = bfhi(w0.z); u[6] = bflo(w0.w); u[7] = bfhi(w0.w);
    u[8] = bflo(w1.x); u[9] = bfhi(w1.x); u[10] = bflo(w1.y); u[11] = bfhi(w1.y); u[12] = bflo(w1.z); u[13] = bfhi(w1.z); u[14] = bflo(w1.w); u[15] = bfhi(w1.w);
}
constexpr int BUP = 68;
typedef short bf16x4_t __attribute__((ext_vector_type(4)));
struct BqT { bf16x4_t v[8]; };
__device__ __forceinline__ bf16x4_t ssm_ld_a(const bf16* zrow0  , int fr, int fq) { return *(const bf16x4_t*)(zrow0 + (size_t)fr * ZW + fq * 4); }
__device__ __forceinline__ void ssm_bu16(const bf16x4_t Af, const bf16x4_t (&Bq)[8], LAS unsigned* BU, int fr, int fq) {
#pragma unroll
    for (int cb = 0; cb < 4; ++cb) { const pg8::f32x4 are = __builtin_amdgcn_mfma_f32_16x16x16bf16_1k(Af, Bq[cb], (pg8::f32x4){0.f, 0.f, 0.f, 0.f}, 0, 0, 0);
        const pg8::f32x4 aim = __builtin_amdgcn_mfma_f32_16x16x16bf16_1k(Af, Bq[cb + 4], (pg8::f32x4){0.f, 0.f, 0.f, 0.f}, 0, 0, 0);
#pragma unroll
        for (int j = 0; j < 4; ++j) BU[(fq * 4 + j) * BUP + cb * 16 + fr] = cvtpk(are[j], aim[j]); }
}
__device__ __forceinline__ void ssm_load_bq(const unsigned char* sb, int g, bf16x4_t (&Bq)[8], int fr, int fq) {
    const bf16* bbh = (const bf16*)(sb + 16384) + (size_t)g * 128 * 16;
#pragma unroll
    for (int cb = 0; cb < 8; ++cb) Bq[cb] = *(const bf16x4_t*)(bbh + (cb * 16 + fr) * 16 + fq * 4);
}
__device__ __forceinline__ void ssm_local_phase(const Args& a, int l, LAS unsigned char* lds) {
    const int z = opq(); (void)z;
    const int tid = opqv((int)threadIdx.x), lane = tid & 63, wave = __builtin_amdgcn_readfirstlane(tid >> 6); const int G = (int)gridDim.x, bx = (int)blockIdx.x;
    const int vcu = (G % 8 == 0) ? (bx % 8) * (G / 8) + bx / 8 : bx; const int gw = vcu * NWAVES + wave, NGW = G * NWAVES;
    unsigned char* ws = (a.ws + z); const bf16* Z = (const bf16*)(ws + WS_Z);
    const unsigned char* sb = ws + WS_SSM + (size_t)l * SSM_L_BYTES;
    f32x2* SL = (f32x2*)(ws + WS_E);
    f32x2* EB = (f32x2*)(ws + WS_CIN);
    LAS unsigned* BU = (LAS unsigned*)(lds + RING_OFF) + wave * (16 * BUP);
    const int fr = lane & 15, fq = lane >> 4;
    __syncthreads();
    for (int w = gw; w < NB * 16 * 16; w += NGW) {
        const int g = w & 15, blk = (w >> 4) & 15, b = w >> 8;
        const f32x2 av = ((const f32x2*)sb)[g * 64 + lane];
        bf16x4_t Bq[8]; ssm_load_bq(sb, g, Bq, fr, fq);
        float xr = 0.f, xi = 0.f;
#pragma unroll 1
        for (int j = 0; j < 4; ++j) { const int c = blk * 4 + j;
            SL[((size_t)(b * 64 + c) * 16 + g) * 64 + lane] = (f32x2){xr, xi};
            const bf16* up = Z + (size_t)(b * SEQ + c * 64) * ZW + ZC + g * 16;
            bf16x4_t Af4[4];
#pragma unroll
            for (int tb = 0; tb < 4; ++tb) Af4[tb] = ssm_ld_a(up + (size_t)(tb * 16) * ZW, fr, fq);
#pragma unroll
            for (int tb = 0; tb < 4; ++tb) {
                ssm_bu16(Af4[tb], Bq, BU, fr, fq);
                LDS_WAIT(); asm volatile("" ::: "memory");
#pragma unroll
                for (int tt = 0; tt < 16; ++tt) { const unsigned bw = BU[tt * BUP + lane];
                    const float nr = av.x * xr - av.y * xi + bflo(bw), ni = av.x * xi + av.y * xr + bfhi(bw); xr = nr; xi = ni; }
                LDS_WAIT(); asm volatile("" ::: "memory");
            } }
        EB[((size_t)(b * 16 + blk) * 16 + g) * 64 + lane] = (f32x2){xr, xi};
    }
}
__device__ __forceinline__ void ssm_carry_phase(const Args& a, int l) {
    const int z = opq(); (void)z;
    const int tid = opqv((int)threadIdx.x), lane = tid & 63, wave = __builtin_amdgcn_readfirstlane(tid >> 6); const int G = (int)gridDim.x, bx = (int)blockIdx.x;
    const int vcu = (G % 8 == 0) ? (bx % 8) * (G / 8) + bx / 8 : bx; const int gw = vcu * NWAVES + wave, NGW = G * NWAVES, gt = vcu * 512 + tid;
    (void)lane; (void)gw; (void)NGW; (void)gt; (void)bx;
    if (gt >= NB * 16 * 64) return;
    unsigned char* ws = (a.ws + z); const unsigned char* sb = ws + WS_SSM + (size_t)l * SSM_L_BYTES;
    const int p = gt & 63, g = (gt >> 6) & 15, b = gt >> 10;
    const f32x2 a64 = ((const f32x2*)(sb + 8192))[g * 64 + p];
    const f32x2* E = (const f32x2*)(ws + WS_E); f32x2* CI = (f32x2*)(ws + WS_CIN);
    float sr = 0.f, si = 0.f;
    for (int c = 0; c < 64; ++c) { const size_t o = ((size_t)((b * 64 + c) * 16 + g)) * 64 + p;
        CI[o] = (f32x2){sr, si}; const f32x2 e = E[o];
        const float nr = a64.x * sr - a64.y * si + e.x, ni = a64.x * si + a64.y * sr + e.y; sr = nr; si = ni; }
}

__device__ __forceinline__ void ssm_final_phase(const Args& a, int l, LAS unsigned char* lds) {
    const int z = opq(); (void)z;
    const int tid = opqv((int)threadIdx.x), lane = tid & 63, wave = __builtin_amdgcn_readfirstlane(tid >> 6); const int G = (int)gridDim.x, bx = (int)blockIdx.x;
    const int vcu = (G % 8 == 0) ? (bx % 8) * (G / 8) + bx / 8 : bx; const int gw = vcu * NWAVES + wave, NGW = G * NWAVES, gt = vcu * 512 + tid;
    (void)lane; (void)gw; (void)NGW; (void)gt; (void)bx;
    unsigned char* ws = (a.ws + z); const bf16* Z = (const bf16*)(ws + WS_Z); bf16* AM = (bf16*)(ws + WS_AMIX);
    const unsigned char* sb = ws + WS_SSM + (size_t)l * SSM_L_BYTES;
    constexpr int YP = 264, XP = 136;
    LAS bf16* Ypre = (LAS bf16*)(lds + RING_OFF);
    LAS bf16* Xb = (LAS bf16*)(lds + RING_OFF + 34816) + wave * (16 * XP);
    LAS unsigned* BU = (LAS unsigned*)(lds + RING_OFF + 69632) + wave * (16 * BUP);
    constexpr int UP = 264; LAS bf16* Ut = (LAS bf16*)(lds + RING_OFF + 104448);
    const int fr = lane & 15, fq = lane >> 4;
    f32x2 av[2], a64[2]; float dsk[2]; bf16x4_t Bq[2][8]; bf16x8 Bf[2][4];
#pragma unroll
    for (int gi = 0; gi < 2; ++gi) { const int g = wave * 2 + gi;
        av[gi] = ((const f32x2*)sb)[g * 64 + lane]; a64[gi] = ((const f32x2*)(sb + 8192))[g * 64 + lane]; dsk[gi] = ((const float*)a.in[z + I_DSKIP])[l * 256 + g * 16 + fr];
        ssm_load_bq(sb, g, Bq[gi], fr, fq);
        const float* cre = (const float*)a.in[z + I_CRE] + ((size_t)(l * 16 + g) * 16 + fr) * 64 + fq * 4; const float* cim = (const float*)a.in[z + I_CIM] + ((size_t)(l * 16 + g) * 16 + fr) * 64 + fq * 4;
#pragma unroll
        for (int ks = 0; ks < 4; ++ks) { const f32x4 cr = *(const f32x4*)(cre + ks * 16), ci = *(const f32x4*)(cim + ks * 16);
#pragma unroll
            for (int q = 0; q < 4; ++q) { Bf[gi][ks][2 * q] = (short)f2bf(cr[q]); Bf[gi][ks][2 * q + 1] = (short)f2bf(-ci[q]); } } }
#pragma unroll 1
    for (int uu = vcu; uu < NB * 64; uu += G) {
        const int b = uu >> 6, c = (uu & 256) ? 63 - (uu & 63) : (uu & 63); const size_t m0 = (size_t)b * SEQ + c * 64;
        { const int row = tid >> 3, sg = tid & 7; const v4u* gp = (const v4u*)(Z + (m0 + row) * ZW + ZC + sg * 32); LAS v4u* lp = (LAS v4u*)(Ut + row * UP + sg * 32);
#pragma unroll
          for (int q = 0; q < 4; ++q) lp[q] = gp[q]; }
        float xr[2] = {0.f, 0.f}, xi[2] = {0.f, 0.f};
        for (int rp_ = 0; rp_ < REPN(15); ++rp_) { xr[0] = xr[1] = xi[0] = xi[1] = 0.f; const int blk = c >> 2, jc = c & 3;
          const f32x2* EBp = (const f32x2*)(ws + WS_CIN) + ((size_t)(b * 16) * 16 + wave * 2) * 64 + lane;
          f32x2 a256[2];
#pragma unroll
          for (int gi = 0; gi < 2; ++gi) { float pr = a64[gi].x, pi = a64[gi].y;
#pragma unroll
              for (int q = 0; q < 2; ++q) { const float tr = pr * pr - pi * pi, ti = 2.0f * pr * pi; pr = tr; pi = ti; }
              a256[gi] = (f32x2){pr, pi}; }
#pragma unroll 4
          for (int q = 0; q < blk; ++q) {
#pragma unroll
              for (int gi = 0; gi < 2; ++gi) { const f32x2 ev = EBp[(size_t)q * 1024 + gi * 64]; const float nr = a256[gi].x * xr[gi] - a256[gi].y * xi[gi] + ev.x, ni = a256[gi].x * xi[gi] + a256[gi].y * xr[gi] + ev.y; xr[gi] = nr; xi[gi] = ni; } }
#pragma unroll
          for (int gi = 0; gi < 2; ++gi) {
              for (int q = 0; q < jc; ++q) { const float nr = a64[gi].x * xr[gi] - a64[gi].y * xi[gi], ni = a64[gi].x * xi[gi] + a64[gi].y * xr[gi]; xr[gi] = nr; xi[gi] = ni; }
              const f32x2 sl = ((const f32x2*)(ws + WS_E))[((size_t)(b * 64 + c) * 16 + wave * 2 + gi) * 64 + lane]; xr[gi] += sl.x; xi[gi] += sl.y; } }
        __syncthreads();
        const float xr0s = xr[0], xi0s = xi[0], xr1s = xr[1], xi1s = xi[1];
#pragma unroll 1
        for (int rq_ = 0; rq_ < REPN(16); ++rq_) { xr[0] = xr0s; xi[0] = xi0s; xr[1] = xr1s; xi[1] = xi1s;
#pragma unroll
        for (int gi = 0; gi < 2; ++gi) {
            const int g = wave * 2 + gi;
#pragma unroll 1
            for (int tb = 0; tb < 4; ++tb) {
                ssm_bu16(*(const LAS bf16x4_t*)(Ut + (tb * 16 + fr) * UP + g * 16 + fq * 4), Bq[gi], BU, fr, fq);
                LDS_WAIT(); asm volatile("" ::: "memory");
                unsigned bw[16];
#pragma unroll
                for (int tt = 0; tt < 16; ++tt) bw[tt] = BU[tt * BUP + lane];
#pragma unroll
                for (int tt = 0; tt < 16; ++tt) {
                    const float nr = av[gi].x * xr[gi] - av[gi].y * xi[gi] + bflo(bw[tt]), ni = av[gi].x * xi[gi] + av[gi].y * xr[gi] + bfhi(bw[tt]); xr[gi] = nr; xi[gi] = ni;
                    ((LAS unsigned*)Xb)[tt * (XP / 2) + lane] = cvtpk(nr, ni); }
                LDS_WAIT(); asm volatile("" ::: "memory");
                pg8::f32x4 acc = {0.f, 0.f, 0.f, 0.f};
#pragma unroll
                for (int ks = 0; ks < 4; ++ks) { const bf16x8 Af = *(const LAS bf16x8*)(Xb + fr * XP + ks * 32 + fq * 8);
                    acc = __builtin_amdgcn_mfma_f32_16x16x32_bf16(Af, Bf[gi][ks], acc, 0, 0, 0); }
#pragma unroll
                for (int j = 0; j < 4; ++j) { const int t = tb * 16 + fq * 4 + j;
                    const float uu2 = bf2f(Ut[t * UP + g * 16 + fr]);
                    Ypre[t * YP + g * 16 + fr] = (bf16)f2bf(gelu_tanh(acc[j] + dsk[gi] * uu2)); }
                LDS_WAIT(); asm volatile("" ::: "memory");
            }
        }
        }
        __syncthreads();
#pragma unroll 1
        for (int rg_ = 0; rg_ < REPN(17); ++rg_)
        { pg8::f32x4 acc[4][2];
#pragma unroll
          for (int rb = 0; rb < 4; ++rb)
#pragma unroll
              for (int nb = 0; nb < 2; ++nb) acc[rb][nb] = (pg8::f32x4){0.f, 0.f, 0.f, 0.f};
          const bf16* wg = (const bf16*)(ws + WS_WGLU) + (size_t)l * 256 * 256;
#pragma unroll 2
          for (int ks = 0; ks < 8; ++ks) {
              bf16x8 Bw[2], Aw[4];
#pragma unroll
              for (int nb = 0; nb < 2; ++nb) Bw[nb] = *(const bf16x8*)(wg + (size_t)(wave * 32 + nb * 16 + fr) * 256 + ks * 32 + fq * 8);
#pragma unroll
              for (int rb = 0; rb < 4; ++rb) Aw[rb] = *(const LAS bf16x8*)(Ypre + (rb * 16 + fr) * YP + ks * 32 + fq * 8);
#pragma unroll
              for (int rb = 0; rb < 4; ++rb)
#pragma unroll
                  for (int nb = 0; nb < 2; ++nb) acc[rb][nb] = __builtin_amdgcn_mfma_f32_16x16x32_bf16(Aw[rb], Bw[nb], acc[rb][nb], 0, 0, 0);
          }
          LAS bf16* Yout = (LAS bf16*)(lds + RING_OFF + 69632);
#pragma unroll
          for (int nb = 0; nb < 2; ++nb) { const int n = wave * 32 + nb * 16 + fr; const float gb = ((const float*)a.in[z + I_GLUB])[l * 256 + n];
#pragma unroll
              for (int rb = 0; rb < 4; ++rb)
#pragma unroll
                  for (int j = 0; j < 4; ++j) { const int t = rb * 16 + fq * 4 + j;
                      const float yv = bf2f(Ypre[t * YP + n]);
                      Yout[t * YP + n] = (bf16)f2bf(yv * sigmoidf_(acc[rb][nb][j] + gb)); } }
          __syncthreads();
          { const int row = tid >> 3, seg = tid & 7; const LAS v4u* sp = (const LAS v4u*)(Yout + row * YP + seg * 32); v4u* dp = (v4u*)(AM + (m0 + row) * D + 768 + seg * 32);
#pragma unroll
            for (int q = 0; q < 4; ++q) dp[q] = sp[q]; }
        }
    }
}

__device__ __forceinline__ void attn_naive_unit(const Args& a, int b, int h, int mp, int cc, LAS unsigned char* lds, int tid, int lane, int wave) {
    const int z = opq();
    const bf16* Z = (const bf16*)((a.ws + z) + WS_Z);
    float* O = (float*)((a.ws + z) + (mp ? WS_O1 : WS_O0));
    const size_t m0 = (size_t)b * SEQ + cc * 64;
    const int qcol = ZQ + h * 128 + mp * 64, kcol = ZK + h * 128 + mp * 64, vcol = ZV + h * 128;
    LAS float* Qs = (LAS float*)(lds + RING_OFF);
    LAS unsigned* Vs = (LAS unsigned*)(lds + RING_OFF + 16384);
    LAS float* Ps = (LAS float*)(lds + RING_OFF + 32768) + wave * 512;
    __syncthreads();
    { const int r = tid >> 3, c8 = (tid & 7) * 8; const v4u w = *(const v4u*)(Z + (m0 + r) * ZW + qcol + c8); LAS float* q = Qs + r * 64 + c8;
      q[0] = bflo(w.x); q[1] = bfhi(w.x); q[2] = bflo(w.y); q[3] = bfhi(w.y); q[4] = bflo(w.z); q[5] = bfhi(w.z); q[6] = bflo(w.w); q[7] = bfhi(w.w); }
    float mrun[8], lrun[8], o0[8], o1[8];
#pragma unroll
    for (int i = 0; i < 8; ++i) { mrun[i] = -1e30f; lrun[i] = 0.f; o0[i] = 0.f; o1[i] = 0.f; }
    const size_t kb0 = (size_t)b * SEQ;
#pragma unroll 1
    for (int kt = 0; kt <= cc; ++kt) {
        __syncthreads();
        { const int key = tid >> 3, part = tid & 7; const bf16* vp = Z + (kb0 + kt * 64 + key) * ZW + vcol + part * 16;
          const v4u w0 = *(const v4u*)vp, w1 = *(const v4u*)(vp + 8); LAS v4u* d = (LAS v4u*)(Vs + key * 64 + part * 8); d[0] = w0; d[1] = w1; }
        float kf[64];
        { const bf16* kp = Z + (kb0 + kt * 64 + lane) * ZW + kcol;
#pragma unroll
          for (int q = 0; q < 8; ++q) { const v4u w = *(const v4u*)(kp + q * 8);
              kf[q * 8 + 0] = bflo(w.x); kf[q * 8 + 1] = bfhi(w.x); kf[q * 8 + 2] = bflo(w.y); kf[q * 8 + 3] = bfhi(w.y);
              kf[q * 8 + 4] = bflo(w.z); kf[q * 8 + 5] = bfhi(w.z); kf[q * 8 + 6] = bflo(w.w); kf[q * 8 + 7] = bfhi(w.w); } }
        __syncthreads();
#pragma unroll
        for (int i = 0; i < 8; ++i) {
            const LAS f32x4* qr = (const LAS f32x4*)(Qs + (wave * 8 + i) * 64);
            float s = 0.f;
#pragma unroll
            for (int d4 = 0; d4 < 16; ++d4) { const f32x4 q4 = qr[d4]; s += q4.x * kf[d4 * 4] + q4.y * kf[d4 * 4 + 1] + q4.z * kf[d4 * 4 + 2] + q4.w * kf[d4 * 4 + 3]; }
            const float mt = wave_max(s), mn = fmaxf(mrun[i], mt), al = __expf(mrun[i] - mn), p = __expf(s - mn);
            lrun[i] = lrun[i] * al + wave_sum(p); o0[i] *= al; o1[i] *= al; mrun[i] = mn;
            Ps[i * 64 + lane] = p;
        }
        LDS_WAIT(); asm volatile("" ::: "memory");
#pragma unroll 4
        for (int j4 = 0; j4 < 16; ++j4) {
            unsigned vw[4];
#pragma unroll
            for (int jj = 0; jj < 4; ++jj) vw[jj] = Vs[(j4 * 4 + jj) * 64 + lane];
#pragma unroll
            for (int i = 0; i < 8; ++i) { const f32x4 p4 = *(const LAS f32x4*)(Ps + i * 64 + j4 * 4);
                o0[i] += p4.x * bflo(vw[0]) + p4.y * bflo(vw[1]) + p4.z * bflo(vw[2]) + p4.w * bflo(vw[3]);
                o1[i] += p4.x * bfhi(vw[0]) + p4.y * bfhi(vw[1]) + p4.z * bfhi(vw[2]) + p4.w * bfhi(vw[3]); }
        }
    }
#pragma unroll
    for (int i = 0; i < 8; ++i) { const float rl = 1.0f / lrun[i];
        *(f32x2*)(O + (m0 + wave * 8 + i) * 512 + h * 128 + lane * 2) = (f32x2){o0[i] * rl, o1[i] * rl}; }
}
__device__ __forceinline__ void attn_naive_phase(const Args& a, LAS unsigned char* lds) {
    const int z = opq(); (void)z;
    const int tid = opqv((int)threadIdx.x), lane = tid & 63, wave = __builtin_amdgcn_readfirstlane(tid >> 6); const int G = (int)gridDim.x, bx = (int)blockIdx.x;
    const int vcu = (G % 8 == 0) ? (bx % 8) * (G / 8) + bx / 8 : bx; const int gw = vcu * NWAVES + wave, NGW = G * NWAVES, gt = vcu * 512 + tid;
    (void)lane; (void)gw; (void)NGW; (void)gt; (void)bx;
    for (int u = vcu; u < 2048; u += G) {
        const int bhm = u >> 5, j = u & 31, b = bhm >> 3, h = (bhm >> 1) & 3, mp = bhm & 1;
        attn_naive_unit(a, b, h, mp, j, lds, tid, lane, wave);
        attn_naive_unit(a, b, h, mp, 63 - j, lds, tid, lane, wave);
    }
}

__device__ __forceinline__ void attn_fast_phase(const Args& a, char* lds_generic) {
    const int z = opq();
    const int G = (int)gridDim.x, bx = (int)blockIdx.x; const int vcu = (G % 8 == 0) ? (bx % 8) * (G / 8) + bx / 8 : bx;
    const attn_body::bf16* Z = (const attn_body::bf16*)((a.ws + z) + WS_Z);
#pragma unroll 1
    for (int p = vcu; p < 1024; p += G) {
        const int stream = (p >> 8) * 32 + ((p & 255) >> 3), j = p & 7;
        const int b = stream >> 4, vh = stream & 15, h = vh >> 2, mp = (vh >> 1) & 1, vhalf = vh & 1;
        const attn_body::bf16* Q = Z + ZQ + h * 128 + mp * 64; const attn_body::bf16* K = Z + ZK + h * 128 + mp * 64; const attn_body::bf16* V = Z + ZV + h * 128 + vhalf * 64;
        attn_body::bf16* O = (attn_body::bf16*)((a.ws + z) + (mp ? WS_O1 : WS_O0)) + h * 128 + vhalf * 64;
#pragma unroll 1
        for (int k2 = 0; k2 < 2; ++k2) attn_body::attn_unit<8>(b, k2 ? 15 - j : j, Q, K, V, O, lds_generic);
    }
}

__device__ __forceinline__ void attn_v128_phase(const Args& a, char* lds_generic) {
    const int z = opq();
    const int G = (int)gridDim.x, bx = (int)blockIdx.x; const int vcu = (G % 8 == 0) ? (bx % 8) * (G / 8) + bx / 8 : bx;
    const attn128::bf16* Z = (const attn128::bf16*)((a.ws + z) + WS_Z);
#pragma unroll 1
    for (int p = vcu; p < 512; p += G) {
        const int stream = (p >> 8) * 32 + ((p & 255) >> 3), j = p & 7;
        const int b = stream >> 3, h = (stream >> 1) & 3, mp = stream & 1;
        const attn128::bf16* Q = Z + ZQ + h * 128 + mp * 64; const attn128::bf16* K = Z + ZK + h * 128 + mp * 64; const attn128::bf16* V = Z + ZV + h * 128;
        attn128::bf16* O = (attn128::bf16*)((a.ws + z) + (mp ? WS_O1 : WS_O0)) + h * 128;
#pragma unroll 1
        for (int k2 = 0; k2 < 2; ++k2) attn128::attn_unit<8>(b, k2 ? 15 - j : j, Q, K, V, O, lds_generic);
    }
}

__device__ __forceinline__ void attn_combine_phase(const Args& a, int l) {
    const int z = opq(); (void)z;
    const int tid = opqv((int)threadIdx.x), lane = tid & 63, wave = __builtin_amdgcn_readfirstlane(tid >> 6); const int G = (int)gridDim.x, bx = (int)blockIdx.x;
    const int vcu = (G % 8 == 0) ? (bx % 8) * (G / 8) + bx / 8 : bx; const int gw = vcu * NWAVES + wave, NGW = G * NWAVES;
    unsigned char* ws = (a.ws + z); const bf16* O0 = (const bf16*)(ws + WS_O0); const bf16* O1 = (const bf16*)(ws + WS_O1); bf16* AM = (bf16*)(ws + WS_AMIX);
    const float lam = ((const float*)(ws + WS_LAM))[l], post = 1.0f - lambda_init_of(l);
    float sg[8];
    { const float* sp = (const float*)a.in[z + I_SUBLN] + l * 128 + 8 * (lane & 15);
#pragma unroll
      for (int i = 0; i < 8; ++i) sg[i] = sp[i] * post; }
#pragma unroll 1
    for (int m4 = gw; m4 < T / 4; m4 += NGW) {
        v4u pw[4], qw[4];
#pragma unroll
        for (int r = 0; r < 4; ++r) { const size_t m = (size_t)m4 * 4 + r; pw[r] = __builtin_nontemporal_load((const v4u*)(O0 + m * 512) + lane); qw[r] = __builtin_nontemporal_load((const v4u*)(O1 + m * 512) + lane); }
#pragma unroll
        for (int r = 0; r < 4; ++r) { const size_t m = (size_t)m4 * 4 + r;
            float d[8];
            d[0] = bflo(pw[r].x) - lam * bflo(qw[r].x); d[1] = bfhi(pw[r].x) - lam * bfhi(qw[r].x); d[2] = bflo(pw[r].y) - lam * bflo(qw[r].y); d[3] = bfhi(pw[r].y) - lam * bfhi(qw[r].y);
            d[4] = bflo(pw[r].z) - lam * bflo(qw[r].z); d[5] = bfhi(pw[r].z) - lam * bfhi(qw[r].z); d[6] = bflo(pw[r].w) - lam * bflo(qw[r].w); d[7] = bfhi(pw[r].w) - lam * bfhi(qw[r].w);
            float ss = 0.f;
#pragma unroll
            for (int i = 0; i < 8; ++i) ss += d[i] * d[i];
            ss += DPPF(ss, 0xB1); ss += DPPF(ss, 0x4E); ss += DPPF(ss, 0x141); ss += DPPF(ss, 0x140);
            const float rr = rsqrtf(ss * (1.0f / 128.0f) + NORM_EPS);
            v4u o; o.x = pk2(d[0] * rr * sg[0], d[1] * rr * sg[1]); o.y = pk2(d[2] * rr * sg[2], d[3] * rr * sg[3]); o.z = pk2(d[4] * rr * sg[4], d[5] * rr * sg[5]); o.w = pk2(d[6] * rr * sg[6], d[7] * rr * sg[7]);
            *((v4u*)(AM + m * D + 256) + lane) = o; }
    }
}

__device__ __forceinline__ void norm2_router_phase(const Args& a, int l, LAS unsigned char* lds, bool do_cnt) {
    const int z = opq(); (void)z;
    const int tid = opqv((int)threadIdx.x), lane = tid & 63, wave = __builtin_amdgcn_readfirstlane(tid >> 6); const int G = (int)gridDim.x, bx = (int)blockIdx.x;
    const int vcu = (G % 8 == 0) ? (bx % 8) * (G / 8) + bx / 8 : bx; const int gw = vcu * NWAVES + wave, NGW = G * NWAVES;
    unsigned char* ws = (a.ws + z);
    const float* mod = (const float*)(ws + WS_MOD); bf16* H = (bf16*)(ws + WS_H);
    int* tok_e = (int*)(ws + WS_TOKE); float* tok_w = (float*)(ws + WS_TOKW); int* tok_l = (int*)(ws + WS_TOKL);
    LAS f32x4* RW4 = (LAS f32x4*)(lds + RING_OFF);
    LAS int* lcnt = (LAS int*)(lds + RING_OFF + 147456);
    LAS float* rbias = (LAS float*)(lds + RING_OFF + 147456 + 128);
    const bf16* XBp = (const bf16*)(ws + WS_XB);
    v4u nx[4][2];
#define P8_PREFETCH(row0) do { _Pragma("unroll") for (int r = 0; r < 4; ++r) { const v4u* xr_ = (const v4u*)(XBp + (size_t)((row0) + r) * D) + lane; nx[r][0] = __builtin_nontemporal_load(xr_); nx[r][1] = __builtin_nontemporal_load(xr_ + 64); } } while (0)
    int blk = gw;
    if (blk < T / 16) P8_PREFETCH(blk * 16);
    __syncthreads();
    { const f32x4* rwt = (const f32x4*)((const float*)(ws + WS_RWT) + (size_t)l * 36 * 1024);
      for (int i = tid; i < 36 * 256; i += 512) { const int q = (i >> 6) & 3; RW4[i] = rwt[(i & ~255) + 128 * (q >> 1) + 2 * (i & 63) + (q & 1)]; }
      if (tid < 32) lcnt[tid] = 0;
      if (tid < 36) rbias[tid] = tid < 4 ? ((const float*)a.in[z + I_RGB])[l * 4 + tid] : ((const float*)a.in[z + I_REB])[l * 32 + tid - 4]; }
    __syncthreads();
#pragma unroll 1
    for (; blk < T / 16; blk += NGW) {
      const float* mrow = mod + ((size_t)l * NB + ((blk * 16) >> 12)) * 6144;
      f32x4 gs_[4], shv_[4];
#pragma unroll
      for (int j = 0; j < 4; ++j) { const int c4 = 128 * (j >> 1) + 2 * lane + (j & 1);
          gs_[j] = *((const f32x4*)((const float*)a.in[z + I_N2G] + l * D) + c4) * (*((const f32x4*)(mrow + 4 * 1024) + c4) + 1.0f); shv_[j] = *((const f32x4*)(mrow + 3 * 1024) + c4); }
#pragma unroll 1
      for (int i4 = 0; i4 < 4; ++i4) {
        const int mb = blk * 16 + i4 * 4;
        f32x4 hv[4][4];
#pragma unroll
        for (int r = 0; r < 4; ++r)
#pragma unroll
            for (int hq = 0; hq < 2; ++hq) { const v4u xw = nx[r][hq];
                hv[r][2 * hq] = (f32x4){bflo(xw.x), bfhi(xw.x), bflo(xw.y), bfhi(xw.y)}; hv[r][2 * hq + 1] = (f32x4){bflo(xw.z), bfhi(xw.z), bflo(xw.w), bfhi(xw.w)}; }
        { const int nrow = i4 < 3 ? mb + 4 : (blk + NGW) * 16;
          if (nrow < T) P8_PREFETCH(nrow); }
        { float ss[4];
#pragma unroll
          for (int r = 0; r < 4; ++r) { f32x2 s2 = {0.f, 0.f};
#pragma unroll
              for (int j = 0; j < 4; ++j) { s2 = hv[r][j].xy * hv[r][j].xy + s2; s2 = hv[r][j].zw * hv[r][j].zw + s2; }
              ss[r] = s2.x + s2.y; }
          wave_sum4(ss[0], ss[1], ss[2], ss[3], lane);
#pragma unroll
          for (int r = 0; r < 4; ++r) {
            const float rr = rsqrtf(ss[r] * (1.0f / D) + NORM_EPS);
            v4u* ho = (v4u*)(H + (size_t)(mb + r) * D) + lane;
#pragma unroll
            for (int j = 0; j < 4; ++j) hv[r][j] = (hv[r][j] * rr) * gs_[j] + shv_[j];
#pragma unroll
            for (int hq = 0; hq < 2; ++hq) { const f32x4 ha = hv[r][2 * hq], hb = hv[r][2 * hq + 1];
                v4u o; o.x = pk2(ha.x, ha.y); o.y = pk2(ha.z, ha.w); o.z = pk2(hb.x, hb.y); o.w = pk2(hb.z, hb.w); ho[64 * hq] = o; }
          } }
        float gl[4][4];
        { f32x2 s2[4][4];
#pragma unroll
          for (int r = 0; r < 4; ++r)
#pragma unroll
              for (int j = 0; j < 4; ++j) s2[r][j] = (f32x2){0.f, 0.f};
#pragma unroll
          for (int j = 0; j < 4; ++j)
#pragma unroll
              for (int q = 0; q < 4; ++q) { const f32x4 w = RW4[j * 256 + 64 * q + lane];
#pragma unroll
                  for (int r = 0; r < 4; ++r) { s2[r][j] = hv[r][q].xy * w.xy + s2[r][j]; s2[r][j] = hv[r][q].zw * w.zw + s2[r][j]; } }
#pragma unroll
          for (int r = 0; r < 4; ++r) {
#pragma unroll
              for (int j = 0; j < 4; ++j) gl[r][j] = s2[r][j].x + s2[r][j].y;
              wave_sum4(gl[r][0], gl[r][1], gl[r][2], gl[r][3], lane); } }
#pragma unroll
        for (int r = 0; r < 4; ++r) {
#pragma unroll
            for (int j = 0; j < 4; ++j) gl[r][j] += rbias[j];
            int gi = 0; float gm = gl[r][0];
#pragma unroll
            for (int j = 1; j < 4; ++j) if (gl[r][j] > gm) { gm = gl[r][j]; gi = j; }
            float gs = 0.f;
#pragma unroll
            for (int j = 0; j < 4; ++j) gs += __expf(gl[r][j] - gm);
            const float pg = __builtin_amdgcn_rcpf(gs);
            gi = __builtin_amdgcn_readfirstlane(gi);
            float el[8];
            { f32x2 s2[8];
#pragma unroll
              for (int j = 0; j < 8; ++j) { s2[j] = (f32x2){0.f, 0.f}; const LAS f32x4* wrow = RW4 + (4 + gi * 8 + j) * 256 + lane;
#pragma unroll
                  for (int q = 0; q < 4; ++q) { const f32x4 w = wrow[64 * q]; s2[j] = hv[r][q].xy * w.xy + s2[j]; s2[j] = hv[r][q].zw * w.zw + s2[j]; }
                  el[j] = s2[j].x + s2[j].y; }
              wave_sum4(el[0], el[1], el[2], el[3], lane); wave_sum4(el[4], el[5], el[6], el[7], lane); }
#pragma unroll
            for (int j = 0; j < 8; ++j) el[j] += rbias[4 + gi * 8 + j];
            int e0 = 0; float m0v = el[0];
#pragma unroll
            for (int j = 1; j < 8; ++j) if (el[j] > m0v) { m0v = el[j]; e0 = j; }
            int e1 = -1; float m1v = -3.0e38f;
#pragma unroll
            for (int j = 0; j < 8; ++j) if (j != e0 && el[j] > m1v) { m1v = el[j]; e1 = j; }
            if (e1 < 0) { e1 = (e0 + 1) & 7; m1v = el[0]; }
            const float x1 = __expf(m1v - m0v), w0 = pg * __builtin_amdgcn_rcpf(1.0f + x1), w1 = w0 * x1;
            if (lane == 0) {
                const int m = mb + r, ea = gi * 8 + e0, eb = gi * 8 + e1;
                typedef int i32x2 __attribute__((ext_vector_type(2)));
                const int l0 = __hip_atomic_fetch_add(&lcnt[ea], 1, __ATOMIC_RELAXED, __HIP_MEMORY_SCOPE_WORKGROUP), l1 = __hip_atomic_fetch_add(&lcnt[eb], 1, __ATOMIC_RELAXED, __HIP_MEMORY_SCOPE_WORKGROUP);
                *(i32x2*)(tok_e + 2 * m) = (i32x2){ea, eb}; *(f32x2*)(tok_w + 2 * m) = (f32x2){w0, w1}; *(i32x2*)(tok_l + 2 * m) = (i32x2){l0, l1};
            }
        }
      }
    }
#undef P8_PREFETCH
    __syncthreads();
    if (tid < 32 && do_cnt) { const int c = lcnt[tid];
        const unsigned old = __hip_atomic_fetch_add((unsigned*)(ws + WS_CTL) + CW_CNT + l * 64 + tid, (unsigned)c, RLX_AGENT);
        ((int*)(ws + WS_WGBASE))[bx * 32 + tid] = (int)old; }
}

__device__ __forceinline__ void moe_scatter_phase(const Args& a, int l, LAS unsigned char* lds) {
    const int z = opq(); (void)z;
    const int tid = opqv((int)threadIdx.x), lane = tid & 63, wave = __builtin_amdgcn_readfirstlane(tid >> 6); const int G = (int)gridDim.x, bx = (int)blockIdx.x;
    const int vcu = (G % 8 == 0) ? (bx % 8) * (G / 8) + bx / 8 : bx; const int gw = vcu * NWAVES + wave, NGW = G * NWAVES;
    unsigned char* ws = (a.ws + z);
    LAS int* pst = (LAS int*)(lds + RING_OFF);
    LAS int* pend = pst + 32;
    int* rowmap = (int*)(ws + WS_ROWMAP);
    __syncthreads();
    if (tid == 0) {
        int run = 0; int* tile_e = (int*)(ws + WS_TILEE);
        for (int e = 0; e < NEXP; ++e) { const int c = (int)__hip_atomic_load((unsigned*)(ws + WS_CTL) + CW_CNT + l * 64 + e, RLX_AGENT); const int pad = (c + 255) & ~255;
            pst[e] = run + ((const int*)(ws + WS_WGBASE))[bx * 32 + e]; pend[e] = run + c; pend[32 + e] = run + pad;
            if (bx == 0) for (int q = 0; q < (pad >> 8); ++q) tile_e[(run >> 8) + q] = e;
            run += pad; }
        if (bx == 0) tile_e[511] = run >> 8;
    }
    __syncthreads();
    { const int e = bx & 31; for (int s = pend[e] + tid; s < pend[32 + e]; s += 512) rowmap[s] = 0; }
    const int* tok_e = (const int*)(ws + WS_TOKE); const int* tok_l = (const int*)(ws + WS_TOKL); int* tok_s = (int*)(ws + WS_TOKS);
    for (int m4b = gw * 4; m4b < T / 4; m4b += NGW * 4) {
        if (lane < 32) { const int m = m4b * 4 + (lane >> 1), k = lane & 1;
            const int s = pst[tok_e[2 * m + k]] + tok_l[2 * m + k]; tok_s[2 * m + k] = s; rowmap[s] = m; }
    }
}

__device__ __forceinline__ void stagger_delay(int steps, int ticks_per_step) {
    const unsigned long long t0 = __builtin_amdgcn_s_memrealtime(), want = (unsigned long long)(steps * ticks_per_step);
    while (__builtin_amdgcn_s_memrealtime() - t0 < want) __builtin_amdgcn_s_sleep(8);
}
__global__ void __launch_bounds__(NWAVES * 64, 2) fwd(Args args) {
    extern __shared__ __attribute__((aligned(16))) unsigned char lds_raw[];
    LAS unsigned char* lds = (LAS unsigned char*)lds_raw;
    for (int u = threadIdx.x; u < (LDS_BYTES - LDSCTL_OFF) / 4; u += NWAVES * 64) ((LAS unsigned*)(lds + LDSCTL_OFF))[u] = 0u;
    __syncthreads();
#if MK_MULTI
#define GRID_BAR() do { } while (0)
#else
    XcdBarrier bar = xcd_barrier_post((unsigned*)(args.ws + WS_CTL) + CW_BAR, (volatile LAS unsigned*)(lds + MISC_OFF) + 8);
#define GRID_BAR() xcd_barrier(bar)
#endif
    const int lo = args.ph_lo, hi = args.ph_hi;
#ifndef PHMASK
#define PHMASK 0xFFFF
#endif
#define EN(p) (((PHMASK) >> (p)) & 1)
#ifndef REPMASK
#define REPMASK 0x80
#endif
#define REPEAT(b) _Pragma("unroll 1") for (int rep_ = 0; rep_ < ((((REPMASK) >> (b)) & 1) ? 2 : 1); ++rep_)
#define IN(k) (lo <= (k) && (k) < hi)
#define SEAM(k) do { if (IN(k) && IN((k) + 1)) { GRID_BAR(); if (((REPMASK) >> 14) & 1) GRID_BAR(); } } while (0)

    if (EN(11) && IN(0)) { REPEAT(11) prologue_phase(args, lds); SEAM(0); }

#pragma unroll 1
    for (int l = 0; l < DEPTH; ++l) {
        const int pb = 1 + l * PH_PER_LAYER;
        if (EN(0) && IN(pb + 0)) { norm1_phase(args, l, l == 0, true); REPEAT(0) moe_weights_phase(args, l, lds); SEAM(pb + 0); }
        if (EN(1) && IN(pb + 1)) { unsigned char* ws = args.ws + opq(); const int G = (int)gridDim.x, bx = (int)blockIdx.x;
            pg8::Gemm g{(const pg8::bf16_t*)(ws + WS_H), (const pg8::bf16_t*)(ws + WS_WCAT) + (size_t)l * NCAT * 1024, 1024, 1024, 1024}; pg8::StaticOrder S; S.init(T, NCAT, G, bx);
            pg8::EpiZG E{(pg8::bf16_t*)(ws + WS_Z), (unsigned char*)(ws + WS_G), (const float*)args.in[opq() + I_GATEB] + l * GWD,
                         (const float*)args.in[opq() + I_QNG] + l * 64, (const float*)args.in[opq() + I_KNG] + l * 64, (const float*)(ws + WS_ROPE_C), (const float*)(ws + WS_ROPE_S)};
#ifdef STAGGER_P2
            stagger_delay((int)(blockIdx.x >> 3) & 7, STAGGER_P2);
#endif
            REPEAT(1) pg8::gemm_phase<pg8::EpiZG, pg8::StaticOrder, true, true>(lds + RING_OFF, g, S, E);
            SEAM(pb + 1);
        }
        if (EN(3) && IN(pb + 3)) {
            REPEAT(2) { pool_phase(args, lds); ssm_local_phase(args, l, lds); }
            __syncthreads();
#if ATTN_FAST
#if ATTN_V128
            REPEAT(3) attn_v128_phase(args, (char*)lds_raw + RING_OFF);
#else
            REPEAT(3) attn_fast_phase(args, (char*)lds_raw + RING_OFF);
#endif
#else
            attn_naive_phase(args, lds);
#endif
            SEAM(pb + 3); }
        if (EN(4) && IN(pb + 4)) { REPEAT(12) attn_combine_phase(args, l); REPEAT(4) ssm_final_phase(args, l, lds); SEAM(pb + 4); }
        if (EN(5) && IN(pb + 5)) { unsigned char* ws = args.ws + opq(); const int G = (int)gridDim.x, bx = (int)blockIdx.x;
            const pg8::bf16_t* am = (const pg8::bf16_t*)(ws + WS_AMIX); pg8::bf16_t* mx = (pg8::bf16_t*)(ws + WS_MIXED); const unsigned char* gt_ = (const unsigned char*)(ws + WS_G);
            const pg8::bf16_t* wmix = (const pg8::bf16_t*)(ws + WS_WMIX) + (size_t)l * 1024 * 1024;
            pg8::StaticOrder S; S.init(T, D, G, bx);
            { pg8::Gemm g{am, wmix, 1024, 1024, 1024}; pg8::EpiMixFused E{mx, gt_}; pg8::MixOrder MS{S};
              REPEAT(5) pg8::gemm_phase<pg8::EpiMixFused, pg8::MixOrder, true, true>(lds + RING_OFF, g, MS, E); }
            SEAM(pb + 5);
        }
        if (EN(6) && IN(pb + 6)) { unsigned char* ws = args.ws + opq(); const int G = (int)gridDim.x, bx = (int)blockIdx.x;
            pg8::Gemm g{(const pg8::bf16_t*)(ws + WS_MIXED), (const pg8::bf16_t*)(ws + WS_WO) + (size_t)l * 1024 * 1024, 1024, 1024, 1024}; pg8::StaticOrder S; S.init(T, D, G, bx);
            REPEAT(6) { pg8::bf16_t* xb = (pg8::bf16_t*)(ws + WS_XB); pg8::bf16_t* xo = xb; if (rep_ + 1 < REPN(6)) xo = (pg8::bf16_t*)(ws + WS_O0);
            const float* g1 = (const float*)(ws + WS_MOD) + (size_t)l * NB * 6144 + 2 * 1024;
            if (l == 0) { pg8::EpiResid<true> E{(const float*)args.in[opq() + I_X], xb, g1, xo};
                pg8::gemm_phase<pg8::EpiResid<true>, pg8::StaticOrder, true, true>(lds + RING_OFF, g, S, E); }
            else { pg8::EpiResid<false> E{nullptr, xb, g1, xo};
                pg8::gemm_phase<pg8::EpiResid<false>, pg8::StaticOrder, true, true>(lds + RING_OFF, g, S, E); } }
            SEAM(pb + 6);
        }
        if (EN(7) && IN(pb + 7)) { REPEAT(7) norm2_router_phase(args, l, lds, rep_ == ((((REPMASK) >> 7) & 1) ? 1 : 0)); SEAM(pb + 7); }
        if (EN(8) && IN(pb + 8)) { REPEAT(8) moe_scatter_phase(args, l, lds); SEAM(pb + 8); }
        if (EN(9) && IN(pb + 9)) { unsigned char* ws = args.ws + opq(); const int G = (int)gridDim.x, bx = (int)blockIdx.x; const int vcu = (G % 8 == 0) ? (bx % 8) * (G / 8) + bx / 8 : bx;
            const int* tile_e = (const int*)(ws + WS_TILEE);
            pg8::GatherOrder S{tile_e, (const int*)(ws + WS_ROWMAP), __builtin_amdgcn_readfirstlane(tile_e[511]), G, vcu};
            pg8::Gemm g{(const pg8::bf16_t*)(ws + WS_H), (const pg8::bf16_t*)(ws + WS_W13), 1024, 1024, 1024};
            pg8::EpiSwiGLU E{(pg8::bf16_t*)(ws + WS_ACT)};
            REPEAT(9) pg8::gemm_phase<pg8::EpiSwiGLU, pg8::GatherOrder, true, true>(lds + RING_OFF, g, S, E);
            SEAM(pb + 9);
        }
        if (EN(10) && IN(pb + 10)) { unsigned char* ws = args.ws + opq(); const int G = (int)gridDim.x, bx = (int)blockIdx.x; const int vcu = (G % 8 == 0) ? (bx % 8) * (G / 8) + bx / 8 : bx;
            const int* tile_e = (const int*)(ws + WS_TILEE);
            pg8::GroupedOrder S{tile_e, __builtin_amdgcn_readfirstlane(tile_e[511]), G, vcu};
            pg8::Gemm g{(const pg8::bf16_t*)(ws + WS_ACT), (const pg8::bf16_t*)(ws + WS_W2), 512, 512, 512};
            pg8::EpiY E{(pg8::bf16_t*)(ws + WS_Y)};
            REPEAT(10) pg8::gemm_phase<pg8::EpiY, pg8::GroupedOrder, true, true>(lds + RING_OFF, g, S, E);
            SEAM(pb + 10);
        }
    }
    if (EN(12) && IN(N_PHASES - 1)) norm1_phase(args, DEPTH, false, false);
#undef IN
#undef SEAM
}

extern "C" void kernel_launch(void* const* d_in, const int* in_sizes, int n_in, void* d_out, int out_size, void* d_ws, size_t ws_size, hipStream_t stream) {
    static int grid = 0;
    if (grid == 0) {
        if (n_in != 40 || out_size != T * D || ws_size < WS_END) { fprintf(stderr, "kernel_launch: unexpected shapes (n_in %d out %d ws %zu)\n", n_in, out_size, ws_size); grid = -1; return; }
        int dev = 0, cus = 0, per_cu = 0;
        if (hipGetDevice(&dev) != hipSuccess || hipDeviceGetAttribute(&cus, hipDeviceAttributeMultiprocessorCount, dev) != hipSuccess) { grid = -1; return; }
        if (hipFuncSetAttribute((const void*)fwd, hipFuncAttributeMaxDynamicSharedMemorySize, LDS_BYTES) != hipSuccess) { fprintf(stderr, "kernel_launch: hipFuncSetAttribute failed\n"); grid = -1; return; }
        if (hipOccupancyMaxActiveBlocksPerMultiprocessor(&per_cu, (const void*)fwd, NWAVES * 64, LDS_BYTES) != hipSuccess || per_cu < 1) fprintf(stderr, "kernel_launch: occupancy query says %d\n", per_cu);
        (void)hipGetLastError();
        grid = cus;
    }
    if (grid < 0) return;
    if (hipMemsetAsync((char*)d_ws + WS_CTL, 0, CTL_ZERO_BYTES, stream) != hipSuccess) return;
    Args a{};
    for (int i = 0; i < 40; ++i) a.in[i] = d_in[i];
    a.out = (float*)d_out; a.ws = (unsigned char*)d_ws;
#if MK_MULTI
    for (int p = 0; p < N_PHASES; ++p) { a.ph_lo = p; a.ph_hi = p + 1; hipLaunchKernelGGL(fwd, dim3(grid), dim3(NWAVES * 64), LDS_BYTES, stream, a); }
#else
    a.ph_lo = 0; a.ph_hi = N_PHASES;
    hipLaunchKernelGGL(fwd, dim3(grid), dim3(NWAVES * 64), LDS_BYTES, stream, a);
#endif
}
```

```cpp
#include <hip/hip_runtime.h>
#include <cstdio>
#include <cstdint>

#ifndef REPMASK
#define REPMASK 0
#endif
#define REPN(b) ((((REPMASK) >> (b)) & 1) ? 2 : 1)
#ifndef MK_MULTI
#define MK_MULTI 0
#endif

__device__ __forceinline__ int opqv(int x) { asm volatile("" : "+v"(x)); return x; }
__device__ __forceinline__ int opq() { int z = 0; asm volatile("" : "+s"(z)); return z; }
namespace pg8 {
#define PG8_LAS __attribute__((address_space(3)))
typedef unsigned short bf16_t;
typedef short bf16x8 __attribute__((ext_vector_type(8)));
typedef float f32x4 __attribute__((ext_vector_type(4)));
typedef unsigned u32x4 __attribute__((ext_vector_type(4)));
typedef unsigned u32x2 __attribute__((ext_vector_type(2)));
constexpr int BM = 256, BK = 64, HALF = 128, HTB = HALF * BK * 2  , STAGE_BYTES = 8 * HTB, NXCD = 8, WGM = 8;

__host__ __device__ __forceinline__ int lds_byte(int r, int c) { const int st = (r >> 4) * 2 + (c >> 5), rr = r & 15, cc = c & 31, ob = rr * 64 + cc * 2; return st * 1024 + (ob ^ (((ob >> 9) & 1) << 5)); }
__host__ __device__ __forceinline__ void stage_rc(int b, int& R, int& C) { const int st = b / 1024, sb = b % 1024, swz = sb ^ (((sb >> 9) & 1) << 5); R = (st >> 1) * 16 + swz / 64; C = (st & 1) * 32 + (swz % 64) / 2; }
__host__ __device__ __forceinline__ int perm32(int rho) { const int n = rho >> 4, i = rho & 15; return 8 * (i >> 2) + 4 * n + (i & 3); }

struct Unit { int pm, pn, pb, seg, koff, nt, zero; };
struct Gemm { const bf16_t* A; const bf16_t* Bt; int lda, ldb, K; };

struct StaticOrder {
    static constexpr bool VARK = false, GATHER = false;
    int nM, nN, nwg, G, c;
    __host__ __device__ void init(int M, int N, int G_, int c_) { nM = M / BM; nN = N / BM; nwg = nM * nN; G = G_; c = c_; }
    __host__ __device__ bool next(int i, Unit& u) const {
        const long L = (long)i * G + c; if (L >= nwg) return false;
        int wgid = (int)L; { const int q = nwg / NXCD, r = nwg % NXCD, xcd = wgid % NXCD, off = wgid / NXCD; wgid = (xcd < r ? xcd * (q + 1) : r * (q + 1) + (xcd - r) * q) + off; }
        const int nig = WGM * nN, gid = wgid / nig, fm = gid * WGM, gsz = (nM - fm) < WGM ? (nM - fm) : WGM;
        u.pm = fm + ((wgid % nig) % gsz); u.pn = (wgid % nig) / gsz; u.pb = u.pn; return true;
    }
    __device__ __forceinline__ void a_ready(const Unit&) const {}
    __device__ __forceinline__ void done(const Unit&) const {}
};
struct GroupedOrder {
    static constexpr bool VARK = false, GATHER = false;
    const int* tile_e; int ntiles, G, c;
    __device__ __forceinline__ bool next(int i, Unit& u) const {
        const long L = (long)i * G + c; if (L >= (long)ntiles * 4) return false;
        const int pm = (int)(L >> 2), pl = (int)(L & 3);
        u.pm = pm; u.pn = pl; u.pb = __builtin_amdgcn_readfirstlane(tile_e[pm]) * 4 + pl; return true;
    }
    __device__ __forceinline__ void a_ready(const Unit&) const {}
    __device__ __forceinline__ void done(const Unit&) const {}
};

struct GatherOrder {
    static constexpr bool VARK = false, GATHER = true;
    const int* tile_e; const int* rowmap; int ntiles, G, c;
    __device__ __forceinline__ bool next(int i, Unit& u) const {
        const long L = (long)i * G + c; if (L >= (long)ntiles * 4) return false;
        const int pm = (int)(L >> 2), pl = (int)(L & 3);
        u.pm = pm; u.pn = pl; u.pb = __builtin_amdgcn_readfirstlane(tile_e[pm]) * 4 + pl; return true;
    }
    __device__ __forceinline__ void a_ready(const Unit&) const {}
    __device__ __forceinline__ void done(const Unit&) const {}
};
struct MixOrder {
    static constexpr bool VARK = true, GATHER = false;
    StaticOrder so;
    __device__ __forceinline__ bool next(int i, Unit& u) const { const int bi = i / 3, seg = i - bi * 3; if (!so.next(bi, u)) return false;
        u.seg = seg; u.koff = seg == 0 ? 0 : (seg == 1 ? 256 : 768); u.nt = seg == 1 ? 8 : 4; u.zero = seg == 2; return true; }
    __device__ __forceinline__ void a_ready(const Unit&) const {}
    __device__ __forceinline__ void done(const Unit&) const {}
};

__device__ __forceinline__ unsigned cvt_pk_bf16(float lo, float hi) { unsigned r; asm volatile("v_cvt_pk_bf16_f32 %0, %1, %2" : "=v"(r) : "v"(lo), "v"(hi)); return r; }
__device__ __forceinline__ float bflo(unsigned w) { return __uint_as_float(w << 16); }
__device__ __forceinline__ float bfhi(unsigned w) { return __uint_as_float(w & 0xffff0000u); }
__device__ __forceinline__ float sigmoidf_(float x) { return __builtin_amdgcn_rcpf(1.0f + __builtin_amdgcn_exp2f(-1.4426950408889634f * x)); }


struct EpiZG {
    static constexpr bool PERM = true, AFTER_DRAIN = false, MIDHOOK = false;
    bf16_t* Z; unsigned char* G8; const float* gbias;
    const float* qg; const float* kg; const float* ropec; const float* ropes;
    __device__ __forceinline__ void operator()(const f32x4 (&acc)[2][2][4][2], const Unit& u, int wr, int wc, int fr, int fq) const {
        asm volatile("" : "+v"(fr), "+v"(fq));
        const int row0 = u.pm * BM + wr * 64 + fr;
        if (u.pn >= 1 && u.pn <= 4) {
            const int vec = (u.pn - 1) * 4 + wc; const bool isq = vec < 8;
            const float* gsrc = isq ? qg : kg; const float sc = isq ? 0.125f * 1.4426950408889634f : 1.0f;
            f32x4 gv[2][2];
#pragma unroll
            for (int bj = 0; bj < 2; ++bj)
#pragma unroll
                for (int n = 0; n < 2; ++n) gv[bj][n] = *(const f32x4*)(gsrc + 32 * bj + 8 * fq + 4 * n) * sc;
#pragma unroll
            for (int ai = 0; ai < 2; ++ai)
#pragma unroll
                for (int m = 0; m < 4; ++m) { const size_t row = (size_t)(row0 + ai * HALF + m * 16);
                    float ss = 0.f;
#pragma unroll
                    for (int bj = 0; bj < 2; ++bj)
#pragma unroll
                        for (int n = 0; n < 2; ++n) { const f32x4 x = acc[ai][bj][m][n]; ss += (x[0] * x[0] + x[1] * x[1]) + (x[2] * x[2] + x[3] * x[3]); }
                    { auto rr = __builtin_amdgcn_permlane16_swap(__float_as_uint(ss), __float_as_uint(ss), false, false); ss = __uint_as_float(rr[0]) + __uint_as_float(rr[1]); }
                    { auto rr = __builtin_amdgcn_permlane32_swap(__float_as_uint(ss), __float_as_uint(ss), false, false); ss = __uint_as_float(rr[0]) + __uint_as_float(rr[1]); }
                    const float rs = __builtin_amdgcn_rsqf(ss * (1.0f / 64.0f) + 1e-6f);
                    f32x4 o[2][2];
#pragma unroll
                    for (int n = 0; n < 2; ++n) { const f32x4 c = *(const f32x4*)(ropec + row * 32 + 8 * fq + 4 * n), s = *(const f32x4*)(ropes + row * 32 + 8 * fq + 4 * n);
                        const f32x4 y0 = acc[ai][0][m][n] * rs * gv[0][n], y1 = acc[ai][1][m][n] * rs * gv[1][n];
                        o[0][n] = y0 * c - y1 * s; o[1][n] = y1 * c + y0 * s; }
                    bf16_t* rowp = Z + row * 2048 + 256 + vec * 64 + 8 * fq;
#pragma unroll
                    for (int bj = 0; bj < 2; ++bj) { u32x4 w; w.x = cvt_pk_bf16(o[bj][0][0], o[bj][0][1]); w.y = cvt_pk_bf16(o[bj][0][2], o[bj][0][3]); w.z = cvt_pk_bf16(o[bj][1][0], o[bj][1][1]); w.w = cvt_pk_bf16(o[bj][1][2], o[bj][1][3]);
                        *(u32x4*)(rowp + 32 * bj) = w; }
                    if (m == 3) asm volatile("" ::: "memory"); }
            return;
        }
        if (u.pn >= 8) {
            const int col0 = (u.pn - 8) * BM + wc * 64 + 16 * fq;
            f32x4 bc[2][2];
#pragma unroll
            for (int bj = 0; bj < 2; ++bj)
#pragma unroll
                for (int n = 0; n < 2; ++n) bc[bj][n] = *(const f32x4*)(gbias + col0 + 8 * bj + 4 * n) * (-1.4426950408889634f) - 7.994353436858858f;
#pragma unroll
            for (int ai = 0; ai < 2; ++ai)
#pragma unroll
                for (int m = 0; m < 4; ++m) { u32x4 w;
#pragma unroll
                    for (int bj = 0; bj < 2; ++bj)
#pragma unroll
                        for (int n = 0; n < 2; ++n) { const f32x4 v = acc[ai][bj][m][n] * (-1.4426950408889634f) + bc[bj][n]; unsigned pw = 0u;
#pragma unroll
                            for (int j = 0; j < 4; ++j) pw = __builtin_amdgcn_cvt_pk_u8_f32(fmaxf(__builtin_rintf(__builtin_amdgcn_rcpf(__builtin_amdgcn_exp2f(v[j]) + (1.0f / 255.0f))), 1.0f), j, pw);
                            w[bj * 2 + n] = pw; }
                    *(u32x4*)(G8 + (size_t)(row0 + ai * HALF + m * 16) * 3072 + col0) = w; }
            return;
        }
        const int colt = u.pn * BM;
        const int col0 = colt + wc * 64 + 8 * fq;
#pragma unroll
        for (int ai = 0; ai < 2; ++ai)
#pragma unroll
            for (int m = 0; m < 4; ++m) { bf16_t* rowp = Z + (size_t)(row0 + ai * HALF + m * 16) * 2048 + col0;
#pragma unroll
                for (int bj = 0; bj < 2; ++bj) { const f32x4 v0 = acc[ai][bj][m][0], v1 = acc[ai][bj][m][1];
                    u32x4 w; w.x = cvt_pk_bf16(v0[0], v0[1]); w.y = cvt_pk_bf16(v0[2], v0[3]); w.z = cvt_pk_bf16(v1[0], v1[1]); w.w = cvt_pk_bf16(v1[2], v1[3]);
                    *(u32x4*)(rowp + bj * 32) = w; } }
    }
};
struct EpiMix {
    static constexpr bool PERM = true, AFTER_DRAIN = false, MIDHOOK = false;
    bf16_t* O; const bf16_t* Gt; int gcol0; bool first;
    __device__ __forceinline__ void operator()(const f32x4 (&acc)[2][2][4][2], const Unit& u, int wr, int wc, int fr, int fq) const {
        asm volatile("" : "+v"(fr), "+v"(fq));
        const int row0 = u.pm * BM + wr * 64 + fr, col0 = u.pn * BM + wc * 32 + 8 * fq;
#pragma unroll
        for (int ai = 0; ai < 2; ++ai)
#pragma unroll
            for (int m = 0; m < 4; ++m) { const size_t row = (size_t)(row0 + ai * HALF + m * 16);
#pragma unroll
                for (int bj = 0; bj < 2; ++bj) {
                    const u32x4 gw = *(const u32x4*)(Gt + row * 3072 + gcol0 + col0 + bj * HALF);
                    bf16_t* op = O + row * 1024 + col0 + bj * HALF;
                    f32x4 v0 = acc[ai][bj][m][0], v1 = acc[ai][bj][m][1];
                    v0[0] *= bflo(gw.x); v0[1] *= bfhi(gw.x); v0[2] *= bflo(gw.y); v0[3] *= bfhi(gw.y);
                    v1[0] *= bflo(gw.z); v1[1] *= bfhi(gw.z); v1[2] *= bflo(gw.w); v1[3] *= bfhi(gw.w);
                    if (!first) { const u32x4 pw = *(const u32x4*)op;
                        v0[0] += bflo(pw.x); v0[1] += bfhi(pw.x); v0[2] += bflo(pw.y); v0[3] += bfhi(pw.y);
                        v1[0] += bflo(pw.z); v1[1] += bfhi(pw.z); v1[2] += bflo(pw.w); v1[3] += bfhi(pw.w); }
                    u32x4 w; w.x = cvt_pk_bf16(v0[0], v0[1]); w.y = cvt_pk_bf16(v0[2], v0[3]); w.z = cvt_pk_bf16(v1[0], v1[1]); w.w = cvt_pk_bf16(v1[2], v1[3]);
                    *(u32x4*)op = w; }
                asm volatile("" ::: "memory"); }
    }
};
struct EpiMixFused {
    static constexpr bool PERM = true, AFTER_DRAIN = false, MIDHOOK = false;
    bf16_t* O; const unsigned char* G8;
    __device__ __forceinline__ static void gld(const unsigned char* p, float (&g)[2][2][4]) { const u32x4 w = *(const u32x4*)p;
#pragma unroll
        for (int q = 0; q < 4; ++q) { const unsigned d = w[q]; g[q >> 1][q & 1][0] = (float)(d & 0xffu); g[q >> 1][q & 1][1] = (float)((d >> 8) & 0xffu); g[q >> 1][q & 1][2] = (float)((d >> 16) & 0xffu); g[q >> 1][q & 1][3] = (float)(d >> 24); } }
    __device__ __forceinline__ void operator()(f32x4 (&acc)[2][2][4][2], const Unit& u, int wr, int wc, int fr, int fq) const {
        asm volatile("" : "+v"(fr), "+v"(fq));
        const int row0 = u.pm * BM + wr * 64 + fr, col0 = u.pn * BM + wc * 64 + 16 * fq;
        if (u.seg < 2) {
#pragma unroll
            for (int ai = 0; ai < 2; ++ai)
#pragma unroll
                for (int m = 0; m < 4; ++m) { const unsigned char* gp = G8 + (size_t)(row0 + ai * HALF + m * 16) * 3072 + u.seg * 1024 + col0;
                    float gn[2][2][4], gd[2][2][4]; gld(gp, gn); gld(gp + 1024, gd);
#pragma unroll
                    for (int bj = 0; bj < 2; ++bj)
#pragma unroll
                        for (int n = 0; n < 2; ++n)
#pragma unroll
                            for (int j = 0; j < 4; ++j) acc[ai][bj][m][n][j] *= gn[bj][n][j] * __builtin_amdgcn_rcpf(gd[bj][n][j]);
                    if (m == 3) asm volatile("" ::: "memory"); }
        } else {
#pragma unroll
            for (int ai = 0; ai < 2; ++ai)
#pragma unroll
                for (int m = 0; m < 4; ++m) { const size_t row = (size_t)(row0 + ai * HALF + m * 16);
                    float g[2][2][4]; gld(G8 + row * 3072 + 2048 + col0, g);
#pragma unroll
                    for (int bj = 0; bj < 2; ++bj) { const f32x4 v0 = acc[ai][bj][m][0] * (1.0f / 255.0f), v1 = acc[ai][bj][m][1] * (1.0f / 255.0f);
                        u32x4 w; w.x = cvt_pk_bf16(v0[0] * g[bj][0][0], v0[1] * g[bj][0][1]); w.y = cvt_pk_bf16(v0[2] * g[bj][0][2], v0[3] * g[bj][0][3]);
                        w.z = cvt_pk_bf16(v1[0] * g[bj][1][0], v1[1] * g[bj][1][1]); w.w = cvt_pk_bf16(v1[2] * g[bj][1][2], v1[3] * g[bj][1][3]);
                        *(u32x4*)(O + row * 1024 + col0 + 8 * bj) = w; }
                    if (m == 3) asm volatile("" ::: "memory"); }
        }
    }
};
template <bool FIRST>
struct EpiResid {
    static constexpr bool PERM = true, AFTER_DRAIN = false, MIDHOOK = false;
    const float* Xf; const bf16_t* X; const float* g1; bf16_t* Xo;
    __device__ __forceinline__ void operator()(const f32x4 (&acc)[2][2][4][2], const Unit& u, int wr, int wc, int fr, int fq) const {
        asm volatile("" : "+v"(fr), "+v"(fq));
        const int row0 = u.pm * BM + wr * 64 + fr, col0 = u.pn * BM + wc * 32 + 8 * fq;
        const float* gp = g1 + (size_t)((u.pm * BM) >> 12) * 6144 + col0;
        f32x4 gv[2][2];
#pragma unroll
        for (int bj = 0; bj < 2; ++bj)
#pragma unroll
            for (int n = 0; n < 2; ++n) gv[bj][n] = *(const f32x4*)(gp + bj * HALF + n * 4);
#pragma unroll
        for (int ai = 0; ai < 2; ++ai)
#pragma unroll
            for (int m = 0; m < 4; ++m) { const size_t ro = (size_t)(row0 + ai * HALF + m * 16) * 1024 + col0;
#pragma unroll
                for (int bj = 0; bj < 2; ++bj) { f32x4 x0, x1;
                    if (FIRST) { x0 = *(const f32x4*)(Xf + ro + bj * HALF); x1 = *(const f32x4*)(Xf + ro + bj * HALF + 4); }
                    else { const u32x4 xb = *(const u32x4*)(X + ro + bj * HALF); x0 = (f32x4){bflo(xb.x), bfhi(xb.x), bflo(xb.y), bfhi(xb.y)}; x1 = (f32x4){bflo(xb.z), bfhi(xb.z), bflo(xb.w), bfhi(xb.w)}; }
                    const f32x4 r0 = x0 + gv[bj][0] * acc[ai][bj][m][0], r1 = x1 + gv[bj][1] * acc[ai][bj][m][1];
                    u32x4 w; w.x = cvt_pk_bf16(r0[0], r0[1]); w.y = cvt_pk_bf16(r0[2], r0[3]); w.z = cvt_pk_bf16(r1[0], r1[1]); w.w = cvt_pk_bf16(r1[2], r1[3]);
                    *(u32x4*)(Xo + ro + bj * HALF) = w; } }
    }
};
struct EpiSwiGLU {
    static constexpr bool PERM = true, AFTER_DRAIN = false, MIDHOOK = false;
    bf16_t* O;
    __device__ __forceinline__ void operator()(const f32x4 (&acc)[2][2][4][2], const Unit& u, int wr, int wc, int fr, int fq) const {
        asm volatile("" : "+v"(fr), "+v"(fq));
        const int row0 = u.pm * BM + wr * 64 + fr, col0 = u.pn * HALF + wc * 32 + 8 * fq;
#pragma unroll
        for (int ai = 0; ai < 2; ++ai)
#pragma unroll
            for (int m = 0; m < 4; ++m) { bf16_t* op = O + (size_t)(row0 + ai * HALF + m * 16) * 512 + col0;
                float r[8];
#pragma unroll
                for (int n = 0; n < 2; ++n)
#pragma unroll
                    for (int j = 0; j < 4; ++j) { const float a = acc[ai][0][m][n][j], b = acc[ai][1][m][n][j]; r[n * 4 + j] = a * sigmoidf_(a) * b; }
                u32x4 w; w.x = cvt_pk_bf16(r[0], r[1]); w.y = cvt_pk_bf16(r[2], r[3]); w.z = cvt_pk_bf16(r[4], r[5]); w.w = cvt_pk_bf16(r[6], r[7]);
                *(u32x4*)op = w; }
    }
};
struct EpiY {
    static constexpr bool PERM = true, AFTER_DRAIN = false, MIDHOOK = false;
    bf16_t* O;
    __device__ __forceinline__ void operator()(const f32x4 (&acc)[2][2][4][2], const Unit& u, int wr, int wc, int fr, int fq) const {
        asm volatile("" : "+v"(fr), "+v"(fq));
        const int row0 = u.pm * BM + wr * 64 + fr, col0 = u.pn * BM + wc * 32 + 8 * fq;
#pragma unroll
        for (int ai = 0; ai < 2; ++ai)
#pragma unroll
            for (int m = 0; m < 4; ++m) { bf16_t* rowp = O + (size_t)(row0 + ai * HALF + m * 16) * 1024 + col0;
#pragma unroll
                for (int bj = 0; bj < 2; ++bj) { const f32x4 v0 = acc[ai][bj][m][0], v1 = acc[ai][bj][m][1];
                    u32x4 w; w.x = cvt_pk_bf16(v0[0], v0[1]); w.y = cvt_pk_bf16(v0[2], v0[3]); w.z = cvt_pk_bf16(v1[0], v1[1]); w.w = cvt_pk_bf16(v1[2], v1[3]);
                    *(u32x4*)(rowp + bj * HALF) = w; } }
    }
};

template <class Epi, class Sched, bool ALIGN_EPI = false, bool SP2 = false>
__device__ __forceinline__ void gemm_phase(PG8_LAS unsigned char* lds, const Gemm g, const Sched& S, const Epi& E) {
    const int tid = opqv((int)threadIdx.x), wid = __builtin_amdgcn_readfirstlane(tid >> 6), lane = tid & 63, wr = wid >> 2, wc = wid & 3, fr = lane & 15, fq = lane >> 4;
    const int K = g.K, nt = K / BK, lda = g.lda, ldb = g.ldb;
    unsigned voffA[2], voffB[2];
#pragma unroll
    for (int i = 0; i < 2; ++i) { int R, C; stage_rc(tid * 16 + i * 8192, R, C); const int Rb = Epi::PERM ? ((R & ~31) + perm32(R & 31)) : R;
        voffA[i] = (unsigned)(R * lda + C) * 2u; voffB[i] = (unsigned)(Rb * ldb + C) * 2u; }
    const size_t kstep = (size_t)(BK * 2);
    const size_t hstepA = (size_t)HALF * lda * 2, hstepB = (size_t)HALF * ldb * 2;
    const size_t tstepA = 2 * hstepA, tstepB = 2 * hstepB;
    const unsigned ldsw = (unsigned)wid * 1024u;
    const int aoff = lds_byte(wr * 64 + fr, fq * 8), boff = lds_byte(wc * 32 + fr, fq * 8);
#define PG8_SA(b, h) (((b) * 2 + (h)) * HTB)
#define PG8_SB(b, h) ((4 + (b) * 2 + (h)) * HTB)
#define PG8_STAGE(bufoff, gbase, voff) do { _Pragma("unroll") for (int _i = 0; _i < 2; ++_i) \
        __builtin_amdgcn_global_load_lds((const unsigned*)((const char*)(gbase) + (voff)[_i]), (PG8_LAS unsigned*)(lds + (bufoff) + ldsw + _i * 8192), 16, 0, 0); } while (0)
#define PG8_LDA(dst, b, h) do { _Pragma("unroll") for (int m = 0; m < 4; ++m) _Pragma("unroll") for (int k = 0; k < 2; ++k) dst[m][k] = *(const PG8_LAS bf16x8*)(lds + PG8_SA(b, h) + aoff + m * 2048 + k * 1024); } while (0)
#define PG8_LDB(dst, b, h) do { _Pragma("unroll") for (int n = 0; n < 2; ++n) _Pragma("unroll") for (int k = 0; k < 2; ++k) dst[n][k] = *(const PG8_LAS bf16x8*)(lds + PG8_SB(b, h) + boff + n * 2048 + k * 1024); } while (0)
#define PG8_MMA(ai, bj, At, Bt) do { __builtin_amdgcn_s_setprio(1); _Pragma("unroll") for (int m = 0; m < 4; ++m) _Pragma("unroll") for (int n = 0; n < 2; ++n) _Pragma("unroll") for (int k = 0; k < 2; ++k) \
        acc[ai][bj][m][n] = __builtin_amdgcn_mfma_f32_16x16x32_bf16(Bt[n][k], At[m][k], acc[ai][bj][m][n], 0, 0, 0); __builtin_amdgcn_s_setprio(0); } while (0)
#define PG8_WAIT_V(n) asm volatile("s_waitcnt vmcnt(" #n ")" ::: "memory")
#define PG8_WAIT_L(n) asm volatile("s_waitcnt lgkmcnt(" #n ")" ::: "memory")
#define PG8_BAR __builtin_amdgcn_s_barrier()
#define PG8_SCHED __builtin_amdgcn_sched_barrier(0)
    Unit cur, nxt; int ui = 0;
    if (!S.next(0, cur)) return;
    unsigned gC[2][2], gN[2][2];
#define PG8_GOFF(dst, U) do { if constexpr (Sched::GATHER) { _Pragma("unroll") for (int _h = 0; _h < 2; ++_h) _Pragma("unroll") for (int _i = 0; _i < 2; ++_i) { int _R, _C; stage_rc(tid * 16 + _i * 8192, _R, _C); \
        dst[_h][_i] = (unsigned)S.rowmap[(U).pm * 256 + _h * 128 + _R] * (unsigned)(lda * 2) + (unsigned)_C * 2u; } } } while (0)
#define PG8_STAGEA(bufoff, ptr, gptr, goff) do { if constexpr (Sched::GATHER) PG8_STAGE(bufoff, gptr, goff); else PG8_STAGE(bufoff, ptr, voffA); } while (0)
#define PG8_STAGEA_SEL(bufoff, ptr, gptr, h) do { if constexpr (Sched::GATHER) { if (last) PG8_STAGE(bufoff, gptr, gN[h]); else PG8_STAGE(bufoff, gptr, gC[h]); } else PG8_STAGE(bufoff, ptr, voffA); } while (0)
    PG8_GOFF(gC, cur);
    f32x4 acc[2][2][4][2];
#pragma unroll
    for (int a = 0; a < 2; ++a)
#pragma unroll
        for (int b = 0; b < 2; ++b)
#pragma unroll
            for (int m = 0; m < 4; ++m)
#pragma unroll
                for (int n = 0; n < 2; ++n) acc[a][b][m][n] = (f32x4){0.f, 0.f, 0.f, 0.f};
    bf16x8 At[4][2], B0[2][2], B1[2][2];
    const char* cA = (const char*)g.A + (size_t)cur.pm * tstepA + (Sched::VARK ? (size_t)cur.koff * 2 : 0); const char* cB = (const char*)g.Bt + (size_t)cur.pb * tstepB + (Sched::VARK ? (size_t)cur.koff * 2 : 0);
    S.a_ready(cur);
    if constexpr (SP2) {
        PG8_STAGE(PG8_SB(0, 0), cB, voffB); PG8_STAGE(PG8_SB(0, 1), cB + hstepB, voffB); PG8_STAGEA(PG8_SA(0, 0), cA, (const char*)g.A, gC[0]); PG8_STAGEA(PG8_SA(0, 1), cA + hstepA, (const char*)g.A, gC[1]);
        if (wr == 1) PG8_BAR;
        PG8_WAIT_V(2); PG8_BAR;
        PG8_STAGE(PG8_SB(1, 0), cB + kstep, voffB); PG8_STAGEA(PG8_SA(1, 0), cA + kstep, (const char*)g.A + kstep, gC[0]); PG8_STAGE(PG8_SB(1, 1), cB + hstepB + kstep, voffB);
        PG8_WAIT_V(6); PG8_BAR;
    } else {
        PG8_STAGE(PG8_SB(0, 0), cB, voffB); PG8_STAGE(PG8_SA(0, 0), cA, voffA); PG8_STAGE(PG8_SB(0, 1), cB + hstepB, voffB); PG8_STAGE(PG8_SA(0, 1), cA + hstepA, voffA);
        if (wr == 1) PG8_BAR;
        PG8_WAIT_V(4); PG8_BAR;
        PG8_STAGE(PG8_SB(1, 0), cB + kstep, voffB); PG8_STAGE(PG8_SA(1, 0), cA + kstep, voffA); PG8_STAGE(PG8_SB(1, 1), cB + hstepB + kstep, voffB);
        PG8_WAIT_V(6); PG8_BAR;
    }
    for (;;) {
        const bool has_next = S.next(ui + 1, nxt);
        const char* nA = has_next ? (const char*)g.A + (size_t)nxt.pm * tstepA + (Sched::VARK ? (size_t)nxt.koff * 2 : 0) : cA; const char* nB = has_next ? (const char*)g.Bt + (size_t)nxt.pb * tstepB + (Sched::VARK ? (size_t)nxt.koff * 2 : 0) : cB;
        const int ntc = Sched::VARK ? cur.nt : nt;
        if constexpr (Sched::GATHER) { if (has_next) PG8_GOFF(gN, nxt); else { gN[0][0] = gC[0][0]; gN[0][1] = gC[0][1]; gN[1][0] = gC[1][0]; gN[1][1] = gC[1][1]; } }
#pragma unroll 1
        for (int t = 0; t < ntc; t += 2) {
            const bool last = (t == ntc - 2);
            const char* a1 = cA + (size_t)(t + 1) * kstep;
            const char* a2 = last ? nA : cA + (size_t)(t + 2) * kstep; const char* b2 = last ? nB : cB + (size_t)(t + 2) * kstep;
            const char* a3 = a2 + kstep; const char* b3 = b2 + kstep;
            if (last && has_next) S.a_ready(nxt);
            const char* gk1 = (const char*)g.A + (size_t)(t + 1) * kstep; const char* gk2 = (const char*)g.A + (size_t)(last ? 0 : t + 2) * kstep; const char* gk3 = gk2 + kstep;
            if constexpr (SP2) {
            PG8_LDB(B0, 0, 0); PG8_LDB(B1, 0, 1); PG8_SCHED; PG8_LDA(At, 0, 0); PG8_STAGEA(PG8_SA(1, 1), a1 + hstepA, gk1, gC[1]);
            PG8_WAIT_V(8); PG8_WAIT_L(0); PG8_BAR; PG8_MMA(0, 0, At, B0); PG8_MMA(0, 1, At, B1); PG8_BAR; PG8_SCHED;
            PG8_LDA(At, 0, 1); PG8_STAGE(PG8_SB(0, 0), b2, voffB); PG8_STAGE(PG8_SB(0, 1), b2 + hstepB, voffB); PG8_STAGEA_SEL(PG8_SA(0, 0), a2, gk2, 0);
            PG8_WAIT_V(8); PG8_WAIT_L(0); PG8_BAR; PG8_MMA(1, 0, At, B0); PG8_MMA(1, 1, At, B1); PG8_BAR; PG8_SCHED;
            PG8_LDB(B0, 1, 0); PG8_LDB(B1, 1, 1); PG8_SCHED; PG8_LDA(At, 1, 0); PG8_STAGEA_SEL(PG8_SA(0, 1), a2 + hstepA, gk2, 1);
            PG8_WAIT_V(8); PG8_WAIT_L(0); PG8_BAR; PG8_MMA(0, 0, At, B0); PG8_MMA(0, 1, At, B1); PG8_BAR; PG8_SCHED;
            PG8_LDA(At, 1, 1); PG8_STAGE(PG8_SB(1, 0), b3, voffB); PG8_STAGE(PG8_SB(1, 1), b3 + hstepB, voffB); PG8_STAGEA_SEL(PG8_SA(1, 0), a3, gk3, 0);
            PG8_WAIT_V(8); PG8_WAIT_L(0); PG8_BAR; PG8_MMA(1, 0, At, B0); PG8_MMA(1, 1, At, B1); PG8_BAR; PG8_SCHED;
            } else {
            PG8_LDB(B0, 0, 0); PG8_SCHED; PG8_LDA(At, 0, 0); PG8_STAGE(PG8_SA(1, 1), a1 + hstepA, voffA);
            PG8_WAIT_L(8); PG8_BAR; PG8_WAIT_L(0); PG8_MMA(0, 0, At, B0); PG8_BAR; PG8_SCHED;
            PG8_LDB(B1, 0, 1); PG8_STAGE(PG8_SB(0, 0), b2, voffB);
            PG8_BAR; PG8_WAIT_L(0); PG8_MMA(0, 1, At, B1); PG8_BAR;
            PG8_LDA(At, 0, 1); PG8_STAGE(PG8_SA(0, 0), a2, voffA);
            PG8_BAR; PG8_WAIT_L(0); PG8_MMA(1, 0, At, B0); PG8_BAR; PG8_SCHED;
            PG8_STAGE(PG8_SB(0, 1), b2 + hstepB, voffB);
            PG8_WAIT_V(6); PG8_BAR; PG8_MMA(1, 1, At, B1); PG8_BAR;
            PG8_LDB(B0, 1, 0); PG8_SCHED; PG8_LDA(At, 1, 0); PG8_STAGE(PG8_SA(0, 1), a2 + hstepA, voffA);
            PG8_WAIT_L(8); PG8_BAR; PG8_WAIT_L(0); PG8_MMA(0, 0, At, B0); PG8_BAR; PG8_SCHED;
            PG8_LDB(B1, 1, 1); PG8_STAGE(PG8_SB(1, 0), b3, voffB);
            PG8_BAR; PG8_WAIT_L(0); PG8_MMA(0, 1, At, B1); PG8_BAR;
            PG8_LDA(At, 1, 1); PG8_STAGE(PG8_SA(1, 0), a3, voffA);
            PG8_BAR; PG8_WAIT_L(0); PG8_MMA(1, 0, At, B0); PG8_BAR; PG8_SCHED;
            PG8_STAGE(PG8_SB(1, 1), b3 + hstepB, voffB);
            PG8_WAIT_V(6); PG8_BAR; PG8_MMA(1, 1, At, B1); PG8_BAR;
            }
        }
        if constexpr (ALIGN_EPI) { if (wr == 0) PG8_BAR; }
        if constexpr (!Epi::AFTER_DRAIN) { E(acc, cur, wr, wc, fr, fq); S.done(cur); }
        if (!has_next) break;
        if (!Sched::VARK || cur.zero) {
#pragma unroll
        for (int a = 0; a < 2; ++a)
#pragma unroll
            for (int b = 0; b < 2; ++b)
#pragma unroll
                for (int m = 0; m < 4; ++m)
#pragma unroll
                    for (int n = 0; n < 2; ++n) acc[a][b][m][n] = (f32x4){0.f, 0.f, 0.f, 0.f};
        }
        cur = nxt; cA = nA; cB = nB; ++ui;
        if constexpr (Sched::GATHER) { gC[0][0] = gN[0][0]; gC[0][1] = gN[0][1]; gC[1][0] = gN[1][0]; gC[1][1] = gN[1][1]; }
        if constexpr (ALIGN_EPI) { if (wr == 1) PG8_BAR; }
    }
    PG8_WAIT_V(0);
    if constexpr (!ALIGN_EPI) { if (wr == 0) PG8_BAR; }
    PG8_BAR;
    if constexpr (Epi::AFTER_DRAIN) { E.fused(acc, cur, wr, wc, fr, fq, lds, wid, lane); S.done(cur); }
#undef PG8_GOFF
#undef PG8_STAGEA
#undef PG8_STAGEA_SEL
#undef PG8_SA
#undef PG8_SB
#undef PG8_STAGE
#undef PG8_LDA
#undef PG8_LDB
#undef PG8_MMA
#undef PG8_WAIT_V
#undef PG8_WAIT_L
#undef PG8_BAR
#undef PG8_SCHED
}
}

#ifndef ATTN_FAST
#define ATTN_FAST 1
#endif
#include <hip/hip_bf16.h>
#include <cmath>
namespace attn_body {
using bf16=__hip_bfloat16;
using bf16x8=__attribute__((ext_vector_type(8)))short;
using s16x4=__attribute__((ext_vector_type(4)))short;
using f32x16=__attribute__((ext_vector_type(16)))float;
using u32x4=__attribute__((ext_vector_type(4)))unsigned;
constexpr int BATCH=8,SEQ=4096,D=64,DM=2048,DMO=512;
constexpr int NW=8,QBLK=32,QB=QBLK*NW,KVBLK=64,NQB=SEQ/QB;
constexpr int ATTN_PITCH=DM, ATTN_UNIT_ROWS=QB;
__device__ __forceinline__ int crow(int r,int hi){return (r&3)+8*(r>>2)+4*hi;}
#define SBAR() __builtin_amdgcn_sched_barrier(0)
__device__ __forceinline__ void cmask(f32x16&p0,f32x16&p1,int jb,int wid){
  if(jb>(wid>>1)){ const float NEG=-INFINITY;
    #pragma unroll
    for(int r=0;r<16;++r){p0[r]=NEG;p1[r]=NEG;} }
}

constexpr int NSLOT=3, SLOTB=8192;
constexpr int LDS_K=0, LDS_V=NSLOT*SLOTB, LDS_WS=2*NSLOT*SLOTB, LDS_OST=LDS_WS+NW*64*4, LDS_BYTES=LDS_OST+NW*4096;
constexpr float C2=0.125f*1.4426950408889634f;
__device__ __forceinline__ void glds16(const void*gsrc,unsigned lds_dst){unsigned keep;
  asm volatile("s_mov_b32 %0, m0\n\ts_mov_b32 m0, %2\n\ts_nop 0\n\tglobal_load_lds_dwordx4 %1, off\n\ts_mov_b32 m0, %0":"=&s"(keep):"v"(gsrc),"s"(lds_dst):"memory");}
__device__ __forceinline__ float max3f(float a,float b,float c){float r;asm("v_max3_f32 %0, %1, %2, %3":"=v"(r):"v"(a),"v"(b),"v"(c));return r;}
__device__ __forceinline__ float max2f(float a,float b){float r;asm("v_max_f32_e32 %0, %1, %2":"=v"(r):"v"(a),"v"(b));return r;}
__device__ __forceinline__ float fadd_s(float a,float b){float r;asm("v_add_f32_e32 %0, %1, %2":"=v"(r):"v"(a),"v"(b));return r;}
__device__ __forceinline__ float fsub_s(float a,float b){float r;asm("v_sub_f32_e32 %0, %1, %2":"=v"(r):"v"(a),"v"(b));return r;}
typedef float f32x2_t __attribute__((ext_vector_type(2))); typedef __bf16 bf16x2_t __attribute__((ext_vector_type(2)));
__device__ __forceinline__ unsigned cvtpk_s(float lo,float hi){f32x2_t v={lo,hi};bf16x2_t b=__builtin_convertvector(v,bf16x2_t);return __builtin_bit_cast(unsigned,b);}
#define WAIT_BAR(N) asm volatile("s_waitcnt vmcnt(" #N ") lgkmcnt(0)\n\ts_barrier":::"memory")

__device__ __forceinline__ void qkt(f32x16&p0,f32x16&p1,const char*Kslot,const bf16x8*qr,const f32x16&negm,int r32,int hi){
  const char*kb=Kslot+hi*1024+r32*16;
  #pragma unroll
  for(int d0=0;d0<4;++d0){
    const bf16x8 b0=*reinterpret_cast<const bf16x8*>(kb+d0*2048);
    const bf16x8 b1=*reinterpret_cast<const bf16x8*>(kb+d0*2048+512);
    if(d0==0){p0=__builtin_amdgcn_mfma_f32_32x32x16_bf16(b0,qr[0],negm,0,0,0);p1=__builtin_amdgcn_mfma_f32_32x32x16_bf16(b1,qr[0],negm,0,0,0);}
    else{p0=__builtin_amdgcn_mfma_f32_32x32x16_bf16(b0,qr[d0],p0,0,0,0);p1=__builtin_amdgcn_mfma_f32_32x32x16_bf16(b1,qr[d0],p1,0,0,0);}}
}
typedef __attribute__((address_space(3))) const char* lds_cptr;
typedef short v4i16_t __attribute__((ext_vector_type(4)));
__device__ __forceinline__ void kload8(bf16x8*kf,lds_cptr kp){
  kf[0]=*(const __attribute__((address_space(3))) bf16x8*)(kp);      kf[1]=*(const __attribute__((address_space(3))) bf16x8*)(kp+512);
  kf[2]=*(const __attribute__((address_space(3))) bf16x8*)(kp+2048); kf[3]=*(const __attribute__((address_space(3))) bf16x8*)(kp+2560);
  kf[4]=*(const __attribute__((address_space(3))) bf16x8*)(kp+4096); kf[5]=*(const __attribute__((address_space(3))) bf16x8*)(kp+4608);
  kf[6]=*(const __attribute__((address_space(3))) bf16x8*)(kp+6144); kf[7]=*(const __attribute__((address_space(3))) bf16x8*)(kp+6656);
}
__device__ __forceinline__ void kload2(bf16x8*kf,lds_cptr kp,int j){ kf[2*j]=*(const __attribute__((address_space(3))) bf16x8*)(kp+j*2048); kf[2*j+1]=*(const __attribute__((address_space(3))) bf16x8*)(kp+j*2048+512); }
__device__ __forceinline__ s16x4 vtr(lds_cptr p){ return __builtin_bit_cast(s16x4,__builtin_amdgcn_ds_read_tr16_b64_v4i16((__attribute__((address_space(3))) v4i16_t*)p)); }
__device__ __forceinline__ float rowmax(const f32x16&p0,const f32x16&p1){
  float a=max3f(p0[0],p0[1],p1[0]),b=max3f(p0[2],p0[3],p1[1]);a=max3f(a,p1[2],p1[3]);
  #pragma unroll
  for(int r=4;r<16;r+=4){a=max3f(a,p0[r],p0[r+1]);b=max3f(b,p0[r+2],p0[r+3]);a=max3f(a,p1[r],p1[r+1]);b=max3f(b,p1[r+2],p1[r+3]);}
  const float m=max2f(a,b);
  auto rr=__builtin_amdgcn_permlane32_swap(__float_as_uint(m),__float_as_uint(m),false,false);
  return max2f(__uint_as_float(rr[0]),__uint_as_float(rr[1]));
}
__device__ __forceinline__ void pv(f32x16*o,int vb,bf16x8 pa0,bf16x8 pa1,bf16x8 pa2,bf16x8 pa3){
  #pragma unroll
  for(int d0=0;d0<2;++d0){s16x4 lo[4],hi[4];
    #pragma unroll
    for(int ks=0;ks<4;++ks){
      asm volatile("ds_read_b64_tr_b16 %0,%1 offset:%c2":"=&v"(lo[ks]):"v"(vb),"i"(d0*4096+ks*1024):"memory");
      asm volatile("ds_read_b64_tr_b16 %0,%1 offset:%c2":"=&v"(hi[ks]):"v"(vb),"i"(d0*4096+ks*1024+512):"memory");}
    asm volatile("s_waitcnt lgkmcnt(0)":::"memory");SBAR();
    #define PK(k) (bf16x8){lo[k][0],lo[k][1],lo[k][2],lo[k][3],hi[k][0],hi[k][1],hi[k][2],hi[k][3]}
    o[d0]=__builtin_amdgcn_mfma_f32_32x32x16_bf16(pa0,PK(0),o[d0],0,0,0);
    o[d0]=__builtin_amdgcn_mfma_f32_32x32x16_bf16(pa1,PK(1),o[d0],0,0,0);
    o[d0]=__builtin_amdgcn_mfma_f32_32x32x16_bf16(pa2,PK(2),o[d0],0,0,0);
    o[d0]=__builtin_amdgcn_mfma_f32_32x32x16_bf16(pa3,PK(3),o[d0],0,0,0);
    #undef PK
  }
}

#ifndef ATTN_STORE16
#define ATTN_STORE16(p,v) (*(u32x4*)(p)=(v))
#endif
template<int THRL> __device__ __forceinline__ void attn_unit(int b,int qb,const bf16*Q,const bf16*__restrict__ K,const bf16*__restrict__ V,bf16*O,char*shm){
  const int tid=opqv((int)threadIdx.x),lane=tid&63,r32=lane&31,hi=lane>>5; const int wid=__builtin_amdgcn_readfirstlane(tid>>6);
  const long rowbase=(long)b*SEQ; const int q0=qb*QB;
  const bf16*Qw=Q+(rowbase+q0+wid*QBLK)*DM;
  const bf16*Kh=K+rowbase*DM,*Vh=V+rowbase*DM;
  const unsigned lds0=(unsigned)(uintptr_t)shm;
  float*wsf=(float*)(shm+LDS_WS)+wid*64;
  const bf16*ksrc=Kh+(long)lane*DM+wid*8;
  const bf16*vsrc=Vh+(long)(16*(wid&3)+(lane>>2))*DM+(wid>>2)*32+(lane&3)*8;
  const unsigned kdst=lds0+LDS_K+wid*1024, vdst=lds0+LDS_V+wid*1024;
  #define DMA_K(t,slot) glds16(ksrc+(long)(t)*KVBLK*DM,(unsigned)__builtin_amdgcn_readfirstlane(kdst+(slot)))
  #define DMA_V(t,slot) glds16(vsrc+(long)(t)*KVBLK*DM,(unsigned)__builtin_amdgcn_readfirstlane(vdst+(slot)))
  const int vb0=(int)(lds0+LDS_V)+((lane>>4)&1)*32+(lane&3)*8+(4*hi+((lane&15)>>2))*64;
  const char*Kbase=shm+LDS_K; bf16x8 kf[8];
  const lds_cptr shm3=(lds_cptr)shm; const lds_cptr kp0=shm3+LDS_K+hi*1024+r32*16; const lds_cptr vp0=shm3+LDS_V+((lane>>4)&1)*32+(lane&3)*8+(4*hi+((lane&15)>>2))*64;
  const int NT=(q0+QB)/KVBLK;
  DMA_K(0,0);DMA_V(0,0);DMA_K(1,SLOTB);
  bf16x8 qr[4];
  #pragma unroll
  for(int d0=0;d0<4;++d0)qr[d0]=*reinterpret_cast<const bf16x8*>(&Qw[(long)r32*DM+d0*16+hi*8]);
  float mhat=0.f,l_reg=0.f;f32x16 o[2];o[0]=f32x16{};o[1]=f32x16{};f32x16 negm=f32x16{};asm volatile("":"+v"(negm));
  #define CMASK(P0,P1,t) do{int jb_=(t)-(NT-4); if(jb_>=0)cmask(P0,P1,jb_,wid);}while(0)
  bool resc=false;
  #define START(P0,P1) do{ const float rm=rowmax(P0,P1); resc=false; \
    { const float dl=rm; mhat=fadd_s(mhat,dl); \
      _Pragma("unroll") for(int r=0;r<16;++r){P0[r]=fsub_s(P0[r],dl);P1[r]=fsub_s(P1[r],dl);} \
      _Pragma("unroll") for(int r=0;r<16;++r)negm[r]=-mhat; asm volatile("":"+v"(negm)); } \
    _Pragma("unroll") for(int r=0;r<16;++r)P0[r]=__builtin_amdgcn_exp2f(P0[r]); }while(0)
  #define RESC() do{ if(resc){ asm volatile("s_waitcnt lgkmcnt(0)":::"memory"); \
      _Pragma("unroll") for(int d_=0;d_<2;++d_) _Pragma("unroll") for(int r=0;r<16;++r)o[d_][r]*=wsf[crow(r,hi)]; } }while(0)
  f32x16 pA0,pA1,pB0,pB1;
  int sl_prev=0,sl_cur=0,sl_next=SLOTB;
  #define ROT() do{sl_prev=sl_cur;sl_cur=sl_next;sl_next=(sl_next==(NSLOT-1)*SLOTB)?0:sl_next+SLOTB;}while(0)
  DMA_K(2,2*SLOTB);
  WAIT_BAR(3);
  qkt(pA0,pA1,Kbase,qr,negm,r32,hi);asm volatile("s_nop 15\n\ts_nop 7":"+v"(pA0),"+v"(pA1));CMASK(pA0,pA1,0);
  START(pA0,pA1);
  _Pragma("unroll") for(int r=0;r<16;++r)pA1[r]=__builtin_amdgcn_exp2f(pA1[r]);
  WAIT_BAR(0);
  DMA_K(3,0);DMA_V(1,SLOTB);
  ROT();
  kload8(kf,kp0+sl_cur);
  WAIT_BAR(2);
  s16x4 vlo[8],vhi[8]; u32x4 pw0,pw1,pw2,pw3;
  #define PKW(P,B) cvtpk_s(P[B],P[B+1])
  #define PAF(k) __builtin_bit_cast(bf16x8,pw##k)
  #define VFR(i) (bf16x8){vlo[i][0],vlo[i][1],vlo[i][2],vlo[i][3],vhi[i][0],vhi[i][1],vhi[i][2],vhi[i][3]}
  #define PIN(x) asm volatile("":"+v"(x))
  #define MX3(a,b,c) __builtin_fmaxf(__builtin_fmaxf((a),(b)),(c))
  #define GAPA(MF,A0,A1,A2,A3,W0,W1,PW) do{ MF; sacc+=A0; sacc+=A1; sacc+=A2; sacc+=A3; PIN(sacc); W0; W1; PIN(PW); SBAR(); }while(0)
  #define EX(v) __builtin_amdgcn_exp2f(v)
  #define GAPB(MF,X,B) do{ MF; X[B]=EX(X[B]); X[B+1]=EX(X[B+1]); X[B+2]=EX(X[B+2]); X[B+3]=EX(X[B+3]); PIN(X); SBAR(); }while(0)
  #define VRD(i) do{ vlo[i]=vtr(vp_+(((i)>>2)*4096+((i)&3)*1024)); vhi[i]=vtr(vp_+(((i)>>2)*4096+((i)&3)*1024+512)); }while(0)
  #define KRD(G,j) do{ if(G){ kload2(kf,kp0+sl_next,j); SBAR(); } }while(0)
  #define STEP(C0,C1,P0,P1,t,GK,GV,GL) do{ SBAR(); \
    const lds_cptr vp_=vp0+sl_prev; \
    VRD(0); SBAR(); float sacc=(P0[0]+P0[1]); \
    GAPA(C0=__builtin_amdgcn_mfma_f32_32x32x16_bf16(kf[0],qr[0],negm,0,0,0), P0[2],P0[3],P0[4],P0[5],     pw0[0]=PKW(P0,0), pw0[1]=PKW(P0,2), pw0); \
    VRD(4); SBAR(); GAPA(C1=__builtin_amdgcn_mfma_f32_32x32x16_bf16(kf[1],qr[0],negm,0,0,0), P0[6],P0[7],P0[8],P0[9],     pw0[2]=PKW(P0,4), pw0[3]=PKW(P0,6), pw0); \
    VRD(1); SBAR(); GAPA(C0=__builtin_amdgcn_mfma_f32_32x32x16_bf16(kf[2],qr[1],C0,0,0,0),   P0[10],P0[11],P0[12],P0[13], pw1[0]=PKW(P0,8), pw1[1]=PKW(P0,10), pw1); \
    VRD(5); SBAR(); GAPA(C1=__builtin_amdgcn_mfma_f32_32x32x16_bf16(kf[3],qr[1],C1,0,0,0),   P0[14],P0[15],P1[0],P1[1],   pw1[2]=PKW(P0,12),pw1[3]=PKW(P0,14), pw1); \
    VRD(2); SBAR(); GAPA(C0=__builtin_amdgcn_mfma_f32_32x32x16_bf16(kf[4],qr[2],C0,0,0,0),   P1[2],P1[3],P1[4],P1[5],     pw2[0]=PKW(P1,0), pw2[1]=PKW(P1,2), pw2); \
    VRD(6); SBAR(); GAPA(C1=__builtin_amdgcn_mfma_f32_32x32x16_bf16(kf[5],qr[2],C1,0,0,0),   P1[6],P1[7],P1[8],P1[9],     pw2[2]=PKW(P1,4), pw2[3]=PKW(P1,6), pw2); \
    VRD(3); SBAR(); GAPA(C0=__builtin_amdgcn_mfma_f32_32x32x16_bf16(kf[6],qr[3],C0,0,0,0),   P1[10],P1[11],P1[12],P1[13], pw3[0]=PKW(P1,8), pw3[1]=PKW(P1,10), pw3); \
    VRD(7); SBAR(); GAPA(C1=__builtin_amdgcn_mfma_f32_32x32x16_bf16(kf[7],qr[3],C1,0,0,0),   P1[14],P1[15],0.f,0.f,       pw3[2]=PKW(P1,12),pw3[3]=PKW(P1,14), pw3); \
    l_reg+=sacc; \
    if(GK){DMA_K((t)+3,sl_cur);} if(GV){DMA_V((t)+1,sl_next);} \
    CMASK(C0,C1,t); \
    { float a=MX3(C0[0],C0[1],C1[0]),b=MX3(C0[2],C0[3],C1[1]); a=MX3(a,C1[2],C1[3]); \
      _Pragma("unroll") for(int r=4;r<16;r+=4){a=MX3(a,C0[r],C0[r+1]);b=MX3(b,C0[r+2],C0[r+3]);a=MX3(a,C1[r],C1[r+1]);b=MX3(b,C1[r+2],C1[r+3]);} \
      float rm=__builtin_fmaxf(a,b); { auto rr=__builtin_amdgcn_permlane32_swap(__float_as_uint(rm),__float_as_uint(rm),false,false); rm=__builtin_fmaxf(__uint_as_float(rr[0]),__uint_as_float(rr[1])); } \
      resc=false; \
      if(__builtin_expect(__any(rm>(float)THRL),0)){ const float dl=__builtin_fmaxf(rm,0.f); mhat+=dl; \
        _Pragma("unroll") for(int r=0;r<16;++r){C0[r]-=dl;C1[r]-=dl;} \
        _Pragma("unroll") for(int r=0;r<16;++r)negm[r]=-mhat; asm volatile("":"+v"(negm)); \
        const float f=__builtin_amdgcn_exp2f(-dl); l_reg*=f; if(hi==0)wsf[r32]=f; resc=true; } } \
    SBAR(); \
    GAPB(o[0]=__builtin_amdgcn_mfma_f32_32x32x16_bf16(PAF(0),VFR(0),o[0],0,0,0), C0,0); \
    GAPB(o[1]=__builtin_amdgcn_mfma_f32_32x32x16_bf16(PAF(0),VFR(4),o[1],0,0,0), C0,4); \
    KRD(GL,0); GAPB(o[0]=__builtin_amdgcn_mfma_f32_32x32x16_bf16(PAF(1),VFR(1),o[0],0,0,0), C0,8); \
    KRD(GL,1); GAPB(o[1]=__builtin_amdgcn_mfma_f32_32x32x16_bf16(PAF(1),VFR(5),o[1],0,0,0), C0,12); \
    KRD(GL,2); GAPB(o[0]=__builtin_amdgcn_mfma_f32_32x32x16_bf16(PAF(2),VFR(2),o[0],0,0,0), C1,0); \
    KRD(GL,3); GAPB(o[1]=__builtin_amdgcn_mfma_f32_32x32x16_bf16(PAF(2),VFR(6),o[1],0,0,0), C1,4); \
    GAPB(o[0]=__builtin_amdgcn_mfma_f32_32x32x16_bf16(PAF(3),VFR(3),o[0],0,0,0), C1,8); \
    GAPB(o[1]=__builtin_amdgcn_mfma_f32_32x32x16_bf16(PAF(3),VFR(7),o[1],0,0,0), C1,12); \
    }while(0)
  int t=1;
  #undef CMASK
  #define CMASK(P0,P1,t) do{}while(0)
  for(;t+5<NT;t+=2){
    STEP(pB0,pB1,pA0,pA1,t,true,true,true);     WAIT_BAR(2); RESC(); ROT();
    STEP(pA0,pA1,pB0,pB1,t+1,true,true,true);   WAIT_BAR(2); RESC(); ROT();
  }
  #undef CMASK
  #define CMASK(P0,P1,t) do{int jb_=(t)-(NT-4); if(jb_>=0)cmask(P0,P1,jb_,wid);}while(0)
  #define ENDW(tt) do{ if((tt)+3<NT){WAIT_BAR(2);} else if((tt)+2<NT){WAIT_BAR(1);} else {WAIT_BAR(0);} }while(0)
  for(;t+1<NT;t+=2){
    STEP(pB0,pB1,pA0,pA1,t,(t+3<NT),(t+1<NT),(t+1<NT));       ENDW(t);   RESC(); ROT();
    STEP(pA0,pA1,pB0,pB1,t+1,(t+4<NT),(t+2<NT),(t+2<NT));     ENDW(t+1); RESC(); ROT();
  }
  STEP(pB0,pB1,pA0,pA1,NT-1,false,false,false); RESC();
  { float sacc=pB0[0]+pB0[1]; _Pragma("unroll") for(int r=2;r<16;++r)sacc+=pB0[r]; _Pragma("unroll") for(int r=0;r<16;++r)sacc+=pB1[r]; l_reg+=sacc;
    pw0=(u32x4){PKW(pB0,0),PKW(pB0,2),PKW(pB0,4),PKW(pB0,6)};pw1=(u32x4){PKW(pB0,8),PKW(pB0,10),PKW(pB0,12),PKW(pB0,14)};pw2=(u32x4){PKW(pB1,0),PKW(pB1,2),PKW(pB1,4),PKW(pB1,6)};pw3=(u32x4){PKW(pB1,8),PKW(pB1,10),PKW(pB1,12),PKW(pB1,14)};
    SBAR(); pv(o,vb0+sl_cur,PAF(0),PAF(1),PAF(2),PAF(3)); }
  #undef PKW
  #undef PAF
  #undef VFR
  #undef PIN
  #undef MX3
  #undef GAPA
  #undef GAPB
  #undef EX
  #undef VRD
  #undef KRD
  #undef STEP
  #undef ENDW
  {auto rr=__builtin_amdgcn_permlane32_swap(__float_as_uint(l_reg),__float_as_uint(l_reg),false,false);l_reg=__uint_as_float(rr[0])+__uint_as_float(rr[1]);}
  if(hi==0)wsf[32+r32]=l_reg;asm volatile("s_waitcnt lgkmcnt(0)":::"memory");
  float rli[16];
  #pragma unroll
  for(int r=0;r<16;++r)rli[r]=__builtin_amdgcn_rcpf(wsf[32+crow(r,hi)]);
  bf16*Ow=O+(rowbase+q0+wid*QBLK)*DMO;
  { bf16*stg=(bf16*)(shm+LDS_OST)+wid*2048;
    #pragma unroll
    for(int r=0;r<16;++r){const int orow=crow(r,hi);
      #pragma unroll
      for(int d0=0;d0<2;++d0)stg[orow*64+d0*32+r32]=__float2bfloat16(o[d0][r]*rli[r]);}
    asm volatile("s_waitcnt lgkmcnt(0)":::"memory");
    #pragma unroll
    for(int i=0;i<4;++i){const int row=i*8+(lane>>3),ch=lane&7; const u32x4 v=*(const u32x4*)(stg+row*64+ch*8); ATTN_STORE16(Ow+(long)row*DMO+ch*8,v);} }
  asm volatile("s_waitcnt lgkmcnt(0)\n\ts_barrier":::"memory");
  #undef DMA_K
  #undef DMA_V
  #undef CMASK
  #undef START
  #undef RESC
  #undef ROT
}
constexpr int ATTN_LDS_BYTES=LDS_BYTES;
#undef SBAR
#undef WAIT_BAR
}
#ifndef ATTN_V128
#define ATTN_V128 1
#endif
namespace attn128 {
using bf16=__hip_bfloat16;
using bf16x8=__attribute__((ext_vector_type(8)))short;
using s16x4=__attribute__((ext_vector_type(4)))short;
using f32x16=__attribute__((ext_vector_type(16)))float;
using u32x4=__attribute__((ext_vector_type(4)))unsigned;
constexpr int BATCH=8,SEQ=4096,D=64,DM=2048,DMO=512;
constexpr int NW=8,QBLK=32,QB=QBLK*NW,KVBLK=64,NQB=SEQ/QB;
constexpr int ATTN_PITCH=DM, ATTN_UNIT_ROWS=QB;
__device__ __forceinline__ int crow(int r,int hi){return (r&3)+8*(r>>2)+4*hi;}
#define SBAR() __builtin_amdgcn_sched_barrier(0)
__device__ __forceinline__ void cmask(f32x16&p0,f32x16&p1,int jb,int wid){
  if(jb>(wid>>1)){ const float NEG=-INFINITY;
    #pragma unroll
    for(int r=0;r<16;++r){p0[r]=NEG;p1[r]=NEG;} }
}

constexpr int NSLOT=3, SLOTB=8192;
constexpr int VSLOTB=2*SLOTB;
constexpr int LDS_K=0, LDS_V=NSLOT*SLOTB, LDS_WS=LDS_V+NSLOT*VSLOTB, LDS_OST=LDS_WS+NW*64*4, LDS_BYTES=LDS_OST+NW*8192;
constexpr float C2=0.125f*1.4426950408889634f;
__device__ __forceinline__ void glds16(const void*gsrc,unsigned lds_dst){unsigned keep;
  asm volatile("s_mov_b32 %0, m0\n\ts_mov_b32 m0, %2\n\ts_nop 0\n\tglobal_load_lds_dwordx4 %1, off\n\ts_mov_b32 m0, %0":"=&s"(keep):"v"(gsrc),"s"(lds_dst):"memory");}
__device__ __forceinline__ float max3f(float a,float b,float c){float r;asm("v_max3_f32 %0, %1, %2, %3":"=v"(r):"v"(a),"v"(b),"v"(c));return r;}
__device__ __forceinline__ float max2f(float a,float b){float r;asm("v_max_f32_e32 %0, %1, %2":"=v"(r):"v"(a),"v"(b));return r;}
__device__ __forceinline__ float fadd_s(float a,float b){float r;asm("v_add_f32_e32 %0, %1, %2":"=v"(r):"v"(a),"v"(b));return r;}
__device__ __forceinline__ float fsub_s(float a,float b){float r;asm("v_sub_f32_e32 %0, %1, %2":"=v"(r):"v"(a),"v"(b));return r;}
typedef float f32x2_t __attribute__((ext_vector_type(2))); typedef __bf16 bf16x2_t __attribute__((ext_vector_type(2)));
__device__ __forceinline__ unsigned cvtpk_s(float lo,float hi){f32x2_t v={lo,hi};bf16x2_t b=__builtin_convertvector(v,bf16x2_t);return __builtin_bit_cast(unsigned,b);}
#define WAIT_BAR(N) asm volatile("s_waitcnt vmcnt(" #N ") lgkmcnt(0)\n\ts_barrier":::"memory")

__device__ __forceinline__ void qkt(f32x16&p0,f32x16&p1,const char*Kslot,const bf16x8*qr,int r32,int hi){
  const char*kb=Kslot+hi*1024+r32*16;
  #pragma unroll
  for(int d0=0;d0<4;++d0){
    const bf16x8 b0=*reinterpret_cast<const bf16x8*>(kb+d0*2048);
    const bf16x8 b1=*reinterpret_cast<const bf16x8*>(kb+d0*2048+512);
    if(d0==0){p0=__builtin_amdgcn_mfma_f32_32x32x16_bf16(b0,qr[0],f32x16{},0,0,0);p1=__builtin_amdgcn_mfma_f32_32x32x16_bf16(b1,qr[0],f32x16{},0,0,0);}
    else{p0=__builtin_amdgcn_mfma_f32_32x32x16_bf16(b0,qr[d0],p0,0,0,0);p1=__builtin_amdgcn_mfma_f32_32x32x16_bf16(b1,qr[d0],p1,0,0,0);}}
}
typedef __attribute__((address_space(3))) const char* lds_cptr;
typedef short v4i16_t __attribute__((ext_vector_type(4)));
__device__ __forceinline__ void kload8(bf16x8*kf,lds_cptr kp){
  kf[0]=*(const __attribute__((address_space(3))) bf16x8*)(kp);      kf[1]=*(const __attribute__((address_space(3))) bf16x8*)(kp+512);
  kf[2]=*(const __attribute__((address_space(3))) bf16x8*)(kp+2048); kf[3]=*(const __attribute__((address_space(3))) bf16x8*)(kp+2560);
  kf[4]=*(const __attribute__((address_space(3))) bf16x8*)(kp+4096); kf[5]=*(const __attribute__((address_space(3))) bf16x8*)(kp+4608);
  kf[6]=*(const __attribute__((address_space(3))) bf16x8*)(kp+6144); kf[7]=*(const __attribute__((address_space(3))) bf16x8*)(kp+6656);
}
__device__ __forceinline__ void kload2(bf16x8*kf,lds_cptr kp,int j){ kf[2*j]=*(const __attribute__((address_space(3))) bf16x8*)(kp+j*2048); kf[2*j+1]=*(const __attribute__((address_space(3))) bf16x8*)(kp+j*2048+512); }
__device__ __forceinline__ s16x4 vtr(lds_cptr p){ return __builtin_bit_cast(s16x4,__builtin_amdgcn_ds_read_tr16_b64_v4i16((__attribute__((address_space(3))) v4i16_t*)p)); }
__device__ __forceinline__ float rowmax(const f32x16&p0,const f32x16&p1){
  float a=max3f(p0[0],p0[1],p1[0]),b=max3f(p0[2],p0[3],p1[1]);a=max3f(a,p1[2],p1[3]);
  #pragma unroll
  for(int r=4;r<16;r+=4){a=max3f(a,p0[r],p0[r+1]);b=max3f(b,p0[r+2],p0[r+3]);a=max3f(a,p1[r],p1[r+1]);b=max3f(b,p1[r+2],p1[r+3]);}
  const float m=max2f(a,b);
  auto rr=__builtin_amdgcn_permlane32_swap(__float_as_uint(m),__float_as_uint(m),false,false);
  return max2f(__uint_as_float(rr[0]),__uint_as_float(rr[1]));
}
__device__ __forceinline__ void pv(f32x16*o,int vb,bf16x8 pa0,bf16x8 pa1,bf16x8 pa2,bf16x8 pa3){
  #pragma unroll
  for(int d0=0;d0<4;++d0){s16x4 lo[4],hi[4];
    #pragma unroll
    for(int ks=0;ks<4;++ks){
      asm volatile("ds_read_b64_tr_b16 %0,%1 offset:%c2":"=&v"(lo[ks]):"v"(vb),"i"(d0*4096+ks*1024):"memory");
      asm volatile("ds_read_b64_tr_b16 %0,%1 offset:%c2":"=&v"(hi[ks]):"v"(vb),"i"(d0*4096+ks*1024+512):"memory");}
    asm volatile("s_waitcnt lgkmcnt(0)":::"memory");SBAR();
    #define PK(k) (bf16x8){lo[k][0],lo[k][1],lo[k][2],lo[k][3],hi[k][0],hi[k][1],hi[k][2],hi[k][3]}
    o[d0]=__builtin_amdgcn_mfma_f32_32x32x16_bf16(pa0,PK(0),o[d0],0,0,0);
    o[d0]=__builtin_amdgcn_mfma_f32_32x32x16_bf16(pa1,PK(1),o[d0],0,0,0);
    o[d0]=__builtin_amdgcn_mfma_f32_32x32x16_bf16(pa2,PK(2),o[d0],0,0,0);
    o[d0]=__builtin_amdgcn_mfma_f32_32x32x16_bf16(pa3,PK(3),o[d0],0,0,0);
    #undef PK
  }
}

#ifndef ATTN_STORE16
#define ATTN_STORE16(p,v) (*(u32x4*)(p)=(v))
#endif
template<int THRL> __device__ __forceinline__ void attn_unit(int b,int qb,const bf16*Q,const bf16*__restrict__ K,const bf16*__restrict__ V,bf16*O,char*shm){
  const int tid=opqv((int)threadIdx.x),lane=tid&63,r32=lane&31,hi=lane>>5; const int wid=__builtin_amdgcn_readfirstlane(tid>>6);
  const long rowbase=(long)b*SEQ; const int q0=qb*QB;
  const bf16*Qw=Q+(rowbase+q0+wid*QBLK)*DM;
  const bf16*Kh=K+rowbase*DM,*Vh=V+rowbase*DM;
  const unsigned lds0=(unsigned)(uintptr_t)shm;
  float*wsf=(float*)(shm+LDS_WS)+wid*64;
  const bf16*ksrc=Kh+(long)lane*DM+wid*8;
  const bf16*vsrc=Vh+(long)(16*(wid&3)+(lane>>2))*DM+(wid>>2)*32+(lane&3)*8;
  const unsigned kdst=lds0+LDS_K+wid*1024, vdst=lds0+LDS_V+wid*1024;
  #define DMA_K(t,slot) glds16(ksrc+(long)(t)*KVBLK*DM,(unsigned)__builtin_amdgcn_readfirstlane(kdst+(slot)))
  #define DMA_V(t,slot) do{ glds16(vsrc+(long)(t)*KVBLK*DM,(unsigned)__builtin_amdgcn_readfirstlane(vdst+2*(slot))); glds16(vsrc+(long)(t)*KVBLK*DM+64,(unsigned)__builtin_amdgcn_readfirstlane(vdst+2*(slot)+8192)); }while(0)
  const int vb0=(int)(lds0+LDS_V)+((lane>>4)&1)*32+(lane&3)*8+(4*hi+((lane&15)>>2))*64;
  const char*Kbase=shm+LDS_K; bf16x8 kf[8];
  const lds_cptr shm3=(lds_cptr)shm; const lds_cptr kp0=shm3+LDS_K+hi*1024+r32*16; const lds_cptr vp0=shm3+LDS_V+((lane>>4)&1)*32+(lane&3)*8+(4*hi+((lane&15)>>2))*64;
  const int NT=(q0+QB)/KVBLK;
  DMA_K(0,0);DMA_V(0,0);DMA_K(1,SLOTB);
  bf16x8 qr[4];
  #pragma unroll
  for(int d0=0;d0<4;++d0)qr[d0]=*reinterpret_cast<const bf16x8*>(&Qw[(long)r32*DM+d0*16+hi*8]);
  float mhat=0.f,l_reg=0.f;f32x16 o[4];o[0]=f32x16{};o[1]=f32x16{};o[2]=f32x16{};o[3]=f32x16{};
  #define CMASK(P0,P1,t) do{int jb_=(t)-(NT-4); if(jb_>=0)cmask(P0,P1,jb_,wid);}while(0)
  bool resc=false;
  #define START(P0,P1) do{ mhat=rowmax(P0,P1); resc=false; \
    _Pragma("unroll") for(int r=0;r<16;++r)P0[r]=__builtin_amdgcn_exp2f(P0[r]-mhat); }while(0)
  #define RESC() do{ if(resc){ asm volatile("s_waitcnt lgkmcnt(0)":::"memory"); \
      _Pragma("unroll") for(int d_=0;d_<4;++d_) _Pragma("unroll") for(int r=0;r<16;++r)o[d_][r]*=wsf[crow(r,hi)]; } }while(0)
  f32x16 pA0,pA1,pB0,pB1;
  int sl_prev=0,sl_cur=0,sl_next=SLOTB;
  #define ROT() do{sl_prev=sl_cur;sl_cur=sl_next;sl_next=(sl_next==(NSLOT-1)*SLOTB)?0:sl_next+SLOTB;}while(0)
  DMA_K(2,2*SLOTB);
  WAIT_BAR(4);
  qkt(pA0,pA1,Kbase,qr,r32,hi);asm volatile("s_nop 15\n\ts_nop 7":"+v"(pA0),"+v"(pA1));CMASK(pA0,pA1,0);
  START(pA0,pA1);
  _Pragma("unroll") for(int r=0;r<16;++r)pA1[r]=__builtin_amdgcn_exp2f(pA1[r]-mhat);
  WAIT_BAR(0);
  DMA_K(3,0);DMA_V(1,SLOTB);
  ROT();
  kload8(kf,kp0+sl_cur);
  WAIT_BAR(3);
  s16x4 vlo[8],vhi[8]; u32x4 pw0,pw1,pw2,pw3;
  #define PKW(P,B) cvtpk_s(P[B],P[B+1])
  #define PAF(k) __builtin_bit_cast(bf16x8,pw##k)
  #define VFR(i) (bf16x8){vlo[i][0],vlo[i][1],vlo[i][2],vlo[i][3],vhi[i][0],vhi[i][1],vhi[i][2],vhi[i][3]}
  #define PIN(x) asm volatile("":"+v"(x))
  #define MX3(a,b,c) __builtin_fmaxf(__builtin_fmaxf((a),(b)),(c))
  #define GAPA(MF,A0,A1,A2,A3,W0,W1,PW) do{ MF; sacc+=A0; sacc+=A1; sacc+=A2; sacc+=A3; PIN(sacc); W0; W1; PIN(PW); SBAR(); }while(0)
  #define EX(v) __builtin_amdgcn_exp2f((v)-mhat)
  #define GAPB(MF,X,B) do{ MF; X[B]=EX(X[B]); X[B+1]=EX(X[B+1]); X[B+2]=EX(X[B+2]); X[B+3]=EX(X[B+3]); PIN(X); SBAR(); }while(0)
  #define VRD(i) do{ vlo[i]=vtr(vp_+(((i)>>2)*4096+((i)&3)*1024)); vhi[i]=vtr(vp_+(((i)>>2)*4096+((i)&3)*1024+512)); }while(0)
  #define VRD2(i) do{ vlo[i]=vtr(vp_+((((i)>>2)+2)*4096+((i)&3)*1024)); vhi[i]=vtr(vp_+((((i)>>2)+2)*4096+((i)&3)*1024+512)); SBAR(); }while(0)
  #define GAPC(MF) do{ MF; SBAR(); }while(0)
  #define KRD(G,j) do{ if(G){ kload2(kf,kp0+sl_next,j); SBAR(); } }while(0)
  #define STEP(C0,C1,P0,P1,t,GK,GV,GL) do{ SBAR(); \
    const lds_cptr vp_=vp0+2*sl_prev; \
    VRD(0); SBAR(); float sacc=(P0[0]+P0[1]); \
    GAPA(C0=__builtin_amdgcn_mfma_f32_32x32x16_bf16(kf[0],qr[0],f32x16{},0,0,0), P0[2],P0[3],P0[4],P0[5],     pw0[0]=PKW(P0,0), pw0[1]=PKW(P0,2), pw0); \
    VRD(4); SBAR(); GAPA(C1=__builtin_amdgcn_mfma_f32_32x32x16_bf16(kf[1],qr[0],f32x16{},0,0,0), P0[6],P0[7],P0[8],P0[9],     pw0[2]=PKW(P0,4), pw0[3]=PKW(P0,6), pw0); \
    VRD(1); SBAR(); GAPA(C0=__builtin_amdgcn_mfma_f32_32x32x16_bf16(kf[2],qr[1],C0,0,0,0),   P0[10],P0[11],P0[12],P0[13], pw1[0]=PKW(P0,8), pw1[1]=PKW(P0,10), pw1); \
    VRD(5); SBAR(); GAPA(C1=__builtin_amdgcn_mfma_f32_32x32x16_bf16(kf[3],qr[1],C1,0,0,0),   P0[14],P0[15],P1[0],P1[1],   pw1[2]=PKW(P0,12),pw1[3]=PKW(P0,14), pw1); \
    VRD(2); SBAR(); GAPA(C0=__builtin_amdgcn_mfma_f32_32x32x16_bf16(kf[4],qr[2],C0,0,0,0),   P1[2],P1[3],P1[4],P1[5],     pw2[0]=PKW(P1,0), pw2[1]=PKW(P1,2), pw2); \
    VRD(6); SBAR(); GAPA(C1=__builtin_amdgcn_mfma_f32_32x32x16_bf16(kf[5],qr[2],C1,0,0,0),   P1[6],P1[7],P1[8],P1[9],     pw2[2]=PKW(P1,4), pw2[3]=PKW(P1,6), pw2); \
    VRD(3); SBAR(); GAPA(C0=__builtin_amdgcn_mfma_f32_32x32x16_bf16(kf[6],qr[3],C0,0,0,0),   P1[10],P1[11],P1[12],P1[13], pw3[0]=PKW(P1,8), pw3[1]=PKW(P1,10), pw3); \
    VRD(7); SBAR(); GAPA(C1=__builtin_amdgcn_mfma_f32_32x32x16_bf16(kf[7],qr[3],C1,0,0,0),   P1[14],P1[15],0.f,0.f,       pw3[2]=PKW(P1,12),pw3[3]=PKW(P1,14), pw3); \
    l_reg+=sacc; \
    if(GK){DMA_K((t)+3,sl_cur);} if(GV){DMA_V((t)+1,sl_next);} \
    CMASK(C0,C1,t); \
    { float a=MX3(C0[0],C0[1],C1[0]),b=MX3(C0[2],C0[3],C1[1]); a=MX3(a,C1[2],C1[3]); \
      _Pragma("unroll") for(int r=4;r<16;r+=4){a=MX3(a,C0[r],C0[r+1]);b=MX3(b,C0[r+2],C0[r+3]);a=MX3(a,C1[r],C1[r+1]);b=MX3(b,C1[r+2],C1[r+3]);} \
      float rm=__builtin_fmaxf(a,b); { auto rr=__builtin_amdgcn_permlane32_swap(__float_as_uint(rm),__float_as_uint(rm),false,false); rm=__builtin_fmaxf(__uint_as_float(rr[0]),__uint_as_float(rr[1])); } \
      resc=false; rm-=mhat;                                                            \
      if(__builtin_expect(__any(rm>(float)THRL),0)){ const float dl=__builtin_fmaxf(rm,0.f); mhat+=dl; \
        const float f=__builtin_amdgcn_exp2f(-dl); l_reg*=f; if(hi==0)wsf[r32]=f; resc=true; } } \
    SBAR(); \
    GAPB(o[0]=__builtin_amdgcn_mfma_f32_32x32x16_bf16(PAF(0),VFR(0),o[0],0,0,0), C0,0);  VRD2(0); \
    GAPB(o[1]=__builtin_amdgcn_mfma_f32_32x32x16_bf16(PAF(0),VFR(4),o[1],0,0,0), C0,4);  VRD2(4); \
    GAPB(o[0]=__builtin_amdgcn_mfma_f32_32x32x16_bf16(PAF(1),VFR(1),o[0],0,0,0), C0,8);  VRD2(1); \
    GAPB(o[1]=__builtin_amdgcn_mfma_f32_32x32x16_bf16(PAF(1),VFR(5),o[1],0,0,0), C0,12); VRD2(5); \
    GAPB(o[0]=__builtin_amdgcn_mfma_f32_32x32x16_bf16(PAF(2),VFR(2),o[0],0,0,0), C1,0);  VRD2(2); \
    GAPB(o[1]=__builtin_amdgcn_mfma_f32_32x32x16_bf16(PAF(2),VFR(6),o[1],0,0,0), C1,4);  VRD2(6); \
    GAPB(o[0]=__builtin_amdgcn_mfma_f32_32x32x16_bf16(PAF(3),VFR(3),o[0],0,0,0), C1,8);  VRD2(3); \
    GAPB(o[1]=__builtin_amdgcn_mfma_f32_32x32x16_bf16(PAF(3),VFR(7),o[1],0,0,0), C1,12); VRD2(7); \
      \
    GAPC(o[2]=__builtin_amdgcn_mfma_f32_32x32x16_bf16(PAF(0),VFR(0),o[2],0,0,0)); \
    GAPC(o[3]=__builtin_amdgcn_mfma_f32_32x32x16_bf16(PAF(0),VFR(4),o[3],0,0,0)); \
    KRD(GL,0); GAPC(o[2]=__builtin_amdgcn_mfma_f32_32x32x16_bf16(PAF(1),VFR(1),o[2],0,0,0)); \
    KRD(GL,1); GAPC(o[3]=__builtin_amdgcn_mfma_f32_32x32x16_bf16(PAF(1),VFR(5),o[3],0,0,0)); \
    KRD(GL,2); GAPC(o[2]=__builtin_amdgcn_mfma_f32_32x32x16_bf16(PAF(2),VFR(2),o[2],0,0,0)); \
    KRD(GL,3); GAPC(o[3]=__builtin_amdgcn_mfma_f32_32x32x16_bf16(PAF(2),VFR(6),o[3],0,0,0)); \
    GAPC(o[2]=__builtin_amdgcn_mfma_f32_32x32x16_bf16(PAF(3),VFR(3),o[2],0,0,0)); \
    GAPC(o[3]=__builtin_amdgcn_mfma_f32_32x32x16_bf16(PAF(3),VFR(7),o[3],0,0,0)); \
    }while(0)
  int t=1;
  #undef CMASK
  #define CMASK(P0,P1,t) do{}while(0)
  for(;t+5<NT;t+=2){
    STEP(pB0,pB1,pA0,pA1,t,true,true,true);     WAIT_BAR(3); RESC(); ROT();
    STEP(pA0,pA1,pB0,pB1,t+1,true,true,true);   WAIT_BAR(3); RESC(); ROT();
  }
  #undef CMASK
  #define CMASK(P0,P1,t) do{int jb_=(t)-(NT-4); if(jb_>=0)cmask(P0,P1,jb_,wid);}while(0)
  #define ENDW(tt) do{ if((tt)+3<NT){WAIT_BAR(3);} else if((tt)+2<NT){WAIT_BAR(2);} else {WAIT_BAR(0);} }while(0)
  for(;t+1<NT;t+=2){
    STEP(pB0,pB1,pA0,pA1,t,(t+3<NT),(t+1<NT),(t+1<NT));       ENDW(t);   RESC(); ROT();
    STEP(pA0,pA1,pB0,pB1,t+1,(t+4<NT),(t+2<NT),(t+2<NT));     ENDW(t+1); RESC(); ROT();
  }
  STEP(pB0,pB1,pA0,pA1,NT-1,false,false,false); RESC();
  { float sacc=pB0[0]+pB0[1]; _Pragma("unroll") for(int r=2;r<16;++r)sacc+=pB0[r]; _Pragma("unroll") for(int r=0;r<16;++r)sacc+=pB1[r]; l_reg+=sacc;
    pw0=(u32x4){PKW(pB0,0),PKW(pB0,2),PKW(pB0,4),PKW(pB0,6)};pw1=(u32x4){PKW(pB0,8),PKW(pB0,10),PKW(pB0,12),PKW(pB0,14)};pw2=(u32x4){PKW(pB1,0),PKW(pB1,2),PKW(pB1,4),PKW(pB1,6)};pw3=(u32x4){PKW(pB1,8),PKW(pB1,10),PKW(pB1,12),PKW(pB1,14)};
    SBAR(); pv(o,vb0+2*sl_cur,PAF(0),PAF(1),PAF(2),PAF(3)); }
  #undef PKW
  #undef PAF
  #undef VFR
  #undef PIN
  #undef MX3
  #undef GAPA
  #undef GAPB
  #undef EX
  #undef VRD
  #undef VRD2
  #undef GAPC
  #undef KRD
  #undef STEP
  #undef ENDW
  {auto rr=__builtin_amdgcn_permlane32_swap(__float_as_uint(l_reg),__float_as_uint(l_reg),false,false);l_reg=__uint_as_float(rr[0])+__uint_as_float(rr[1]);}
  if(hi==0)wsf[32+r32]=l_reg;asm volatile("s_waitcnt lgkmcnt(0)":::"memory");
  float rli[16];
  #pragma unroll
  for(int r=0;r<16;++r)rli[r]=__builtin_amdgcn_rcpf(wsf[32+crow(r,hi)]);
  bf16*Ow=O+(rowbase+q0+wid*QBLK)*DMO;
  { bf16*stg=(bf16*)(shm+LDS_OST)+wid*4096;
    #pragma unroll
    for(int r=0;r<16;++r){const int orow=crow(r,hi);
      #pragma unroll
      for(int d0=0;d0<4;++d0)stg[orow*128+d0*32+r32]=__float2bfloat16(o[d0][r]*rli[r]);}
    asm volatile("s_waitcnt lgkmcnt(0)":::"memory");
    #pragma unroll
    for(int i=0;i<8;++i){const int row=i*4+(lane>>4),ch=lane&15; const u32x4 v=*(const u32x4*)(stg+row*128+ch*8); ATTN_STORE16(Ow+(long)row*DMO+ch*8,v);} }
  asm volatile("s_waitcnt lgkmcnt(0)\n\ts_barrier":::"memory");
  #undef DMA_K
  #undef DMA_V
  #undef CMASK
  #undef START
  #undef RESC
  #undef ROT
}
constexpr int ATTN_LDS_BYTES=LDS_BYTES;
#undef SBAR
#undef WAIT_BAR
}


constexpr int NB = 8, SEQ = 4096, T = NB * SEQ, D = 1024, DEPTH = 4;
constexpr int ZW = 2048, GWD = 3072, NCAT = ZW + GWD;
constexpr int ZQ = 256, ZK = 768, ZV = 1280, ZC = 1792;
constexpr int NEXP = 32, FF = 512, MAXSLOT = 2 * T + NEXP * 256;
constexpr float NORM_EPS = 1e-6f;
constexpr int NWAVES = 8;
constexpr int PH_PER_LAYER = 11, N_PHASES = 1 + DEPTH * PH_PER_LAYER + 1;

constexpr size_t MiB = 1u << 20;
constexpr size_t WS_CTL = 0, CTL_ZERO_BYTES = 1 * MiB;
constexpr size_t WS_MOD = 1 * MiB;
constexpr size_t WS_LAM = WS_MOD + (size_t)DEPTH * NB * 6144 * 4;
constexpr size_t WS_ROPE_C = 2 * MiB, WS_ROPE_S = 6 * MiB;
constexpr size_t WS_SSM = 10 * MiB;
constexpr size_t SSM_L_BYTES = 8192 + 8192 + 65536;
constexpr size_t WS_RWT = 11 * MiB;
constexpr size_t WS_TOKE = 12 * MiB, WS_TOKW = WS_TOKE + 256 * 1024, WS_TOKL = WS_TOKW + 256 * 1024, WS_TOKS = WS_TOKL + 256 * 1024;
constexpr size_t WS_WGBASE = 13 * MiB, WS_TILEE = WS_WGBASE + 64 * 1024;
constexpr size_t WS_ROWMAP = WS_WGBASE + 128 * 1024;
constexpr size_t WS_E = 14 * MiB, WS_CIN = 18 * MiB;
constexpr size_t WS_WCAT = 24 * MiB;
constexpr size_t WS_WMIX = 64 * MiB;
constexpr size_t WS_WO = 72 * MiB;
constexpr size_t WS_WGLU = 80 * MiB;
constexpr size_t WS_W13 = 82 * MiB;
constexpr size_t WS_W2 = 146 * MiB;
constexpr size_t WS_H = 178 * MiB;
constexpr size_t WS_Z = 242 * MiB;
constexpr size_t WS_G = 370 * MiB;
constexpr size_t WS_O0 = 562 * MiB, WS_O1 = 626 * MiB;
constexpr size_t WS_AMIX = 690 * MiB;
constexpr size_t WS_MIXED = 754 * MiB;
constexpr size_t WS_AG = 242 * MiB;
constexpr size_t WS_ACT = 386 * MiB;
constexpr size_t WS_Y = 458 * MiB;
constexpr size_t WS_XB = 818 * MiB;
constexpr size_t WS_END = 882 * MiB;
static_assert(WS_AG + (size_t)MAXSLOT * 1024 * 2 <= WS_ACT && WS_ACT + (size_t)MAXSLOT * 512 * 2 <= WS_Y && WS_Y + (size_t)MAXSLOT * 1024 * 2 <= WS_AMIX, "moe overlay map");
constexpr int CW_BAR = 4096;
constexpr int CW_CNT = 16384;

constexpr int RING_OFF = 0, RING_BYTES = 159744;
constexpr int LDSCTL_OFF = RING_BYTES, MISC_OFF = LDSCTL_OFF + 320;
constexpr int LDS_BYTES = 163840;

#define GAS __attribute__((address_space(1)))
#define LAS __attribute__((address_space(3)))
typedef unsigned short bf16;
typedef unsigned v4u __attribute__((ext_vector_type(4)));
typedef unsigned v2u __attribute__((ext_vector_type(2)));
typedef float f32x4 __attribute__((ext_vector_type(4)));
typedef float f32x2 __attribute__((ext_vector_type(2)));
typedef short bf16x8 __attribute__((ext_vector_type(8)));
typedef GAS unsigned gu32;
#define RLX_AGENT __ATOMIC_RELAXED, __HIP_MEMORY_SCOPE_AGENT
#define LDS_WAIT() asm volatile("s_waitcnt lgkmcnt(0)" ::: "memory")
#define VM_WAIT() asm volatile("s_waitcnt vmcnt(0)" ::: "memory")
__device__ __forceinline__ unsigned f2bf(float f) { unsigned u = __builtin_bit_cast(unsigned, f); return (u + 0x7fffu + ((u >> 16) & 1u)) >> 16; }
__device__ __forceinline__ unsigned pk2(float lo, float hi) { return f2bf(lo) | (f2bf(hi) << 16); }
__device__ __forceinline__ float bf2f(unsigned short b) { return __uint_as_float(((unsigned)b) << 16); }
__device__ __forceinline__ float bflo(unsigned w) { return __uint_as_float(w << 16); }
__device__ __forceinline__ float bfhi(unsigned w) { return __uint_as_float(w & 0xffff0000u); }

#define XB_TMO      128
#define XB_XCNT(j)  (256  + 64 * (j))
#define XB_XSUB(j)  (1280 + 64 * (j))
#define XB_XGEN(j)  (2304 + 64 * (j))
#define XB_TOP      3328
#define XB_TOPGEN   3392
#define XCD_BAR_WORDS 3456
#define XB_SPIN_CAP (1u << 18)

__device__ __forceinline__ unsigned xb_ld(unsigned* p)              { return __hip_atomic_load(p, __ATOMIC_RELAXED, __HIP_MEMORY_SCOPE_AGENT); }
__device__ __forceinline__ unsigned xb_add(unsigned* p, unsigned v) { return __hip_atomic_fetch_add(p, v, __ATOMIC_RELAXED, __HIP_MEMORY_SCOPE_AGENT); }
__device__ __forceinline__ unsigned xb_xcc_id() { return (unsigned)__builtin_amdgcn_s_getreg((3 << 11) | 20) & 0xFu; }
#define XB_SPIN(cond, bar) do { unsigned _sp = 0; while (cond) { __builtin_amdgcn_s_sleep(1); \
    if ((++_sp & 255u) == 0u) { if (xb_ld(&(bar)[XB_TMO])) break; if (_sp > XB_SPIN_CAP) { atomicAdd(&(bar)[XB_TMO], 1u); break; } } } } while (0)

struct XcdBarrier {
    unsigned* bar; unsigned x;
    volatile LAS unsigned* st;
};

__device__ __forceinline__ XcdBarrier xcd_barrier_post(unsigned* bar, volatile LAS unsigned* st) {
    XcdBarrier b; b.bar = bar; b.x = xb_xcc_id(); b.st = st;
    if (threadIdx.x == 0) (void)xb_add(&bar[XB_XCNT(b.x)], 1u);
    return b;
}
__device__ __forceinline__ void xcd_barrier_complete(unsigned* bar, unsigned x, unsigned& nloc, unsigned& nx) {
    const unsigned G = gridDim.x * gridDim.y * gridDim.z;
    unsigned sum, cnt, mine, sp = 0u;
    for (;;) {
        sum = 0u; cnt = 0u; mine = 0u;
#pragma unroll
        for (unsigned j = 0; j < 16; ++j) { const unsigned c = xb_ld(&bar[XB_XCNT(j)]); sum += c; cnt += (c > 0u) ? 1u : 0u; mine = (j == x) ? c : mine; }
        if (sum == G) break;
        __builtin_amdgcn_s_sleep(1);
        if ((++sp & 255u) == 0u) { if (xb_ld(&bar[XB_TMO])) break; if (sp > XB_SPIN_CAP) { atomicAdd(&bar[XB_TMO], 1u); break; } }
    }
    nloc = mine > 0u ? mine : 1u; nx = cnt > 0u ? cnt : 1u;
}

__device__ __forceinline__ void xcd_barrier(const XcdBarrier& b) {
    asm volatile("s_waitcnt vmcnt(0)" ::: "memory");
    __syncthreads();
    if (threadIdx.x == 0) {
        unsigned* bar = b.bar;
        __builtin_amdgcn_s_waitcnt(0);
        unsigned nloc = b.st[0], nx = b.st[1];
        if (nloc == 0u) { xcd_barrier_complete(bar, b.x, nloc, nx); b.st[0] = nloc; b.st[1] = nx; }
        const unsigned old = xb_add(&bar[XB_XSUB(b.x)], 1u);
        const unsigned gen = old / nloc;
        if (old + 1u == (gen + 1u) * nloc) {
            __builtin_amdgcn_fence(__ATOMIC_RELEASE, "agent");
            asm volatile("s_waitcnt vmcnt(0)" ::: "memory");
            const unsigned og = xb_add(&bar[XB_TOP], 1u);
            const unsigned tg = og / nx;
            if (og + 1u == (tg + 1u) * nx) xb_add(&bar[XB_TOPGEN], 1u);
            else XB_SPIN(xb_ld(&bar[XB_TOPGEN]) == tg, bar);
            __builtin_amdgcn_fence(__ATOMIC_ACQUIRE, "agent");
            xb_add(&bar[XB_XGEN(b.x)], 1u);
            asm volatile("s_waitcnt vmcnt(0)" ::: "memory");
        } else {
            XB_SPIN(xb_ld(&bar[XB_XGEN(b.x)]) == gen, bar);
            __builtin_amdgcn_fence(__ATOMIC_ACQUIRE, "agent");
            asm volatile("s_waitcnt vmcnt(0)" ::: "memory");
        }
    }
    __syncthreads();
}


typedef float f32x2_cv __attribute__((ext_vector_type(2))); typedef __bf16 bf16x2_cv __attribute__((ext_vector_type(2)));
__device__ __forceinline__ unsigned cvtpk(float lo, float hi) { f32x2_cv v = {lo, hi}; bf16x2_cv b = __builtin_convertvector(v, bf16x2_cv); return __builtin_bit_cast(unsigned, b); }
#define DPPF(v, ctrl) __builtin_bit_cast(float, __builtin_amdgcn_update_dpp(0, __builtin_bit_cast(int, (v)), (ctrl), 0xF, 0xF, false))
__device__ __forceinline__ float wave_sum(float v) {
    v += DPPF(v, 0xB1);
    v += DPPF(v, 0x4E);
    v += DPPF(v, 0x141);
    v += DPPF(v, 0x140);
    { auto rr = __builtin_amdgcn_permlane16_swap(__float_as_uint(v), __float_as_uint(v), false, false); v = __uint_as_float(rr[0]) + __uint_as_float(rr[1]); }
    { auto rr = __builtin_amdgcn_permlane32_swap(__float_as_uint(v), __float_as_uint(v), false, false); v = __uint_as_float(rr[0]) + __uint_as_float(rr[1]); }
    return v;
}
__device__ __forceinline__ void wave_sum4(float& a0, float& a1, float& a2, float& a3, int lane) {
    const bool o1 = (lane & 1) != 0, o2 = (lane & 2) != 0;
    float u = o1 ? a1 : a0; const float us = o1 ? a0 : a1; u += DPPF(us, 0xB1);
    float w = o1 ? a3 : a2; const float wsn = o1 ? a2 : a3; w += DPPF(wsn, 0xB1);
    float p = o2 ? w : u; const float ps = o2 ? u : w; p += DPPF(ps, 0x4E);
    p += DPPF(p, 0x124);
    p += DPPF(p, 0x128);
    { auto rr = __builtin_amdgcn_permlane16_swap(__float_as_uint(p), __float_as_uint(p), false, false); p = __uint_as_float(rr[0]) + __uint_as_float(rr[1]); }
    { auto rr = __builtin_amdgcn_permlane32_swap(__float_as_uint(p), __float_as_uint(p), false, false); p = __uint_as_float(rr[0]) + __uint_as_float(rr[1]); }
    a0 = DPPF(p, 0x00); a1 = DPPF(p, 0x55); a2 = DPPF(p, 0xAA); a3 = DPPF(p, 0xFF);
}
__device__ __forceinline__ float wave_max(float v) {
#pragma unroll
    for (int o = 1; o < 64; o <<= 1) v = fmaxf(v, __shfl_xor(v, o));
    return v;
}
__device__ __forceinline__ float sigmoidf_(float x) { return __builtin_amdgcn_rcpf(1.0f + __builtin_amdgcn_exp2f(-1.4426950408889634f * x)); }
__device__ __forceinline__ float gelu_tanh(float x) { const float u = 0.7978845608028654f * (x + 0.044715f * x * x * x); return x * __builtin_amdgcn_rcpf(1.0f + __builtin_amdgcn_exp2f(-2.8853900817779268f * u)); }

__device__ __forceinline__ void tr_item(const float* __restrict__ W, int N, int k0, int n0, bf16* WT, int ldt, int drow0, int dcol0, LAS float* scr, int lane, bool mode16 = false) {
#pragma unroll 1
    for (int hb = 0; hb < 2; ++hb) { f32x4 v[4];
#pragma unroll
      for (int i = 0; i < 4; ++i) v[i] = __builtin_nontemporal_load((const f32x4*)(W + (size_t)(k0 + 8 * (4 * hb + i) + (lane >> 3)) * N + n0 + 4 * (lane & 7)));
#pragma unroll
      for (int i = 0; i < 4; ++i) { LAS float* d = scr + (8 * (4 * hb + i) + (lane >> 3)) * 33 + 4 * (lane & 7); d[0] = v[i].x; d[1] = v[i].y; d[2] = v[i].z; d[3] = v[i].w; } }
    LDS_WAIT(); asm volatile("" ::: "memory");
    const int c = lane & 7;
#pragma unroll
    for (int j = 0; j < 4; ++j) { const int n = (lane >> 3) + 8 * j; const LAS float* s = scr + (8 * c) * 33 + n;
        v4u o; o.x = pk2(s[0 * 33], s[1 * 33]); o.y = pk2(s[2 * 33], s[3 * 33]); o.z = pk2(s[4 * 33], s[5 * 33]); o.w = pk2(s[6 * 33], s[7 * 33]);
        const int c0 = n0 & 255, drow = mode16 ? drow0 + 128 * (j & 1) + 32 * (c0 >> 6) + 16 * ((c0 >> 5) & 1) + 8 * (j >> 1) + (lane >> 3) : drow0 + n;
        *(v4u*)(WT + (size_t)drow * ldt + dcol0 + 8 * c) = o; }
    LDS_WAIT(); asm volatile("" ::: "memory");
}

struct Args { const void* in[40]; float* out; unsigned char* ws; int ph_lo, ph_hi; };

enum { I_X = 0, I_C, I_POS, I_ADAW, I_ADAB, I_N1G, I_WIN, I_POOLW, I_POOLS, I_QNG, I_KNG, I_LQ1, I_LK1, I_LQ2, I_LK2, I_SUBLN,
       I_LAMRE, I_LAMIM, I_LOGDT, I_BRE, I_BIM, I_CRE, I_CIM, I_DSKIP, I_GLUW, I_GLUB, I_PROJA, I_PROJB, I_PROJC, I_GATEW, I_GATEB,
       I_WOUT, I_N2G, I_RGW, I_RGB, I_REW, I_REB, I_W1, I_W3, I_W2 };

__device__ __forceinline__ float lambda_init_of(int l) { return l == 0 ? 0.2f : (l == 1 ? 0.35550906759096926f : (l == 2 ? 0.47071302343358413f : 0.5560582041556841f)); }

__device__ __forceinline__ void prologue_phase(const Args& a, LAS unsigned char* lds) {
    const int z = opq(); (void)z;
    const int tid = opqv((int)threadIdx.x), lane = tid & 63, wave = __builtin_amdgcn_readfirstlane(tid >> 6); const int G = (int)gridDim.x, bx = (int)blockIdx.x;
    const int vcu = (G % 8 == 0) ? (bx % 8) * (G / 8) + bx / 8 : bx; const int gw = vcu * NWAVES + wave, NGW = G * NWAVES, gt = vcu * 512 + tid;
    (void)lane; (void)gw; (void)NGW; (void)gt; (void)bx;
    unsigned char* ws = (a.ws + z);
    const int NGT = G * 512;
    LAS float* scr = (LAS float*)(lds + RING_OFF + wave * 16384);
    {
        constexpr int I_IN = 16 * 64, I_GT = 16 * 96, I_PB = 8 * 32, I_PC = 4 * 32, I_WOI = 16 * 32, I_GL = 4 * 8;
        constexpr int PER_L = I_IN + I_GT + I_PB + I_PC + I_WOI + I_GL;
        for (int it = gw; it < DEPTH * PER_L; it += NGW) {
            const int l = it / PER_L; int r = it - l * PER_L;
            bf16* wcat = (bf16*)(ws + WS_WCAT) + (size_t)l * NCAT * 1024;
            bf16* wmix = (bf16*)(ws + WS_WMIX) + (size_t)l * 1024 * 1024;
            if (r < I_IN) { const int kb = r / 64, nb = r % 64; int drow = nb * 32;
                { const int lg = nb & 7, p = 4 * (lg & 1) + (lg >> 1); drow = (nb & ~7) * 32 + 32 * p; }
                tr_item((const float*)a.in[z + I_WIN] + (size_t)l * 1024 * ZW, ZW, kb * 64, nb * 32, wcat, 1024, drow, kb * 64, scr, lane); continue; } r -= I_IN;
            if (r < I_GT) { const int kb = r / 96, nb = r % 96;
                tr_item((const float*)a.in[z + I_GATEW] + (size_t)l * 1024 * GWD, GWD, kb * 64, nb * 32, wcat, 1024, ZW + (nb & ~7) * 32, kb * 64, scr, lane, true); continue; } r -= I_GT;
            if (r < I_PB) { const int kb = r / 32, nb = r % 32; tr_item((const float*)a.in[z + I_PROJB] + (size_t)l * 512 * 1024, 1024, kb * 64, nb * 32, wmix, 1024, (nb & ~7) * 32, 256 + kb * 64, scr, lane, true); continue; } r -= I_PB;
            if (r < I_PC) { const int kb = r / 32, nb = r % 32; tr_item((const float*)a.in[z + I_PROJC] + (size_t)l * 256 * 1024, 1024, kb * 64, nb * 32, wmix, 1024, (nb & ~7) * 32, 768 + kb * 64, scr, lane, true); continue; } r -= I_PC;
            if (r < I_WOI) { const int kb = r / 32, nb = r % 32; tr_item((const float*)a.in[z + I_WOUT] + (size_t)l * 1024 * 1024, 1024, kb * 64, nb * 32, (bf16*)(ws + WS_WO) + (size_t)l * 1024 * 1024, 1024, nb * 32, kb * 64, scr, lane); continue; } r -= I_WOI;
            { const int kb = r / 8, nb = r % 8; tr_item((const float*)a.in[z + I_GLUW] + (size_t)l * 256 * 256, 256, kb * 64, nb * 32, (bf16*)(ws + WS_WGLU) + (size_t)l * 256 * 256, 256, nb * 32, kb * 64, scr, lane); }
        }
    }
    for (int idx = gt; idx < DEPTH * 256 * 1024; idx += NGT) {
        const int l = idx >> 18, k = (idx >> 10) & 255, n = idx & 1023, g = k >> 6, c = k & 63;
        const float* pw = (const float*)a.in[z + I_POOLW] + ((size_t)(l * 4 + g) * 64 + c) * 64;
        const float* ps = (const float*)a.in[z + I_POOLS] + l * 256 + g * 64;
        const float* pa = (const float*)a.in[z + I_PROJA] + ((size_t)l * 256 + g * 64) * 1024 + n;
        float s = 0.f;
        for (int d = 0; d < 64; ++d) s += pw[d] * ps[d] * pa[(size_t)d * 1024];
        const int cc = n & 255, prow = (n & ~255) + 128 * ((cc >> 3) & 1) + 32 * (cc >> 6) + 8 * ((cc >> 4) & 3) + (cc & 7);
        ((bf16*)(ws + WS_WMIX))[((size_t)l * 1024 + prow) * 1024 + k] = (bf16)f2bf(s);
    }
    for (int idx = gt; idx < T * 32; idx += NGT) {
        const int t = idx >> 5, i = idx & 31;
        const float inv = powf(10000.0f, -(float)(2 * i) / 64.0f);
        const float ang = (float)((const int*)a.in[z + I_POS])[t] * inv;
        ((float*)(ws + WS_ROPE_C))[idx] = cosf(ang); ((float*)(ws + WS_ROPE_S))[idx] = sinf(ang);
    }
    for (int idx = gt; idx < DEPTH * 16 * 64; idx += NGT) {
        const int l = idx >> 10, g = (idx >> 6) & 15, p = idx & 63;
        const float lr = ((const float*)a.in[z + I_LAMRE])[idx], li = ((const float*)a.in[z + I_LAMIM])[idx];
        const float dt = expf(((const float*)a.in[z + I_LOGDT])[l * 16 + g]);
        const float mag = expf(lr * dt), ar = mag * cosf(li * dt), ai = mag * sinf(li * dt);
        const float nr = ar - 1.0f, ni = ai, den = lr * lr + li * li;
        const float kr = (nr * lr + ni * li) / den, ki = (ni * lr - nr * li) / den;
        unsigned char* base = ws + WS_SSM + (size_t)l * SSM_L_BYTES;
        ((f32x2*)base)[g * 64 + p] = (f32x2){ar, ai};
        float pr = ar, pi = ai;
#pragma unroll
        for (int q = 0; q < 6; ++q) { const float tr = pr * pr - pi * pi, ti = 2.0f * pr * pi; pr = tr; pi = ti; }
        ((f32x2*)(base + 8192))[g * 64 + p] = (f32x2){pr, pi};
        const float* br = (const float*)a.in[z + I_BRE] + (size_t)idx * 16; const float* bi = (const float*)a.in[z + I_BIM] + (size_t)idx * 16;
        bf16* bbh = (bf16*)(base + 16384) + (size_t)g * 128 * 16;
        for (int ch = 0; ch < 16; ++ch) { bbh[p * 16 + ch] = (bf16)f2bf(kr * br[ch] - ki * bi[ch]); bbh[(64 + p) * 16 + ch] = (bf16)f2bf(kr * bi[ch] + ki * br[ch]); }
    }
    if (gt < DEPTH) {
        const int l = gt; float s1 = 0.f, s2 = 0.f;
        for (int d = 0; d < 64; ++d) { s1 += ((const float*)a.in[z + I_LQ1])[l * 64 + d] * ((const float*)a.in[z + I_LK1])[l * 64 + d]; s2 += ((const float*)a.in[z + I_LQ2])[l * 64 + d] * ((const float*)a.in[z + I_LK2])[l * 64 + d]; }
        ((float*)(ws + WS_LAM))[l] = expf(s1) - expf(s2) + lambda_init_of(l);
    }
    for (int idx = gt; idx < DEPTH * 36 * 1024; idx += NGT) {
        const int l = idx / (36 * 1024), r = idx - l * 36 * 1024, j = r >> 10, k = r & 1023;
        ((float*)(ws + WS_RWT))[idx] = j < 4 ? ((const float*)a.in[z + I_RGW])[((size_t)l * 1024 + k) * 4 + j] : ((const float*)a.in[z + I_REW])[((size_t)l * 1024 + k) * 32 + (j - 4)];
    }
    {
        LAS float* cact = (LAS float*)(lds + RING_OFF);
        __syncthreads();
        for (int i = tid; i < NB * 1024; i += 512) { const float cv = ((const float*)a.in[z + I_C])[i]; cact[i] = cv * sigmoidf_(cv); }
        __syncthreads();
        const int c4 = tid & 15, kp = tid >> 4;
        for (int u = vcu; u < DEPTH * 96; u += G) {
            const int l = u / 96, cg = u % 96;
            const float* w = (const float*)a.in[z + I_ADAW] + (size_t)l * 1024 * 6144 + cg * 64 + 4 * c4;
            f32x4 acc[NB];
#pragma unroll
            for (int b = 0; b < NB; ++b) acc[b] = (f32x4){0.f, 0.f, 0.f, 0.f};
#pragma unroll 4
            for (int k = kp * 32; k < kp * 32 + 32; ++k) { const f32x4 wv = __builtin_nontemporal_load((const f32x4*)(w + (size_t)k * 6144));
#pragma unroll
                for (int b = 0; b < NB; ++b) acc[b] = acc[b] + wv * cact[b * 1024 + k]; }
            LAS float* red = (LAS float*)(lds + RING_OFF + 32768);
#pragma unroll
            for (int b = 0; b < NB; ++b) *(LAS f32x4*)(red + (kp * NB + b) * 64 + 4 * c4) = acc[b];
            __syncthreads();
            { const int b = tid >> 6, col = tid & 63; float s = 0.f;
#pragma unroll
              for (int q = 0; q < 32; ++q) s += red[(q * NB + b) * 64 + col];
              ((float*)(ws + WS_MOD))[((size_t)l * NB + b) * 6144 + cg * 64 + col] = s + ((const float*)a.in[z + I_ADAB])[l * 6144 + cg * 64 + col]; }
            __syncthreads();
        }
    }
}

__device__ __forceinline__ void moe_weights_phase(const Args& a, int l, LAS unsigned char* lds) {
    const int z = opq(); (void)z;
    const int tid = opqv((int)threadIdx.x), lane = tid & 63, wave = __builtin_amdgcn_readfirstlane(tid >> 6); const int G = (int)gridDim.x, bx = (int)blockIdx.x;
    const int vcu = (G % 8 == 0) ? (bx % 8) * (G / 8) + bx / 8 : bx; const int gw = vcu * NWAVES + wave, NGW = G * NWAVES, gt = vcu * 512 + tid;
    (void)lane; (void)gw; (void)NGW; (void)gt; (void)bx;
    LAS float* scr = (LAS float*)(lds + RING_OFF + wave * 16384);
    bf16* w13 = (bf16*)((a.ws + z) + WS_W13); bf16* w2t = (bf16*)((a.ws + z) + WS_W2);
    for (int it = gw; it < NEXP * 768; it += NGW) {
        const int e = it / 768; int r = it - e * 768;
        if (r < 512) { const int which = r >> 8; r &= 255; const int kb = r >> 4, nb = r & 15, n0 = nb * 32;
            const float* W = (const float*)a.in[which ? I_W3 : I_W1] + ((size_t)l * NEXP + e) * 1024 * 512;
            tr_item(W, 512, kb * 64, n0, w13, 1024, e * 1024 + (n0 >> 7) * 256 + which * 128 + (n0 & 127), kb * 64, scr, lane); }
        else { r -= 512; const int kb = r >> 5, nb = r & 31;
            const float* W = (const float*)a.in[z + I_W2] + ((size_t)l * NEXP + e) * 512 * 1024;
            tr_item(W, 1024, kb * 64, nb * 32, w2t, 512, e * 1024 + nb * 32, kb * 64, scr, lane); }
    }
}

__device__ __forceinline__ void norm1_phase(const Args& a, int l, bool first, bool do_norm) {
    const int z = opq(); (void)z;
    const int tid = opqv((int)threadIdx.x), lane = tid & 63, wave = __builtin_amdgcn_readfirstlane(tid >> 6); const int G = (int)gridDim.x, bx = (int)blockIdx.x;
    const int vcu = (G % 8 == 0) ? (bx % 8) * (G / 8) + bx / 8 : bx; const int gw = vcu * NWAVES + wave, NGW = G * NWAVES;
    unsigned char* ws = (a.ws + z);
    const float* mod = (const float*)(ws + WS_MOD);
    const bf16* Y = (const bf16*)(ws + WS_Y);
    const int* tok_slot = (const int*)(ws + WS_TOKS); const float* tok_w = (const float*)(ws + WS_TOKW);
    bf16* H = (bf16*)(ws + WS_H);
    const float* xin = (const float*)a.in[z + I_X]; bf16* XB = (bf16*)(ws + WS_XB);
#pragma unroll 1
    for (int blk = gw; blk < T / 16; blk += NGW) {
        const int mB = blk * 16, b = mB >> 12;
        f32x4 g2v[4], gnv[4], shv[4], scv[4];
        if (!first) { const float* g2 = mod + ((size_t)(l - 1) * NB + b) * 6144 + 5 * 1024;
#pragma unroll
            for (int q = 0; q < 4; ++q) g2v[q] = *(const f32x4*)(g2 + 512 * (q >> 1) + 8 * lane + 4 * (q & 1)); }
        if (do_norm) { const float* mrow = mod + ((size_t)l * NB + b) * 6144; const float* gn = (const float*)a.in[z + I_N1G] + l * D;
#pragma unroll
            for (int q = 0; q < 4; ++q) { const int co = 512 * (q >> 1) + 8 * lane + 4 * (q & 1); gnv[q] = *(const f32x4*)(gn + co); shv[q] = *(const f32x4*)(mrow + co); scv[q] = *(const f32x4*)(mrow + 1024 + co) + 1.0f; } }
#pragma unroll 1
        for (int r2 = 0; r2 < 16; r2 += 2) {
            f32x4 v[2][4]; v4u yp[2][2], yq[2][2]; float w0[2], w1[2];
            if (first) {
#pragma unroll
            for (int r = 0; r < 2; ++r) { const float* xr = xin + (size_t)(mB + r2 + r) * D;
#pragma unroll
                for (int q = 0; q < 4; ++q) v[r][q] = __builtin_nontemporal_load((const f32x4*)(xr + 512 * (q >> 1) + 8 * lane + 4 * (q & 1))); }
            } else {
#pragma unroll
            for (int r = 0; r < 2; ++r)
#pragma unroll
                for (int hq = 0; hq < 2; ++hq) { const v4u xw = __builtin_nontemporal_load((const v4u*)(XB + (size_t)(mB + r2 + r) * D + 512 * hq + 8 * lane));
                    v[r][2 * hq] = (f32x4){bflo(xw.x), bfhi(xw.x), bflo(xw.y), bfhi(xw.y)}; v[r][2 * hq + 1] = (f32x4){bflo(xw.z), bfhi(xw.z), bflo(xw.w), bfhi(xw.w)}; }
            }
            if (!first) {
#pragma unroll
                for (int r = 0; r < 2; ++r) { const int m = mB + r2 + r; const int s0 = tok_slot[2 * m], s1 = tok_slot[2 * m + 1]; w0[r] = tok_w[2 * m]; w1[r] = tok_w[2 * m + 1];
#pragma unroll
                    for (int hq = 0; hq < 2; ++hq) { yp[r][hq] = __builtin_nontemporal_load((const v4u*)(Y + (size_t)s0 * D + 512 * hq + 8 * lane)); yq[r][hq] = __builtin_nontemporal_load((const v4u*)(Y + (size_t)s1 * D + 512 * hq + 8 * lane)); } }
#pragma unroll
                for (int r = 0; r < 2; ++r)
#pragma unroll
                    for (int hq = 0; hq < 2; ++hq) { const v4u p = yp[r][hq], q = yq[r][hq]; f32x4& va = v[r][2 * hq]; f32x4& vb = v[r][2 * hq + 1]; const f32x4 ga = g2v[2 * hq], gb = g2v[2 * hq + 1];
                        va.x += ga.x * (w0[r] * bflo(p.x) + w1[r] * bflo(q.x)); va.y += ga.y * (w0[r] * bfhi(p.x) + w1[r] * bfhi(q.x));
                        va.z += ga.z * (w0[r] * bflo(p.y) + w1[r] * bflo(q.y)); va.w += ga.w * (w0[r] * bfhi(p.y) + w1[r] * bfhi(q.y));
                        vb.x += gb.x * (w0[r] * bflo(p.z) + w1[r] * bflo(q.z)); vb.y += gb.y * (w0[r] * bfhi(p.z) + w1[r] * bfhi(q.z));
                        vb.z += gb.z * (w0[r] * bflo(p.w) + w1[r] * bflo(q.w)); vb.w += gb.w * (w0[r] * bfhi(p.w) + w1[r] * bfhi(q.w)); }
            }
            if (!first && do_norm) {
#pragma unroll
            for (int r = 0; r < 2; ++r)
#pragma unroll
                for (int hq = 0; hq < 2; ++hq) { const f32x4 xa = v[r][2 * hq], xb = v[r][2 * hq + 1];
                    v4u o; o.x = pk2(xa.x, xa.y); o.y = pk2(xa.z, xa.w); o.z = pk2(xb.x, xb.y); o.w = pk2(xb.z, xb.w);
                    *(v4u*)(XB + (size_t)(mB + r2 + r) * D + 512 * hq + 8 * lane) = o; } }
            if (!do_norm) {
#pragma unroll
            for (int r = 0; r < 2; ++r) { float* xo = (a.out + z) + (size_t)(mB + r2 + r) * D;
#pragma unroll
                for (int q = 0; q < 4; ++q) __builtin_nontemporal_store(v[r][q], (f32x4*)(xo + 512 * (q >> 1) + 8 * lane + 4 * (q & 1))); } }
            if (do_norm) {
#pragma unroll
                for (int r = 0; r < 2; ++r) {
                    float ss = 0.f;
#pragma unroll
                    for (int q = 0; q < 4; ++q) ss += (v[r][q].x * v[r][q].x + v[r][q].y * v[r][q].y) + (v[r][q].z * v[r][q].z + v[r][q].w * v[r][q].w);
                    const float rr = rsqrtf(wave_sum(ss) * (1.0f / D) + NORM_EPS);
#pragma unroll
                    for (int hq = 0; hq < 2; ++hq) { const f32x4 ha = (v[r][2 * hq] * rr * gnv[2 * hq]) * scv[2 * hq] + shv[2 * hq], hb = (v[r][2 * hq + 1] * rr * gnv[2 * hq + 1]) * scv[2 * hq + 1] + shv[2 * hq + 1];
                        v4u o; o.x = pk2(ha.x, ha.y); o.y = pk2(ha.z, ha.w); o.z = pk2(hb.x, hb.y); o.w = pk2(hb.z, hb.w);
                        *(v4u*)(H + (size_t)(mB + r2 + r) * D + 512 * hq + 8 * lane) = o; }
                }
            }
        }
    }
}

__device__ __forceinline__ void qkprep_phase(const Args& a, int l) {
    const int z = opq(); (void)z;
    const int tid = opqv((int)threadIdx.x), lane = tid & 63, wave = __builtin_amdgcn_readfirstlane(tid >> 6); const int G = (int)gridDim.x, bx = (int)blockIdx.x;
    const int vcu = (G % 8 == 0) ? (bx % 8) * (G / 8) + bx / 8 : bx; const int gw = vcu * NWAVES + wave, NGW = G * NWAVES;
    unsigned char* ws = (a.ws + z); bf16* Z = (bf16*)(ws + WS_Z);
    const int sq = lane & 3; const bool isq = lane < 32, lowhalf = sq < 2;
    float gn[16];
    { const float* gp = (const float*)a.in[z + (isq ? I_QNG : I_KNG)] + l * 64 + 16 * sq;
#pragma unroll
      for (int i = 0; i < 16; ++i) gn[i] = gp[i] * (isq ? (ATTN_FAST ? 0.125f * 1.4426950408889634f : 0.125f) : 1.0f); }
    const float* RC = (const float*)(ws + WS_ROPE_C) + 16 * (sq & 1); const float* RS = (const float*)(ws + WS_ROPE_S) + 16 * (sq & 1);
#pragma unroll 1
    for (int m2 = gw; m2 < T / 2; m2 += NGW) {
        v4u w[2][2]; f32x4 cs[2][4], sn[2][4];
#pragma unroll
        for (int r = 0; r < 2; ++r) { const int m = m2 * 2 + r; const v4u* zp = (const v4u*)(Z + (size_t)m * ZW + ZQ) + 2 * lane; w[r][0] = zp[0]; w[r][1] = zp[1];
#pragma unroll
            for (int q = 0; q < 4; ++q) { cs[r][q] = *((const f32x4*)(RC + (size_t)m * 32) + q); sn[r][q] = *((const f32x4*)(RS + (size_t)m * 32) + q); } }
#pragma unroll
        for (int r = 0; r < 2; ++r) { const int m = m2 * 2 + r;
            float x[16];
#pragma unroll
            for (int q = 0; q < 2; ++q) { x[8 * q + 0] = bflo(w[r][q].x); x[8 * q + 1] = bfhi(w[r][q].x); x[8 * q + 2] = bflo(w[r][q].y); x[8 * q + 3] = bfhi(w[r][q].y);
                x[8 * q + 4] = bflo(w[r][q].z); x[8 * q + 5] = bfhi(w[r][q].z); x[8 * q + 6] = bflo(w[r][q].w); x[8 * q + 7] = bfhi(w[r][q].w); }
            float ss = 0.f;
#pragma unroll
            for (int i = 0; i < 16; ++i) ss += x[i] * x[i];
            ss += DPPF(ss, 0xB1); ss += DPPF(ss, 0x4E);
            const float rr = rsqrtf(ss * (1.0f / 64.0f) + NORM_EPS);
            unsigned ow[8];
#pragma unroll
            for (int i = 0; i < 16; i += 2) {
                const float y0 = x[i] * rr * gn[i], y1 = x[i + 1] * rr * gn[i + 1];
                const float p0 = DPPF(y0, 0x4E), p1 = DPPF(y1, 0x4E);
                const float c0 = cs[r][i >> 2][i & 3], c1 = cs[r][i >> 2][(i & 3) + 1], s0 = sn[r][i >> 2][i & 3], s1 = sn[r][i >> 2][(i & 3) + 1];
                const float o0 = lowhalf ? y0 * c0 - p0 * s0 : y0 * c0 + p0 * s0, o1 = lowhalf ? y1 * c1 - p1 * s1 : y1 * c1 + p1 * s1;
                ow[i >> 1] = pk2(o0, o1); }
            v4u* zo = (v4u*)(Z + (size_t)m * ZW + ZQ) + 2 * lane;
            zo[0] = (v4u){ow[0], ow[1], ow[2], ow[3]}; zo[1] = (v4u){ow[4], ow[5], ow[6], ow[7]}; }
    }
}

__device__ __forceinline__ void pool_phase(const Args& a, LAS unsigned char* lds) {
    const int z = opq(); (void)z;
    const int tid = opqv((int)threadIdx.x), lane = tid & 63, wave = __builtin_amdgcn_readfirstlane(tid >> 6); const int G = (int)gridDim.x, bx = (int)blockIdx.x;
    const int vcu = (G % 8 == 0) ? (bx % 8) * (G / 8) + bx / 8 : bx; const int gw = vcu * NWAVES + wave, NGW = G * NWAVES, gt = vcu * 512 + tid;
    (void)lane; (void)gw; (void)NGW; (void)gt; (void)bx;
    const bf16* Z = (const bf16*)((a.ws + z) + WS_Z); bf16* AM = (bf16*)((a.ws + z) + WS_AMIX);
    LAS float* U = (LAS float*)(lds + RING_OFF);
    for (int tl = vcu; tl < T / 64; tl += G) {
        const int m0 = tl * 64, s0 = m0 & (SEQ - 1);
        __syncthreads();
        for (int idx = tid; idx < 80 * 32; idx += 512) { const int r = idx >> 5, c8 = (idx & 31) * 8; const int sp = s0 - 16 + r;
            v4u w = (v4u){0u, 0u, 0u, 0u};
            if (sp >= 0) w = *(const v4u*)(Z + (size_t)(m0 - 16 + r) * ZW + c8);
            LAS float* u = U + r * 256 + c8;
            u[0] = bflo(w.x); u[1] = bfhi(w.x); u[2] = bflo(w.y); u[3] = bfhi(w.y); u[4] = bflo(w.z); u[5] = bfhi(w.z); u[6] = bflo(w.w); u[7] = bfhi(w.w); }
        __syncthreads();
        const int cc = tid & 31, tg = tid >> 5, g = cc >> 3, w = 2 << g;
        const LAS f32x4* U4 = (const LAS f32x4*)U + cc * 2;
        f32x4 sa = (f32x4){0.f, 0.f, 0.f, 0.f}, sb = sa; const int t0 = tg * 4;
        for (int q = 0; q < w; ++q) { sa = sa + U4[(16 + t0 - q) * 64]; sb = sb + U4[(16 + t0 - q) * 64 + 1]; }
#pragma unroll
        for (int i = 0; i < 4; ++i) { const int t = t0 + i;
            if (i > 0) { sa = sa + U4[(16 + t) * 64] - U4[(16 + t - w) * 64]; sb = sb + U4[(16 + t) * 64 + 1] - U4[(16 + t - w) * 64 + 1]; }
            const int cnt = (s0 + t + 1) < w ? (s0 + t + 1) : w; const float rc = 1.0f / (float)cnt;
            const f32x4 ua = U4[(16 + t) * 64], ub = U4[(16 + t) * 64 + 1], oa = sa * rc - ua, ob = sb * rc - ub;
            v4u o; o.x = pk2(oa.x, oa.y); o.y = pk2(oa.z, oa.w); o.z = pk2(ob.x, ob.y); o.w = pk2(ob.z, ob.w);
            *(v4u*)(AM + (size_t)(m0 + t) * D + cc * 8) = o; }
    }
}

__device__ __forceinline__ void load_u16(const bf16* up, float (&u)[16]) {
    const v4u w0 = *(const v4u*)up, w1 = *(const v4u*)(up + 8);
    u[0] = bflo(w0.x); u[1] = bfhi(w0.x); u[2] = bflo(w0.y); u[3] = bfhi(w0.y); u[4] = bflo(w0.z); u[5] = bfhi(w0.z); u[6] = bflo(w0.w); u[7] = bfhi(w0.w);
    u[8] = bflo(w1.x); u[9] = bfhi(w1.x); u[10] = bflo(w1.y); u[11] = bfhi(w1.y); u[12] = bflo(w1.z); u[13] = bfhi(w1.z); u[14] = bflo(w1.w); u[15] = bfhi(w1.w);
}
constexpr int BUP = 68;
typedef short bf16x4_t __attribute__((ext_vector_type(4)));
struct BqT { bf16x4_t v[8]; };
__device__ __forceinline__ bf16x4_t ssm_ld_a(const bf16* zrow0  , int fr, int fq) { return *(const bf16x4_t*)(zrow0 + (size_t)fr * ZW + fq * 4); }
__device__ __forceinline__ void ssm_bu16(const bf16x4_t Af, const bf16x4_t (&Bq)[8], LAS unsigned* BU, int fr, int fq) {
#pragma unroll
    for (int cb = 0; cb < 4; ++cb) { const pg8::f32x4 are = __builtin_amdgcn_mfma_f32_16x16x16bf16_1k(Af, Bq[cb], (pg8::f32x4){0.f, 0.f, 0.f, 0.f}, 0, 0, 0);
        const pg8::f32x4 aim = __builtin_amdgcn_mfma_f32_16x16x16bf16_1k(Af, Bq[cb + 4], (pg8::f32x4){0.f, 0.f, 0.f, 0.f}, 0, 0, 0);
#pragma unroll
        for (int j = 0; j < 4; ++j) BU[(fq * 4 + j) * BUP + cb * 16 + fr] = cvtpk(are[j], aim[j]); }
}
__device__ __forceinline__ void ssm_load_bq(const unsigned char* sb, int g, bf16x4_t (&Bq)[8], int fr, int fq) {
    const bf16* bbh = (const bf16*)(sb + 16384) + (size_t)g * 128 * 16;
#pragma unroll
    for (int cb = 0; cb < 8; ++cb) Bq[cb] = *(const bf16x4_t*)(bbh + (cb * 16 + fr) * 16 + fq * 4);
}
__device__ __forceinline__ void ssm_local_phase(const Args& a, int l, LAS unsigned char* lds) {
    const int z = opq(); (void)z;
    const int tid = opqv((int)threadIdx.x), lane = tid & 63, wave = __builtin_amdgcn_readfirstlane(tid >> 6); const int G = (int)gridDim.x, bx = (int)blockIdx.x;
    const int vcu = (G % 8 == 0) ? (bx % 8) * (G / 8) + bx / 8 : bx; const int gw = vcu * NWAVES + wave, NGW = G * NWAVES;
    unsigned char* ws = (a.ws + z); const bf16* Z = (const bf16*)(ws + WS_Z);
    const unsigned char* sb = ws + WS_SSM + (size_t)l * SSM_L_BYTES;
    f32x2* SL = (f32x2*)(ws + WS_E);
    f32x2* EB = (f32x2*)(ws + WS_CIN);
    LAS unsigned* BU = (LAS unsigned*)(lds + RING_OFF) + wave * (16 * BUP);
    const int fr = lane & 15, fq = lane >> 4;
    __syncthreads();
    for (int w = gw; w < NB * 16 * 16; w += NGW) {
        const int g = w & 15, blk = (w >> 4) & 15, b = w >> 8;
        const f32x2 av = ((const f32x2*)sb)[g * 64 + lane];
        bf16x4_t Bq[8]; ssm_load_bq(sb, g, Bq, fr, fq);
        float xr = 0.f, xi = 0.f;
#pragma unroll 1
        for (int j = 0; j < 4; ++j) { const int c = blk * 4 + j;
            SL[((size_t)(b * 64 + c) * 16 + g) * 64 + lane] = (f32x2){xr, xi};
            const bf16* up = Z + (size_t)(b * SEQ + c * 64) * ZW + ZC + g * 16;
            bf16x4_t Af4[4];
#pragma unroll
            for (int tb = 0; tb < 4; ++tb) Af4[tb] = ssm_ld_a(up + (size_t)(tb * 16) * ZW, fr, fq);
#pragma unroll
            for (int tb = 0; tb < 4; ++tb) {
                ssm_bu16(Af4[tb], Bq, BU, fr, fq);
                LDS_WAIT(); asm volatile("" ::: "memory");
#pragma unroll
                for (int tt = 0; tt < 16; ++tt) { const unsigned bw = BU[tt * BUP + lane];
                    const float nr = av.x * xr - av.y * xi + bflo(bw), ni = av.x * xi + av.y * xr + bfhi(bw); xr = nr; xi = ni; }
                LDS_WAIT(); asm volatile("" ::: "memory");
            } }
        EB[((size_t)(b * 16 + blk) * 16 + g) * 64 + lane] = (f32x2){xr, xi};
    }
}
__device__ __forceinline__ void ssm_carry_phase(const Args& a, int l) {
    const int z = opq(); (void)z;
    const int tid = opqv((int)threadIdx.x), lane = tid & 63, wave = __builtin_amdgcn_readfirstlane(tid >> 6); const int G = (int)gridDim.x, bx = (int)blockIdx.x;
    const int vcu = (G % 8 == 0) ? (bx % 8) * (G / 8) + bx / 8 : bx; const int gw = vcu * NWAVES + wave, NGW = G * NWAVES, gt = vcu * 512 + tid;
    (void)lane; (void)gw; (void)NGW; (void)gt; (void)bx;
    if (gt >= NB * 16 * 64) return;
    unsigned char* ws = (a.ws + z); const unsigned char* sb = ws + WS_SSM + (size_t)l * SSM_L_BYTES;
    const int p = gt & 63, g = (gt >> 6) & 15, b = gt >> 10;
    const f32x2 a64 = ((const f32x2*)(sb + 8192))[g * 64 + p];
    const f32x2* E = (const f32x2*)(ws + WS_E); f32x2* CI = (f32x2*)(ws + WS_CIN);
    float sr = 0.f, si = 0.f;
    for (int c = 0; c < 64; ++c) { const size_t o = ((size_t)((b * 64 + c) * 16 + g)) * 64 + p;
        CI[o] = (f32x2){sr, si}; const f32x2 e = E[o];
        const float nr = a64.x * sr - a64.y * si + e.x, ni = a64.x * si + a64.y * sr + e.y; sr = nr; si = ni; }
}

__device__ __forceinline__ void ssm_final_phase(const Args& a, int l, LAS unsigned char* lds) {
    const int z = opq(); (void)z;
    const int tid = opqv((int)threadIdx.x), lane = tid & 63, wave = __builtin_amdgcn_readfirstlane(tid >> 6); const int G = (int)gridDim.x, bx = (int)blockIdx.x;
    const int vcu = (G % 8 == 0) ? (bx % 8) * (G / 8) + bx / 8 : bx; const int gw = vcu * NWAVES + wave, NGW = G * NWAVES, gt = vcu * 512 + tid;
    (void)lane; (void)gw; (void)NGW; (void)gt; (void)bx;
    unsigned char* ws = (a.ws + z); const bf16* Z = (const bf16*)(ws + WS_Z); bf16* AM = (bf16*)(ws + WS_AMIX);
    const unsigned char* sb = ws + WS_SSM + (size_t)l * SSM_L_BYTES;
    constexpr int YP = 264, XP = 136;
    LAS bf16* Ypre = (LAS bf16*)(lds + RING_OFF);
    LAS bf16* Xb = (LAS bf16*)(lds + RING_OFF + 34816) + wave * (16 * XP);
    LAS unsigned* BU = (LAS unsigned*)(lds + RING_OFF + 69632) + wave * (16 * BUP);
    constexpr int UP = 264; LAS bf16* Ut = (LAS bf16*)(lds + RING_OFF + 104448);
    const int fr = lane & 15, fq = lane >> 4;
    f32x2 av[2], a64[2]; float dsk[2]; bf16x4_t Bq[2][8]; bf16x8 Bf[2][4];
#pragma unroll
    for (int gi = 0; gi < 2; ++gi) { const int g = wave * 2 + gi;
        av[gi] = ((const f32x2*)sb)[g * 64 + lane]; a64[gi] = ((const f32x2*)(sb + 8192))[g * 64 + lane]; dsk[gi] = ((const float*)a.in[z + I_DSKIP])[l * 256 + g * 16 + fr];
        ssm_load_bq(sb, g, Bq[gi], fr, fq);
        const float* cre = (const float*)a.in[z + I_CRE] + ((size_t)(l * 16 + g) * 16 + fr) * 64 + fq * 4; const float* cim = (const float*)a.in[z + I_CIM] + ((size_t)(l * 16 + g) * 16 + fr) * 64 + fq * 4;
#pragma unroll
        for (int ks = 0; ks < 4; ++ks) { const f32x4 cr = *(const f32x4*)(cre + ks * 16), ci = *(const f32x4*)(cim + ks * 16);
#pragma unroll
            for (int q = 0; q < 4; ++q) { Bf[gi][ks][2 * q] = (short)f2bf(cr[q]); Bf[gi][ks][2 * q + 1] = (short)f2bf(-ci[q]); } } }
#pragma unroll 1
    for (int uu = vcu; uu < NB * 64; uu += G) {
        const int b = uu >> 6, c = (uu & 256) ? 63 - (uu & 63) : (uu & 63); const size_t m0 = (size_t)b * SEQ + c * 64;
        { const int row = tid >> 3, sg = tid & 7; const v4u* gp = (const v4u*)(Z + (m0 + row) * ZW + ZC + sg * 32); LAS v4u* lp = (LAS v4u*)(Ut + row * UP + sg * 32);
#pragma unroll
          for (int q = 0; q < 4; ++q) lp[q] = gp[q]; }
        float xr[2] = {0.f, 0.f}, xi[2] = {0.f, 0.f};
        for (int rp_ = 0; rp_ < REPN(15); ++rp_) { xr[0] = xr[1] = xi[0] = xi[1] = 0.f; const int blk = c >> 2, jc = c & 3;
          const f32x2* EBp = (const f32x2*)(ws + WS_CIN) + ((size_t)(b * 16) * 16 + wave * 2) * 64 + lane;
          f32x2 a256[2];
#pragma unroll
          for (int gi = 0; gi < 2; ++gi) { float pr = a64[gi].x, pi = a64[gi].y;
#pragma unroll
              for (int q = 0; q < 2; ++q) { const float tr = pr * pr - pi * pi, ti = 2.0f * pr * pi; pr = tr; pi = ti; }
              a256[gi] = (f32x2){pr, pi}; }
#pragma unroll 4
          for (int q = 0; q < blk; ++q) {
#pragma unroll
              for (int gi = 0; gi < 2; ++gi) { const f32x2 ev = EBp[(size_t)q * 1024 + gi * 64]; const float nr = a256[gi].x * xr[gi] - a256[gi].y * xi[gi] + ev.x, ni = a256[gi].x * xi[gi] + a256[gi].y * xr[gi] + ev.y; xr[gi] = nr; xi[gi] = ni; } }
#pragma unroll
          for (int gi = 0; gi < 2; ++gi) {
              for (int q = 0; q < jc; ++q) { const float nr = a64[gi].x * xr[gi] - a64[gi].y * xi[gi], ni = a64[gi].x * xi[gi] + a64[gi].y * xr[gi]; xr[gi] = nr; xi[gi] = ni; }
              const f32x2 sl = ((const f32x2*)(ws + WS_E))[((size_t)(b * 64 + c) * 16 + wave * 2 + gi) * 64 + lane]; xr[gi] += sl.x; xi[gi] += sl.y; } }
        __syncthreads();
        const float xr0s = xr[0], xi0s = xi[0], xr1s = xr[1], xi1s = xi[1];
#pragma unroll 1
        for (int rq_ = 0; rq_ < REPN(16); ++rq_) { xr[0] = xr0s; xi[0] = xi0s; xr[1] = xr1s; xi[1] = xi1s;
#pragma unroll
        for (int gi = 0; gi < 2; ++gi) {
            const int g = wave * 2 + gi;
#pragma unroll 1
            for (int tb = 0; tb < 4; ++tb) {
                ssm_bu16(*(const LAS bf16x4_t*)(Ut + (tb * 16 + fr) * UP + g * 16 + fq * 4), Bq[gi], BU, fr, fq);
                LDS_WAIT(); asm volatile("" ::: "memory");
                unsigned bw[16];
#pragma unroll
                for (int tt = 0; tt < 16; ++tt) bw[tt] = BU[tt * BUP + lane];
#pragma unroll
                for (int tt = 0; tt < 16; ++tt) {
                    const float nr = av[gi].x * xr[gi] - av[gi].y * xi[gi] + bflo(bw[tt]), ni = av[gi].x * xi[gi] + av[gi].y * xr[gi] + bfhi(bw[tt]); xr[gi] = nr; xi[gi] = ni;
                    ((LAS unsigned*)Xb)[tt * (XP / 2) + lane] = cvtpk(nr, ni); }
                LDS_WAIT(); asm volatile("" ::: "memory");
                pg8::f32x4 acc = {0.f, 0.f, 0.f, 0.f};
#pragma unroll
                for (int ks = 0; ks < 4; ++ks) { const bf16x8 Af = *(const LAS bf16x8*)(Xb + fr * XP + ks * 32 + fq * 8);
                    acc = __builtin_amdgcn_mfma_f32_16x16x32_bf16(Af, Bf[gi][ks], acc, 0, 0, 0); }
#pragma unroll
                for (int j = 0; j < 4; ++j) { const int t = tb * 16 + fq * 4 + j;
                    const float uu2 = bf2f(Ut[t * UP + g * 16 + fr]);
                    Ypre[t * YP + g * 16 + fr] = (bf16)f2bf(gelu_tanh(acc[j] + dsk[gi] * uu2)); }
                LDS_WAIT(); asm volatile("" ::: "memory");
            }
        }
        }
        __syncthreads();
#pragma unroll 1
        for (int rg_ = 0; rg_ < REPN(17); ++rg_)
        { pg8::f32x4 acc[4][2];
#pragma unroll
          for (int rb = 0; rb < 4; ++rb)
#pragma unroll
              for (int nb = 0; nb < 2; ++nb) acc[rb][nb] = (pg8::f32x4){0.f, 0.f, 0.f, 0.f};
          const bf16* wg = (const bf16*)(ws + WS_WGLU) + (size_t)l * 256 * 256;
#pragma unroll 2
          for (int ks = 0; ks < 8; ++ks) {
              bf16x8 Bw[2], Aw[4];
#pragma unroll
              for (int nb = 0; nb < 2; ++nb) Bw[nb] = *(const bf16x8*)(wg + (size_t)(wave * 32 + nb * 16 + fr) * 256 + ks * 32 + fq * 8);
#pragma unroll
              for (int rb = 0; rb < 4; ++rb) Aw[rb] = *(const LAS bf16x8*)(Ypre + (rb * 16 + fr) * YP + ks * 32 + fq * 8);
#pragma unroll
              for (int rb = 0; rb < 4; ++rb)
#pragma unroll
                  for (int nb = 0; nb < 2; ++nb) acc[rb][nb] = __builtin_amdgcn_mfma_f32_16x16x32_bf16(Aw[rb], Bw[nb], acc[rb][nb], 0, 0, 0);
          }
          LAS bf16* Yout = (LAS bf16*)(lds + RING_OFF + 69632);
#pragma unroll
          for (int nb = 0; nb < 2; ++nb) { const int n = wave * 32 + nb * 16 + fr; const float gb = ((const float*)a.in[z + I_GLUB])[l * 256 + n];
#pragma unroll
              for (int rb = 0; rb < 4; ++rb)
#pragma unroll
                  for (int j = 0; j < 4; ++j) { const int t = rb * 16 + fq * 4 + j;
                      const float yv = bf2f(Ypre[t * YP + n]);
                      Yout[t * YP + n] = (bf16)f2bf(yv * sigmoidf_(acc[rb][nb][j] + gb)); } }
          __syncthreads();
          { const int row = tid >> 3, seg = tid & 7; const LAS v4u* sp = (const LAS v4u*)(Yout + row * YP + seg * 32); v4u* dp = (v4u*)(AM + (m0 + row) * D + 768 + seg * 32);
#pragma unroll
            for (int q = 0; q < 4; ++q) dp[q] = sp[q]; }
        }
    }
}

__device__ __forceinline__ void attn_naive_unit(const Args& a, int b, int h, int mp, int cc, LAS unsigned char* lds, int tid, int lane, int wave) {
    const int z = opq();
    const bf16* Z = (const bf16*)((a.ws + z) + WS_Z);
    float* O = (float*)((a.ws + z) + (mp ? WS_O1 : WS_O0));
    const size_t m0 = (size_t)b * SEQ + cc * 64;
    const int qcol = ZQ + h * 128 + mp * 64, kcol = ZK + h * 128 + mp * 64, vcol = ZV + h * 128;
    LAS float* Qs = (LAS float*)(lds + RING_OFF);
    LAS unsigned* Vs = (LAS unsigned*)(lds + RING_OFF + 16384);
    LAS float* Ps = (LAS float*)(lds + RING_OFF + 32768) + wave * 512;
    __syncthreads();
    { const int r = tid >> 3, c8 = (tid & 7) * 8; const v4u w = *(const v4u*)(Z + (m0 + r) * ZW + qcol + c8); LAS float* q = Qs + r * 64 + c8;
      q[0] = bflo(w.x); q[1] = bfhi(w.x); q[2] = bflo(w.y); q[3] = bfhi(w.y); q[4] = bflo(w.z); q[5] = bfhi(w.z); q[6] = bflo(w.w); q[7] = bfhi(w.w); }
    float mrun[8], lrun[8], o0[8], o1[8];
#pragma unroll
    for (int i = 0; i < 8; ++i) { mrun[i] = -1e30f; lrun[i] = 0.f; o0[i] = 0.f; o1[i] = 0.f; }
    const size_t kb0 = (size_t)b * SEQ;
#pragma unroll 1
    for (int kt = 0; kt <= cc; ++kt) {
        __syncthreads();
        { const int key = tid >> 3, part = tid & 7; const bf16* vp = Z + (kb0 + kt * 64 + key) * ZW + vcol + part * 16;
          const v4u w0 = *(const v4u*)vp, w1 = *(const v4u*)(vp + 8); LAS v4u* d = (LAS v4u*)(Vs + key * 64 + part * 8); d[0] = w0; d[1] = w1; }
        float kf[64];
        { const bf16* kp = Z + (kb0 + kt * 64 + lane) * ZW + kcol;
#pragma unroll
          for (int q = 0; q < 8; ++q) { const v4u w = *(const v4u*)(kp + q * 8);
              kf[q * 8 + 0] = bflo(w.x); kf[q * 8 + 1] = bfhi(w.x); kf[q * 8 + 2] = bflo(w.y); kf[q * 8 + 3] = bfhi(w.y);
              kf[q * 8 + 4] = bflo(w.z); kf[q * 8 + 5] = bfhi(w.z); kf[q * 8 + 6] = bflo(w.w); kf[q * 8 + 7] = bfhi(w.w); } }
        __syncthreads();
#pragma unroll
        for (int i = 0; i < 8; ++i) {
            const LAS f32x4* qr = (const LAS f32x4*)(Qs + (wave * 8 + i) * 64);
            float s = 0.f;
#pragma unroll
            for (int d4 = 0; d4 < 16; ++d4) { const f32x4 q4 = qr[d4]; s += q4.x * kf[d4 * 4] + q4.y * kf[d4 * 4 + 1] + q4.z * kf[d4 * 4 + 2] + q4.w * kf[d4 * 4 + 3]; }
            const float mt = wave_max(s), mn = fmaxf(mrun[i], mt), al = __expf(mrun[i] - mn), p = __expf(s - mn);
            lrun[i] = lrun[i] * al + wave_sum(p); o0[i] *= al; o1[i] *= al; mrun[i] = mn;
            Ps[i * 64 + lane] = p;
        }
        LDS_WAIT(); asm volatile("" ::: "memory");
#pragma unroll 4
        for (int j4 = 0; j4 < 16; ++j4) {
            unsigned vw[4];
#pragma unroll
            for (int jj = 0; jj < 4; ++jj) vw[jj] = Vs[(j4 * 4 + jj) * 64 + lane];
#pragma unroll
            for (int i = 0; i < 8; ++i) { const f32x4 p4 = *(const LAS f32x4*)(Ps + i * 64 + j4 * 4);
                o0[i] += p4.x * bflo(vw[0]) + p4.y * bflo(vw[1]) + p4.z * bflo(vw[2]) + p4.w * bflo(vw[3]);
                o1[i] += p4.x * bfhi(vw[0]) + p4.y * bfhi(vw[1]) + p4.z * bfhi(vw[2]) + p4.w * bfhi(vw[3]); }
        }
    }
#pragma unroll
    for (int i = 0; i < 8; ++i) { const float rl = 1.0f / lrun[i];
        *(f32x2*)(O + (m0 + wave * 8 + i) * 512 + h * 128 + lane * 2) = (f32x2){o0[i] * rl, o1[i] * rl}; }
}
__device__ __forceinline__ void attn_naive_phase(const Args& a, LAS unsigned char* lds) {
    const int z = opq(); (void)z;
    const int tid = opqv((int)threadIdx.x), lane = tid & 63, wave = __builtin_amdgcn_readfirstlane(tid >> 6); const int G = (int)gridDim.x, bx = (int)blockIdx.x;
    const int vcu = (G % 8 == 0) ? (bx % 8) * (G / 8) + bx / 8 : bx; const int gw = vcu * NWAVES + wave, NGW = G * NWAVES, gt = vcu * 512 + tid;
    (void)lane; (void)gw; (void)NGW; (void)gt; (void)bx;
    for (int u = vcu; u < 2048; u += G) {
        const int bhm = u >> 5, j = u & 31, b = bhm >> 3, h = (bhm >> 1) & 3, mp = bhm & 1;
        attn_naive_unit(a, b, h, mp, j, lds, tid, lane, wave);
        attn_naive_unit(a, b, h, mp, 63 - j, lds, tid, lane, wave);
    }
}

__device__ __forceinline__ void attn_fast_phase(const Args& a, char* lds_generic) {
    const int z = opq();
    const int G = (int)gridDim.x, bx = (int)blockIdx.x; const int vcu = (G % 8 == 0) ? (bx % 8) * (G / 8) + bx / 8 : bx;
    const attn_body::bf16* Z = (const attn_body::bf16*)((a.ws + z) + WS_Z);
#pragma unroll 1
    for (int p = vcu; p < 1024; p += G) {
        const int stream = (p >> 8) * 32 + ((p & 255) >> 3), j = p & 7;
        const int b = stream >> 4, vh = stream & 15, h = vh >> 2, mp = (vh >> 1) & 1, vhalf = vh & 1;
        const attn_body::bf16* Q = Z + ZQ + h * 128 + mp * 64; const attn_body::bf16* K = Z + ZK + h * 128 + mp * 64; const attn_body::bf16* V = Z + ZV + h * 128 + vhalf * 64;
        attn_body::bf16* O = (attn_body::bf16*)((a.ws + z) + (mp ? WS_O1 : WS_O0)) + h * 128 + vhalf * 64;
#pragma unroll 1
        for (int k2 = 0; k2 < 2; ++k2) attn_body::attn_unit<8>(b, k2 ? 15 - j : j, Q, K, V, O, lds_generic);
    }
}

__device__ __forceinline__ void attn_v128_phase(const Args& a, char* lds_generic) {
    const int z = opq();
    const int G = (int)gridDim.x, bx = (int)blockIdx.x; const int vcu = (G % 8 == 0) ? (bx % 8) * (G / 8) + bx / 8 : bx;
    const attn128::bf16* Z = (const attn128::bf16*)((a.ws + z) + WS_Z);
#pragma unroll 1
    for (int p = vcu; p < 512; p += G) {
        const int stream = (p >> 8) * 32 + ((p & 255) >> 3), j = p & 7;
        const int b = stream >> 3, h = (stream >> 1) & 3, mp = stream & 1;
        const attn128::bf16* Q = Z + ZQ + h * 128 + mp * 64; const attn128::bf16* K = Z + ZK + h * 128 + mp * 64; const attn128::bf16* V = Z + ZV + h * 128;
        attn128::bf16* O = (attn128::bf16*)((a.ws + z) + (mp ? WS_O1 : WS_O0)) + h * 128;
#pragma unroll 1
        for (int k2 = 0; k2 < 2; ++k2) attn128::attn_unit<8>(b, k2 ? 15 - j : j, Q, K, V, O, lds_generic);
    }
}

__device__ __forceinline__ void attn_combine_phase(const Args& a, int l) {
    const int z = opq(); (void)z;
    const int tid = opqv((int)threadIdx.x), lane = tid & 63, wave = __builtin_amdgcn_readfirstlane(tid >> 6); const int G = (int)gridDim.x, bx = (int)blockIdx.x;
    const int vcu = (G % 8 == 0) ? (bx % 8) * (G / 8) + bx / 8 : bx; const int gw = vcu * NWAVES + wave, NGW = G * NWAVES;
    unsigned char* ws = (a.ws + z); const bf16* O0 = (const bf16*)(ws + WS_O0); const bf16* O1 = (const bf16*)(ws + WS_O1); bf16* AM = (bf16*)(ws + WS_AMIX);
    const float lam = ((const float*)(ws + WS_LAM))[l], post = 1.0f - lambda_init_of(l);
    float sg[8];
    { const float* sp = (const float*)a.in[z + I_SUBLN] + l * 128 + 8 * (lane & 15);
#pragma unroll
      for (int i = 0; i < 8; ++i) sg[i] = sp[i] * post; }
#pragma unroll 1
    for (int m4 = gw; m4 < T / 4; m4 += NGW) {
        v4u pw[4], qw[4];
#pragma unroll
        for (int r = 0; r < 4; ++r) { const size_t m = (size_t)m4 * 4 + r; pw[r] = __builtin_nontemporal_load((const v4u*)(O0 + m * 512) + lane); qw[r] = __builtin_nontemporal_load((const v4u*)(O1 + m * 512) + lane); }
#pragma unroll
        for (int r = 0; r < 4; ++r) { const size_t m = (size_t)m4 * 4 + r;
            float d[8];
            d[0] = bflo(pw[r].x) - lam * bflo(qw[r].x); d[1] = bfhi(pw[r].x) - lam * bfhi(qw[r].x); d[2] = bflo(pw[r].y) - lam * bflo(qw[r].y); d[3] = bfhi(pw[r].y) - lam * bfhi(qw[r].y);
            d[4] = bflo(pw[r].z) - lam * bflo(qw[r].z); d[5] = bfhi(pw[r].z) - lam * bfhi(qw[r].z); d[6] = bflo(pw[r].w) - lam * bflo(qw[r].w); d[7] = bfhi(pw[r].w) - lam * bfhi(qw[r].w);
            float ss = 0.f;
#pragma unroll
            for (int i = 0; i < 8; ++i) ss += d[i] * d[i];
            ss += DPPF(ss, 0xB1); ss += DPPF(ss, 0x4E); ss += DPPF(ss, 0x141); ss += DPPF(ss, 0x140);
            const float rr = rsqrtf(ss * (1.0f / 128.0f) + NORM_EPS);
            v4u o; o.x = pk2(d[0] * rr * sg[0], d[1] * rr * sg[1]); o.y = pk2(d[2] * rr * sg[2], d[3] * rr * sg[3]); o.z = pk2(d[4] * rr * sg[4], d[5] * rr * sg[5]); o.w = pk2(d[6] * rr * sg[6], d[7] * rr * sg[7]);
            *((v4u*)(AM + m * D + 256) + lane) = o; }
    }
}

__device__ __forceinline__ void norm2_router_phase(const Args& a, int l, LAS unsigned char* lds, bool do_cnt) {
    const int z = opq(); (void)z;
    const int tid = opqv((int)threadIdx.x), lane = tid & 63, wave = __builtin_amdgcn_readfirstlane(tid >> 6); const int G = (int)gridDim.x, bx = (int)blockIdx.x;
    const int vcu = (G % 8 == 0) ? (bx % 8) * (G / 8) + bx / 8 : bx; const int gw = vcu * NWAVES + wave, NGW = G * NWAVES;
    unsigned char* ws = (a.ws + z);
    const float* mod = (const float*)(ws + WS_MOD); bf16* H = (bf16*)(ws + WS_H);
    int* tok_e = (int*)(ws + WS_TOKE); float* tok_w = (float*)(ws + WS_TOKW); int* tok_l = (int*)(ws + WS_TOKL);
    LAS f32x4* RW4 = (LAS f32x4*)(lds + RING_OFF);
    LAS int* lcnt = (LAS int*)(lds + RING_OFF + 147456);
    LAS float* rbias = (LAS float*)(lds + RING_OFF + 147456 + 128);
    const bf16* XBp = (const bf16*)(ws + WS_XB);
    v4u nx[4][2];
#define P8_PREFETCH(row0) do { _Pragma("unroll") for (int r = 0; r < 4; ++r) { const v4u* xr_ = (const v4u*)(XBp + (size_t)((row0) + r) * D) + lane; nx[r][0] = __builtin_nontemporal_load(xr_); nx[r][1] = __builtin_nontemporal_load(xr_ + 64); } } while (0)
    int blk = gw;
    if (blk < T / 16) P8_PREFETCH(blk * 16);
    __syncthreads();
    { const f32x4* rwt = (const f32x4*)((const float*)(ws + WS_RWT) + (size_t)l * 36 * 1024);
      for (int i = tid; i < 36 * 256; i += 512) { const int q = (i >> 6) & 3; RW4[i] = rwt[(i & ~255) + 128 * (q >> 1) + 2 * (i & 63) + (q & 1)]; }
      if (tid < 32) lcnt[tid] = 0;
      if (tid < 36) rbias[tid] = tid < 4 ? ((const float*)a.in[z + I_RGB])[l * 4 + tid] : ((const float*)a.in[z + I_REB])[l * 32 + tid - 4]; }
    __syncthreads();
#pragma unroll 1
    for (; blk < T / 16; blk += NGW) {
      const float* mrow = mod + ((size_t)l * NB + ((blk * 16) >> 12)) * 6144;
      f32x4 gs_[4], shv_[4];
#pragma unroll
      for (int j = 0; j < 4; ++j) { const int c4 = 128 * (j >> 1) + 2 * lane + (j & 1);
          gs_[j] = *((const f32x4*)((const float*)a.in[z + I_N2G] + l * D) + c4) * (*((const f32x4*)(mrow + 4 * 1024) + c4) + 1.0f); shv_[j] = *((const f32x4*)(mrow + 3 * 1024) + c4); }
#pragma unroll 1
      for (int i4 = 0; i4 < 4; ++i4) {
        const int mb = blk * 16 + i4 * 4;
        f32x4 hv[4][4];
#pragma unroll
        for (int r = 0; r < 4; ++r)
#pragma unroll
            for (int hq = 0; hq < 2; ++hq) { const v4u xw = nx[r][hq];
                hv[r][2 * hq] = (f32x4){bflo(xw.x), bfhi(xw.x), bflo(xw.y), bfhi(xw.y)}; hv[r][2 * hq + 1] = (f32x4){bflo(xw.z), bfhi(xw.z), bflo(xw.w), bfhi(xw.w)}; }
        { const int nrow = i4 < 3 ? mb + 4 : (blk + NGW) * 16;
          if (nrow < T) P8_PREFETCH(nrow); }
        { float ss[4];
#pragma unroll
          for (int r = 0; r < 4; ++r) { f32x2 s2 = {0.f, 0.f};
#pragma unroll
              for (int j = 0; j < 4; ++j) { s2 = hv[r][j].xy * hv[r][j].xy + s2; s2 = hv[r][j].zw * hv[r][j].zw + s2; }
              ss[r] = s2.x + s2.y; }
          wave_sum4(ss[0], ss[1], ss[2], ss[3], lane);
#pragma unroll
          for (int r = 0; r < 4; ++r) {
            const float rr = rsqrtf(ss[r] * (1.0f / D) + NORM_EPS);
            v4u* ho = (v4u*)(H + (size_t)(mb + r) * D) + lane;
#pragma unroll
            for (int j = 0; j < 4; ++j) hv[r][j] = (hv[r][j] * rr) * gs_[j] + shv_[j];
#pragma unroll
            for (int hq = 0; hq < 2; ++hq) { const f32x4 ha = hv[r][2 * hq], hb = hv[r][2 * hq + 1];
                v4u o; o.x = pk2(ha.x, ha.y); o.y = pk2(ha.z, ha.w); o.z = pk2(hb.x, hb.y); o.w = pk2(hb.z, hb.w); ho[64 * hq] = o; }
          } }
        float gl[4][4];
        { f32x2 s2[4][4];
#pragma unroll
          for (int r = 0; r < 4; ++r)
#pragma unroll
              for (int j = 0; j < 4; ++j) s2[r][j] = (f32x2){0.f, 0.f};
#pragma unroll
          for (int j = 0; j < 4; ++j)
#pragma unroll
              for (int q = 0; q < 4; ++q) { const f32x4 w = RW4[j * 256 + 64 * q + lane];
#pragma unroll
                  for (int r = 0; r < 4; ++r) { s2[r][j] = hv[r][q].xy * w.xy + s2[r][j]; s2[r][j] = hv[r][q].zw * w.zw + s2[r][j]; } }
#pragma unroll
          for (int r = 0; r < 4; ++r) {
#pragma unroll
              for (int j = 0; j < 4; ++j) gl[r][j] = s2[r][j].x + s2[r][j].y;
              wave_sum4(gl[r][0], gl[r][1], gl[r][2], gl[r][3], lane); } }
#pragma unroll
        for (int r = 0; r < 4; ++r) {
#pragma unroll
            for (int j = 0; j < 4; ++j) gl[r][j] += rbias[j];
            int gi = 0; float gm = gl[r][0];
#pragma unroll
            for (int j = 1; j < 4; ++j) if (gl[r][j] > gm) { gm = gl[r][j]; gi = j; }
            float gs = 0.f;
#pragma unroll
            for (int j = 0; j < 4; ++j) gs += __expf(gl[r][j] - gm);
            const float pg = __builtin_amdgcn_rcpf(gs);
            gi = __builtin_amdgcn_readfirstlane(gi);
            float el[8];
            { f32x2 s2[8];
#pragma unroll
              for (int j = 0; j < 8; ++j) { s2[j] = (f32x2){0.f, 0.f}; const LAS f32x4* wrow = RW4 + (4 + gi * 8 + j) * 256 + lane;
#pragma unroll
                  for (int q = 0; q < 4; ++q) { const f32x4 w = wrow[64 * q]; s2[j] = hv[r][q].xy * w.xy + s2[j]; s2[j] = hv[r][q].zw * w.zw + s2[j]; }
                  el[j] = s2[j].x + s2[j].y; }
              wave_sum4(el[0], el[1], el[2], el[3], lane); wave_sum4(el[4], el[5], el[6], el[7], lane); }
#pragma unroll
            for (int j = 0; j < 8; ++j) el[j] += rbias[4 + gi * 8 + j];
            int e0 = 0; float m0v = el[0];
#pragma unroll
            for (int j = 1; j < 8; ++j) if (el[j] > m0v) { m0v = el[j]; e0 = j; }
            int e1 = -1; float m1v = -3.0e38f;
#pragma unroll
            for (int j = 0; j < 8; ++j) if (j != e0 && el[j] > m1v) { m1v = el[j]; e1 = j; }
            if (e1 < 0) { e1 = (e0 + 1) & 7; m1v = el[0]; }
            const float x1 = __expf(m1v - m0v), w0 = pg * __builtin_amdgcn_rcpf(1.0f + x1), w1 = w0 * x1;
            if (lane == 0) {
                const int m = mb + r, ea = gi * 8 + e0, eb = gi * 8 + e1;
                typedef int i32x2 __attribute__((ext_vector_type(2)));
                const int l0 = __hip_atomic_fetch_add(&lcnt[ea], 1, __ATOMIC_RELAXED, __HIP_MEMORY_SCOPE_WORKGROUP), l1 = __hip_atomic_fetch_add(&lcnt[eb], 1, __ATOMIC_RELAXED, __HIP_MEMORY_SCOPE_WORKGROUP);
                *(i32x2*)(tok_e + 2 * m) = (i32x2){ea, eb}; *(f32x2*)(tok_w + 2 * m) = (f32x2){w0, w1}; *(i32x2*)(tok_l + 2 * m) = (i32x2){l0, l1};
            }
        }
      }
    }
#undef P8_PREFETCH
    __syncthreads();
    if (tid < 32 && do_cnt) { const int c = lcnt[tid];
        const unsigned old = __hip_atomic_fetch_add((unsigned*)(ws + WS_CTL) + CW_CNT + l * 64 + tid, (unsigned)c, RLX_AGENT);
        ((int*)(ws + WS_WGBASE))[bx * 32 + tid] = (int)old; }
}

__device__ __forceinline__ void moe_scatter_phase(const Args& a, int l, LAS unsigned char* lds) {
    const int z = opq(); (void)z;
    const int tid = opqv((int)threadIdx.x), lane = tid & 63, wave = __builtin_amdgcn_readfirstlane(tid >> 6); const int G = (int)gridDim.x, bx = (int)blockIdx.x;
    const int vcu = (G % 8 == 0) ? (bx % 8) * (G / 8) + bx / 8 : bx; const int gw = vcu * NWAVES + wave, NGW = G * NWAVES;
    unsigned char* ws = (a.ws + z);
    LAS int* pst = (LAS int*)(lds + RING_OFF);
    LAS int* pend = pst + 32;
    int* rowmap = (int*)(ws + WS_ROWMAP);
    __syncthreads();
    if (tid == 0) {
        int run = 0; int* tile_e = (int*)(ws + WS_TILEE);
        for (int e = 0; e < NEXP; ++e) { const int c = (int)__hip_atomic_load((unsigned*)(ws + WS_CTL) + CW_CNT + l * 64 + e, RLX_AGENT); const int pad = (c + 255) & ~255;
            pst[e] = run + ((const int*)(ws + WS_WGBASE))[bx * 32 + e]; pend[e] = run + c; pend[32 + e] = run + pad;
            if (bx == 0) for (int q = 0; q < (pad >> 8); ++q) tile_e[(run >> 8) + q] = e;
            run += pad; }
        if (bx == 0) tile_e[511] = run >> 8;
    }
    __syncthreads();
    { const int e = bx & 31; for (int s = pend[e] + tid; s < pend[32 + e]; s += 512) rowmap[s] = 0; }
    const int* tok_e = (const int*)(ws + WS_TOKE); const int* tok_l = (const int*)(ws + WS_TOKL); int* tok_s = (int*)(ws + WS_TOKS);
    for (int m4b = gw * 4; m4b < T / 4; m4b += NGW * 4) {
        if (lane < 32) { const int m = m4b * 4 + (lane >> 1), k = lane & 1;
            const int s = pst[tok_e[2 * m + k]] + tok_l[2 * m + k]; tok_s[2 * m + k] = s; rowmap[s] = m; }
    }
}

__device__ __forceinline__ void stagger_delay(int steps, int ticks_per_step) {
    const unsigned long long t0 = __builtin_amdgcn_s_memrealtime(), want = (unsigned long long)(steps * ticks_per_step);
    while (__builtin_amdgcn_s_memrealtime() - t0 < want) __builtin_amdgcn_s_sleep(8);
}
__global__ void __launch_bounds__(NWAVES * 64, 2) fwd(Args args) {
    extern __shared__ __attribute__((aligned(16))) unsigned char lds_raw[];
    LAS unsigned char* lds = (LAS unsigned char*)lds_raw;
    for (int u = threadIdx.x; u < (LDS_BYTES - LDSCTL_OFF) / 4; u += NWAVES * 64) ((LAS unsigned*)(lds + LDSCTL_OFF))[u] = 0u;
    __syncthreads();
#if MK_MULTI
#define GRID_BAR() do { } while (0)
#else
    XcdBarrier bar = xcd_barrier_post((unsigned*)(args.ws + WS_CTL) + CW_BAR, (volatile LAS unsigned*)(lds + MISC_OFF) + 8);
#define GRID_BAR() xcd_barrier(bar)
#endif
    const int lo = args.ph_lo, hi = args.ph_hi;
#ifndef PHMASK
#define PHMASK 0xFFFF
#endif
#define EN(p) (((PHMASK) >> (p)) & 1)
#ifndef REPMASK
#define REPMASK 0
#endif
#define REPEAT(b) _Pragma("unroll 1") for (int rep_ = 0; rep_ < ((((REPMASK) >> (b)) & 1) ? 2 : 1); ++rep_)
#define IN(k) (lo <= (k) && (k) < hi)
#define SEAM(k) do { if (IN(k) && IN((k) + 1)) { GRID_BAR(); if (((REPMASK) >> 14) & 1) GRID_BAR(); } } while (0)

    if (EN(11) && IN(0)) { REPEAT(11) prologue_phase(args, lds); SEAM(0); }

#pragma unroll 1
    for (int l = 0; l < DEPTH; ++l) {
        const int pb = 1 + l * PH_PER_LAYER;
        if (EN(0) && IN(pb + 0)) { norm1_phase(args, l, l == 0, true); REPEAT(0) moe_weights_phase(args, l, lds); SEAM(pb + 0); }
        if (EN(1) && IN(pb + 1)) { unsigned char* ws = args.ws + opq(); const int G = (int)gridDim.x, bx = (int)blockIdx.x;
            pg8::Gemm g{(const pg8::bf16_t*)(ws + WS_H), (const pg8::bf16_t*)(ws + WS_WCAT) + (size_t)l * NCAT * 1024, 1024, 1024, 1024}; pg8::StaticOrder S; S.init(T, NCAT, G, bx);
            pg8::EpiZG E{(pg8::bf16_t*)(ws + WS_Z), (unsigned char*)(ws + WS_G), (const float*)args.in[opq() + I_GATEB] + l * GWD,
                         (const float*)args.in[opq() + I_QNG] + l * 64, (const float*)args.in[opq() + I_KNG] + l * 64, (const float*)(ws + WS_ROPE_C), (const float*)(ws + WS_ROPE_S)};
#ifdef STAGGER_P2
            stagger_delay((int)(blockIdx.x >> 3) & 7, STAGGER_P2);
#endif
            REPEAT(1) pg8::gemm_phase<pg8::EpiZG, pg8::StaticOrder, true, true>(lds + RING_OFF, g, S, E);
            SEAM(pb + 1);
        }
        if (EN(3) && IN(pb + 3)) {
            REPEAT(2) { pool_phase(args, lds); ssm_local_phase(args, l, lds); }
            __syncthreads();
#if ATTN_FAST
#if ATTN_V128
            REPEAT(3) attn_v128_phase(args, (char*)lds_raw + RING_OFF);
#else
            REPEAT(3) attn_fast_phase(args, (char*)lds_raw + RING_OFF);
#endif
#else
            attn_naive_phase(args, lds);
#endif
            SEAM(pb + 3); }
        if (EN(4) && IN(pb + 4)) { REPEAT(12) attn_combine_phase(args, l); REPEAT(4) ssm_final_phase(args, l, lds); SEAM(pb + 4); }
        if (EN(5) && IN(pb + 5)) { unsigned char* ws = args.ws + opq(); const int G = (int)gridDim.x, bx = (int)blockIdx.x;
            const pg8::bf16_t* am = (const pg8::bf16_t*)(ws + WS_AMIX); pg8::bf16_t* mx = (pg8::bf16_t*)(ws + WS_MIXED); const unsigned char* gt_ = (const unsigned char*)(ws + WS_G);
            const pg8::bf16_t* wmix = (const pg8::bf16_t*)(ws + WS_WMIX) + (size_t)l * 1024 * 1024;
            pg8::StaticOrder S; S.init(T, D, G, bx);
            { pg8::Gemm g{am, wmix, 1024, 1024, 1024}; pg8::EpiMixFused E{mx, gt_}; pg8::MixOrder MS{S};
              REPEAT(5) pg8::gemm_phase<pg8::EpiMixFused, pg8::MixOrder, true, true>(lds + RING_OFF, g, MS, E); }
            SEAM(pb + 5);
        }
        if (EN(6) && IN(pb + 6)) { unsigned char* ws = args.ws + opq(); const int G = (int)gridDim.x, bx = (int)blockIdx.x;
            pg8::Gemm g{(const pg8::bf16_t*)(ws + WS_MIXED), (const pg8::bf16_t*)(ws + WS_WO) + (size_t)l * 1024 * 1024, 1024, 1024, 1024}; pg8::StaticOrder S; S.init(T, D, G, bx);
            REPEAT(6) { pg8::bf16_t* xb = (pg8::bf16_t*)(ws + WS_XB); pg8::bf16_t* xo = xb; if (rep_ + 1 < REPN(6)) xo = (pg8::bf16_t*)(ws + WS_O0);
            const float* g1 = (const float*)(ws + WS_MOD) + (size_t)l * NB * 6144 + 2 * 1024;
            if (l == 0) { pg8::EpiResid<true> E{(const float*)args.in[opq() + I_X], xb, g1, xo};
                pg8::gemm_phase<pg8::EpiResid<true>, pg8::StaticOrder, true, true>(lds + RING_OFF, g, S, E); }
            else { pg8::EpiResid<false> E{nullptr, xb, g1, xo};
                pg8::gemm_phase<pg8::EpiResid<false>, pg8::StaticOrder, true, true>(lds + RING_OFF, g, S, E); } }
            SEAM(pb + 6);
        }
        if (EN(7) && IN(pb + 7)) { REPEAT(7) norm2_router_phase(args, l, lds, rep_ == ((((REPMASK) >> 7) & 1) ? 1 : 0)); SEAM(pb + 7); }
        if (EN(8) && IN(pb + 8)) { REPEAT(8) moe_scatter_phase(args, l, lds); SEAM(pb + 8); }
        if (EN(9) && IN(pb + 9)) { unsigned char* ws = args.ws + opq(); const int G = (int)gridDim.x, bx = (int)blockIdx.x; const int vcu = (G % 8 == 0) ? (bx % 8) * (G / 8) + bx / 8 : bx;
            const int* tile_e = (const int*)(ws + WS_TILEE);
            pg8::GatherOrder S{tile_e, (const int*)(ws + WS_ROWMAP), __builtin_amdgcn_readfirstlane(tile_e[511]), G, vcu};
            pg8::Gemm g{(const pg8::bf16_t*)(ws + WS_H), (const pg8::bf16_t*)(ws + WS_W13), 1024, 1024, 1024};
            pg8::EpiSwiGLU E{(pg8::bf16_t*)(ws + WS_ACT)};
            REPEAT(9) pg8::gemm_phase<pg8::EpiSwiGLU, pg8::GatherOrder, true, true>(lds + RING_OFF, g, S, E);
            SEAM(pb + 9);
        }
        if (EN(10) && IN(pb + 10)) { unsigned char* ws = args.ws + opq(); const int G = (int)gridDim.x, bx = (int)blockIdx.x; const int vcu = (G % 8 == 0) ? (bx % 8) * (G / 8) + bx / 8 : bx;
            const int* tile_e = (const int*)(ws + WS_TILEE);
            pg8::GroupedOrder S{tile_e, __builtin_amdgcn_readfirstlane(tile_e[511]), G, vcu};
            pg8::Gemm g{(const pg8::bf16_t*)(ws + WS_ACT), (const pg8::bf16_t*)(ws + WS_W2), 512, 512, 512};
            pg8::EpiY E{(pg8::bf16_t*)(ws + WS_Y)};
            REPEAT(10) pg8::gemm_phase<pg8::EpiY, pg8::GroupedOrder, true, true>(lds + RING_OFF, g, S, E);
            SEAM(pb + 10);
        }
    }
    if (EN(12) && IN(N_PHASES - 1)) norm1_phase(args, DEPTH, false, false);
#undef IN
#undef SEAM
}

extern "C" void kernel_launch(void* const* d_in, const int* in_sizes, int n_in, void* d_out, int out_size, void* d_ws, size_t ws_size, hipStream_t stream) {
    static int grid = 0;
    if (grid == 0) {
        if (n_in != 40 || out_size != T * D || ws_size < WS_END) { fprintf(stderr, "kernel_launch: unexpected shapes (n_in %d out %d ws %zu)\n", n_in, out_size, ws_size); grid = -1; return; }
        int dev = 0, cus = 0, per_cu = 0;
        if (hipGetDevice(&dev) != hipSuccess || hipDeviceGetAttribute(&cus, hipDeviceAttributeMultiprocessorCount, dev) != hipSuccess) { grid = -1; return; }
        if (hipFuncSetAttribute((const void*)fwd, hipFuncAttributeMaxDynamicSharedMemorySize, LDS_BYTES) != hipSuccess) { fprintf(stderr, "kernel_launch: hipFuncSetAttribute failed\n"); grid = -1; return; }
        if (hipOccupancyMaxActiveBlocksPerMultiprocessor(&per_cu, (const void*)fwd, NWAVES * 64, LDS_BYTES) != hipSuccess || per_cu < 1) fprintf(stderr, "kernel_launch: occupancy query says %d\n", per_cu);
        (void)hipGetLastError();
        grid = cus;
    }
    if (grid < 0) return;
    if (hipMemsetAsync((char*)d_ws + WS_CTL, 0, CTL_ZERO_BYTES, stream) != hipSuccess) return;
    Args a{};
    for (int i = 0; i < 40; ++i) a.in[i] = d_in[i];
    a.out = (float*)d_out; a.ws = (unsigned char*)d_ws;
#if MK_MULTI
    for (int p = 0; p < N_PHASES; ++p) { a.ph_lo = p; a.ph_hi = p + 1; hipLaunchKernelGGL(fwd, dim3(grid), dim3(NWAVES * 64), LDS_BYTES, stream, a); }
#else
    a.ph_lo = 0; a.ph_hi = N_PHASES;
    hipLaunchKernelGGL(fwd, dim3(grid), dim3(NWAVES * 64), LDS_BYTES, stream, a);
#endif
}
```

```cpp
#include <hip/hip_runtime.h>
#include <cstdio>
#include <cstdint>

#ifndef REPMASK
#define REPMASK 0
#endif
#define REPN(b) ((((REPMASK) >> (b)) & 1) ? 2 : 1)
#ifndef MK_MULTI
#define MK_MULTI 0
#endif

__device__ __forceinline__ int opqv(int x) { asm volatile("" : "+v"(x)); return x; }
__device__ __forceinline__ int opq() { int z = 0; asm volatile("" : "+s"(z)); return z; }
namespace pg8 {
#define PG8_LAS __attribute__((address_space(3)))
typedef unsigned short bf16_t;
typedef short bf16x8 __attribute__((ext_vector_type(8)));
typedef float f32x4 __attribute__((ext_vector_type(4)));
typedef unsigned u32x4 __attribute__((ext_vector_type(4)));
typedef unsigned u32x2 __attribute__((ext_vector_type(2)));
constexpr int BM = 256, BK = 64, HALF = 128, HTB = HALF * BK * 2  , STAGE_BYTES = 8 * HTB, NXCD = 8, WGM = 8;

__host__ __device__ __forceinline__ int lds_byte(int r, int c) { const int st = (r >> 4) * 2 + (c >> 5), rr = r & 15, cc = c & 31, ob = rr * 64 + cc * 2; return st * 1024 + (ob ^ (((ob >> 9) & 1) << 5)); }
__host__ __device__ __forceinline__ void stage_rc(int b, int& R, int& C) { const int st = b / 1024, sb = b % 1024, swz = sb ^ (((sb >> 9) & 1) << 5); R = (st >> 1) * 16 + swz / 64; C = (st & 1) * 32 + (swz % 64) / 2; }
__host__ __device__ __forceinline__ int perm32(int rho) { const int n = rho >> 4, i = rho & 15; return 8 * (i >> 2) + 4 * n + (i & 3); }

struct Unit { int pm, pn, pb, seg, koff, nt, zero; };
struct Gemm { const bf16_t* A; const bf16_t* Bt; int lda, ldb, K; };

struct StaticOrder {
    static constexpr bool VARK = false, GATHER = false;
    int nM, nN, nwg, G, c;
    __host__ __device__ void init(int M, int N, int G_, int c_) { nM = M / BM; nN = N / BM; nwg = nM * nN; G = G_; c = c_; }
    __host__ __device__ bool next(int i, Unit& u) const {
        const long L = (long)i * G + c; if (L >= nwg) return false;
        int wgid = (int)L; { const int q = nwg / NXCD, r = nwg % NXCD, xcd = wgid % NXCD, off = wgid / NXCD; wgid = (xcd < r ? xcd * (q + 1) : r * (q + 1) + (xcd - r) * q) + off; }
        const int nig = WGM * nN, gid = wgid / nig, fm = gid * WGM, gsz = (nM - fm) < WGM ? (nM - fm) : WGM;
        u.pm = fm + ((wgid % nig) % gsz); u.pn = (wgid % nig) / gsz; u.pb = u.pn; return true;
    }
    __device__ __forceinline__ void a_ready(const Unit&) const {}
    __device__ __forceinline__ void done(const Unit&) const {}
};
struct GroupedOrder {
    static constexpr bool VARK = false, GATHER = false;
    const int* tile_e; int ntiles, G, c;
    __device__ __forceinline__ bool next(int i, Unit& u) const {
        const long L = (long)i * G + c; if (L >= (long)ntiles * 4) return false;
        const int pm = (int)(L >> 2), pl = (int)(L & 3);
        u.pm = pm; u.pn = pl; u.pb = __builtin_amdgcn_readfirstlane(tile_e[pm]) * 4 + pl; return true;
    }
    __device__ __forceinline__ void a_ready(const Unit&) const {}
    __device__ __forceinline__ void done(const Unit&) const {}
};

struct GatherOrder {
    static constexpr bool VARK = false, GATHER = true;
    const int* tile_e; const int* rowmap; int ntiles, G, c;
    __device__ __forceinline__ bool next(int i, Unit& u) const {
        const long L = (long)i * G + c; if (L >= (long)ntiles * 4) return false;
        const int pm = (int)(L >> 2), pl = (int)(L & 3);
        u.pm = pm; u.pn = pl; u.pb = __builtin_amdgcn_readfirstlane(tile_e[pm]) * 4 + pl; return true;
    }
    __device__ __forceinline__ void a_ready(const Unit&) const {}
    __device__ __forceinline__ void done(const Unit&) const {}
};
struct MixOrder {
    static constexpr bool VARK = true, GATHER = false;
    StaticOrder so;
    __device__ __forceinline__ bool next(int i, Unit& u) const { const int bi = i / 3, seg = i - bi * 3; if (!so.next(bi, u)) return false;
        u.seg = seg; u.koff = seg == 0 ? 0 : (seg == 1 ? 256 : 768); u.nt = seg == 1 ? 8 : 4; u.zero = seg == 2; return true; }
    __device__ __forceinline__ void a_ready(const Unit&) const {}
    __device__ __forceinline__ void done(const Unit&) const {}
};

__device__ __forceinline__ unsigned cvt_pk_bf16(float lo, float hi) { unsigned r; asm volatile("v_cvt_pk_bf16_f32 %0, %1, %2" : "=v"(r) : "v"(lo), "v"(hi)); return r; }
__device__ __forceinline__ float bflo(unsigned w) { return __uint_as_float(w << 16); }
__device__ __forceinline__ float bfhi(unsigned w) { return __uint_as_float(w & 0xffff0000u); }
__device__ __forceinline__ float sigmoidf_(float x) { return __builtin_amdgcn_rcpf(1.0f + __builtin_amdgcn_exp2f(-1.4426950408889634f * x)); }


struct EpiZG {
    static constexpr bool PERM = true, AFTER_DRAIN = false, MIDHOOK = false;
    bf16_t* Z; unsigned char* G8; const float* gbias;
    const float* qg; const float* kg; const float* ropec; const float* ropes;
    __device__ __forceinline__ void operator()(const f32x4 (&acc)[2][2][4][2], const Unit& u, int wr, int wc, int fr, int fq) const {
        asm volatile("" : "+v"(fr), "+v"(fq));
        const int row0 = u.pm * BM + wr * 64 + fr;
        if (u.pn >= 1 && u.pn <= 4) {
            const int vec = (u.pn - 1) * 4 + wc; const bool isq = vec < 8;
            const float* gsrc = isq ? qg : kg; const float sc = isq ? 0.125f * 1.4426950408889634f : 1.0f;
            f32x4 gv[2][2];
#pragma unroll
            for (int bj = 0; bj < 2; ++bj)
#pragma unroll
                for (int n = 0; n < 2; ++n) gv[bj][n] = *(const f32x4*)(gsrc + 32 * bj + 8 * fq + 4 * n) * sc;
#pragma unroll
            for (int ai = 0; ai < 2; ++ai)
#pragma unroll
                for (int m = 0; m < 4; ++m) { const size_t row = (size_t)(row0 + ai * HALF + m * 16);
                    float ss = 0.f;
#pragma unroll
                    for (int bj = 0; bj < 2; ++bj)
#pragma unroll
                        for (int n = 0; n < 2; ++n) { const f32x4 x = acc[ai][bj][m][n]; ss += (x[0] * x[0] + x[1] * x[1]) + (x[2] * x[2] + x[3] * x[3]); }
                    { auto rr = __builtin_amdgcn_permlane16_swap(__float_as_uint(ss), __float_as_uint(ss), false, false); ss = __uint_as_float(rr[0]) + __uint_as_float(rr[1]); }
                    { auto rr = __builtin_amdgcn_permlane32_swap(__float_as_uint(ss), __float_as_uint(ss), false, false); ss = __uint_as_float(rr[0]) + __uint_as_float(rr[1]); }
                    const float rs = __builtin_amdgcn_rsqf(ss * (1.0f / 64.0f) + 1e-6f);
                    f32x4 o[2][2];
#pragma unroll
                    for (int n = 0; n < 2; ++n) { const f32x4 c = *(const f32x4*)(ropec + row * 32 + 8 * fq + 4 * n), s = *(const f32x4*)(ropes + row * 32 + 8 * fq + 4 * n);
                        const f32x4 y0 = acc[ai][0][m][n] * rs * gv[0][n], y1 = acc[ai][1][m][n] * rs * gv[1][n];
                        o[0][n] = y0 * c - y1 * s; o[1][n] = y1 * c + y0 * s; }
                    bf16_t* rowp = Z + row * 2048 + 256 + vec * 64 + 8 * fq;
#pragma unroll
                    for (int bj = 0; bj < 2; ++bj) { u32x4 w; w.x = cvt_pk_bf16(o[bj][0][0], o[bj][0][1]); w.y = cvt_pk_bf16(o[bj][0][2], o[bj][0][3]); w.z = cvt_pk_bf16(o[bj][1][0], o[bj][1][1]); w.w = cvt_pk_bf16(o[bj][1][2], o[bj][1][3]);
                        *(u32x4*)(rowp + 32 * bj) = w; }
                    if (m == 3) asm volatile("" ::: "memory"); }
            return;
        }
        if (u.pn >= 8) {
            const int col0 = (u.pn - 8) * BM + wc * 64 + 16 * fq;
            f32x4 bc[2][2];
#pragma unroll
            for (int bj = 0; bj < 2; ++bj)
#pragma unroll
                for (int n = 0; n < 2; ++n) bc[bj][n] = *(const f32x4*)(gbias + col0 + 8 * bj + 4 * n) * (-1.4426950408889634f) - 7.994353436858858f;
#pragma unroll
            for (int ai = 0; ai < 2; ++ai)
#pragma unroll
                for (int m = 0; m < 4; ++m) { u32x4 w;
#pragma unroll
                    for (int bj = 0; bj < 2; ++bj)
#pragma unroll
                        for (int n = 0; n < 2; ++n) { const f32x4 v = acc[ai][bj][m][n] * (-1.4426950408889634f) + bc[bj][n]; unsigned pw = 0u;
#pragma unroll
                            for (int j = 0; j < 4; ++j) pw = __builtin_amdgcn_cvt_pk_u8_f32(fmaxf(__builtin_rintf(__builtin_amdgcn_rcpf(__builtin_amdgcn_exp2f(v[j]) + (1.0f / 255.0f))), 1.0f), j, pw);
                            w[bj * 2 + n] = pw; }
                    *(u32x4*)(G8 + (size_t)(row0 + ai * HALF + m * 16) * 3072 + col0) = w; }
            return;
        }
        const int colt = u.pn * BM;
        const int col0 = colt + wc * 64 + 8 * fq;
#pragma unroll
        for (int ai = 0; ai < 2; ++ai)
#pragma unroll
            for (int m = 0; m < 4; ++m) { bf16_t* rowp = Z + (size_t)(row0 + ai * HALF + m * 16) * 2048 + col0;
#pragma unroll
                for (int bj = 0; bj < 2; ++bj) { const f32x4 v0 = acc[ai][bj][m][0], v1 = acc[ai][bj][m][1];
                    u32x4 w; w.x = cvt_pk_bf16(v0[0], v0[1]); w.y = cvt_pk_bf16(v0[2], v0[3]); w.z = cvt_pk_bf16(v1[0], v1[1]); w.w = cvt_pk_bf16(v1[2], v1[3]);
                    *(u32x4*)(rowp + bj * 32) = w; } }
    }
};
struct EpiMix {
    static constexpr bool PERM = true, AFTER_DRAIN = false, MIDHOOK = false;
    bf16_t* O; const bf16_t* Gt; int gcol0; bool first;
    __device__ __forceinline__ void operator()(const f32x4 (&acc)[2][2][4][2], const Unit& u, int wr, int wc, int fr, int fq) const {
        asm volatile("" : "+v"(fr), "+v"(fq));
        const int row0 = u.pm * BM + wr * 64 + fr, col0 = u.pn * BM + wc * 32 + 8 * fq;
#pragma unroll
        for (int ai = 0; ai < 2; ++ai)
#pragma unroll
            for (int m = 0; m < 4; ++m) { const size_t row = (size_t)(row0 + ai * HALF + m * 16);
#pragma unroll
                for (int bj = 0; bj < 2; ++bj) {
                    const u32x4 gw = *(const u32x4*)(Gt + row * 3072 + gcol0 + col0 + bj * HALF);
                    bf16_t* op = O + row * 1024 + col0 + bj * HALF;
                    f32x4 v0 = acc[ai][bj][m][0], v1 = acc[ai][bj][m][1];
                    v0[0] *= bflo(gw.x); v0[1] *= bfhi(gw.x); v0[2] *= bflo(gw.y); v0[3] *= bfhi(gw.y);
                    v1[0] *= bflo(gw.z); v1[1] *= bfhi(gw.z); v1[2] *= bflo(gw.w); v1[3] *= bfhi(gw.w);
                    if (!first) { const u32x4 pw = *(const u32x4*)op;
                        v0[0] += bflo(pw.x); v0[1] += bfhi(pw.x); v0[2] += bflo(pw.y); v0[3] += bfhi(pw.y);
                        v1[0] += bflo(pw.z); v1[1] += bfhi(pw.z); v1[2] += bflo(pw.w); v1[3] += bfhi(pw.w); }
                    u32x4 w; w.x = cvt_pk_bf16(v0[0], v0[1]); w.y = cvt_pk_bf16(v0[2], v0[3]); w.z = cvt_pk_bf16(v1[0], v1[1]); w.w = cvt_pk_bf16(v1[2], v1[3]);
                    *(u32x4*)op = w; }
                asm volatile("" ::: "memory"); }
    }
};
struct EpiMixFused {
    static constexpr bool PERM = true, AFTER_DRAIN = false, MIDHOOK = false;
    bf16_t* O; const unsigned char* G8;
    __device__ __forceinline__ static void gld(const unsigned char* p, float (&g)[2][2][4]) { const u32x4 w = *(const u32x4*)p;
#pragma unroll
        for (int q = 0; q < 4; ++q) { const unsigned d = w[q]; g[q >> 1][q & 1][0] = (float)(d & 0xffu); g[q >> 1][q & 1][1] = (float)((d >> 8) & 0xffu); g[q >> 1][q & 1][2] = (float)((d >> 16) & 0xffu); g[q >> 1][q & 1][3] = (float)(d >> 24); } }
    __device__ __forceinline__ void operator()(f32x4 (&acc)[2][2][4][2], const Unit& u, int wr, int wc, int fr, int fq) const {
        asm volatile("" : "+v"(fr), "+v"(fq));
        const int row0 = u.pm * BM + wr * 64 + fr, col0 = u.pn * BM + wc * 64 + 16 * fq;
        if (u.seg < 2) {
#pragma unroll
            for (int ai = 0; ai < 2; ++ai)
#pragma unroll
                for (int m = 0; m < 4; ++m) { const unsigned char* gp = G8 + (size_t)(row0 + ai * HALF + m * 16) * 3072 + u.seg * 1024 + col0;
                    float gn[2][2][4], gd[2][2][4]; gld(gp, gn); gld(gp + 1024, gd);
#pragma unroll
                    for (int bj = 0; bj < 2; ++bj)
#pragma unroll
                        for (int n = 0; n < 2; ++n)
#pragma unroll
                            for (int j = 0; j < 4; ++j) acc[ai][bj][m][n][j] *= gn[bj][n][j] * __builtin_amdgcn_rcpf(gd[bj][n][j]);
                    if (m == 3) asm volatile("" ::: "memory"); }
        } else {
#pragma unroll
            for (int ai = 0; ai < 2; ++ai)
#pragma unroll
                for (int m = 0; m < 4; ++m) { const size_t row = (size_t)(row0 + ai * HALF + m * 16);
                    float g[2][2][4]; gld(G8 + row * 3072 + 2048 + col0, g);
#pragma unroll
                    for (int bj = 0; bj < 2; ++bj) { const f32x4 v0 = acc[ai][bj][m][0] * (1.0f / 255.0f), v1 = acc[ai][bj][m][1] * (1.0f / 255.0f);
                        u32x4 w; w.x = cvt_pk_bf16(v0[0] * g[bj][0][0], v0[1] * g[bj][0][1]); w.y = cvt_pk_bf16(v0[2] * g[bj][0][2], v0[3] * g[bj][0][3]);
                        w.z = cvt_pk_bf16(v1[0] * g[bj][1][0], v1[1] * g[bj][1][1]); w.w = cvt_pk_bf16(v1[2] * g[bj][1][2], v1[3] * g[bj][1][3]);
                        *(u32x4*)(O + row * 1024 + col0 + 8 * bj) = w; }
                    if (m == 3) asm volatile("" ::: "memory"); }
        }
    }
};
template <bool FIRST>
struct EpiResid {
    static constexpr bool PERM = true, AFTER_DRAIN = false, MIDHOOK = false;
    const float* Xf; const bf16_t* X; const float* g1; bf16_t* Xo;
    __device__ __forceinline__ void operator()(const f32x4 (&acc)[2][2][4][2], const Unit& u, int wr, int wc, int fr, int fq) const {
        asm volatile("" : "+v"(fr), "+v"(fq));
        const int row0 = u.pm * BM + wr * 64 + fr, col0 = u.pn * BM + wc * 32 + 8 * fq;
        const float* gp = g1 + (size_t)((u.pm * BM) >> 12) * 6144 + col0;
        f32x4 gv[2][2];
#pragma unroll
        for (int bj = 0; bj < 2; ++bj)
#pragma unroll
            for (int n = 0; n < 2; ++n) gv[bj][n] = *(const f32x4*)(gp + bj * HALF + n * 4);
#pragma unroll
        for (int ai = 0; ai < 2; ++ai)
#pragma unroll
            for (int m = 0; m < 4; ++m) { const size_t ro = (size_t)(row0 + ai * HALF + m * 16) * 1024 + col0;
#pragma unroll
                for (int bj = 0; bj < 2; ++bj) { f32x4 x0, x1;
                    if (FIRST) { x0 = *(const f32x4*)(Xf + ro + bj * HALF); x1 = *(const f32x4*)(Xf + ro + bj * HALF + 4); }
                    else { const u32x4 xb = *(const u32x4*)(X + ro + bj * HALF); x0 = (f32x4){bflo(xb.x), bfhi(xb.x), bflo(xb.y), bfhi(xb.y)}; x1 = (f32x4){bflo(xb.z), bfhi(xb.z), bflo(xb.w), bfhi(xb.w)}; }
                    const f32x4 r0 = x0 + gv[bj][0] * acc[ai][bj][m][0], r1 = x1 + gv[bj][1] * acc[ai][bj][m][1];
                    u32x4 w; w.x = cvt_pk_bf16(r0[0], r0[1]); w.y = cvt_pk_bf16(r0[2], r0[3]); w.z = cvt_pk_bf16(r1[0], r1[1]); w.w = cvt_pk_bf16(r1[2], r1[3]);
                    *(u32x4*)(Xo + ro + bj * HALF) = w; } }
    }
};
struct EpiSwiGLU {
    static constexpr bool PERM = true, AFTER_DRAIN = false, MIDHOOK = false;
    bf16_t* O;
    __device__ __forceinline__ void operator()(const f32x4 (&acc)[2][2][4][2], const Unit& u, int wr, int wc, int fr, int fq) const {
        asm volatile("" : "+v"(fr), "+v"(fq));
        const int row0 = u.pm * BM + wr * 64 + fr, col0 = u.pn * HALF + wc * 32 + 8 * fq;
#pragma unroll
        for (int ai = 0; ai < 2; ++ai)
#pragma unroll
            for (int m = 0; m < 4; ++m) { bf16_t* op = O + (size_t)(row0 + ai * HALF + m * 16) * 512 + col0;
                float r[8];
#pragma unroll
                for (int n = 0; n < 2; ++n)
#pragma unroll
                    for (int j = 0; j < 4; ++j) { const float a = acc[ai][0][m][n][j], b = acc[ai][1][m][n][j]; r[n * 4 + j] = a * sigmoidf_(a) * b; }
                u32x4 w; w.x = cvt_pk_bf16(r[0], r[1]); w.y = cvt_pk_bf16(r[2], r[3]); w.z = cvt_pk_bf16(r[4], r[5]); w.w = cvt_pk_bf16(r[6], r[7]);
                *(u32x4*)op = w; }
    }
};
struct EpiY {
    static constexpr bool PERM = true, AFTER_DRAIN = false, MIDHOOK = false;
    bf16_t* O;
    __device__ __forceinline__ void operator()(const f32x4 (&acc)[2][2][4][2], const Unit& u, int wr, int wc, int fr, int fq) const {
        asm volatile("" : "+v"(fr), "+v"(fq));
        const int row0 = u.pm * BM + wr * 64 + fr, col0 = u.pn * BM + wc * 32 + 8 * fq;
#pragma unroll
        for (int ai = 0; ai < 2; ++ai)
#pragma unroll
            for (int m = 0; m < 4; ++m) { bf16_t* rowp = O + (size_t)(row0 + ai * HALF + m * 16) * 1024 + col0;
#pragma unroll
                for (int bj = 0; bj < 2; ++bj) { const f32x4 v0 = acc[ai][bj][m][0], v1 = acc[ai][bj][m][1];
                    u32x4 w; w.x = cvt_pk_bf16(v0[0], v0[1]); w.y = cvt_pk_bf16(v0[2], v0[3]); w.z = cvt_pk_bf16(v1[0], v1[1]); w.w = cvt_pk_bf16(v1[2], v1[3]);
                    *(u32x4*)(rowp + bj * HALF) = w; } }
    }
};

template <class Epi, class Sched, bool ALIGN_EPI = false, bool SP2 = false>
__device__ __forceinline__ void gemm_phase(PG8_LAS unsigned char* lds, const Gemm g, const Sched& S, const Epi& E) {
    const int tid = opqv((int)threadIdx.x), wid = __builtin_amdgcn_readfirstlane(tid >> 6), lane = tid & 63, wr = wid >> 2, wc = wid & 3, fr = lane & 15, fq = lane >> 4;
    const int K = g.K, nt = K / BK, lda = g.lda, ldb = g.ldb;
    unsigned voffA[2], voffB[2];
#pragma unroll
    for (int i = 0; i < 2; ++i) { int R, C; stage_rc(tid * 16 + i * 8192, R, C); const int Rb = Epi::PERM ? ((R & ~31) + perm32(R & 31)) : R;
        voffA[i] = (unsigned)(R * lda + C) * 2u; voffB[i] = (unsigned)(Rb * ldb + C) * 2u; }
    const size_t kstep = (size_t)(BK * 2);
    const size_t hstepA = (size_t)HALF * lda * 2, hstepB = (size_t)HALF * ldb * 2;
    const size_t tstepA = 2 * hstepA, tstepB = 2 * hstepB;
    const unsigned ldsw = (unsigned)wid * 1024u;
    const int aoff = lds_byte(wr * 64 + fr, fq * 8), boff = lds_byte(wc * 32 + fr, fq * 8);
#define PG8_SA(b, h) (((b) * 2 + (h)) * HTB)
#define PG8_SB(b, h) ((4 + (b) * 2 + (h)) * HTB)
#define PG8_STAGE(bufoff, gbase, voff) do { _Pragma("unroll") for (int _i = 0; _i < 2; ++_i) \
        __builtin_amdgcn_global_load_lds((const unsigned*)((const char*)(gbase) + (voff)[_i]), (PG8_LAS unsigned*)(lds + (bufoff) + ldsw + _i * 8192), 16, 0, 0); } while (0)
#define PG8_LDA(dst, b, h) do { _Pragma("unroll") for (int m = 0; m < 4; ++m) _Pragma("unroll") for (int k = 0; k < 2; ++k) dst[m][k] = *(const PG8_LAS bf16x8*)(lds + PG8_SA(b, h) + aoff + m * 2048 + k * 1024); } while (0)
#define PG8_LDB(dst, b, h) do { _Pragma("unroll") for (int n = 0; n < 2; ++n) _Pragma("unroll") for (int k = 0; k < 2; ++k) dst[n][k] = *(const PG8_LAS bf16x8*)(lds + PG8_SB(b, h) + boff + n * 2048 + k * 1024); } while (0)
#define PG8_MMA(ai, bj, At, Bt) do { __builtin_amdgcn_s_setprio(1); _Pragma("unroll") for (int m = 0; m < 4; ++m) _Pragma("unroll") for (int n = 0; n < 2; ++n) _Pragma("unroll") for (int k = 0; k < 2; ++k) \
        acc[ai][bj][m][n] = __builtin_amdgcn_mfma_f32_16x16x32_bf16(Bt[n][k], At[m][k], acc[ai][bj][m][n], 0, 0, 0); __builtin_amdgcn_s_setprio(0); } while (0)
#define PG8_WAIT_V(n) asm volatile("s_waitcnt vmcnt(" #n ")" ::: "memory")
#define PG8_WAIT_L(n) asm volatile("s_waitcnt lgkmcnt(" #n ")" ::: "memory")
#define PG8_BAR __builtin_amdgcn_s_barrier()
#define PG8_SCHED __builtin_amdgcn_sched_barrier(0)
    Unit cur, nxt; int ui = 0;
    if (!S.next(0, cur)) return;
    unsigned gC[2][2], gN[2][2];
#define PG8_GOFF(dst, U) do { if constexpr (Sched::GATHER) { _Pragma("unroll") for (int _h = 0; _h < 2; ++_h) _Pragma("unroll") for (int _i = 0; _i < 2; ++_i) { int _R, _C; stage_rc(tid * 16 + _i * 8192, _R, _C); \
        dst[_h][_i] = (unsigned)S.rowmap[(U).pm * 256 + _h * 128 + _R] * (unsigned)(lda * 2) + (unsigned)_C * 2u; } } } while (0)
#define PG8_STAGEA(bufoff, ptr, gptr, goff) do { if constexpr (Sched::GATHER) PG8_STAGE(bufoff, gptr, goff); else PG8_STAGE(bufoff, ptr, voffA); } while (0)
#define PG8_STAGEA_SEL(bufoff, ptr, gptr, h) do { if constexpr (Sched::GATHER) { if (last) PG8_STAGE(bufoff, gptr, gN[h]); else PG8_STAGE(bufoff, gptr, gC[h]); } else PG8_STAGE(bufoff, ptr, voffA); } while (0)
    PG8_GOFF(gC, cur);
    f32x4 acc[2][2][4][2];
#pragma unroll
    for (int a = 0; a < 2; ++a)
#pragma unroll
        for (int b = 0; b < 2; ++b)
#pragma unroll
            for (int m = 0; m < 4; ++m)
#pragma unroll
                for (int n = 0; n < 2; ++n) acc[a][b][m][n] = (f32x4){0.f, 0.f, 0.f, 0.f};
    bf16x8 At[4][2], B0[2][2], B1[2][2];
    const char* cA = (const char*)g.A + (size_t)cur.pm * tstepA + (Sched::VARK ? (size_t)cur.koff * 2 : 0); const char* cB = (const char*)g.Bt + (size_t)cur.pb * tstepB + (Sched::VARK ? (size_t)cur.koff * 2 : 0);
    S.a_ready(cur);
    if constexpr (SP2) {
        PG8_STAGE(PG8_SB(0, 0), cB, voffB); PG8_STAGE(PG8_SB(0, 1), cB + hstepB, voffB); PG8_STAGEA(PG8_SA(0, 0), cA, (const char*)g.A, gC[0]); PG8_STAGEA(PG8_SA(0, 1), cA + hstepA, (const char*)g.A, gC[1]);
        if (wr == 1) PG8_BAR;
        PG8_WAIT_V(2); PG8_BAR;
        PG8_STAGE(PG8_SB(1, 0), cB + kstep, voffB); PG8_STAGEA(PG8_SA(1, 0), cA + kstep, (const char*)g.A + kstep, gC[0]); PG8_STAGE(PG8_SB(1, 1), cB + hstepB + kstep, voffB);
        PG8_WAIT_V(6); PG8_BAR;
    } else {
        PG8_STAGE(PG8_SB(0, 0), cB, voffB); PG8_STAGE(PG8_SA(0, 0), cA, voffA); PG8_STAGE(PG8_SB(0, 1), cB + hstepB, voffB); PG8_STAGE(PG8_SA(0, 1), cA + hstepA, voffA);
        if (wr == 1) PG8_BAR;
        PG8_WAIT_V(4); PG8_BAR;
        PG8_STAGE(PG8_SB(1, 0), cB + kstep, voffB); PG8_STAGE(PG8_SA(1, 0), cA + kstep, voffA); PG8_STAGE(PG8_SB(1, 1), cB + hstepB + kstep, voffB);
        PG8_WAIT_V(6); PG8_BAR;
    }
    for (;;) {
        const bool has_next = S.next(ui + 1, nxt);
        const char* nA = has_next ? (const char*)g.A + (size_t)nxt.pm * tstepA + (Sched::VARK ? (size_t)nxt.koff * 2 : 0) : cA; const char* nB = has_next ? (const char*)g.Bt + (size_t)nxt.pb * tstepB + (Sched::VARK ? (size_t)nxt.koff * 2 : 0) : cB;
        const int ntc = Sched::VARK ? cur.nt : nt;
        if constexpr (Sched::GATHER) { if (has_next) PG8_GOFF(gN, nxt); else { gN[0][0] = gC[0][0]; gN[0][1] = gC[0][1]; gN[1][0] = gC[1][0]; gN[1][1] = gC[1][1]; } }
#pragma unroll 1
        for (int t = 0; t < ntc; t += 2) {
            const bool last = (t == ntc - 2);
            const char* a1 = cA + (size_t)(t + 1) * kstep;
            const char* a2 = last ? nA : cA + (size_t)(t + 2) * kstep; const char* b2 = last ? nB : cB + (size_t)(t + 2) * kstep;
            const char* a3 = a2 + kstep; const char* b3 = b2 + kstep;
            if (last && has_next) S.a_ready(nxt);
            const char* gk1 = (const char*)g.A + (size_t)(t + 1) * kstep; const char* gk2 = (const char*)g.A + (size_t)(last ? 0 : t + 2) * kstep; const char* gk3 = gk2 + kstep;
            if constexpr (SP2) {
            PG8_LDB(B0, 0, 0); PG8_LDB(B1, 0, 1); PG8_SCHED; PG8_LDA(At, 0, 0); PG8_STAGEA(PG8_SA(1, 1), a1 + hstepA, gk1, gC[1]);
            PG8_WAIT_V(8); PG8_WAIT_L(0); PG8_BAR; PG8_MMA(0, 0, At, B0); PG8_MMA(0, 1, At, B1); PG8_BAR; PG8_SCHED;
            PG8_LDA(At, 0, 1); PG8_STAGE(PG8_SB(0, 0), b2, voffB); PG8_STAGE(PG8_SB(0, 1), b2 + hstepB, voffB); PG8_STAGEA_SEL(PG8_SA(0, 0), a2, gk2, 0);
            PG8_WAIT_V(8); PG8_WAIT_L(0); PG8_BAR; PG8_MMA(1, 0, At, B0); PG8_MMA(1, 1, At, B1); PG8_BAR; PG8_SCHED;
            PG8_LDB(B0, 1, 0); PG8_LDB(B1, 1, 1); PG8_SCHED; PG8_LDA(At, 1, 0); PG8_STAGEA_SEL(PG8_SA(0, 1), a2 + hstepA, gk2, 1);
            PG8_WAIT_V(8); PG8_WAIT_L(0); PG8_BAR; PG8_MMA(0, 0, At, B0); PG8_MMA(0, 1, At, B1); PG8_BAR; PG8_SCHED;
            PG8_LDA(At, 1, 1); PG8_STAGE(PG8_SB(1, 0), b3, voffB); PG8_STAGE(PG8_SB(1, 1), b3 + hstepB, voffB); PG8_STAGEA_SEL(PG8_SA(1, 0), a3, gk3, 0);
            PG8_WAIT_V(8); PG8_WAIT_L(0); PG8_BAR; PG8_MMA(1, 0, At, B0); PG8_MMA(1, 1, At, B1); PG8_BAR; PG8_SCHED;
            } else {
            PG8_LDB(B0, 0, 0); PG8_SCHED; PG8_LDA(At, 0, 0); PG8_STAGE(PG8_SA(1, 1), a1 + hstepA, voffA);
            PG8_WAIT_L(8); PG8_BAR; PG8_WAIT_L(0); PG8_MMA(0, 0, At, B0); PG8_BAR; PG8_SCHED;
            PG8_LDB(B1, 0, 1); PG8_STAGE(PG8_SB(0, 0), b2, voffB);
            PG8_BAR; PG8_WAIT_L(0); PG8_MMA(0, 1, At, B1); PG8_BAR;
            PG8_LDA(At, 0, 1); PG8_STAGE(PG8_SA(0, 0), a2, voffA);
            PG8_BAR; PG8_WAIT_L(0); PG8_MMA(1, 0, At, B0); PG8_BAR; PG8_SCHED;
            PG8_STAGE(PG8_SB(0, 1), b2 + hstepB, voffB);
            PG8_WAIT_V(6); PG8_BAR; PG8_MMA(1, 1, At, B1); PG8_BAR;
            PG8_LDB(B0, 1, 0); PG8_SCHED; PG8_LDA(At, 1, 0); PG8_STAGE(PG8_SA(0, 1), a2 + hstepA, voffA);
            PG8_WAIT_L(8); PG8_BAR; PG8_WAIT_L(0); PG8_MMA(0, 0, At, B0); PG8_BAR; PG8_SCHED;
            PG8_LDB(B1, 1, 1); PG8_STAGE(PG8_SB(1, 0), b3, voffB);
            PG8_BAR; PG8_WAIT_L(0); PG8_MMA(0, 1, At, B1); PG8_BAR;
            PG8_LDA(At, 1, 1); PG8_STAGE(PG8_SA(1, 0), a3, voffA);
            PG8_BAR; PG8_WAIT_L(0); PG8_MMA(1, 0, At, B0); PG8_BAR; PG8_SCHED;
            PG8_STAGE(PG8_SB(1, 1), b3 + hstepB, voffB);
            PG8_WAIT_V(6); PG8_BAR; PG8_MMA(1, 1, At, B1); PG8_BAR;
            }
        }
        if constexpr (ALIGN_EPI) { if (wr == 0) PG8_BAR; }
        if constexpr (!Epi::AFTER_DRAIN) { E(acc, cur, wr, wc, fr, fq); S.done(cur); }
        if (!has_next) break;
        if (!Sched::VARK || cur.zero) {
#pragma unroll
        for (int a = 0; a < 2; ++a)
#pragma unroll
            for (int b = 0; b < 2; ++b)
#pragma unroll
                for (int m = 0; m < 4; ++m)
#pragma unroll
                    for (int n = 0; n < 2; ++n) acc[a][b][m][n] = (f32x4){0.f, 0.f, 0.f, 0.f};
        }
        cur = nxt; cA = nA; cB = nB; ++ui;
        if constexpr (Sched::GATHER) { gC[0][0] = gN[0][0]; gC[0][1] = gN[0][1]; gC[1][0] = gN[1][0]; gC[1][1] = gN[1][1]; }
        if constexpr (ALIGN_EPI) { if (wr == 1) PG8_BAR; }
    }
    PG8_WAIT_V(0);
    if constexpr (!ALIGN_EPI) { if (wr == 0) PG8_BAR; }
    PG8_BAR;
    if constexpr (Epi::AFTER_DRAIN) { E.fused(acc, cur, wr, wc, fr, fq, lds, wid, lane); S.done(cur); }
#undef PG8_GOFF
#undef PG8_STAGEA
#undef PG8_STAGEA_SEL
#undef PG8_SA
#undef PG8_SB
#undef PG8_STAGE
#undef PG8_LDA
#undef PG8_LDB
#undef PG8_MMA
#undef PG8_WAIT_V
#undef PG8_WAIT_L
#undef PG8_BAR
#undef PG8_SCHED
}
}

#ifndef ATTN_FAST
#define ATTN_FAST 1
#endif
#include <hip/hip_bf16.h>
#include <cmath>
namespace attn_body {
using bf16=__hip_bfloat16;
using bf16x8=__attribute__((ext_vector_type(8)))short;
using s16x4=__attribute__((ext_vector_type(4)))short;
using f32x16=__attribute__((ext_vector_type(16)))float;
using u32x4=__attribute__((ext_vector_type(4)))unsigned;
constexpr int BATCH=8,SEQ=4096,D=64,DM=2048,DMO=512;
constexpr int NW=8,QBLK=32,QB=QBLK*NW,KVBLK=64,NQB=SEQ/QB;
constexpr int ATTN_PITCH=DM, ATTN_UNIT_ROWS=QB;
__device__ __forceinline__ int crow(int r,int hi){return (r&3)+8*(r>>2)+4*hi;}
#define SBAR() __builtin_amdgcn_sched_barrier(0)
__device__ __forceinline__ void cmask(f32x16&p0,f32x16&p1,int jb,int wid){
  if(jb>(wid>>1)){ const float NEG=-INFINITY;
    #pragma unroll
    for(int r=0;r<16;++r){p0[r]=NEG;p1[r]=NEG;} }
}

constexpr int NSLOT=3, SLOTB=8192;
constexpr int LDS_K=0, LDS_V=NSLOT*SLOTB, LDS_WS=2*NSLOT*SLOTB, LDS_OST=LDS_WS+NW*64*4, LDS_BYTES=LDS_OST+NW*4096;
constexpr float C2=0.125f*1.4426950408889634f;
__device__ __forceinline__ void glds16(const void*gsrc,unsigned lds_dst){unsigned keep;
  asm volatile("s_mov_b32 %0, m0\n\ts_mov_b32 m0, %2\n\ts_nop 0\n\tglobal_load_lds_dwordx4 %1, off\n\ts_mov_b32 m0, %0":"=&s"(keep):"v"(gsrc),"s"(lds_dst):"memory");}
__device__ __forceinline__ float max3f(float a,float b,float c){float r;asm("v_max3_f32 %0, %1, %2, %3":"=v"(r):"v"(a),"v"(b),"v"(c));return r;}
__device__ __forceinline__ float max2f(float a,float b){float r;asm("v_max_f32_e32 %0, %1, %2":"=v"(r):"v"(a),"v"(b));return r;}
__device__ __forceinline__ float fadd_s(float a,float b){float r;asm("v_add_f32_e32 %0, %1, %2":"=v"(r):"v"(a),"v"(b));return r;}
__device__ __forceinline__ float fsub_s(float a,float b){float r;asm("v_sub_f32_e32 %0, %1, %2":"=v"(r):"v"(a),"v"(b));return r;}
typedef float f32x2_t __attribute__((ext_vector_type(2))); typedef __bf16 bf16x2_t __attribute__((ext_vector_type(2)));
__device__ __forceinline__ unsigned cvtpk_s(float lo,float hi){f32x2_t v={lo,hi};bf16x2_t b=__builtin_convertvector(v,bf16x2_t);return __builtin_bit_cast(unsigned,b);}
#define WAIT_BAR(N) asm volatile("s_waitcnt vmcnt(" #N ") lgkmcnt(0)\n\ts_barrier":::"memory")

__device__ __forceinline__ void qkt(f32x16&p0,f32x16&p1,const char*Kslot,const bf16x8*qr,const f32x16&negm,int r32,int hi){
  const char*kb=Kslot+hi*1024+r32*16;
  #pragma unroll
  for(int d0=0;d0<4;++d0){
    const bf16x8 b0=*reinterpret_cast<const bf16x8*>(kb+d0*2048);
    const bf16x8 b1=*reinterpret_cast<const bf16x8*>(kb+d0*2048+512);
    if(d0==0){p0=__builtin_amdgcn_mfma_f32_32x32x16_bf16(b0,qr[0],negm,0,0,0);p1=__builtin_amdgcn_mfma_f32_32x32x16_bf16(b1,qr[0],negm,0,0,0);}
    else{p0=__builtin_amdgcn_mfma_f32_32x32x16_bf16(b0,qr[d0],p0,0,0,0);p1=__builtin_amdgcn_mfma_f32_32x32x16_bf16(b1,qr[d0],p1,0,0,0);}}
}
typedef __attribute__((address_space(3))) const char* lds_cptr;
typedef short v4i16_t __attribute__((ext_vector_type(4)));
__device__ __forceinline__ void kload8(bf16x8*kf,lds_cptr kp){
  kf[0]=*(const __attribute__((address_space(3))) bf16x8*)(kp);      kf[1]=*(const __attribute__((address_space(3))) bf16x8*)(kp+512);
  kf[2]=*(const __attribute__((address_space(3))) bf16x8*)(kp+2048); kf[3]=*(const __attribute__((address_space(3))) bf16x8*)(kp+2560);
  kf[4]=*(const __attribute__((address_space(3))) bf16x8*)(kp+4096); kf[5]=*(const __attribute__((address_space(3))) bf16x8*)(kp+4608);
  kf[6]=*(const __attribute__((address_space(3))) bf16x8*)(kp+6144); kf[7]=*(const __attribute__((address_space(3))) bf16x8*)(kp+6656);
}
__device__ __forceinline__ void kload2(bf16x8*kf,lds_cptr kp,int j){ kf[2*j]=*(const __attribute__((address_space(3))) bf16x8*)(kp+j*2048); kf[2*j+1]=*(const __attribute__((address_space(3))) bf16x8*)(kp+j*2048+512); }
__device__ __forceinline__ s16x4 vtr(lds_cptr p){ return __builtin_bit_cast(s16x4,__builtin_amdgcn_ds_read_tr16_b64_v4i16((__attribute__((address_space(3))) v4i16_t*)p)); }
__device__ __forceinline__ float rowmax(const f32x16&p0,const f32x16&p1){
  float a=max3f(p0[0],p0[1],p1[0]),b=max3f(p0[2],p0[3],p1[1]);a=max3f(a,p1[2],p1[3]);
  #pragma unroll
  for(int r=4;r<16;r+=4){a=max3f(a,p0[r],p0[r+1]);b=max3f(b,p0[r+2],p0[r+3]);a=max3f(a,p1[r],p1[r+1]);b=max3f(b,p1[r+2],p1[r+3]);}
  const float m=max2f(a,b);
  auto rr=__builtin_amdgcn_permlane32_swap(__float_as_uint(m),__float_as_uint(m),false,false);
  return max2f(__uint_as_float(rr[0]),__uint_as_float(rr[1]));
}
__device__ __forceinline__ void pv(f32x16*o,int vb,bf16x8 pa0,bf16x8 pa1,bf16x8 pa2,bf16x8 pa3){
  #pragma unroll
  for(int d0=0;d0<2;++d0){s16x4 lo[4],hi[4];
    #pragma unroll
    for(int ks=0;ks<4;++ks){
      asm volatile("ds_read_b64_tr_b16 %0,%1 offset:%c2":"=&v"(lo[ks]):"v"(vb),"i"(d0*4096+ks*1024):"memory");
      asm volatile("ds_read_b64_tr_b16 %0,%1 offset:%c2":"=&v"(hi[ks]):"v"(vb),"i"(d0*4096+ks*1024+512):"memory");}
    asm volatile("s_waitcnt lgkmcnt(0)":::"memory");SBAR();
    #define PK(k) (bf16x8){lo[k][0],lo[k][1],lo[k][2],lo[k][3],hi[k][0],hi[k][1],hi[k][2],hi[k][3]}
    o[d0]=__builtin_amdgcn_mfma_f32_32x32x16_bf16(pa0,PK(0),o[d0],0,0,0);
    o[d0]=__builtin_amdgcn_mfma_f32_32x32x16_bf16(pa1,PK(1),o[d0],0,0,0);
    o[d0]=__builtin_amdgcn_mfma_f32_32x32x16_bf16(pa2,PK(2),o[d0],0,0,0);
    o[d0]=__builtin_amdgcn_mfma_f32_32x32x16_bf16(pa3,PK(3),o[d0],0,0,0);
    #undef PK
  }
}

#ifndef ATTN_STORE16
#define ATTN_STORE16(p,v) (*(u32x4*)(p)=(v))
#endif
template<int THRL> __device__ __forceinline__ void attn_unit(int b,int qb,const bf16*Q,const bf16*__restrict__ K,const bf16*__restrict__ V,bf16*O,char*shm){
  const int tid=opqv((int)threadIdx.x),lane=tid&63,r32=lane&31,hi=lane>>5; const int wid=__builtin_amdgcn_readfirstlane(tid>>6);
  const long rowbase=(long)b*SEQ; const int q0=qb*QB;
  const bf16*Qw=Q+(rowbase+q0+wid*QBLK)*DM;
  const bf16*Kh=K+rowbase*DM,*Vh=V+rowbase*DM;
  const unsigned lds0=(unsigned)(uintptr_t)shm;
  float*wsf=(float*)(shm+LDS_WS)+wid*64;
  const bf16*ksrc=Kh+(long)lane*DM+wid*8;
  const bf16*vsrc=Vh+(long)(16*(wid&3)+(lane>>2))*DM+(wid>>2)*32+(lane&3)*8;
  const unsigned kdst=lds0+LDS_K+wid*1024, vdst=lds0+LDS_V+wid*1024;
  #define DMA_K(t,slot) glds16(ksrc+(long)(t)*KVBLK*DM,(unsigned)__builtin_amdgcn_readfirstlane(kdst+(slot)))
  #define DMA_V(t,slot) glds16(vsrc+(long)(t)*KVBLK*DM,(unsigned)__builtin_amdgcn_readfirstlane(vdst+(slot)))
  const int vb0=(int)(lds0+LDS_V)+((lane>>4)&1)*32+(lane&3)*8+(4*hi+((lane&15)>>2))*64;
  const char*Kbase=shm+LDS_K; bf16x8 kf[8];
  const lds_cptr shm3=(lds_cptr)shm; const lds_cptr kp0=shm3+LDS_K+hi*1024+r32*16; const lds_cptr vp0=shm3+LDS_V+((lane>>4)&1)*32+(lane&3)*8+(4*hi+((lane&15)>>2))*64;
  const int NT=(q0+QB)/KVBLK;
  DMA_K(0,0);DMA_V(0,0);DMA_K(1,SLOTB);
  bf16x8 qr[4];
  #pragma unroll
  for(int d0=0;d0<4;++d0)qr[d0]=*reinterpret_cast<const bf16x8*>(&Qw[(long)r32*DM+d0*16+hi*8]);
  float mhat=0.f,l_reg=0.f;f32x16 o[2];o[0]=f32x16{};o[1]=f32x16{};f32x16 negm=f32x16{};asm volatile("":"+v"(negm));
  #define CMASK(P0,P1,t) do{int jb_=(t)-(NT-4); if(jb_>=0)cmask(P0,P1,jb_,wid);}while(0)
  bool resc=false;
  #define START(P0,P1) do{ const float rm=rowmax(P0,P1); resc=false; \
    { const float dl=rm; mhat=fadd_s(mhat,dl); \
      _Pragma("unroll") for(int r=0;r<16;++r){P0[r]=fsub_s(P0[r],dl);P1[r]=fsub_s(P1[r],dl);} \
      _Pragma("unroll") for(int r=0;r<16;++r)negm[r]=-mhat; asm volatile("":"+v"(negm)); } \
    _Pragma("unroll") for(int r=0;r<16;++r)P0[r]=__builtin_amdgcn_exp2f(P0[r]); }while(0)
  #define RESC() do{ if(resc){ asm volatile("s_waitcnt lgkmcnt(0)":::"memory"); \
      _Pragma("unroll") for(int d_=0;d_<2;++d_) _Pragma("unroll") for(int r=0;r<16;++r)o[d_][r]*=wsf[crow(r,hi)]; } }while(0)
  f32x16 pA0,pA1,pB0,pB1;
  int sl_prev=0,sl_cur=0,sl_next=SLOTB;
  #define ROT() do{sl_prev=sl_cur;sl_cur=sl_next;sl_next=(sl_next==(NSLOT-1)*SLOTB)?0:sl_next+SLOTB;}while(0)
  DMA_K(2,2*SLOTB);
  WAIT_BAR(3);
  qkt(pA0,pA1,Kbase,qr,negm,r32,hi);asm volatile("s_nop 15\n\ts_nop 7":"+v"(pA0),"+v"(pA1));CMASK(pA0,pA1,0);
  START(pA0,pA1);
  _Pragma("unroll") for(int r=0;r<16;++r)pA1[r]=__builtin_amdgcn_exp2f(pA1[r]);
  WAIT_BAR(0);
  DMA_K(3,0);DMA_V(1,SLOTB);
  ROT();
  kload8(kf,kp0+sl_cur);
  WAIT_BAR(2);
  s16x4 vlo[8],vhi[8]; u32x4 pw0,pw1,pw2,pw3;
  #define PKW(P,B) cvtpk_s(P[B],P[B+1])
  #define PAF(k) __builtin_bit_cast(bf16x8,pw##k)
  #define VFR(i) (bf16x8){vlo[i][0],vlo[i][1],vlo[i][2],vlo[i][3],vhi[i][0],vhi[i][1],vhi[i][2],vhi[i][3]}
  #define PIN(x) asm volatile("":"+v"(x))
  #define MX3(a,b,c) __builtin_fmaxf(__builtin_fmaxf((a),(b)),(c))
  #define GAPA(MF,A0,A1,A2,A3,W0,W1,PW) do{ MF; sacc+=A0; sacc+=A1; sacc+=A2; sacc+=A3; PIN(sacc); W0; W1; PIN(PW); SBAR(); }while(0)
  #define EX(v) __builtin_amdgcn_exp2f(v)
  #define GAPB(MF,X,B) do{ MF; X[B]=EX(X[B]); X[B+1]=EX(X[B+1]); X[B+2]=EX(X[B+2]); X[B+3]=EX(X[B+3]); PIN(X); SBAR(); }while(0)
  #define VRD(i) do{ vlo[i]=vtr(vp_+(((i)>>2)*4096+((i)&3)*1024)); vhi[i]=vtr(vp_+(((i)>>2)*4096+((i)&3)*1024+512)); }while(0)
  #define KRD(G,j) do{ if(G){ kload2(kf,kp0+sl_next,j); SBAR(); } }while(0)
  #define STEP(C0,C1,P0,P1,t,GK,GV,GL) do{ SBAR(); \
    const lds_cptr vp_=vp0+sl_prev; \
    VRD(0); SBAR(); float sacc=(P0[0]+P0[1]); \
    GAPA(C0=__builtin_amdgcn_mfma_f32_32x32x16_bf16(kf[0],qr[0],negm,0,0,0), P0[2],P0[3],P0[4],P0[5],     pw0[0]=PKW(P0,0), pw0[1]=PKW(P0,2), pw0); \
    VRD(4); SBAR(); GAPA(C1=__builtin_amdgcn_mfma_f32_32x32x16_bf16(kf[1],qr[0],negm,0,0,0), P0[6],P0[7],P0[8],P0[9],     pw0[2]=PKW(P0,4), pw0[3]=PKW(P0,6), pw0); \
    VRD(1); SBAR(); GAPA(C0=__builtin_amdgcn_mfma_f32_32x32x16_bf16(kf[2],qr[1],C0,0,0,0),   P0[10],P0[11],P0[12],P0[13], pw1[0]=PKW(P0,8), pw1[1]=PKW(P0,10), pw1); \
    VRD(5); SBAR(); GAPA(C1=__builtin_amdgcn_mfma_f32_32x32x16_bf16(kf[3],qr[1],C1,0,0,0),   P0[14],P0[15],P1[0],P1[1],   pw1[2]=PKW(P0,12),pw1[3]=PKW(P0,14), pw1); \
    VRD(2); SBAR(); GAPA(C0=__builtin_amdgcn_mfma_f32_32x32x16_bf16(kf[4],qr[2],C0,0,0,0),   P1[2],P1[3],P1[4],P1[5],     pw2[0]=PKW(P1,0), pw2[1]=PKW(P1,2), pw2); \
    VRD(6); SBAR(); GAPA(C1=__builtin_amdgcn_mfma_f32_32x32x16_bf16(kf[5],qr[2],C1,0,0,0),   P1[6],P1[7],P1[8],P1[9],     pw2[2]=PKW(P1,4), pw2[3]=PKW(P1,6), pw2); \
    VRD(3); SBAR(); GAPA(C0=__builtin_amdgcn_mfma_f32_32x32x16_bf16(kf[6],qr[3],C0,0,0,0),   P1[10],P1[11],P1[12],P1[13], pw3[0]=PKW(P1,8), pw3[1]=PKW(P1,10), pw3); \
    VRD(7); SBAR(); GAPA(C1=__builtin_amdgcn_mfma_f32_32x32x16_bf16(kf[7],qr[3],C1,0,0,0),   P1[14],P1[15],0.f,0.f,       pw3[2]=PKW(P1,12),pw3[3]=PKW(P1,14), pw3); \
    l_reg+=sacc; \
    if(GK){DMA_K((t)+3,sl_cur);} if(GV){DMA_V((t)+1,sl_next);} \
    CMASK(C0,C1,t); \
    { float a=MX3(C0[0],C0[1],C1[0]),b=MX3(C0[2],C0[3],C1[1]); a=MX3(a,C1[2],C1[3]); \
      _Pragma("unroll") for(int r=4;r<16;r+=4){a=MX3(a,C0[r],C0[r+1]);b=MX3(b,C0[r+2],C0[r+3]);a=MX3(a,C1[r],C1[r+1]);b=MX3(b,C1[r+2],C1[r+3]);} \
      float rm=__builtin_fmaxf(a,b); { auto rr=__builtin_amdgcn_permlane32_swap(__float_as_uint(rm),__float_as_uint(rm),false,false); rm=__builtin_fmaxf(__uint_as_float(rr[0]),__uint_as_float(rr[1])); } \
      resc=false; \
      if(__builtin_expect(__any(rm>(float)THRL),0)){ const float dl=__builtin_fmaxf(rm,0.f); mhat+=dl; \
        _Pragma("unroll") for(int r=0;r<16;++r){C0[r]-=dl;C1[r]-=dl;} \
        _Pragma("unroll") for(int r=0;r<16;++r)negm[r]=-mhat; asm volatile("":"+v"(negm)); \
        const float f=__builtin_amdgcn_exp2f(-dl); l_reg*=f; if(hi==0)wsf[r32]=f; resc=true; } } \
    SBAR(); \
    GAPB(o[0]=__builtin_amdgcn_mfma_f32_32x32x16_bf16(PAF(0),VFR(0),o[0],0,0,0), C0,0); \
    GAPB(o[1]=__builtin_amdgcn_mfma_f32_32x32x16_bf16(PAF(0),VFR(4),o[1],0,0,0), C0,4); \
    KRD(GL,0); GAPB(o[0]=__builtin_amdgcn_mfma_f32_32x32x16_bf16(PAF(1),VFR(1),o[0],0,0,0), C0,8); \
    KRD(GL,1); GAPB(o[1]=__builtin_amdgcn_mfma_f32_32x32x16_bf16(PAF(1),VFR(5),o[1],0,0,0), C0,12); \
    KRD(GL,2); GAPB(o[0]=__builtin_amdgcn_mfma_f32_32x32x16_bf16(PAF(2),VFR(2),o[0],0,0,0), C1,0); \
    KRD(GL,3); GAPB(o[1]=__builtin_amdgcn_mfma_f32_32x32x16_bf16(PAF(2),VFR(6),o[1],0,0,0), C1,4); \
    GAPB(o[0]=__builtin_amdgcn_mfma_f32_32x32x16_bf16(PAF(3),VFR(3),o[0],0,0,0), C1,8); \
    GAPB(o[1]=__builtin_amdgcn_mfma_f32_32x32x16_bf16(PAF(3),VFR(7),o[1],0,0,0), C1,12); \
    }while(0)
  int t=1;
  #undef CMASK
  #define CMASK(P0,P1,t) do{}while(0)
  for(;t+5<NT;t+=2){
    STEP(pB0,pB1,pA0,pA1,t,true,true,true);     WAIT_BAR(2); RESC(); ROT();
    STEP(pA0,pA1,pB0,pB1,t+1,true,true,true);   WAIT_BAR(2); RESC(); ROT();
  }
  #undef CMASK
  #define CMASK(P0,P1,t) do{int jb_=(t)-(NT-4); if(jb_>=0)cmask(P0,P1,jb_,wid);}while(0)
  #define ENDW(tt) do{ if((tt)+3<NT){WAIT_BAR(2);} else if((tt)+2<NT){WAIT_BAR(1);} else {WAIT_BAR(0);} }while(0)
  for(;t+1<NT;t+=2){
    STEP(pB0,pB1,pA0,pA1,t,(t+3<NT),(t+1<NT),(t+1<NT));       ENDW(t);   RESC(); ROT();
    STEP(pA0,pA1,pB0,pB1,t+1,(t+4<NT),(t+2<NT),(t+2<NT));     ENDW(t+1); RESC(); ROT();
  }
  STEP(pB0,pB1,pA0,pA1,NT-1,false,false,false); RESC();
  { float sacc=pB0[0]+pB0[1]; _Pragma("unroll") for(int r=2;r<16;++r)sacc+=pB0[r]; _Pragma("unroll") for(int r=0;r<16;++r)sacc+=pB1[r]; l_reg+=sacc;
    pw0=(u32x4){PKW(pB0,0),PKW(pB0,2),PKW(pB0,4),PKW(pB0,6)};pw1=(u32x4){PKW(pB0,8),PKW(pB0,10),PKW(pB0,12),PKW(pB0,14)};pw2=(u32x4){PKW(pB1,0),PKW(pB1,2),PKW(pB1,4),PKW(pB1,6)};pw3=(u32x4){PKW(pB1,8),PKW(pB1,10),PKW(pB1,12),PKW(pB1,14)};
    SBAR(); pv(o,vb0+sl_cur,PAF(0),PAF(1),PAF(2),PAF(3)); }
  #undef PKW
  #undef PAF
  #undef VFR
  #undef PIN
  #undef MX3
  #undef GAPA
  #undef GAPB
  #undef EX
  #undef VRD
  #undef KRD
  #undef STEP
  #undef ENDW
  {auto rr=__builtin_amdgcn_permlane32_swap(__float_as_uint(l_reg),__float_as_uint(l_reg),false,false);l_reg=__uint_as_float(rr[0])+__uint_as_float(rr[1]);}
  if(hi==0)wsf[32+r32]=l_reg;asm volatile("s_waitcnt lgkmcnt(0)":::"memory");
  float rli[16];
  #pragma unroll
  for(int r=0;r<16;++r)rli[r]=__builtin_amdgcn_rcpf(wsf[32+crow(r,hi)]);
  bf16*Ow=O+(rowbase+q0+wid*QBLK)*DMO;
  { bf16*stg=(bf16*)(shm+LDS_OST)+wid*2048;
    #pragma unroll
    for(int r=0;r<16;++r){const int orow=crow(r,hi);
      #pragma unroll
      for(int d0=0;d0<2;++d0)stg[orow*64+d0*32+r32]=__float2bfloat16(o[d0][r]*rli[r]);}
    asm volatile("s_waitcnt lgkmcnt(0)":::"memory");
    #pragma unroll
    for(int i=0;i<4;++i){const int row=i*8+(lane>>3),ch=lane&7; const u32x4 v=*(const u32x4*)(stg+row*64+ch*8); ATTN_STORE16(Ow+(long)row*DMO+ch*8,v);} }
  asm volatile("s_waitcnt lgkmcnt(0)\n\ts_barrier":::"memory");
  #undef DMA_K
  #undef DMA_V
  #undef CMASK
  #undef START
  #undef RESC
  #undef ROT
}
constexpr int ATTN_LDS_BYTES=LDS_BYTES;
#undef SBAR
#undef WAIT_BAR
}
#ifndef ATTN_V128
#define ATTN_V128 1
#endif
namespace attn128 {
using bf16=__hip_bfloat16;
using bf16x8=__attribute__((ext_vector_type(8)))short;
using s16x4=__attribute__((ext_vector_type(4)))short;
using f32x16=__attribute__((ext_vector_type(16)))float;
using u32x4=__attribute__((ext_vector_type(4)))unsigned;
constexpr int BATCH=8,SEQ=4096,D=64,DM=2048,DMO=512;
constexpr int NW=8,QBLK=32,QB=QBLK*NW,KVBLK=64,NQB=SEQ/QB;
constexpr int ATTN_PITCH=DM, ATTN_UNIT_ROWS=QB;
__device__ __forceinline__ int crow(int r,int hi){return (r&3)+8*(r>>2)+4*hi;}
#define SBAR() __builtin_amdgcn_sched_barrier(0)
__device__ __forceinline__ void cmask(f32x16&p0,f32x16&p1,int jb,int wid){
  if(jb>(wid>>1)){ const float NEG=-INFINITY;
    #pragma unroll
    for(int r=0;r<16;++r){p0[r]=NEG;p1[r]=NEG;} }
}

constexpr int NSLOT=3, SLOTB=8192;
constexpr int VSLOTB=2*SLOTB;
constexpr int LDS_K=0, LDS_V=NSLOT*SLOTB, LDS_WS=LDS_V+NSLOT*VSLOTB, LDS_OST=LDS_WS+NW*64*4, LDS_BYTES=LDS_OST+NW*8192;
constexpr float C2=0.125f*1.4426950408889634f;
__device__ __forceinline__ void glds16(const void*gsrc,unsigned lds_dst){unsigned keep;
  asm volatile("s_mov_b32 %0, m0\n\ts_mov_b32 m0, %2\n\ts_nop 0\n\tglobal_load_lds_dwordx4 %1, off\n\ts_mov_b32 m0, %0":"=&s"(keep):"v"(gsrc),"s"(lds_dst):"memory");}
__device__ __forceinline__ float max3f(float a,float b,float c){float r;asm("v_max3_f32 %0, %1, %2, %3":"=v"(r):"v"(a),"v"(b),"v"(c));return r;}
__device__ __forceinline__ float max2f(float a,float b){float r;asm("v_max_f32_e32 %0, %1, %2":"=v"(r):"v"(a),"v"(b));return r;}
__device__ __forceinline__ float fadd_s(float a,float b){float r;asm("v_add_f32_e32 %0, %1, %2":"=v"(r):"v"(a),"v"(b));return r;}
__device__ __forceinline__ float fsub_s(float a,float b){float r;asm("v_sub_f32_e32 %0, %1, %2":"=v"(r):"v"(a),"v"(b));return r;}
typedef float f32x2_t __attribute__((ext_vector_type(2))); typedef __bf16 bf16x2_t __attribute__((ext_vector_type(2)));
__device__ __forceinline__ unsigned cvtpk_s(float lo,float hi){f32x2_t v={lo,hi};bf16x2_t b=__builtin_convertvector(v,bf16x2_t);return __builtin_bit_cast(unsigned,b);}
#define WAIT_BAR(N) asm volatile("s_waitcnt vmcnt(" #N ") lgkmcnt(0)\n\ts_barrier":::"memory")

__device__ __forceinline__ void qkt(f32x16&p0,f32x16&p1,const char*Kslot,const bf16x8*qr,int r32,int hi){
  const char*kb=Kslot+hi*1024+r32*16;
  #pragma unroll
  for(int d0=0;d0<4;++d0){
    const bf16x8 b0=*reinterpret_cast<const bf16x8*>(kb+d0*2048);
    const bf16x8 b1=*reinterpret_cast<const bf16x8*>(kb+d0*2048+512);
    if(d0==0){p0=__builtin_amdgcn_mfma_f32_32x32x16_bf16(b0,qr[0],f32x16{},0,0,0);p1=__builtin_amdgcn_mfma_f32_32x32x16_bf16(b1,qr[0],f32x16{},0,0,0);}
    else{p0=__builtin_amdgcn_mfma_f32_32x32x16_bf16(b0,qr[d0],p0,0,0,0);p1=__builtin_amdgcn_mfma_f32_32x32x16_bf16(b1,qr[d0],p1,0,0,0);}}
}
typedef __attribute__((address_space(3))) const char* lds_cptr;
typedef short v4i16_t __attribute__((ext_vector_type(4)));
__device__ __forceinline__ void kload8(bf16x8*kf,lds_cptr kp){
  kf[0]=*(const __attribute__((address_space(3))) bf16x8*)(kp);      kf[1]=*(const __attribute__((address_space(3))) bf16x8*)(kp+512);
  kf[2]=*(const __attribute__((address_space(3))) bf16x8*)(kp+2048); kf[3]=*(const __attribute__((address_space(3))) bf16x8*)(kp+2560);
  kf[4]=*(const __attribute__((address_space(3))) bf16x8*)(kp+4096); kf[5]=*(const __attribute__((address_space(3))) bf16x8*)(kp+4608);
  kf[6]=*(const __attribute__((address_space(3))) bf16x8*)(kp+6144); kf[7]=*(const __attribute__((address_space(3))) bf16x8*)(kp+6656);
}
__device__ __forceinline__ void kload2(bf16x8*kf,lds_cptr kp,int j){ kf[2*j]=*(const __attribute__((address_space(3))) bf16x8*)(kp+j*2048); kf[2*j+1]=*(const __attribute__((address_space(3))) bf16x8*)(kp+j*2048+512); }
__device__ __forceinline__ s16x4 vtr(lds_cptr p){ return __builtin_bit_cast(s16x4,__builtin_amdgcn_ds_read_tr16_b64_v4i16((__attribute__((address_space(3))) v4i16_t*)p)); }
__device__ __forceinline__ float rowmax(const f32x16&p0,const f32x16&p1){
  float a=max3f(p0[0],p0[1],p1[0]),b=max3f(p0[2],p0[3],p1[1]);a=max3f(a,p1[2],p1[3]);
  #pragma unroll
  for(int r=4;r<16;r+=4){a=max3f(a,p0[r],p0[r+1]);b=max3f(b,p0[r+2],p0[r+3]);a=max3f(a,p1[r],p1[r+1]);b=max3f(b,p1[r+2],p1[r+3]);}
  const float m=max2f(a,b);
  auto rr=__builtin_amdgcn_permlane32_swap(__float_as_uint(m),__float_as_uint(m),false,false);
  return max2f(__uint_as_float(rr[0]),__uint_as_float(rr[1]));
}
__device__ __forceinline__ void pv(f32x16*o,int vb,bf16x8 pa0,bf16x8 pa1,bf16x8 pa2,bf16x8 pa3){
  #pragma unroll
  for(int d0=0;d0<4;++d0){s16x4 lo[4],hi[4];
    #pragma unroll
    for(int ks=0;ks<4;++ks){
      asm volatile("ds_read_b64_tr_b16 %0,%1 offset:%c2":"=&v"(lo[ks]):"v"(vb),"i"(d0*4096+ks*1024):"memory");
      asm volatile("ds_read_b64_tr_b16 %0,%1 offset:%c2":"=&v"(hi[ks]):"v"(vb),"i"(d0*4096+ks*1024+512):"memory");}
    asm volatile("s_waitcnt lgkmcnt(0)":::"memory");SBAR();
    #define PK(k) (bf16x8){lo[k][0],lo[k][1],lo[k][2],lo[k][3],hi[k][0],hi[k][1],hi[k][2],hi[k][3]}
    o[d0]=__builtin_amdgcn_mfma_f32_32x32x16_bf16(pa0,PK(0),o[d0],0,0,0);
    o[d0]=__builtin_amdgcn_mfma_f32_32x32x16_bf16(pa1,PK(1),o[d0],0,0,0);
    o[d0]=__builtin_amdgcn_mfma_f32_32x32x16_bf16(pa2,PK(2),o[d0],0,0,0);
    o[d0]=__builtin_amdgcn_mfma_f32_32x32x16_bf16(pa3,PK(3),o[d0],0,0,0);
    #undef PK
  }
}

#ifndef ATTN_STORE16
#define ATTN_STORE16(p,v) (*(u32x4*)(p)=(v))
#endif
template<int THRL> __device__ __forceinline__ void attn_unit(int b,int qb,const bf16*Q,const bf16*__restrict__ K,const bf16*__restrict__ V,bf16*O,char*shm){
  const int tid=opqv((int)threadIdx.x),lane=tid&63,r32=lane&31,hi=lane>>5; const int wid=__builtin_amdgcn_readfirstlane(tid>>6);
  const long rowbase=(long)b*SEQ; const int q0=qb*QB;
  const bf16*Qw=Q+(rowbase+q0+wid*QBLK)*DM;
  const bf16*Kh=K+rowbase*DM,*Vh=V+rowbase*DM;
  const unsigned lds0=(unsigned)(uintptr_t)shm;
  float*wsf=(float*)(shm+LDS_WS)+wid*64;
  const bf16*ksrc=Kh+(long)lane*DM+wid*8;
  const bf16*vsrc=Vh+(long)(16*(wid&3)+(lane>>2))*DM+(wid>>2)*32+(lane&3)*8;
  const unsigned kdst=lds0+LDS_K+wid*1024, vdst=lds0+LDS_V+wid*1024;
  #define DMA_K(t,slot) glds16(ksrc+(long)(t)*KVBLK*DM,(unsigned)__builtin_amdgcn_readfirstlane(kdst+(slot)))
  #define DMA_V(t,slot) do{ glds16(vsrc+(long)(t)*KVBLK*DM,(unsigned)__builtin_amdgcn_readfirstlane(vdst+2*(slot))); glds16(vsrc+(long)(t)*KVBLK*DM+64,(unsigned)__builtin_amdgcn_readfirstlane(vdst+2*(slot)+8192)); }while(0)
  const int vb0=(int)(lds0+LDS_V)+((lane>>4)&1)*32+(lane&3)*8+(4*hi+((lane&15)>>2))*64;
  const char*Kbase=shm+LDS_K; bf16x8 kf[8];
  const lds_cptr shm3=(lds_cptr)shm; const lds_cptr kp0=shm3+LDS_K+hi*1024+r32*16; const lds_cptr vp0=shm3+LDS_V+((lane>>4)&1)*32+(lane&3)*8+(4*hi+((lane&15)>>2))*64;
  const int NT=(q0+QB)/KVBLK;
  DMA_K(0,0);DMA_V(0,0);DMA_K(1,SLOTB);
  bf16x8 qr[4];
  #pragma unroll
  for(int d0=0;d0<4;++d0)qr[d0]=*reinterpret_cast<const bf16x8*>(&Qw[(long)r32*DM+d0*16+hi*8]);
  float mhat=0.f,l_reg=0.f;f32x16 o[4];o[0]=f32x16{};o[1]=f32x16{};o[2]=f32x16{};o[3]=f32x16{};
  #define CMASK(P0,P1,t) do{int jb_=(t)-(NT-4); if(jb_>=0)cmask(P0,P1,jb_,wid);}while(0)
  bool resc=false;
  #define START(P0,P1) do{ mhat=rowmax(P0,P1); resc=false; \
    _Pragma("unroll") for(int r=0;r<16;++r)P0[r]=__builtin_amdgcn_exp2f(P0[r]-mhat); }while(0)
  #define RESC() do{ if(resc){ asm volatile("s_waitcnt lgkmcnt(0)":::"memory"); \
      _Pragma("unroll") for(int d_=0;d_<4;++d_) _Pragma("unroll") for(int r=0;r<16;++r)o[d_][r]*=wsf[crow(r,hi)]; } }while(0)
  f32x16 pA0,pA1,pB0,pB1;
  int sl_prev=0,sl_cur=0,sl_next=SLOTB;
  #define ROT() do{sl_prev=sl_cur;sl_cur=sl_next;sl_next=(sl_next==(NSLOT-1)*SLOTB)?0:sl_next+SLOTB;}while(0)
  DMA_K(2,2*SLOTB);
  WAIT_BAR(4);
  qkt(pA0,pA1,Kbase,qr,r32,hi);asm volatile("s_nop 15\n\ts_nop 7":"+v"(pA0),"+v"(pA1));CMASK(pA0,pA1,0);
  START(pA0,pA1);
  _Pragma("unroll") for(int r=0;r<16;++r)pA1[r]=__builtin_amdgcn_exp2f(pA1[r]-mhat);
  WAIT_BAR(0);
  DMA_K(3,0);DMA_V(1,SLOTB);
  ROT();
  kload8(kf,kp0+sl_cur);
  WAIT_BAR(3);
  s16x4 vlo[8],vhi[8]; u32x4 pw0,pw1,pw2,pw3;
  #define PKW(P,B) cvtpk_s(P[B],P[B+1])
  #define PAF(k) __builtin_bit_cast(bf16x8,pw##k)
  #define VFR(i) (bf16x8){vlo[i][0],vlo[i][1],vlo[i][2],vlo[i][3],vhi[i][0],vhi[i][1],vhi[i][2],vhi[i][3]}
  #define PIN(x) asm volatile("":"+v"(x))
  #define MX3(a,b,c) __builtin_fmaxf(__builtin_fmaxf((a),(b)),(c))
  #define GAPA(MF,A0,A1,A2,A3,W0,W1,PW) do{ MF; sacc+=A0; sacc+=A1; sacc+=A2; sacc+=A3; PIN(sacc); W0; W1; PIN(PW); SBAR(); }while(0)
  #define EX(v) __builtin_amdgcn_exp2f((v)-mhat)
  #define GAPB(MF,X,B) do{ MF; X[B]=EX(X[B]); X[B+1]=EX(X[B+1]); X[B+2]=EX(X[B+2]); X[B+3]=EX(X[B+3]); PIN(X); SBAR(); }while(0)
  #define VRD(i) do{ vlo[i]=vtr(vp_+(((i)>>2)*4096+((i)&3)*1024)); vhi[i]=vtr(vp_+(((i)>>2)*4096+((i)&3)*1024+512)); }while(0)
  #define VRD2(i) do{ vlo[i]=vtr(vp_+((((i)>>2)+2)*4096+((i)&3)*1024)); vhi[i]=vtr(vp_+((((i)>>2)+2)*4096+((i)&3)*1024+512)); SBAR(); }while(0)
  #define GAPC(MF) do{ MF; SBAR(); }while(0)
  #define KRD(G,j) do{ if(G){ kload2(kf,kp0+sl_next,j); SBAR(); } }while(0)
  #define STEP(C0,C1,P0,P1,t,GK,GV,GL) do{ SBAR(); \
    const lds_cptr vp_=vp0+2*sl_prev; \
    VRD(0); SBAR(); float sacc=(P0[0]+P0[1]); \
    GAPA(C0=__builtin_amdgcn_mfma_f32_32x32x16_bf16(kf[0],qr[0],f32x16{},0,0,0), P0[2],P0[3],P0[4],P0[5],     pw0[0]=PKW(P0,0), pw0[1]=PKW(P0,2), pw0); \
    VRD(4); SBAR(); GAPA(C1=__builtin_amdgcn_mfma_f32_32x32x16_bf16(kf[1],qr[0],f32x16{},0,0,0), P0[6],P0[7],P0[8],P0[9],     pw0[2]=PKW(P0,4), pw0[3]=PKW(P0,6), pw0); \
    VRD(1); SBAR(); GAPA(C0=__builtin_amdgcn_mfma_f32_32x32x16_bf16(kf[2],qr[1],C0,0,0,0),   P0[10],P0[11],P0[12],P0[13], pw1[0]=PKW(P0,8), pw1[1]=PKW(P0,10), pw1); \
    VRD(5); SBAR(); GAPA(C1=__builtin_amdgcn_mfma_f32_32x32x16_bf16(kf[3],qr[1],C1,0,0,0),   P0[14],P0[15],P1[0],P1[1],   pw1[2]=PKW(P0,12),pw1[3]=PKW(P0,14), pw1); \
    VRD(2); SBAR(); GAPA(C0=__builtin_amdgcn_mfma_f32_32x32x16_bf16(kf[4],qr[2],C0,0,0,0),   P1[2],P1[3],P1[4],P1[5],     pw2[0]=PKW(P1,0), pw2[1]=PKW(P1,2), pw2); \
    VRD(6); SBAR(); GAPA(C1=__builtin_amdgcn_mfma_f32_32x32x16_bf16(kf[5],qr[2],C1,0,0,0),   P1[6],P1[7],P1[8],P1[9],     pw2[2]=PKW(P1,4), pw2[3]=PKW(P1,6), pw2); \
    VRD(3); SBAR(); GAPA(C0=__builtin_amdgcn_mfma_f32_32x32x16_bf16(kf[6],qr[3],C0,0,0,0),   P1[10],P1[11],P1[12],P1[13], pw3[0]=PKW(P1,8), pw3[1]=PKW(P1,10), pw3); \
    VRD(7); SBAR(); GAPA(C1=__builtin_amdgcn_mfma_f32_32x32x16_bf16(kf[7],qr[3],C1,0,0,0),   P1[14],P1[15],0.f,0.f,       pw3[2]=PKW(P1,12),pw3[3]=PKW(P1,14), pw3); \
    l_reg+=sacc; \
    if(GK){DMA_K((t)+3,sl_cur);} if(GV){DMA_V((t)+1,sl_next);} \
    CMASK(C0,C1,t); \
    { float a=MX3(C0[0],C0[1],C1[0]),b=MX3(C0[2],C0[3],C1[1]); a=MX3(a,C1[2],C1[3]); \
      _Pragma("unroll") for(int r=4;r<16;r+=4){a=MX3(a,C0[r],C0[r+1]);b=MX3(b,C0[r+2],C0[r+3]);a=MX3(a,C1[r],C1[r+1]);b=MX3(b,C1[r+2],C1[r+3]);} \
      float rm=__builtin_fmaxf(a,b); { auto rr=__builtin_amdgcn_permlane32_swap(__float_as_uint(rm),__float_as_uint(rm),false,false); rm=__builtin_fmaxf(__uint_as_float(rr[0]),__uint_as_float(rr[1])); } \
      resc=false; rm-=mhat;                                                            \
      if(__builtin_expect(__any(rm>(float)THRL),0)){ const float dl=__builtin_fmaxf(rm,0.f); mhat+=dl; \
        const float f=__builtin_amdgcn_exp2f(-dl); l_reg*=f; if(hi==0)wsf[r32]=f; resc=true; } } \
    SBAR(); \
    GAPB(o[0]=__builtin_amdgcn_mfma_f32_32x32x16_bf16(PAF(0),VFR(0),o[0],0,0,0), C0,0);  VRD2(0); \
    GAPB(o[1]=__builtin_amdgcn_mfma_f32_32x32x16_bf16(PAF(0),VFR(4),o[1],0,0,0), C0,4);  VRD2(4); \
    GAPB(o[0]=__builtin_amdgcn_mfma_f32_32x32x16_bf16(PAF(1),VFR(1),o[0],0,0,0), C0,8);  VRD2(1); \
    GAPB(o[1]=__builtin_amdgcn_mfma_f32_32x32x16_bf16(PAF(1),VFR(5),o[1],0,0,0), C0,12); VRD2(5); \
    GAPB(o[0]=__builtin_amdgcn_mfma_f32_32x32x16_bf16(PAF(2),VFR(2),o[0],0,0,0), C1,0);  VRD2(2); \
    GAPB(o[1]=__builtin_amdgcn_mfma_f32_32x32x16_bf16(PAF(2),VFR(6),o[1],0,0,0), C1,4);  VRD2(6); \
    GAPB(o[0]=__builtin_amdgcn_mfma_f32_32x32x16_bf16(PAF(3),VFR(3),o[0],0,0,0), C1,8);  VRD2(3); \
    GAPB(o[1]=__builtin_amdgcn_mfma_f32_32x32x16_bf16(PAF(3),VFR(7),o[1],0,0,0), C1,12); VRD2(7); \
      \
    GAPC(o[2]=__builtin_amdgcn_mfma_f32_32x32x16_bf16(PAF(0),VFR(0),o[2],0,0,0)); \
    GAPC(o[3]=__builtin_amdgcn_mfma_f32_32x32x16_bf16(PAF(0),VFR(4),o[3],0,0,0)); \
    KRD(GL,0); GAPC(o[2]=__builtin_amdgcn_mfma_f32_32x32x16_bf16(PAF(1),VFR(1),o[2],0,0,0)); \
    KRD(GL,1); GAPC(o[3]=__builtin_amdgcn_mfma_f32_32x32x16_bf16(PAF(1),VFR(5),o[3],0,0,0)); \
    KRD(GL,2); GAPC(o[2]=__builtin_amdgcn_mfma_f32_32x32x16_bf16(PAF(2),VFR(2),o[2],0,0,0)); \
    KRD(GL,3); GAPC(o[3]=__builtin_amdgcn_mfma_f32_32x32x16_bf16(PAF(2),VFR(6),o[3],0,0,0)); \
    GAPC(o[2]=__builtin_amdgcn_mfma_f32_32x32x16_bf16(PAF(3),VFR(3),o[2],0,0,0)); \
    GAPC(o[3]=__builtin_amdgcn_mfma_f32_32x32x16_bf16(PAF(3),VFR(7),o[3],0,0,0)); \
    }while(0)
  int t=1;
  #undef CMASK
  #define CMASK(P0,P1,t) do{}while(0)
  for(;t+5<NT;t+=2){
    STEP(pB0,pB1,pA0,pA1,t,true,true,true);     WAIT_BAR(3); RESC(); ROT();
    STEP(pA0,pA1,pB0,pB1,t+1,true,true,true);   WAIT_BAR(3); RESC(); ROT();
  }
  #undef CMASK
  #define CMASK(P0,P1,t) do{int jb_=(t)-(NT-4); if(jb_>=0)cmask(P0,P1,jb_,wid);}while(0)
  #define ENDW(tt) do{ if((tt)+3<NT){WAIT_BAR(3);} else if((tt)+2<NT){WAIT_BAR(2);} else {WAIT_BAR(0);} }while(0)
  for(;t+1<NT;t+=2){
    STEP(pB0,pB1,pA0,pA1,t,(t+3<NT),(t+1<NT),(t+1<NT));       ENDW(t);   RESC(); ROT();
    STEP(pA0,pA1,pB0,pB1,t+1,(t+4<NT),(t+2<NT),(t+2<NT));     ENDW(t+1); RESC(); ROT();
  }
  STEP(pB0,pB1,pA0,pA1,NT-1,false,false,false); RESC();
  { float sacc=pB0[0]+pB0[1]; _Pragma("unroll") for(int r=2;r<16;++r)sacc+=pB0[r]; _Pragma("unroll") for(int r=0;r<16;++r)sacc+=pB1[r]; l_reg+=sacc;
    pw0=(u32x4){PKW(pB0,0),PKW(pB0,2),PKW(pB0,4),PKW(pB0,6)};pw1=(u32x4){PKW(pB0,8),PKW(pB0,10),PKW(pB0,12),PKW(pB0,14)};pw2=(u32x4){PKW(pB1,0),PKW(pB1,2),PKW(pB1,4),PKW(pB1,6)};pw3=(u32x4){PKW(pB1,8),PKW(pB1,10),PKW(pB1,12),PKW(pB1,14)};
    SBAR(); pv(o,vb0+2*sl_cur,PAF(0),PAF(1),PAF(2),PAF(3)); }
  #undef PKW
  #undef PAF
  #undef VFR
  #undef PIN
  #undef MX3
  #undef GAPA
  #undef GAPB
  #undef EX
  #undef VRD
  #undef VRD2
  #undef GAPC
  #undef KRD
  #undef STEP
  #undef ENDW
  {auto rr=__builtin_amdgcn_permlane32_swap(__float_as_uint(l_reg),__float_as_uint(l_reg),false,false);l_reg=__uint_as_float(rr[0])+__uint_as_float(rr[1]);}
  if(hi==0)wsf[32+r32]=l_reg;asm volatile("s_waitcnt lgkmcnt(0)":::"memory");
  float rli[16];
  #pragma unroll
  for(int r=0;r<16;++r)rli[r]=__builtin_amdgcn_rcpf(wsf[32+crow(r,hi)]);
  bf16*Ow=O+(rowbase+q0+wid*QBLK)*DMO;
  { bf16*stg=(bf16*)(shm+LDS_OST)+wid*4096;
    #pragma unroll
    for(int r=0;r<16;++r){const int orow=crow(r,hi);
      #pragma unroll
      for(int d0=0;d0<4;++d0)stg[orow*128+d0*32+r32]=__float2bfloat16(o[d0][r]*rli[r]);}
    asm volatile("s_waitcnt lgkmcnt(0)":::"memory");
    #pragma unroll
    for(int i=0;i<8;++i){const int row=i*4+(lane>>4),ch=lane&15; const u32x4 v=*(const u32x4*)(stg+row*128+ch*8); ATTN_STORE16(Ow+(long)row*DMO+ch*8,v);} }
  asm volatile("s_waitcnt lgkmcnt(0)\n\ts_barrier":::"memory");
  #undef DMA_K
  #undef DMA_V
  #undef CMASK
  #undef START
  #undef RESC
  #undef ROT
}
constexpr int ATTN_LDS_BYTES=LDS_BYTES;
#undef SBAR
#undef WAIT_BAR
}


constexpr int NB = 8, SEQ = 4096, T = NB * SEQ, D = 1024, DEPTH = 4;
constexpr int ZW = 2048, GWD = 3072, NCAT = ZW + GWD;
constexpr int ZQ = 256, ZK = 768, ZV = 1280, ZC = 1792;
constexpr int NEXP = 32, FF = 512, MAXSLOT = 2 * T + NEXP * 256;
constexpr float NORM_EPS = 1e-6f;
constexpr int NWAVES = 8;
constexpr int PH_PER_LAYER = 11, N_PHASES = 1 + DEPTH * PH_PER_LAYER + 1;

constexpr size_t MiB = 1u << 20;
constexpr size_t WS_CTL = 0, CTL_ZERO_BYTES = 1 * MiB;
constexpr size_t WS_MOD = 1 * MiB;
constexpr size_t WS_LAM = WS_MOD + (size_t)DEPTH * NB * 6144 * 4;
constexpr size_t WS_ROPE_C = 2 * MiB, WS_ROPE_S = 6 * MiB;
constexpr size_t WS_SSM = 10 * MiB;
constexpr size_t SSM_L_BYTES = 8192 + 8192 + 65536;
constexpr size_t WS_RWT = 11 * MiB;
constexpr size_t WS_TOKE = 12 * MiB, WS_TOKW = WS_TOKE + 256 * 1024, WS_TOKL = WS_TOKW + 256 * 1024, WS_TOKS = WS_TOKL + 256 * 1024;
constexpr size_t WS_WGBASE = 13 * MiB, WS_TILEE = WS_WGBASE + 64 * 1024;
constexpr size_t WS_ROWMAP = WS_WGBASE + 128 * 1024;
constexpr size_t WS_E = 14 * MiB, WS_CIN = 18 * MiB;
constexpr size_t WS_WCAT = 24 * MiB;
constexpr size_t WS_WMIX = 64 * MiB;
constexpr size_t WS_WO = 72 * MiB;
constexpr size_t WS_WGLU = 80 * MiB;
constexpr size_t WS_W13 = 82 * MiB;
constexpr size_t WS_W2 = 146 * MiB;
constexpr size_t WS_H = 178 * MiB;
constexpr size_t WS_Z = 242 * MiB;
constexpr size_t WS_G = 370 * MiB;
constexpr size_t WS_O0 = 562 * MiB, WS_O1 = 626 * MiB;
constexpr size_t WS_AMIX = 690 * MiB;
constexpr size_t WS_MIXED = 754 * MiB;
constexpr size_t WS_AG = 242 * MiB;
constexpr size_t WS_ACT = 386 * MiB;
constexpr size_t WS_Y = 458 * MiB;
constexpr size_t WS_XB = 818 * MiB;
constexpr size_t WS_END = 882 * MiB;
static_assert(WS_AG + (size_t)MAXSLOT * 1024 * 2 <= WS_ACT && WS_ACT + (size_t)MAXSLOT * 512 * 2 <= WS_Y && WS_Y + (size_t)MAXSLOT * 1024 * 2 <= WS_AMIX, "moe overlay map");
constexpr int CW_BAR = 4096;
constexpr int CW_CNT = 16384;

constexpr int RING_OFF = 0, RING_BYTES = 159744;
constexpr int LDSCTL_OFF = RING_BYTES, MISC_OFF = LDSCTL_OFF + 320;
constexpr int LDS_BYTES = 163840;

#define GAS __attribute__((address_space(1)))
#define LAS __attribute__((address_space(3)))
typedef unsigned short bf16;
typedef unsigned v4u __attribute__((ext_vector_type(4)));
typedef unsigned v2u __attribute__((ext_vector_type(2)));
typedef float f32x4 __attribute__((ext_vector_type(4)));
typedef float f32x2 __attribute__((ext_vector_type(2)));
typedef short bf16x8 __attribute__((ext_vector_type(8)));
typedef GAS unsigned gu32;
#define RLX_AGENT __ATOMIC_RELAXED, __HIP_MEMORY_SCOPE_AGENT
#define LDS_WAIT() asm volatile("s_waitcnt lgkmcnt(0)" ::: "memory")
#define VM_WAIT() asm volatile("s_waitcnt vmcnt(0)" ::: "memory")
__device__ __forceinline__ unsigned f2bf(float f) { unsigned u = __builtin_bit_cast(unsigned, f); return (u + 0x7fffu + ((u >> 16) & 1u)) >> 16; }
__device__ __forceinline__ unsigned pk2(float lo, float hi) { return f2bf(lo) | (f2bf(hi) << 16); }
__device__ __forceinline__ float bf2f(unsigned short b) { return __uint_as_float(((unsigned)b) << 16); }
__device__ __forceinline__ float bflo(unsigned w) { return __uint_as_float(w << 16); }
__device__ __forceinline__ float bfhi(unsigned w) { return __uint_as_float(w & 0xffff0000u); }

#define XB_TMO      128
#define XB_XCNT(j)  (256  + 64 * (j))
#define XB_XSUB(j)  (1280 + 64 * (j))
#define XB_XGEN(j)  (2304 + 64 * (j))
#define XB_TOP      3328
#define XB_TOPGEN   3392
#define XCD_BAR_WORDS 3456
#define XB_SPIN_CAP (1u << 18)

__device__ __forceinline__ unsigned xb_ld(unsigned* p)              { return __hip_atomic_load(p, __ATOMIC_RELAXED, __HIP_MEMORY_SCOPE_AGENT); }
__device__ __forceinline__ unsigned xb_add(unsigned* p, unsigned v) { return __hip_atomic_fetch_add(p, v, __ATOMIC_RELAXED, __HIP_MEMORY_SCOPE_AGENT); }
__device__ __forceinline__ unsigned xb_xcc_id() { return (unsigned)__builtin_amdgcn_s_getreg((3 << 11) | 20) & 0xFu; }
#define XB_SPIN(cond, bar) do { unsigned _sp = 0; while (cond) { __builtin_amdgcn_s_sleep(1); \
    if ((++_sp & 255u) == 0u) { if (xb_ld(&(bar)[XB_TMO])) break; if (_sp > XB_SPIN_CAP) { atomicAdd(&(bar)[XB_TMO], 1u); break; } } } } while (0)

struct XcdBarrier {
    unsigned* bar; unsigned x;
    volatile LAS unsigned* st;
};

__device__ __forceinline__ XcdBarrier xcd_barrier_post(unsigned* bar, volatile LAS unsigned* st) {
    XcdBarrier b; b.bar = bar; b.x = xb_xcc_id(); b.st = st;
    if (threadIdx.x == 0) (void)xb_add(&bar[XB_XCNT(b.x)], 1u);
    return b;
}
__device__ __forceinline__ void xcd_barrier_complete(unsigned* bar, unsigned x, unsigned& nloc, unsigned& nx) {
    const unsigned G = gridDim.x * gridDim.y * gridDim.z;
    unsigned sum, cnt, mine, sp = 0u;
    for (;;) {
        sum = 0u; cnt = 0u; mine = 0u;
#pragma unroll
        for (unsigned j = 0; j < 16; ++j) { const unsigned c = xb_ld(&bar[XB_XCNT(j)]); sum += c; cnt += (c > 0u) ? 1u : 0u; mine = (j == x) ? c : mine; }
        if (sum == G) break;
        __builtin_amdgcn_s_sleep(1);
        if ((++sp & 255u) == 0u) { if (xb_ld(&bar[XB_TMO])) break; if (sp > XB_SPIN_CAP) { atomicAdd(&bar[XB_TMO], 1u); break; } }
    }
    nloc = mine > 0u ? mine : 1u; nx = cnt > 0u ? cnt : 1u;
}

__device__ __forceinline__ void xcd_barrier(const XcdBarrier& b) {
    asm volatile("s_waitcnt vmcnt(0)" ::: "memory");
    __syncthreads();
    if (threadIdx.x == 0) {
        unsigned* bar = b.bar;
        __builtin_amdgcn_s_waitcnt(0);
        unsigned nloc = b.st[0], nx = b.st[1];
        if (nloc == 0u) { xcd_barrier_complete(bar, b.x, nloc, nx); b.st[0] = nloc; b.st[1] = nx; }
        const unsigned old = xb_add(&bar[XB_XSUB(b.x)], 1u);
        const unsigned gen = old / nloc;
        if (old + 1u == (gen + 1u) * nloc) {
            __builtin_amdgcn_fence(__ATOMIC_RELEASE, "agent");
            asm volatile("s_waitcnt vmcnt(0)" ::: "memory");
            const unsigned og = xb_add(&bar[XB_TOP], 1u);
            const unsigned tg = og / nx;
            if (og + 1u == (tg + 1u) * nx) xb_add(&bar[XB_TOPGEN], 1u);
            else XB_SPIN(xb_ld(&bar[XB_TOPGEN]) == tg, bar);
            __builtin_amdgcn_fence(__ATOMIC_ACQUIRE, "agent");
            xb_add(&bar[XB_XGEN(b.x)], 1u);
            asm volatile("s_waitcnt vmcnt(0)" ::: "memory");
        } else {
            XB_SPIN(xb_ld(&bar[XB_XGEN(b.x)]) == gen, bar);
            __builtin_amdgcn_fence(__ATOMIC_ACQUIRE, "agent");
            asm volatile("s_waitcnt vmcnt(0)" ::: "memory");
        }
    }
    __syncthreads();
}


typedef float f32x2_cv __attribute__((ext_vector_type(2))); typedef __bf16 bf16x2_cv __attribute__((ext_vector_type(2)));
__device__ __forceinline__ unsigned cvtpk(float lo, float hi) { f32x2_cv v = {lo, hi}; bf16x2_cv b = __builtin_convertvector(v, bf16x2_cv); return __builtin_bit_cast(unsigned, b); }
#define DPPF(v, ctrl) __builtin_bit_cast(float, __builtin_amdgcn_update_dpp(0, __builtin_bit_cast(int, (v)), (ctrl), 0xF, 0xF, false))
__device__ __forceinline__ float wave_sum(float v) {
    v += DPPF(v, 0xB1);
    v += DPPF(v, 0x4E);
    v += DPPF(v, 0x141);
    v += DPPF(v, 0x140);
    { auto rr = __builtin_amdgcn_permlane16_swap(__float_as_uint(v), __float_as_uint(v), false, false); v = __uint_as_float(rr[0]) + __uint_as_float(rr[1]); }
    { auto rr = __builtin_amdgcn_permlane32_swap(__float_as_uint(v), __float_as_uint(v), false, false); v = __uint_as_float(rr[0]) + __uint_as_float(rr[1]); }
    return v;
}
__device__ __forceinline__ void wave_sum4(float& a0, float& a1, float& a2, float& a3, int lane) {
    const bool o1 = (lane & 1) != 0, o2 = (lane & 2) != 0;
    float u = o1 ? a1 : a0; const float us = o1 ? a0 : a1; u += DPPF(us, 0xB1);
    float w = o1 ? a3 : a2; const float wsn = o1 ? a2 : a3; w += DPPF(wsn, 0xB1);
    float p = o2 ? w : u; const float ps = o2 ? u : w; p += DPPF(ps, 0x4E);
    p += DPPF(p, 0x124);
    p += DPPF(p, 0x128);
    { auto rr = __builtin_amdgcn_permlane16_swap(__float_as_uint(p), __float_as_uint(p), false, false); p = __uint_as_float(rr[0]) + __uint_as_float(rr[1]); }
    { auto rr = __builtin_amdgcn_permlane32_swap(__float_as_uint(p), __float_as_uint(p), false, false); p = __uint_as_float(rr[0]) + __uint_as_float(rr[1]); }
    a0 = DPPF(p, 0x00); a1 = DPPF(p, 0x55); a2 = DPPF(p, 0xAA); a3 = DPPF(p, 0xFF);
}
__device__ __forceinline__ float wave_max(float v) {
#pragma unroll
    for (int o = 1; o < 64; o <<= 1) v = fmaxf(v, __shfl_xor(v, o));
    return v;
}
__device__ __forceinline__ float sigmoidf_(float x) { return __builtin_amdgcn_rcpf(1.0f + __builtin_amdgcn_exp2f(-1.4426950408889634f * x)); }
__device__ __forceinline__ float gelu_tanh(float x) { const float u = 0.7978845608028654f * (x + 0.044715f * x * x * x); return x * __builtin_amdgcn_rcpf(1.0f + __builtin_amdgcn_exp2f(-2.8853900817779268f * u)); }

__device__ __forceinline__ void tr_item(const float* __restrict__ W, int N, int k0, int n0, bf16* WT, int ldt, int drow0, int dcol0, LAS float* scr, int lane, bool mode16 = false) {
#pragma unroll 1
    for (int hb = 0; hb < 2; ++hb) { f32x4 v[4];
#pragma unroll
      for (int i = 0; i < 4; ++i) v[i] = __builtin_nontemporal_load((const f32x4*)(W + (size_t)(k0 + 8 * (4 * hb + i) + (lane >> 3)) * N + n0 + 4 * (lane & 7)));
#pragma unroll
      for (int i = 0; i < 4; ++i) { LAS float* d = scr + (8 * (4 * hb + i) + (lane >> 3)) * 33 + 4 * (lane & 7); d[0] = v[i].x; d[1] = v[i].y; d[2] = v[i].z; d[3] = v[i].w; } }
    LDS_WAIT(); asm volatile("" ::: "memory");
    const int c = lane & 7;
#pragma unroll
    for (int j = 0; j < 4; ++j) { const int n = (lane >> 3) + 8 * j; const LAS float* s = scr + (8 * c) * 33 + n;
        v4u o; o.x = pk2(s[0 * 33], s[1 * 33]); o.y = pk2(s[2 * 33], s[3 * 33]); o.z = pk2(s[4 * 33], s[5 * 33]); o.w = pk2(s[6 * 33], s[7 * 33]);
        const int c0 = n0 & 255, drow = mode16 ? drow0 + 128 * (j & 1) + 32 * (c0 >> 6) + 16 * ((c0 >> 5) & 1) + 8 * (j >> 1) + (lane >> 3) : drow0 + n;
        *(v4u*)(WT + (size_t)drow * ldt + dcol0 + 8 * c) = o; }
    LDS_WAIT(); asm volatile("" ::: "memory");
}

struct Args { const void* in[40]; float* out; unsigned char* ws; int ph_lo, ph_hi; };

enum { I_X = 0, I_C, I_POS, I_ADAW, I_ADAB, I_N1G, I_WIN, I_POOLW, I_POOLS, I_QNG, I_KNG, I_LQ1, I_LK1, I_LQ2, I_LK2, I_SUBLN,
       I_LAMRE, I_LAMIM, I_LOGDT, I_BRE, I_BIM, I_CRE, I_CIM, I_DSKIP, I_GLUW, I_GLUB, I_PROJA, I_PROJB, I_PROJC, I_GATEW, I_GATEB,
       I_WOUT, I_N2G, I_RGW, I_RGB, I_REW, I_REB, I_W1, I_W3, I_W2 };

__device__ __forceinline__ float lambda_init_of(int l) { return l == 0 ? 0.2f : (l == 1 ? 0.35550906759096926f : (l == 2 ? 0.47071302343358413f : 0.5560582041556841f)); }

__device__ __forceinline__ void prologue_phase(const Args& a, LAS unsigned char* lds) {
    const int z = opq(); (void)z;
    const int tid = opqv((int)threadIdx.x), lane = tid & 63, wave = __builtin_amdgcn_readfirstlane(tid >> 6); const int G = (int)gridDim.x, bx = (int)blockIdx.x;
    const int vcu = (G % 8 == 0) ? (bx % 8) * (G / 8) + bx / 8 : bx; const int gw = vcu * NWAVES + wave, NGW = G * NWAVES, gt = vcu * 512 + tid;
    (void)lane; (void)gw; (void)NGW; (void)gt; (void)bx;
    unsigned char* ws = (a.ws + z);
    const int NGT = G * 512;
    LAS float* scr = (LAS float*)(lds + RING_OFF + wave * 16384);
    {
        constexpr int I_IN = 16 * 64, I_GT = 16 * 96, I_PB = 8 * 32, I_PC = 4 * 32, I_WOI = 16 * 32, I_GL = 4 * 8;
        constexpr int PER_L = I_IN + I_GT + I_PB + I_PC + I_WOI + I_GL;
        for (int it = gw; it < DEPTH * PER_L; it += NGW) {
            const int l = it / PER_L; int r = it - l * PER_L;
            bf16* wcat = (bf16*)(ws + WS_WCAT) + (size_t)l * NCAT * 1024;
            bf16* wmix = (bf16*)(ws + WS_WMIX) + (size_t)l * 1024 * 1024;
            if (r < I_IN) { const int kb = r / 64, nb = r % 64; int drow = nb * 32;
                { const int lg = nb & 7, p = 4 * (lg & 1) + (lg >> 1); drow = (nb & ~7) * 32 + 32 * p; }
                tr_item((const float*)a.in[z + I_WIN] + (size_t)l * 1024 * ZW, ZW, kb * 64, nb * 32, wcat, 1024, drow, kb * 64, scr, lane); continue; } r -= I_IN;
            if (r < I_GT) { const int kb = r / 96, nb = r % 96;
                tr_item((const float*)a.in[z + I_GATEW] + (size_t)l * 1024 * GWD, GWD, kb * 64, nb * 32, wcat, 1024, ZW + (nb & ~7) * 32, kb * 64, scr, lane, true); continue; } r -= I_GT;
            if (r < I_PB) { const int kb = r / 32, nb = r % 32; tr_item((const float*)a.in[z + I_PROJB] + (size_t)l * 512 * 1024, 1024, kb * 64, nb * 32, wmix, 1024, (nb & ~7) * 32, 256 + kb * 64, scr, lane, true); continue; } r -= I_PB;
            if (r < I_PC) { const int kb = r / 32, nb = r % 32; tr_item((const float*)a.in[z + I_PROJC] + (size_t)l * 256 * 1024, 1024, kb * 64, nb * 32, wmix, 1024, (nb & ~7) * 32, 768 + kb * 64, scr, lane, true); continue; } r -= I_PC;
            if (r < I_WOI) { const int kb = r / 32, nb = r % 32; tr_item((const float*)a.in[z + I_WOUT] + (size_t)l * 1024 * 1024, 1024, kb * 64, nb * 32, (bf16*)(ws + WS_WO) + (size_t)l * 1024 * 1024, 1024, nb * 32, kb * 64, scr, lane); continue; } r -= I_WOI;
            { const int kb = r / 8, nb = r % 8; tr_item((const float*)a.in[z + I_GLUW] + (size_t)l * 256 * 256, 256, kb * 64, nb * 32, (bf16*)(ws + WS_WGLU) + (size_t)l * 256 * 256, 256, nb * 32, kb * 64, scr, lane); }
        }
    }
    for (int idx = gt; idx < DEPTH * 256 * 1024; idx += NGT) {
        const int l = idx >> 18, k = (idx >> 10) & 255, n = idx & 1023, g = k >> 6, c = k & 63;
        const float* pw = (const float*)a.in[z + I_POOLW] + ((size_t)(l * 4 + g) * 64 + c) * 64;
        const float* ps = (const float*)a.in[z + I_POOLS] + l * 256 + g * 64;
        const float* pa = (const float*)a.in[z + I_PROJA] + ((size_t)l * 256 + g * 64) * 1024 + n;
        float s = 0.f;
        for (int d = 0; d < 64; ++d) s += pw[d] * ps[d] * pa[(size_t)d * 1024];
        const int cc = n & 255, prow = (n & ~255) + 128 * ((cc >> 3) & 1) + 32 * (cc >> 6) + 8 * ((cc >> 4) & 3) + (cc & 7);
        ((bf16*)(ws + WS_WMIX))[((size_t)l * 1024 + prow) * 1024 + k] = (bf16)f2bf(s);
    }
    for (int idx = gt; idx < T * 32; idx += NGT) {
        const int t = idx >> 5, i = idx & 31;
        const float inv = powf(10000.0f, -(float)(2 * i) / 64.0f);
        const float ang = (float)((const int*)a.in[z + I_POS])[t] * inv;
        ((float*)(ws + WS_ROPE_C))[idx] = cosf(ang); ((float*)(ws + WS_ROPE_S))[idx] = sinf(ang);
    }
    for (int idx = gt; idx < DEPTH * 16 * 64; idx += NGT) {
        const int l = idx >> 10, g = (idx >> 6) & 15, p = idx & 63;
        const float lr = ((const float*)a.in[z + I_LAMRE])[idx], li = ((const float*)a.in[z + I_LAMIM])[idx];
        const float dt = expf(((const float*)a.in[z + I_LOGDT])[l * 16 + g]);
        const float mag = expf(lr * dt), ar = mag * cosf(li * dt), ai = mag * sinf(li * dt);
        const float nr = ar - 1.0f, ni = ai, den = lr * lr + li * li;
        const float kr = (nr * lr + ni * li) / den, ki = (ni * lr - nr * li) / den;
        unsigned char* base = ws + WS_SSM + (size_t)l * SSM_L_BYTES;
        ((f32x2*)base)[g * 64 + p] = (f32x2){ar, ai};
        float pr = ar, pi = ai;
#pragma unroll
        for (int q = 0; q < 6; ++q) { const float tr = pr * pr - pi * pi, ti = 2.0f * pr * pi; pr = tr; pi = ti; }
        ((f32x2*)(base + 8192))[g * 64 + p] = (f32x2){pr, pi};
        const float* br = (const float*)a.in[z + I_BRE] + (size_t)idx * 16; const float* bi = (const float*)a.in[z + I_BIM] + (size_t)idx * 16;
        bf16* bbh = (bf16*)(base + 16384) + (size_t)g * 128 * 16;
        for (int ch = 0; ch < 16; ++ch) { bbh[p * 16 + ch] = (bf16)f2bf(kr * br[ch] - ki * bi[ch]); bbh[(64 + p) * 16 + ch] = (bf16)f2bf(kr * bi[ch] + ki * br[ch]); }
    }
    if (gt < DEPTH) {
        const int l = gt; float s1 = 0.f, s2 = 0.f;
        for (int d = 0; d < 64; ++d) { s1 += ((const float*)a.in[z + I_LQ1])[l * 64 + d] * ((const float*)a.in[z + I_LK1])[l * 64 + d]; s2 += ((const float*)a.in[z + I_LQ2])[l * 64 + d] * ((const float*)a.in[z + I_LK2])[l * 64 + d]; }
        ((float*)(ws + WS_LAM))[l] = expf(s1) - expf(s2) + lambda_init_of(l);
    }
    for (int idx = gt; idx < DEPTH * 36 * 1024; idx += NGT) {
        const int l = idx / (36 * 1024), r = idx - l * 36 * 1024, j = r >> 10, k = r & 1023;
        ((float*)(ws + WS_RWT))[idx] = j < 4 ? ((const float*)a.in[z + I_RGW])[((size_t)l * 1024 + k) * 4 + j] : ((const float*)a.in[z + I_REW])[((size_t)l * 1024 + k) * 32 + (j - 4)];
    }
    {
        LAS float* cact = (LAS float*)(lds + RING_OFF);
        __syncthreads();
        for (int i = tid; i < NB * 1024; i += 512) { const float cv = ((const float*)a.in[z + I_C])[i]; cact[i] = cv * sigmoidf_(cv); }
        __syncthreads();
        const int c4 = tid & 15, kp = tid >> 4;
        for (int u = vcu; u < DEPTH * 96; u += G) {
            const int l = u / 96, cg = u % 96;
            const float* w = (const float*)a.in[z + I_ADAW] + (size_t)l * 1024 * 6144 + cg * 64 + 4 * c4;
            f32x4 acc[NB];
#pragma unroll
            for (int b = 0; b < NB; ++b) acc[b] = (f32x4){0.f, 0.f, 0.f, 0.f};
#pragma unroll 4
            for (int k = kp * 32; k < kp * 32 + 32; ++k) { const f32x4 wv = __builtin_nontemporal_load((const f32x4*)(w + (size_t)k * 6144));
#pragma unroll
                for (int b = 0; b < NB; ++b) acc[b] = acc[b] + wv * cact[b * 1024 + k]; }
            LAS float* red = (LAS float*)(lds + RING_OFF + 32768);
#pragma unroll
            for (int b = 0; b < NB; ++b) *(LAS f32x4*)(red + (kp * NB + b) * 64 + 4 * c4) = acc[b];
            __syncthreads();
            { const int b = tid >> 6, col = tid & 63; float s = 0.f;
#pragma unroll
              for (int q = 0; q < 32; ++q) s += red[(q * NB + b) * 64 + col];
              ((float*)(ws + WS_MOD))[((size_t)l * NB + b) * 6144 + cg * 64 + col] = s + ((const float*)a.in[z + I_ADAB])[l * 6144 + cg * 64 + col]; }
            __syncthreads();
        }
    }
}

__device__ __forceinline__ void moe_weights_phase(const Args& a, int l, LAS unsigned char* lds) {
    const int z = opq(); (void)z;
    const int tid = opqv((int)threadIdx.x), lane = tid & 63, wave = __builtin_amdgcn_readfirstlane(tid >> 6); const int G = (int)gridDim.x, bx = (int)blockIdx.x;
    const int vcu = (G % 8 == 0) ? (bx % 8) * (G / 8) + bx / 8 : bx; const int gw = vcu * NWAVES + wave, NGW = G * NWAVES, gt = vcu * 512 + tid;
    (void)lane; (void)gw; (void)NGW; (void)gt; (void)bx;
    LAS float* scr = (LAS float*)(lds + RING_OFF + wave * 16384);
    bf16* w13 = (bf16*)((a.ws + z) + WS_W13); bf16* w2t = (bf16*)((a.ws + z) + WS_W2);
    for (int it = gw; it < NEXP * 768; it += NGW) {
        const int e = it / 768; int r = it - e * 768;
        if (r < 512) { const int which = r >> 8; r &= 255; const int kb = r >> 4, nb = r & 15, n0 = nb * 32;
            const float* W = (const float*)a.in[which ? I_W3 : I_W1] + ((size_t)l * NEXP + e) * 1024 * 512;
            tr_item(W, 512, kb * 64, n0, w13, 1024, e * 1024 + (n0 >> 7) * 256 + which * 128 + (n0 & 127), kb * 64, scr, lane); }
        else { r -= 512; const int kb = r >> 5, nb = r & 31;
            const float* W = (const float*)a.in[z + I_W2] + ((size_t)l * NEXP + e) * 512 * 1024;
            tr_item(W, 1024, kb * 64, nb * 32, w2t, 512, e * 1024 + nb * 32, kb * 64, scr, lane); }
    }
}

__device__ __forceinline__ void norm1_phase(const Args& a, int l, bool first, bool do_norm) {
    const int z = opq(); (void)z;
    const int tid = opqv((int)threadIdx.x), lane = tid & 63, wave = __builtin_amdgcn_readfirstlane(tid >> 6); const int G = (int)gridDim.x, bx = (int)blockIdx.x;
    const int vcu = (G % 8 == 0) ? (bx % 8) * (G / 8) + bx / 8 : bx; const int gw = vcu * NWAVES + wave, NGW = G * NWAVES;
    unsigned char* ws = (a.ws + z);
    const float* mod = (const float*)(ws + WS_MOD);
    const bf16* Y = (const bf16*)(ws + WS_Y);
    const int* tok_slot = (const int*)(ws + WS_TOKS); const float* tok_w = (const float*)(ws + WS_TOKW);
    bf16* H = (bf16*)(ws + WS_H);
    const float* xin = (const float*)a.in[z + I_X]; bf16* XB = (bf16*)(ws + WS_XB);
#pragma unroll 1
    for (int blk = gw; blk < T / 16; blk += NGW) {
        const int mB = blk * 16, b = mB >> 12;
        f32x4 g2v[4], gnv[4], shv[4], scv[4];
        if (!first) { const float* g2 = mod + ((size_t)(l - 1) * NB + b) * 6144 + 5 * 1024;
#pragma unroll
            for (int q = 0; q < 4; ++q) g2v[q] = *(const f32x4*)(g2 + 512 * (q >> 1) + 8 * lane + 4 * (q & 1)); }
        if (do_norm) { const float* mrow = mod + ((size_t)l * NB + b) * 6144; const float* gn = (const float*)a.in[z + I_N1G] + l * D;
#pragma unroll
            for (int q = 0; q < 4; ++q) { const int co = 512 * (q >> 1) + 8 * lane + 4 * (q & 1); gnv[q] = *(const f32x4*)(gn + co); shv[q] = *(const f32x4*)(mrow + co); scv[q] = *(const f32x4*)(mrow + 1024 + co) + 1.0f; } }
#pragma unroll 1
        for (int r2 = 0; r2 < 16; r2 += 2) {
            f32x4 v[2][4]; v4u yp[2][2], yq[2][2]; float w0[2], w1[2];
            if (first) {
#pragma unroll
            for (int r = 0; r < 2; ++r) { const float* xr = xin + (size_t)(mB + r2 + r) * D;
#pragma unroll
                for (int q = 0; q < 4; ++q) v[r][q] = __builtin_nontemporal_load((const f32x4*)(xr + 512 * (q >> 1) + 8 * lane + 4 * (q & 1))); }
            } else {
#pragma unroll
            for (int r = 0; r < 2; ++r)
#pragma unroll
                for (int hq = 0; hq < 2; ++hq) { const v4u xw = __builtin_nontemporal_load((const v4u*)(XB + (size_t)(mB + r2 + r) * D + 512 * hq + 8 * lane));
                    v[r][2 * hq] = (f32x4){bflo(xw.x), bfhi(xw.x), bflo(xw.y), bfhi(xw.y)}; v[r][2 * hq + 1] = (f32x4){bflo(xw.z), bfhi(xw.z), bflo(xw.w), bfhi(xw.w)}; }
            }
            if (!first) {
#pragma unroll
                for (int r = 0; r < 2; ++r) { const int m = mB + r2 + r; const int s0 = tok_slot[2 * m], s1 = tok_slot[2 * m + 1]; w0[r] = tok_w[2 * m]; w1[r] = tok_w[2 * m + 1];
#pragma unroll
                    for (int hq = 0; hq < 2; ++hq) { yp[r][hq] = __builtin_nontemporal_load((const v4u*)(Y + (size_t)s0 * D + 512 * hq + 8 * lane)); yq[r][hq] = __builtin_nontemporal_load((const v4u*)(Y + (size_t)s1 * D + 512 * hq + 8 * lane)); } }
#pragma unroll
                for (int r = 0; r < 2; ++r)
#pragma unroll
                    for (int hq = 0; hq < 2; ++hq) { const v4u p = yp[r][hq], q = yq[r][hq]; f32x4& va = v[r][2 * hq]; f32x4& vb = v[r][2 * hq + 1]; const f32x4 ga = g2v[2 * hq], gb = g2v[2 * hq + 1];
                        va.x += ga.x * (w0[r] * bflo(p.x) + w1[r] * bflo(q.x)); va.y += ga.y * (w0[r] * bfhi(p.x) + w1[r] * bfhi(q.x));
                        va.z += ga.z * (w0[r] * bflo(p.y) + w1[r] * bflo(q.y)); va.w += ga.w * (w0[r] * bfhi(p.y) + w1[r] * bfhi(q.y));
                        vb.x += gb.x * (w0[r] * bflo(p.z) + w1[r] * bflo(q.z)); vb.y += gb.y * (w0[r] * bfhi(p.z) + w1[r] * bfhi(q.z));
                        vb.z += gb.z * (w0[r] * bflo(p.w) + w1[r] * bflo(q.w)); vb.w += gb.w * (w0[r] * bfhi(p.w) + w1[r] * bfhi(q.w)); }
            }
            if (!first && do_norm) {
#pragma unroll
            for (int r = 0; r < 2; ++r)
#pragma unroll
                for (int hq = 0; hq < 2; ++hq) { const f32x4 xa = v[r][2 * hq], xb = v[r][2 * hq + 1];
                    v4u o; o.x = pk2(xa.x, xa.y); o.y = pk2(xa.z, xa.w); o.z = pk2(xb.x, xb.y); o.w = pk2(xb.z, xb.w);
                    *(v4u*)(XB + (size_t)(mB + r2 + r) * D + 512 * hq + 8 * lane) = o; } }
            if (!do_norm) {
#pragma unroll
            for (int r = 0; r < 2; ++r) { float* xo = (a.out + z) + (size_t)(mB + r2 + r) * D;
#pragma unroll
                for (int q = 0; q < 4; ++q) __builtin_nontemporal_store(v[r][q], (f32x4*)(xo + 512 * (q >> 1) + 8 * lane + 4 * (q & 1))); } }
            if (do_norm) {
#pragma unroll
                for (int r = 0; r < 2; ++r) {
                    float ss = 0.f;
#pragma unroll
                    for (int q = 0; q < 4; ++q) ss += (v[r][q].x * v[r][q].x + v[r][q].y * v[r][q].y) + (v[r][q].z * v[r][q].z + v[r][q].w * v[r][q].w);
                    const float rr = rsqrtf(wave_sum(ss) * (1.0f / D) + NORM_EPS);
#pragma unroll
                    for (int hq = 0; hq < 2; ++hq) { const f32x4 ha = (v[r][2 * hq] * rr * gnv[2 * hq]) * scv[2 * hq] + shv[2 * hq], hb = (v[r][2 * hq + 1] * rr * gnv[2 * hq + 1]) * scv[2 * hq + 1] + shv[2 * hq + 1];
                        v4u o; o.x = pk2(ha.x, ha.y); o.y = pk2(ha.z, ha.w); o.z = pk2(hb.x, hb.y); o.w = pk2(hb.z, hb.w);
                        *(v4u*)(H + (size_t)(mB + r2 + r) * D + 512 * hq + 8 * lane) = o; }
                }
            }
        }
    }
}

__device__ __forceinline__ void qkprep_phase(const Args& a, int l) {
    const int z = opq(); (void)z;
    const int tid = opqv((int)threadIdx.x), lane = tid & 63, wave = __builtin_amdgcn_readfirstlane(tid >> 6); const int G = (int)gridDim.x, bx = (int)blockIdx.x;
    const int vcu = (G % 8 == 0) ? (bx % 8) * (G / 8) + bx / 8 : bx; const int gw = vcu * NWAVES + wave, NGW = G * NWAVES;
    unsigned char* ws = (a.ws + z); bf16* Z = (bf16*)(ws + WS_Z);
    const int sq = lane & 3; const bool isq = lane < 32, lowhalf = sq < 2;
    float gn[16];
    { const float* gp = (const float*)a.in[z + (isq ? I_QNG : I_KNG)] + l * 64 + 16 * sq;
#pragma unroll
      for (int i = 0; i < 16; ++i) gn[i] = gp[i] * (isq ? (ATTN_FAST ? 0.125f * 1.4426950408889634f : 0.125f) : 1.0f); }
    const float* RC = (const float*)(ws + WS_ROPE_C) + 16 * (sq & 1); const float* RS = (const float*)(ws + WS_ROPE_S) + 16 * (sq & 1);
#pragma unroll 1
    for (int m2 = gw; m2 < T / 2; m2 += NGW) {
        v4u w[2][2]; f32x4 cs[2][4], sn[2][4];
#pragma unroll
        for (int r = 0; r < 2; ++r) { const int m = m2 * 2 + r; const v4u* zp = (const v4u*)(Z + (size_t)m * ZW + ZQ) + 2 * lane; w[r][0] = zp[0]; w[r][1] = zp[1];
#pragma unroll
            for (int q = 0; q < 4; ++q) { cs[r][q] = *((const f32x4*)(RC + (size_t)m * 32) + q); sn[r][q] = *((const f32x4*)(RS + (size_t)m * 32) + q); } }
#pragma unroll
        for (int r = 0; r < 2; ++r) { const int m = m2 * 2 + r;
            float x[16];
#pragma unroll
            for (int q = 0; q < 2; ++q) { x[8 * q + 0] = bflo(w[r][q].x); x[8 * q + 1] = bfhi(w[r][q].x); x[8 * q + 2] = bflo(w[r][q].y); x[8 * q + 3] = bfhi(w[r][q].y);
                x[8 * q + 4] = bflo(w[r][q].z); x[8 * q + 5] = bfhi(w[r][q].z); x[8 * q + 6] = bflo(w[r][q].w); x[8 * q + 7] = bfhi(w[r][q].w); }
            float ss = 0.f;
#pragma unroll
            for (int i = 0; i < 16; ++i) ss += x[i] * x[i];
            ss += DPPF(ss, 0xB1); ss += DPPF(ss, 0x4E);
            const float rr = rsqrtf(ss * (1.0f / 64.0f) + NORM_EPS);
            unsigned ow[8];
#pragma unroll
            for (int i = 0; i < 16; i += 2) {
                const float y0 = x[i] * rr * gn[i], y1 = x[i + 1] * rr * gn[i + 1];
                const float p0 = DPPF(y0, 0x4E), p1 = DPPF(y1, 0x4E);
                const float c0 = cs[r][i >> 2][i & 3], c1 = cs[r][i >> 2][(i & 3) + 1], s0 = sn[r][i >> 2][i & 3], s1 = sn[r][i >> 2][(i & 3) + 1];
                const float o0 = lowhalf ? y0 * c0 - p0 * s0 : y0 * c0 + p0 * s0, o1 = lowhalf ? y1 * c1 - p1 * s1 : y1 * c1 + p1 * s1;
                ow[i >> 1] = pk2(o0, o1); }
            v4u* zo = (v4u*)(Z + (size_t)m * ZW + ZQ) + 2 * lane;
            zo[0] = (v4u){ow[0], ow[1], ow[2], ow[3]}; zo[1] = (v4u){ow[4], ow[5], ow[6], ow[7]}; }
    }
}

__device__ __forceinline__ void pool_phase(const Args& a, LAS unsigned char* lds) {
    const int z = opq(); (void)z;
    const int tid = opqv((int)threadIdx.x), lane = tid & 63, wave = __builtin_amdgcn_readfirstlane(tid >> 6); const int G = (int)gridDim.x, bx = (int)blockIdx.x;
    const int vcu = (G % 8 == 0) ? (bx % 8) * (G / 8) + bx / 8 : bx; const int gw = vcu * NWAVES + wave, NGW = G * NWAVES, gt = vcu * 512 + tid;
    (void)lane; (void)gw; (void)NGW; (void)gt; (void)bx;
    const bf16* Z = (const bf16*)((a.ws + z) + WS_Z); bf16* AM = (bf16*)((a.ws + z) + WS_AMIX);
    LAS float* U = (LAS float*)(lds + RING_OFF);
    for (int tl = vcu; tl < T / 64; tl += G) {
        const int m0 = tl * 64, s0 = m0 & (SEQ - 1);
        __syncthreads();
        for (int idx = tid; idx < 80 * 32; idx += 512) { const int r = idx >> 5, c8 = (idx & 31) * 8; const int sp = s0 - 16 + r;
            v4u w = (v4u){0u, 0u, 0u, 0u};
            if (sp >= 0) w = *(const v4u*)(Z + (size_t)(m0 - 16 + r) * ZW + c8);
            LAS float* u = U + r * 256 + c8;
            u[0] = bflo(w.x); u[1] = bfhi(w.x); u[2] = bflo(w.y); u[3] = bfhi(w.y); u[4] = bflo(w.z); u[5] = bfhi(w.z); u[6] = bflo(w.w); u[7] = bfhi(w.w); }
        __syncthreads();
        const int cc = tid & 31, tg = tid >> 5, g = cc >> 3, w = 2 << g;
        const LAS f32x4* U4 = (const LAS f32x4*)U + cc * 2;
        f32x4 sa = (f32x4){0.f, 0.f, 0.f, 0.f}, sb = sa; const int t0 = tg * 4;
        for (int q = 0; q < w; ++q) { sa = sa + U4[(16 + t0 - q) * 64]; sb = sb + U4[(16 + t0 - q) * 64 + 1]; }
#pragma unroll
        for (int i = 0; i < 4; ++i) { const int t = t0 + i;
            if (i > 0) { sa = sa + U4[(16 + t) * 64] - U4[(16 + t - w) * 64]; sb = sb + U4[(16 + t) * 64 + 1] - U4[(16 + t - w) * 64 + 1]; }
            const int cnt = (s0 + t + 1) < w ? (s0 + t + 1) : w; const float rc = 1.0f / (float)cnt;
            const f32x4 ua = U4[(16 + t) * 64], ub = U4[(16 + t) * 64 + 1], oa = sa * rc - ua, ob = sb * rc - ub;
            v4u o; o.x = pk2(oa.x, oa.y); o.y = pk2(oa.z, oa.w); o.z = pk2(ob.x, ob.y); o.w = pk2(ob.z, ob.w);
            *(v4u*)(AM + (size_t)(m0 + t) * D + cc * 8) = o; }
    }
}

__device__ __forceinline__ void load_u16(const bf16* up, float (&u)[16]) {
    const v4u w0 = *(const v4u*)up, w1 = *(const v4u*)(up + 8);
    u[0] = bflo(w0.x); u[1] = bfhi(w0.x); u[2] = bflo(w0.y); u[3] = bfhi(w0.y); u[4] = bflo(w0.z); u[5] = bfhi(w0.z); u[6] = bflo(w0.w); u[7] = bfhi(w0.w);
    u[8] = bflo(w1.x); u[9] = bfhi(w1.x); u[10] = bflo(w1.y); u[11] = bfhi(w1.y); u[12] = bflo(w1.z); u[13] = bfhi(w1.z); u[14] = bflo(w1.w); u[15] = bfhi(w1.w);
}
constexpr int BUP = 68;
typedef short bf16x4_t __attribute__((ext_vector_type(4)));
struct BqT { bf16x4_t v[8]; };
__device__ __forceinline__ bf16x4_t ssm_ld_a(const bf16* zrow0  , int fr, int fq) { return *(const bf16x4_t*)(zrow0 + (size_t)fr * ZW + fq * 4); }
__device__ __forceinline__ void ssm_bu16(const bf16x4_t Af, const bf16x4_t (&Bq)[8], LAS unsigned* BU, int fr, int fq) {
#pragma unroll
    for (int cb = 0; cb < 4; ++cb) { const pg8::f32x4 are = __builtin_amdgcn_mfma_f32_16x16x16bf16_1k(Af, Bq[cb], (pg8::f32x4){0.f, 0.f, 0.f, 0.f}, 0, 0, 0);
        const pg8::f32x4 aim = __builtin_amdgcn_mfma_f32_16x16x16bf16_1k(Af, Bq[cb + 4], (pg8::f32x4){0.f, 0.f, 0.f, 0.f}, 0, 0, 0);
#pragma unroll
        for (int j = 0; j < 4; ++j) BU[(fq * 4 + j) * BUP + cb * 16 + fr] = cvtpk(are[j], aim[j]); }
}
__device__ __forceinline__ void ssm_load_bq(const unsigned char* sb, int g, bf16x4_t (&Bq)[8], int fr, int fq) {
    const bf16* bbh = (const bf16*)(sb + 16384) + (size_t)g * 128 * 16;
#pragma unroll
    for (int cb = 0; cb < 8; ++cb) Bq[cb] = *(const bf16x4_t*)(bbh + (cb * 16 + fr) * 16 + fq * 4);
}
__device__ __forceinline__ void ssm_local_phase(const Args& a, int l, LAS unsigned char* lds) {
    const int z = opq(); (void)z;
    const int tid = opqv((int)threadIdx.x), lane = tid & 63, wave = __builtin_amdgcn_readfirstlane(tid >> 6); const int G = (int)gridDim.x, bx = (int)blockIdx.x;
    const int vcu = (G % 8 == 0) ? (bx % 8) * (G / 8) + bx / 8 : bx; const int gw = vcu * NWAVES + wave, NGW = G * NWAVES;
    unsigned char* ws = (a.ws + z); const bf16* Z = (const bf16*)(ws + WS_Z);
    const unsigned char* sb = ws + WS_SSM + (size_t)l * SSM_L_BYTES;
    f32x2* SL = (f32x2*)(ws + WS_E);
    f32x2* EB = (f32x2*)(ws + WS_CIN);
    LAS unsigned* BU = (LAS unsigned*)(lds + RING_OFF) + wave * (16 * BUP);
    const int fr = lane & 15, fq = lane >> 4;
    __syncthreads();
    for (int w = gw; w < NB * 16 * 16; w += NGW) {
        const int g = w & 15, blk = (w >> 4) & 15, b = w >> 8;
        const f32x2 av = ((const f32x2*)sb)[g * 64 + lane];
        bf16x4_t Bq[8]; ssm_load_bq(sb, g, Bq, fr, fq);
        float xr = 0.f, xi = 0.f;
#pragma unroll 1
        for (int j = 0; j < 4; ++j) { const int c = blk * 4 + j;
            SL[((size_t)(b * 64 + c) * 16 + g) * 64 + lane] = (f32x2){xr, xi};
            const bf16* up = Z + (size_t)(b * SEQ + c * 64) * ZW + ZC + g * 16;
            bf16x4_t Af4[4];
#pragma unroll
            for (int tb = 0; tb < 4; ++tb) Af4[tb] = ssm_ld_a(up + (size_t)(tb * 16) * ZW, fr, fq);
#pragma unroll
            for (int tb = 0; tb < 4; ++tb) {
                ssm_bu16(Af4[tb], Bq, BU, fr, fq);
                LDS_WAIT(); asm volatile("" ::: "memory");
#pragma unroll
                for (int tt = 0; tt < 16; ++tt) { const unsigned bw = BU[tt * BUP + lane];
                    const float nr = av.x * xr - av.y * xi + bflo(bw), ni = av.x * xi + av.y * xr + bfhi(bw); xr = nr; xi = ni; }
                LDS_WAIT(); asm volatile("" ::: "memory");
            } }
        EB[((size_t)(b * 16 + blk) * 16 + g) * 64 + lane] = (f32x2){xr, xi};
    }
}
__device__ __forceinline__ void ssm_carry_phase(const Args& a, int l) {
    const int z = opq(); (void)z;
    const int tid = opqv((int)threadIdx.x), lane = tid & 63, wave = __builtin_amdgcn_readfirstlane(tid >> 6); const int G = (int)gridDim.x, bx = (int)blockIdx.x;
    const int vcu = (G % 8 == 0) ? (bx % 8) * (G / 8) + bx / 8 : bx; const int gw = vcu * NWAVES + wave, NGW = G * NWAVES, gt = vcu * 512 + tid;
    (void)lane; (void)gw; (void)NGW; (void)gt; (void)bx;
    if (gt >= NB * 16 * 64) return;
    unsigned char* ws = (a.ws + z); const unsigned char* sb = ws + WS_SSM + (size_t)l * SSM_L_BYTES;
    const int p = gt & 63, g = (gt >> 6) & 15, b = gt >> 10;
    const f32x2 a64 = ((const f32x2*)(sb + 8192))[g * 64 + p];
    const f32x2* E = (const f32x2*)(ws + WS_E); f32x2* CI = (f32x2*)(ws + WS_CIN);
    float sr = 0.f, si = 0.f;
    for (int c = 0; c < 64; ++c) { const size_t o = ((size_t)((b * 64 + c) * 16 + g)) * 64 + p;
        CI[o] = (f32x2){sr, si}; const f32x2 e = E[o];
        const float nr = a64.x * sr - a64.y * si + e.x, ni = a64.x * si + a64.y * sr + e.y; sr = nr; si = ni; }
}

__device__ __forceinline__ void ssm_final_phase(const Args& a, int l, LAS unsigned char* lds) {
    const int z = opq(); (void)z;
    const int tid = opqv((int)threadIdx.x), lane = tid & 63, wave = __builtin_amdgcn_readfirstlane(tid >> 6); const int G = (int)gridDim.x, bx = (int)blockIdx.x;
    const int vcu = (G % 8 == 0) ? (bx % 8) * (G / 8) + bx / 8 : bx; const int gw = vcu * NWAVES + wave, NGW = G * NWAVES, gt = vcu * 512 + tid;
    (void)lane; (void)gw; (void)NGW; (void)gt; (void)bx;
    unsigned char* ws = (a.ws + z); const bf16* Z = (const bf16*)(ws + WS_Z); bf16* AM = (bf16*)(ws + WS_AMIX);
    const unsigned char* sb = ws + WS_SSM + (size_t)l * SSM_L_BYTES;
    constexpr int YP = 264, XP = 136;
    LAS bf16* Ypre = (LAS bf16*)(lds + RING_OFF);
    LAS bf16* Xb = (LAS bf16*)(lds + RING_OFF + 34816) + wave * (16 * XP);
    LAS unsigned* BU = (LAS unsigned*)(lds + RING_OFF + 69632) + wave * (16 * BUP);
    constexpr int UP = 264; LAS bf16* Ut = (LAS bf16*)(lds + RING_OFF + 104448);
    const int fr = lane & 15, fq = lane >> 4;
    f32x2 av[2], a64[2]; float dsk[2]; bf16x4_t Bq[2][8]; bf16x8 Bf[2][4];
#pragma unroll
    for (int gi = 0; gi < 2; ++gi) { const int g = wave * 2 + gi;
        av[gi] = ((const f32x2*)sb)[g * 64 + lane]; a64[gi] = ((const f32x2*)(sb + 8192))[g * 64 + lane]; dsk[gi] = ((const float*)a.in[z + I_DSKIP])[l * 256 + g * 16 + fr];
        ssm_load_bq(sb, g, Bq[gi], fr, fq);
        const float* cre = (const float*)a.in[z + I_CRE] + ((size_t)(l * 16 + g) * 16 + fr) * 64 + fq * 4; const float* cim = (const float*)a.in[z + I_CIM] + ((size_t)(l * 16 + g) * 16 + fr) * 64 + fq * 4;
#pragma unroll
        for (int ks = 0; ks < 4; ++ks) { const f32x4 cr = *(const f32x4*)(cre + ks * 16), ci = *(const f32x4*)(cim + ks * 16);
#pragma unroll
            for (int q = 0; q < 4; ++q) { Bf[gi][ks][2 * q] = (short)f2bf(cr[q]); Bf[gi][ks][2 * q + 1] = (short)f2bf(-ci[q]); } } }
#pragma unroll 1
    for (int uu = vcu; uu < NB * 64; uu += G) {
        const int b = uu >> 6, c = (uu & 256) ? 63 - (uu & 63) : (uu & 63); const size_t m0 = (size_t)b * SEQ + c * 64;
        { const int row = tid >> 3, sg = tid & 7; const v4u* gp = (const v4u*)(Z + (m0 + row) * ZW + ZC + sg * 32); LAS v4u* lp = (LAS v4u*)(Ut + row * UP + sg * 32);
#pragma unroll
          for (int q = 0; q < 4; ++q) lp[q] = gp[q]; }
        float xr[2] = {0.f, 0.f}, xi[2] = {0.f, 0.f};
        for (int rp_ = 0; rp_ < REPN(15); ++rp_) { xr[0] = xr[1] = xi[0] = xi[1] = 0.f; const int blk = c >> 2, jc = c & 3;
          const f32x2* EBp = (const f32x2*)(ws + WS_CIN) + ((size_t)(b * 16) * 16 + wave * 2) * 64 + lane;
          f32x2 a256[2];
#pragma unroll
          for (int gi = 0; gi < 2; ++gi) { float pr = a64[gi].x, pi = a64[gi].y;
#pragma unroll
              for (int q = 0; q < 2; ++q) { const float tr = pr * pr - pi * pi, ti = 2.0f * pr * pi; pr = tr; pi = ti; }
              a256[gi] = (f32x2){pr, pi}; }
#pragma unroll 4
          for (int q = 0; q < blk; ++q) {
#pragma unroll
              for (int gi = 0; gi < 2; ++gi) { const f32x2 ev = EBp[(size_t)q * 1024 + gi * 64]; const float nr = a256[gi].x * xr[gi] - a256[gi].y * xi[gi] + ev.x, ni = a256[gi].x * xi[gi] + a256[gi].y * xr[gi] + ev.y; xr[gi] = nr; xi[gi] = ni; } }
#pragma unroll
          for (int gi = 0; gi < 2; ++gi) {
              for (int q = 0; q < jc; ++q) { const float nr = a64[gi].x * xr[gi] - a64[gi].y * xi[gi], ni = a64[gi].x * xi[gi] + a64[gi].y * xr[gi]; xr[gi] = nr; xi[gi] = ni; }
              const f32x2 sl = ((const f32x2*)(ws + WS_E))[((size_t)(b * 64 + c) * 16 + wave * 2 + gi) * 64 + lane]; xr[gi] += sl.x; xi[gi] += sl.y; } }
        __syncthreads();
        const float xr0s = xr[0], xi0s = xi[0], xr1s = xr[1], xi1s = xi[1];
#pragma unroll 1
        for (int rq_ = 0; rq_ < REPN(16); ++rq_) { xr[0] = xr0s; xi[0] = xi0s; xr[1] = xr1s; xi[1] = xi1s;
#pragma unroll
        for (int gi = 0; gi < 2; ++gi) {
            const int g = wave * 2 + gi;
#pragma unroll 1
            for (int tb = 0; tb < 4; ++tb) {
                ssm_bu16(*(const LAS bf16x4_t*)(Ut + (tb * 16 + fr) * UP + g * 16 + fq * 4), Bq[gi], BU, fr, fq);
                LDS_WAIT(); asm volatile("" ::: "memory");
                unsigned bw[16];
#pragma unroll
                for (int tt = 0; tt < 16; ++tt) bw[tt] = BU[tt * BUP + lane];
#pragma unroll
                for (int tt = 0; tt < 16; ++tt) {
                    const float nr = av[gi].x * xr[gi] - av[gi].y * xi[gi] + bflo(bw[tt]), ni = av[gi].x * xi[gi] + av[gi].y * xr[gi] + bfhi(bw[tt]); xr[gi] = nr; xi[gi] = ni;
                    ((LAS unsigned*)Xb)[tt * (XP / 2) + lane] = cvtpk(nr, ni); }
                LDS_WAIT(); asm volatile("" ::: "memory");
                pg8::f32x4 acc = {0.f, 0.f, 0.f, 0.f};
#pragma unroll
                for (int ks = 0; ks < 4; ++ks) { const bf16x8 Af = *(const LAS bf16x8*)(Xb + fr * XP + ks * 32 + fq * 8);
                    acc = __builtin_amdgcn_mfma_f32_16x16x32_bf16(Af, Bf[gi][ks], acc, 0, 0, 0); }
#pragma unroll
                for (int j = 0; j < 4; ++j) { const int t = tb * 16 + fq * 4 + j;
                    const float uu2 = bf2f(Ut[t * UP + g * 16 + fr]);
                    Ypre[t * YP + g * 16 + fr] = (bf16)f2bf(gelu_tanh(acc[j] + dsk[gi] * uu2)); }
                LDS_WAIT(); asm volatile("" ::: "memory");
            }
        }
        }
        __syncthreads();
#pragma unroll 1
        for (int rg_ = 0; rg_ < REPN(17); ++rg_)
        { pg8::f32x4 acc[4][2];
#pragma unroll
          for (int rb = 0; rb < 4; ++rb)
#pragma unroll
              for (int nb = 0; nb < 2; ++nb) acc[rb][nb] = (pg8::f32x4){0.f, 0.f, 0.f, 0.f};
          const bf16* wg = (const bf16*)(ws + WS_WGLU) + (size_t)l * 256 * 256;
#pragma unroll 2
          for (int ks = 0; ks < 8; ++ks) {
              bf16x8 Bw[2], Aw[4];
#pragma unroll
              for (int nb = 0; nb < 2; ++nb) Bw[nb] = *(const bf16x8*)(wg + (size_t)(wave * 32 + nb * 16 + fr) * 256 + ks * 32 + fq * 8);
#pragma unroll
              for (int rb = 0; rb < 4; ++rb) Aw[rb] = *(const LAS bf16x8*)(Ypre + (rb * 16 + fr) * YP + ks * 32 + fq * 8);
#pragma unroll
              for (int rb = 0; rb < 4; ++rb)
#pragma unroll
                  for (int nb = 0; nb < 2; ++nb) acc[rb][nb] = __builtin_amdgcn_mfma_f32_16x16x32_bf16(Aw[rb], Bw[nb], acc[rb][nb], 0, 0, 0);
          }
          LAS bf16* Yout = (LAS bf16*)(lds + RING_OFF + 69632);
#pragma unroll
          for (int nb = 0; nb < 2; ++nb) { const int n = wave * 32 + nb * 16 + fr; const float gb = ((const float*)a.in[z + I_GLUB])[l * 256 + n];
#pragma unroll
              for (int rb = 0; rb < 4; ++rb)
#pragma unroll
                  for (int j = 0; j < 4; ++j) { const int t = rb * 16 + fq * 4 + j;
                      const float yv = bf2f(Ypre[t * YP + n]);
                      Yout[t * YP + n] = (bf16)f2bf(yv * sigmoidf_(acc[rb][nb][j] + gb)); } }
          __syncthreads();
          { const int row = tid >> 3, seg = tid & 7; const LAS v4u* sp = (const LAS v4u*)(Yout + row * YP + seg * 32); v4u* dp = (v4u*)(AM + (m0 + row) * D + 768 + seg * 32);
#pragma unroll
            for (int q = 0; q < 4; ++q) dp[q] = sp[q]; }
        }
    }
}

__device__ __forceinline__ void attn_naive_unit(const Args& a, int b, int h, int mp, int cc, LAS unsigned char* lds, int tid, int lane, int wave) {
    const int z = opq();
    const bf16* Z = (const bf16*)((a.ws + z) + WS_Z);
    float* O = (float*)((a.ws + z) + (mp ? WS_O1 : WS_O0));
    const size_t m0 = (size_t)b * SEQ + cc * 64;
    const int qcol = ZQ + h * 128 + mp * 64, kcol = ZK + h * 128 + mp * 64, vcol = ZV + h * 128;
    LAS float* Qs = (LAS float*)(lds + RING_OFF);
    LAS unsigned* Vs = (LAS unsigned*)(lds + RING_OFF + 16384);
    LAS float* Ps = (LAS float*)(lds + RING_OFF + 32768) + wave * 512;
    __syncthreads();
    { const int r = tid >> 3, c8 = (tid & 7) * 8; const v4u w = *(const v4u*)(Z + (m0 + r) * ZW + qcol + c8); LAS float* q = Qs + r * 64 + c8;
      q[0] = bflo(w.x); q[1] = bfhi(w.x); q[2] = bflo(w.y); q[3] = bfhi(w.y); q[4] = bflo(w.z); q[5] = bfhi(w.z); q[6] = bflo(w.w); q[7] = bfhi(w.w); }
    float mrun[8], lrun[8], o0[8], o1[8];
#pragma unroll
    for (int i = 0; i < 8; ++i) { mrun[i] = -1e30f; lrun[i] = 0.f; o0[i] = 0.f; o1[i] = 0.f; }
    const size_t kb0 = (size_t)b * SEQ;
#pragma unroll 1
    for (int kt = 0; kt <= cc; ++kt) {
        __syncthreads();
        { const int key = tid >> 3, part = tid & 7; const bf16* vp = Z + (kb0 + kt * 64 + key) * ZW + vcol + part * 16;
          const v4u w0 = *(const v4u*)vp, w1 = *(const v4u*)(vp + 8); LAS v4u* d = (LAS v4u*)(Vs + key * 64 + part * 8); d[0] = w0; d[1] = w1; }
        float kf[64];
        { const bf16* kp = Z + (kb0 + kt * 64 + lane) * ZW + kcol;
#pragma unroll
          for (int q = 0; q < 8; ++q) { const v4u w = *(const v4u*)(kp + q * 8);
              kf[q * 8 + 0] = bflo(w.x); kf[q * 8 + 1] = bfhi(w.x); kf[q * 8 + 2] = bflo(w.y); kf[q * 8 + 3] = bfhi(w.y);
              kf[q * 8 + 4] = bflo(w.z); kf[q * 8 + 5] = bfhi(w.z); kf[q * 8 + 6] = bflo(w.w); kf[q * 8 + 7] = bfhi(w.w); } }
        __syncthreads();
#pragma unroll
        for (int i = 0; i < 8; ++i) {
            const LAS f32x4* qr = (const LAS f32x4*)(Qs + (wave * 8 + i) * 64);
            float s = 0.f;
#pragma unroll
            for (int d4 = 0; d4 < 16; ++d4) { const f32x4 q4 = qr[d4]; s += q4.x * kf[d4 * 4] + q4.y * kf[d4 * 4 + 1] + q4.z * kf[d4 * 4 + 2] + q4.w * kf[d4 * 4 + 3]; }
            const float mt = wave_max(s), mn = fmaxf(mrun[i], mt), al = __expf(mrun[i] - mn), p = __expf(s - mn);
            lrun[i] = lrun[i] * al + wave_sum(p); o0[i] *= al; o1[i] *= al; mrun[i] = mn;
            Ps[i * 64 + lane] = p;
        }
        LDS_WAIT(); asm volatile("" ::: "memory");
#pragma unroll 4
        for (int j4 = 0; j4 < 16; ++j4) {
            unsigned vw[4];
#pragma unroll
            for (int jj = 0; jj < 4; ++jj) vw[jj] = Vs[(j4 * 4 + jj) * 64 + lane];
#pragma unroll
            for (int i = 0; i < 8; ++i) { const f32x4 p4 = *(const LAS f32x4*)(Ps + i * 64 + j4 * 4);
                o0[i] += p4.x * bflo(vw[0]) + p4.y * bflo(vw[1]) + p4.z * bflo(vw[2]) + p4.w * bflo(vw[3]);
                o1[i] += p4.x * bfhi(vw[0]) + p4.y * bfhi(vw[1]) + p4.z * bfhi(vw[2]) + p4.w * bfhi(vw[3]); }
        }
    }
#pragma unroll
    for (int i = 0; i < 8; ++i) { const float rl = 1.0f / lrun[i];
        *(f32x2*)(O + (m0 + wave * 8 + i) * 512 + h * 128 + lane * 2) = (f32x2){o0[i] * rl, o1[i] * rl}; }
}
__device__ __forceinline__ void attn_naive_phase(const Args& a, LAS unsigned char* lds) {
    const int z = opq(); (void)z;
    const int tid = opqv((int)threadIdx.x), lane = tid & 63, wave = __builtin_amdgcn_readfirstlane(tid >> 6); const int G = (int)gridDim.x, bx = (int)blockIdx.x;
    const int vcu = (G % 8 == 0) ? (bx % 8) * (G / 8) + bx / 8 : bx; const int gw = vcu * NWAVES + wave, NGW = G * NWAVES, gt = vcu * 512 + tid;
    (void)lane; (void)gw; (void)NGW; (void)gt; (void)bx;
    for (int u = vcu; u < 2048; u += G) {
        const int bhm = u >> 5, j = u & 31, b = bhm >> 3, h = (bhm >> 1) & 3, mp = bhm & 1;
        attn_naive_unit(a, b, h, mp, j, lds, tid, lane, wave);
        attn_naive_unit(a, b, h, mp, 63 - j, lds, tid, lane, wave);
    }
}

__device__ __forceinline__ void attn_fast_phase(const Args& a, char* lds_generic) {
    const int z = opq();
    const int G = (int)gridDim.x, bx = (int)blockIdx.x; const int vcu = (G % 8 == 0) ? (bx % 8) * (G / 8) + bx / 8 : bx;
    const attn_body::bf16* Z = (const attn_body::bf16*)((a.ws + z) + WS_Z);
#pragma unroll 1
    for (int p = vcu; p < 1024; p += G) {
        const int stream = (p >> 8) * 32 + ((p & 255) >> 3), j = p & 7;
        const int b = stream >> 4, vh = stream & 15, h = vh >> 2, mp = (vh >> 1) & 1, vhalf = vh & 1;
        const attn_body::bf16* Q = Z + ZQ + h * 128 + mp * 64; const attn_body::bf16* K = Z + ZK + h * 128 + mp * 64; const attn_body::bf16* V = Z + ZV + h * 128 + vhalf * 64;
        attn_body::bf16* O = (attn_body::bf16*)((a.ws + z) + (mp ? WS_O1 : WS_O0)) + h * 128 + vhalf * 64;
#pragma unroll 1
        for (int k2 = 0; k2 < 2; ++k2) attn_body::attn_unit<8>(b, k2 ? 15 - j : j, Q, K, V, O, lds_generic);
    }
}

__device__ __forceinline__ void attn_v128_phase(const Args& a, char* lds_generic) {
    const int z = opq();
    const int G = (int)gridDim.x, bx = (int)blockIdx.x; const int vcu = (G % 8 == 0) ? (bx % 8) * (G / 8) + bx / 8 : bx;
    const attn128::bf16* Z = (const attn128::bf16*)((a.ws + z) + WS_Z);
#pragma unroll 1
    for (int p = vcu; p < 512; p += G) {
        const int stream = (p >> 8) * 32 + ((p & 255) >> 3), j = p & 7;
        const int b = stream >> 3, h = (stream >> 1) & 3, mp = stream & 1;
        const attn128::bf16* Q = Z + ZQ + h * 128 + mp * 64; const attn128::bf16* K = Z + ZK + h * 128 + mp * 64; const attn128::bf16* V = Z + ZV + h * 128;
        attn128::bf16* O = (attn128::bf16*)((a.ws + z) + (mp ? WS_O1 : WS_O0)) + h * 128;
#pragma unroll 1
        for (int k2 = 0; k2 < 2; ++k2) attn128::attn_unit<8>(b, k2 ? 15 - j : j, Q, K, V, O, lds_generic);
    }
}

__device__ __forceinline__ void attn_combine_phase(const Args& a, int l) {
    const int z = opq(); (void)z;
    const int tid = opqv((int)threadIdx.x), lane = tid & 63, wave = __builtin_amdgcn_readfirstlane(tid >> 6); const int G = (int)gridDim.x, bx = (int)blockIdx.x;
    const int vcu = (G % 8 == 0) ? (bx % 8) * (G / 8) + bx / 8 : bx; const int gw = vcu * NWAVES + wave, NGW = G * NWAVES;
    unsigned char* ws = (a.ws + z); const bf16* O0 = (const bf16*)(ws + WS_O0); const bf16* O1 = (const bf16*)(ws + WS_O1); bf16* AM = (bf16*)(ws + WS_AMIX);
    const float lam = ((const float*)(ws + WS_LAM))[l], post = 1.0f - lambda_init_of(l);
    float sg[8];
    { const float* sp = (const float*)a.in[z + I_SUBLN] + l * 128 + 8 * (lane & 15);
#pragma unroll
      for (int i = 0; i < 8; ++i) sg[i] = sp[i] * post; }
#pragma unroll 1
    for (int m4 = gw; m4 < T / 4; m4 += NGW) {
        v4u pw[4], qw[4];
#pragma unroll
        for (int r = 0; r < 4; ++r) { const size_t m = (size_t)m4 * 4 + r; pw[r] = __builtin_nontemporal_load((const v4u*)(O0 + m * 512) + lane); qw[r] = __builtin_nontemporal_load((const v4u*)(O1 + m * 512) + lane); }
#pragma unroll
        for (int r = 0; r < 4; ++r) { const size_t m = (size_t)m4 * 4 + r;
            float d[8];
            d[0] = bflo(pw[r].x) - lam * bflo(qw[r].x); d[1] = bfhi(pw[r].x) - lam * bfhi(qw[r].x); d[2] = bflo(pw[r].y) - lam * bflo(qw[r].y); d[3] = bfhi(pw[r].y) - lam * bfhi(qw[r].y);
            d[4] = bflo(pw[r].z) - lam * bflo(qw[r].z); d[5] = bfhi(pw[r].z) - lam * bfhi(qw[r].z); d[6] = bflo(pw[r].w) - lam * bflo(qw[r].w); d[7] = bfhi(pw[r].w) - lam * bfhi(qw[r].w);
            float ss = 0.f;
#pragma unroll
            for (int i = 0; i < 8; ++i) ss += d[i] * d[i];
            ss += DPPF(ss, 0xB1); ss += DPPF(ss, 0x4E); ss += DPPF(ss, 0x141); ss += DPPF(ss, 0x140);
            const float rr = rsqrtf(ss * (1.0f / 128.0f) + NORM_EPS);
            v4u o; o.x = pk2(d[0] * rr * sg[0], d[1] * rr * sg[1]); o.y = pk2(d[2] * rr * sg[2], d[3] * rr * sg[3]); o.z = pk2(d[4] * rr * sg[4], d[5] * rr * sg[5]); o.w = pk2(d[6] * rr * sg[6], d[7] * rr * sg[7]);
            *((v4u*)(AM + m * D + 256) + lane) = o; }
    }
}

__device__ __forceinline__ void norm2_router_phase(const Args& a, int l, LAS unsigned char* lds, bool do_cnt) {
    const int z = opq(); (void)z;
    const int tid = opqv((int)threadIdx.x), lane = tid & 63, wave = __builtin_amdgcn_readfirstlane(tid >> 6); const int G = (int)gridDim.x, bx = (int)blockIdx.x;
    const int vcu = (G % 8 == 0) ? (bx % 8) * (G / 8) + bx / 8 : bx; const int gw = vcu * NWAVES + wave, NGW = G * NWAVES;
    unsigned char* ws = (a.ws + z);
    const float* mod = (const float*)(ws + WS_MOD); bf16* H = (bf16*)(ws + WS_H);
    int* tok_e = (int*)(ws + WS_TOKE); float* tok_w = (float*)(ws + WS_TOKW); int* tok_l = (int*)(ws + WS_TOKL);
    LAS f32x4* RW4 = (LAS f32x4*)(lds + RING_OFF);
    LAS int* lcnt = (LAS int*)(lds + RING_OFF + 147456);
    LAS float* rbias = (LAS float*)(lds + RING_OFF + 147456 + 128);
    const bf16* XBp = (const bf16*)(ws + WS_XB);
    v4u nx[4][2];
#define P8_PREFETCH(row0) do { _Pragma("unroll") for (int r = 0; r < 4; ++r) { const v4u* xr_ = (const v4u*)(XBp + (size_t)((row0) + r) * D) + lane; nx[r][0] = __builtin_nontemporal_load(xr_); nx[r][1] = __builtin_nontemporal_load(xr_ + 64); } } while (0)
    int blk = gw;
    if (blk < T / 16) P8_PREFETCH(blk * 16);
    __syncthreads();
    { const f32x4* rwt = (const f32x4*)((const float*)(ws + WS_RWT) + (size_t)l * 36 * 1024);
#pragma unroll
      for (int hb = 0; hb < 2; ++hb) { f32x4 t_[9];
#pragma unroll
          for (int k = 0; k < 9; ++k) { const int i = tid + 512 * (hb * 9 + k), q = (i >> 6) & 3; t_[k] = rwt[(i & ~255) + 128 * (q >> 1) + 2 * (i & 63) + (q & 1)]; }
#pragma unroll
          for (int k = 0; k < 9; ++k) RW4[tid + 512 * (hb * 9 + k)] = t_[k]; }
      if (tid < 32) lcnt[tid] = 0;
      if (tid < 36) rbias[tid] = tid < 4 ? ((const float*)a.in[z + I_RGB])[l * 4 + tid] : ((const float*)a.in[z + I_REB])[l * 32 + tid - 4]; }
    __syncthreads();
#pragma unroll 1
    for (; blk < T / 16; blk += NGW) {
      const float* mrow = mod + ((size_t)l * NB + ((blk * 16) >> 12)) * 6144;
      f32x4 gs_[4], shv_[4];
#pragma unroll
      for (int j = 0; j < 4; ++j) { const int c4 = 128 * (j >> 1) + 2 * lane + (j & 1);
          gs_[j] = *((const f32x4*)((const float*)a.in[z + I_N2G] + l * D) + c4) * (*((const f32x4*)(mrow + 4 * 1024) + c4) + 1.0f); shv_[j] = *((const f32x4*)(mrow + 3 * 1024) + c4); }
#pragma unroll 1
      for (int i4 = 0; i4 < 4; ++i4) {
        const int mb = blk * 16 + i4 * 4;
        f32x4 hv[4][4];
#pragma unroll
        for (int r = 0; r < 4; ++r)
#pragma unroll
            for (int hq = 0; hq < 2; ++hq) { const v4u xw = nx[r][hq];
                hv[r][2 * hq] = (f32x4){bflo(xw.x), bfhi(xw.x), bflo(xw.y), bfhi(xw.y)}; hv[r][2 * hq + 1] = (f32x4){bflo(xw.z), bfhi(xw.z), bflo(xw.w), bfhi(xw.w)}; }
        { const int nrow = i4 < 3 ? mb + 4 : (blk + NGW) * 16;
          if (nrow < T) P8_PREFETCH(nrow); }
        { float ss[4];
#pragma unroll
          for (int r = 0; r < 4; ++r) { f32x2 s2 = {0.f, 0.f};
#pragma unroll
              for (int j = 0; j < 4; ++j) { s2 = hv[r][j].xy * hv[r][j].xy + s2; s2 = hv[r][j].zw * hv[r][j].zw + s2; }
              ss[r] = s2.x + s2.y; }
          wave_sum4(ss[0], ss[1], ss[2], ss[3], lane);
#pragma unroll
          for (int r = 0; r < 4; ++r) {
            const float rr = rsqrtf(ss[r] * (1.0f / D) + NORM_EPS);
            v4u* ho = (v4u*)(H + (size_t)(mb + r) * D) + lane;
#pragma unroll
            for (int j = 0; j < 4; ++j) hv[r][j] = (hv[r][j] * rr) * gs_[j] + shv_[j];
#pragma unroll
            for (int hq = 0; hq < 2; ++hq) { const f32x4 ha = hv[r][2 * hq], hb = hv[r][2 * hq + 1];
                v4u o; o.x = pk2(ha.x, ha.y); o.y = pk2(ha.z, ha.w); o.z = pk2(hb.x, hb.y); o.w = pk2(hb.z, hb.w); ho[64 * hq] = o; }
          } }
        float gl[4][4];
        { f32x2 s2[4][4];
#pragma unroll
          for (int r = 0; r < 4; ++r)
#pragma unroll
              for (int j = 0; j < 4; ++j) s2[r][j] = (f32x2){0.f, 0.f};
#pragma unroll
          for (int j = 0; j < 4; ++j)
#pragma unroll
              for (int q = 0; q < 4; ++q) { const f32x4 w = RW4[j * 256 + 64 * q + lane];
#pragma unroll
                  for (int r = 0; r < 4; ++r) { s2[r][j] = hv[r][q].xy * w.xy + s2[r][j]; s2[r][j] = hv[r][q].zw * w.zw + s2[r][j]; } }
#pragma unroll
          for (int r = 0; r < 4; ++r) {
#pragma unroll
              for (int j = 0; j < 4; ++j) gl[r][j] = s2[r][j].x + s2[r][j].y;
              wave_sum4(gl[r][0], gl[r][1], gl[r][2], gl[r][3], lane); } }
#pragma unroll
        for (int r = 0; r < 4; ++r) {
#pragma unroll
            for (int j = 0; j < 4; ++j) gl[r][j] += rbias[j];
            int gi = 0; float gm = gl[r][0];
#pragma unroll
            for (int j = 1; j < 4; ++j) if (gl[r][j] > gm) { gm = gl[r][j]; gi = j; }
            float gs = 0.f;
#pragma unroll
            for (int j = 0; j < 4; ++j) gs += __expf(gl[r][j] - gm);
            const float pg = __builtin_amdgcn_rcpf(gs);
            gi = __builtin_amdgcn_readfirstlane(gi);
            float el[8];
            { f32x2 s2[8];
#pragma unroll
              for (int j = 0; j < 8; ++j) { s2[j] = (f32x2){0.f, 0.f}; const LAS f32x4* wrow = RW4 + (4 + gi * 8 + j) * 256 + lane;
#pragma unroll
                  for (int q = 0; q < 4; ++q) { const f32x4 w = wrow[64 * q]; s2[j] = hv[r][q].xy * w.xy + s2[j]; s2[j] = hv[r][q].zw * w.zw + s2[j]; }
                  el[j] = s2[j].x + s2[j].y; }
              wave_sum4(el[0], el[1], el[2], el[3], lane); wave_sum4(el[4], el[5], el[6], el[7], lane); }
#pragma unroll
            for (int j = 0; j < 8; ++j) el[j] += rbias[4 + gi * 8 + j];
            int e0 = 0; float m0v = el[0];
#pragma unroll
            for (int j = 1; j < 8; ++j) if (el[j] > m0v) { m0v = el[j]; e0 = j; }
            int e1 = -1; float m1v = -3.0e38f;
#pragma unroll
            for (int j = 0; j < 8; ++j) if (j != e0 && el[j] > m1v) { m1v = el[j]; e1 = j; }
            if (e1 < 0) { e1 = (e0 + 1) & 7; m1v = el[0]; }
            const float x1 = __expf(m1v - m0v), w0 = pg * __builtin_amdgcn_rcpf(1.0f + x1), w1 = w0 * x1;
            if (lane == 0) {
                const int m = mb + r, ea = gi * 8 + e0, eb = gi * 8 + e1;
                typedef int i32x2 __attribute__((ext_vector_type(2)));
                const int l0 = __hip_atomic_fetch_add(&lcnt[ea], 1, __ATOMIC_RELAXED, __HIP_MEMORY_SCOPE_WORKGROUP), l1 = __hip_atomic_fetch_add(&lcnt[eb], 1, __ATOMIC_RELAXED, __HIP_MEMORY_SCOPE_WORKGROUP);
                *(i32x2*)(tok_e + 2 * m) = (i32x2){ea, eb}; *(f32x2*)(tok_w + 2 * m) = (f32x2){w0, w1}; *(i32x2*)(tok_l + 2 * m) = (i32x2){l0, l1};
            }
        }
      }
    }
#undef P8_PREFETCH
    __syncthreads();
    if (tid < 32 && do_cnt) { const int c = lcnt[tid];
        const unsigned old = __hip_atomic_fetch_add((unsigned*)(ws + WS_CTL) + CW_CNT + l * 64 + tid, (unsigned)c, RLX_AGENT);
        ((int*)(ws + WS_WGBASE))[bx * 32 + tid] = (int)old; }
}

__device__ __forceinline__ void moe_scatter_phase(const Args& a, int l, LAS unsigned char* lds) {
    const int z = opq(); (void)z;
    const int tid = opqv((int)threadIdx.x), lane = tid & 63, wave = __builtin_amdgcn_readfirstlane(tid >> 6); const int G = (int)gridDim.x, bx = (int)blockIdx.x;
    const int vcu = (G % 8 == 0) ? (bx % 8) * (G / 8) + bx / 8 : bx; const int gw = vcu * NWAVES + wave, NGW = G * NWAVES;
    unsigned char* ws = (a.ws + z);
    LAS int* pst = (LAS int*)(lds + RING_OFF);
    LAS int* pend = pst + 32;
    int* rowmap = (int*)(ws + WS_ROWMAP);
    __syncthreads();
    if (tid == 0) {
        int run = 0; int* tile_e = (int*)(ws + WS_TILEE);
        for (int e = 0; e < NEXP; ++e) { const int c = (int)__hip_atomic_load((unsigned*)(ws + WS_CTL) + CW_CNT + l * 64 + e, RLX_AGENT); const int pad = (c + 255) & ~255;
            pst[e] = run + ((const int*)(ws + WS_WGBASE))[bx * 32 + e]; pend[e] = run + c; pend[32 + e] = run + pad;
            if (bx == 0) for (int q = 0; q < (pad >> 8); ++q) tile_e[(run >> 8) + q] = e;
            run += pad; }
        if (bx == 0) tile_e[511] = run >> 8;
    }
    __syncthreads();
    { const int e = bx & 31; for (int s = pend[e] + tid; s < pend[32 + e]; s += 512) rowmap[s] = 0; }
    const int* tok_e = (const int*)(ws + WS_TOKE); const int* tok_l = (const int*)(ws + WS_TOKL); int* tok_s = (int*)(ws + WS_TOKS);
    for (int m4b = gw * 4; m4b < T / 4; m4b += NGW * 4) {
        if (lane < 32) { const int m = m4b * 4 + (lane >> 1), k = lane & 1;
            const int s = pst[tok_e[2 * m + k]] + tok_l[2 * m + k]; tok_s[2 * m + k] = s; rowmap[s] = m; }
    }
}

__device__ __forceinline__ void stagger_delay(int steps, int ticks_per_step) {
    const unsigned long long t0 = __builtin_amdgcn_s_memrealtime(), want = (unsigned long long)(steps * ticks_per_step);
    while (__builtin_amdgcn_s_memrealtime() - t0 < want) __builtin_amdgcn_s_sleep(8);
}
__global__ void __launch_bounds__(NWAVES * 64, 2) fwd(Args args) {
    extern __shared__ __attribute__((aligned(16))) unsigned char lds_raw[];
    LAS unsigned char* lds = (LAS unsigned char*)lds_raw;
    for (int u = threadIdx.x; u < (LDS_BYTES - LDSCTL_OFF) / 4; u += NWAVES * 64) ((LAS unsigned*)(lds + LDSCTL_OFF))[u] = 0u;
    __syncthreads();
#if MK_MULTI
#define GRID_BAR() do { } while (0)
#else
    XcdBarrier bar = xcd_barrier_post((unsigned*)(args.ws + WS_CTL) + CW_BAR, (volatile LAS unsigned*)(lds + MISC_OFF) + 8);
#define GRID_BAR() xcd_barrier(bar)
#endif
    const int lo = args.ph_lo, hi = args.ph_hi;
#ifndef PHMASK
#define PHMASK 0xFFFF
#endif
#define EN(p) (((PHMASK) >> (p)) & 1)
#ifndef REPMASK
#define REPMASK 0
#endif
#define REPEAT(b) _Pragma("unroll 1") for (int rep_ = 0; rep_ < ((((REPMASK) >> (b)) & 1) ? 2 : 1); ++rep_)
#define IN(k) (lo <= (k) && (k) < hi)
#define SEAM(k) do { if (IN(k) && IN((k) + 1)) { GRID_BAR(); if (((REPMASK) >> 14) & 1) GRID_BAR(); } } while (0)

    if (EN(11) && IN(0)) { REPEAT(11) prologue_phase(args, lds); SEAM(0); }

#pragma unroll 1
    for (int l = 0; l < DEPTH; ++l) {
        const int pb = 1 + l * PH_PER_LAYER;
        if (EN(0) && IN(pb + 0)) { norm1_phase(args, l, l == 0, true); REPEAT(0) moe_weights_phase(args, l, lds); SEAM(pb + 0); }
        if (EN(1) && IN(pb + 1)) { unsigned char* ws = args.ws + opq(); const int G = (int)gridDim.x, bx = (int)blockIdx.x;
            pg8::Gemm g{(const pg8::bf16_t*)(ws + WS_H), (const pg8::bf16_t*)(ws + WS_WCAT) + (size_t)l * NCAT * 1024, 1024, 1024, 1024}; pg8::StaticOrder S; S.init(T, NCAT, G, bx);
            pg8::EpiZG E{(pg8::bf16_t*)(ws + WS_Z), (unsigned char*)(ws + WS_G), (const float*)args.in[opq() + I_GATEB] + l * GWD,
                         (const float*)args.in[opq() + I_QNG] + l * 64, (const float*)args.in[opq() + I_KNG] + l * 64, (const float*)(ws + WS_ROPE_C), (const float*)(ws + WS_ROPE_S)};
#ifdef STAGGER_P2
            stagger_delay((int)(blockIdx.x >> 3) & 7, STAGGER_P2);
#endif
            REPEAT(1) pg8::gemm_phase<pg8::EpiZG, pg8::StaticOrder, true, true>(lds + RING_OFF, g, S, E);
            SEAM(pb + 1);
        }
        if (EN(3) && IN(pb + 3)) {
            REPEAT(2) { pool_phase(args, lds); ssm_local_phase(args, l, lds); }
            __syncthreads();
#if ATTN_FAST
#if ATTN_V128
            REPEAT(3) attn_v128_phase(args, (char*)lds_raw + RING_OFF);
#else
            REPEAT(3) attn_fast_phase(args, (char*)lds_raw + RING_OFF);
#endif
#else
            attn_naive_phase(args, lds);
#endif
            SEAM(pb + 3); }
        if (EN(4) && IN(pb + 4)) { REPEAT(12) attn_combine_phase(args, l); REPEAT(4) ssm_final_phase(args, l, lds); SEAM(pb + 4); }
        if (EN(5) && IN(pb + 5)) { unsigned char* ws = args.ws + opq(); const int G = (int)gridDim.x, bx = (int)blockIdx.x;
            const pg8::bf16_t* am = (const pg8::bf16_t*)(ws + WS_AMIX); pg8::bf16_t* mx = (pg8::bf16_t*)(ws + WS_MIXED); const unsigned char* gt_ = (const unsigned char*)(ws + WS_G);
            const pg8::bf16_t* wmix = (const pg8::bf16_t*)(ws + WS_WMIX) + (size_t)l * 1024 * 1024;
            pg8::StaticOrder S; S.init(T, D, G, bx);
            { pg8::Gemm g{am, wmix, 1024, 1024, 1024}; pg8::EpiMixFused E{mx, gt_}; pg8::MixOrder MS{S};
              REPEAT(5) pg8::gemm_phase<pg8::EpiMixFused, pg8::MixOrder, true, true>(lds + RING_OFF, g, MS, E); }
            SEAM(pb + 5);
        }
        if (EN(6) && IN(pb + 6)) { unsigned char* ws = args.ws + opq(); const int G = (int)gridDim.x, bx = (int)blockIdx.x;
            pg8::Gemm g{(const pg8::bf16_t*)(ws + WS_MIXED), (const pg8::bf16_t*)(ws + WS_WO) + (size_t)l * 1024 * 1024, 1024, 1024, 1024}; pg8::StaticOrder S; S.init(T, D, G, bx);
            REPEAT(6) { pg8::bf16_t* xb = (pg8::bf16_t*)(ws + WS_XB); pg8::bf16_t* xo = xb; if (rep_ + 1 < REPN(6)) xo = (pg8::bf16_t*)(ws + WS_O0);
            const float* g1 = (const float*)(ws + WS_MOD) + (size_t)l * NB * 6144 + 2 * 1024;
            if (l == 0) { pg8::EpiResid<true> E{(const float*)args.in[opq() + I_X], xb, g1, xo};
                pg8::gemm_phase<pg8::EpiResid<true>, pg8::StaticOrder, true, true>(lds + RING_OFF, g, S, E); }
            else { pg8::EpiResid<false> E{nullptr, xb, g1, xo};
                pg8::gemm_phase<pg8::EpiResid<false>, pg8::StaticOrder, true, true>(lds + RING_OFF, g, S, E); } }
            SEAM(pb + 6);
        }
        if (EN(7) && IN(pb + 7)) { REPEAT(7) norm2_router_phase(args, l, lds, rep_ == ((((REPMASK) >> 7) & 1) ? 1 : 0)); SEAM(pb + 7); }
        if (EN(8) && IN(pb + 8)) { REPEAT(8) moe_scatter_phase(args, l, lds); SEAM(pb + 8); }
        if (EN(9) && IN(pb + 9)) { unsigned char* ws = args.ws + opq(); const int G = (int)gridDim.x, bx = (int)blockIdx.x; const int vcu = (G % 8 == 0) ? (bx % 8) * (G / 8) + bx / 8 : bx;
            const int* tile_e = (const int*)(ws + WS_TILEE);
            pg8::GatherOrder S{tile_e, (const int*)(ws + WS_ROWMAP), __builtin_amdgcn_readfirstlane(tile_e[511]), G, vcu};
            pg8::Gemm g{(const pg8::bf16_t*)(ws + WS_H), (const pg8::bf16_t*)(ws + WS_W13), 1024, 1024, 1024};
            pg8::EpiSwiGLU E{(pg8::bf16_t*)(ws + WS_ACT)};
            REPEAT(9) pg8::gemm_phase<pg8::EpiSwiGLU, pg8::GatherOrder, true, true>(lds + RING_OFF, g, S, E);
            SEAM(pb + 9);
        }
        if (EN(10) && IN(pb + 10)) { unsigned char* ws = args.ws + opq(); const int G = (int)gridDim.x, bx = (int)blockIdx.x; const int vcu = (G % 8 == 0) ? (bx % 8) * (G / 8) + bx / 8 : bx;
            const int* tile_e = (const int*)(ws + WS_TILEE);
            pg8::GroupedOrder S{tile_e, __builtin_amdgcn_readfirstlane(tile_e[511]), G, vcu};
            pg8::Gemm g{(const pg8::bf16_t*)(ws + WS_ACT), (const pg8::bf16_t*)(ws + WS_W2), 512, 512, 512};
            pg8::EpiY E{(pg8::bf16_t*)(ws + WS_Y)};
            REPEAT(10) pg8::gemm_phase<pg8::EpiY, pg8::GroupedOrder, true, true>(lds + RING_OFF, g, S, E);
            SEAM(pb + 10);
        }
    }
    if (EN(12) && IN(N_PHASES - 1)) norm1_phase(args, DEPTH, false, false);
#undef IN
#undef SEAM
}

extern "C" void kernel_launch(void* const* d_in, const int* in_sizes, int n_in, void* d_out, int out_size, void* d_ws, size_t ws_size, hipStream_t stream) {
    static int grid = 0;
    if (grid == 0) {
        if (n_in != 40 || out_size != T * D || ws_size < WS_END) { fprintf(stderr, "kernel_launch: unexpected shapes (n_in %d out %d ws %zu)\n", n_in, out_size, ws_size); grid = -1; return; }
        int dev = 0, cus = 0, per_cu = 0;
        if (hipGetDevice(&dev) != hipSuccess || hipDeviceGetAttribute(&cus, hipDeviceAttributeMultiprocessorCount, dev) != hipSuccess) { grid = -1; return; }
        if (hipFuncSetAttribute((const void*)fwd, hipFuncAttributeMaxDynamicSharedMemorySize, LDS_BYTES) != hipSuccess) { fprintf(stderr, "kernel_launch: hipFuncSetAttribute failed\n"); grid = -1; return; }
        if (hipOccupancyMaxActiveBlocksPerMultiprocessor(&per_cu, (const void*)fwd, NWAVES * 64, LDS_BYTES) != hipSuccess || per_cu < 1) fprintf(stderr, "kernel_launch: occupancy query says %d\n", per_cu);
        (void)hipGetLastError();
        grid = cus;
    }
    if (grid < 0) return;
    if (hipMemsetAsync((char*)d_ws + WS_CTL, 0, CTL_ZERO_BYTES, stream) != hipSuccess) return;
    Args a{};
    for (int i = 0; i < 40; ++i) a.in[i] = d_in[i];
    a.out = (float*)d_out; a.ws = (unsigned char*)d_ws;
#if MK_MULTI
    for (int p = 0; p < N_PHASES; ++p) { a.ph_lo = p; a.ph_hi = p + 1; hipLaunchKernelGGL(fwd, dim3(grid), dim3(NWAVES * 64), LDS_BYTES, stream, a); }
#else
    a.ph_lo = 0; a.ph_hi = N_PHASES;
    hipLaunchKernelGGL(fwd, dim3(grid), dim3(NWAVES * 64), LDS_BYTES, stream, a);
#endif
}
```

```cpp
#include <hip/hip_runtime.h>
#include <cstdio>
#include <cstdint>

#ifndef REPMASK
#define REPMASK 0
#endif
#define REPN(b) ((((REPMASK) >> (b)) & 1) ? 2 : 1)
#ifndef MK_MULTI
#define MK_MULTI 0
#endif

__device__ __forceinline__ int opqv(int x) { asm volatile("" : "+v"(x)); return x; }
__device__ __forceinline__ int opq() { int z = 0; asm volatile("" : "+s"(z)); return z; }
namespace pg8 {
#define PG8_LAS __attribute__((address_space(3)))
typedef unsigned short bf16_t;
typedef short bf16x8 __attribute__((ext_vector_type(8)));
typedef float f32x4 __attribute__((ext_vector_type(4)));
typedef unsigned u32x4 __attribute__((ext_vector_type(4)));
typedef unsigned u32x2 __attribute__((ext_vector_type(2)));
constexpr int BM = 256, BK = 64, HALF = 128, HTB = HALF * BK * 2  , STAGE_BYTES = 8 * HTB, NXCD = 8, WGM = 8;

__host__ __device__ __forceinline__ int lds_byte(int r, int c) { const int st = (r >> 4) * 2 + (c >> 5), rr = r & 15, cc = c & 31, ob = rr * 64 + cc * 2; return st * 1024 + (ob ^ (((ob >> 9) & 1) << 5)); }
__host__ __device__ __forceinline__ void stage_rc(int b, int& R, int& C) { const int st = b / 1024, sb = b % 1024, swz = sb ^ (((sb >> 9) & 1) << 5); R = (st >> 1) * 16 + swz / 64; C = (st & 1) * 32 + (swz % 64) / 2; }
__host__ __device__ __forceinline__ int perm32(int rho) { const int n = rho >> 4, i = rho & 15; return 8 * (i >> 2) + 4 * n + (i & 3); }

struct Unit { int pm, pn, pb, seg, koff, nt, zero; };
struct Gemm { const bf16_t* A; const bf16_t* Bt; int lda, ldb, K; };

struct StaticOrder {
    static constexpr bool VARK = false, GATHER = false;
    int nM, nN, nwg, G, c;
    __host__ __device__ void init(int M, int N, int G_, int c_) { nM = M / BM; nN = N / BM; nwg = nM * nN; G = G_; c = c_; }
    __host__ __device__ bool next(int i, Unit& u) const {
        const long L = (long)i * G + c; if (L >= nwg) return false;
        int wgid = (int)L; { const int q = nwg / NXCD, r = nwg % NXCD, xcd = wgid % NXCD, off = wgid / NXCD; wgid = (xcd < r ? xcd * (q + 1) : r * (q + 1) + (xcd - r) * q) + off; }
        const int nig = WGM * nN, gid = wgid / nig, fm = gid * WGM, gsz = (nM - fm) < WGM ? (nM - fm) : WGM;
        u.pm = fm + ((wgid % nig) % gsz); u.pn = (wgid % nig) / gsz; u.pb = u.pn; return true;
    }
    __device__ __forceinline__ void a_ready(const Unit&) const {}
    __device__ __forceinline__ void done(const Unit&) const {}
};
struct GroupedOrder {
    static constexpr bool VARK = false, GATHER = false;
    const int* tile_e; int ntiles, G, c;
    __device__ __forceinline__ bool next(int i, Unit& u) const {
        const long L = (long)i * G + c; if (L >= (long)ntiles * 4) return false;
        const int pm = (int)(L >> 2), pl = (int)(L & 3);
        u.pm = pm; u.pn = pl; u.pb = __builtin_amdgcn_readfirstlane(tile_e[pm]) * 4 + pl; return true;
    }
    __device__ __forceinline__ void a_ready(const Unit&) const {}
    __device__ __forceinline__ void done(const Unit&) const {}
};

struct GatherOrder {
    static constexpr bool VARK = false, GATHER = true;
    const int* tile_e; const int* rowmap; int ntiles, G, c;
    __device__ __forceinline__ bool next(int i, Unit& u) const {
        const long L = (long)i * G + c; if (L >= (long)ntiles * 4) return false;
        const int pm = (int)(L >> 2), pl = (int)(L & 3);
        u.pm = pm; u.pn = pl; u.pb = __builtin_amdgcn_readfirstlane(tile_e[pm]) * 4 + pl; return true;
    }
    __device__ __forceinline__ void a_ready(const Unit&) const {}
    __device__ __forceinline__ void done(const Unit&) const {}
};
struct MixOrder {
    static constexpr bool VARK = true, GATHER = false;
    StaticOrder so;
    __device__ __forceinline__ bool next(int i, Unit& u) const { const int bi = i / 3, seg = i - bi * 3; if (!so.next(bi, u)) return false;
        u.seg = seg; u.koff = seg == 0 ? 0 : (seg == 1 ? 256 : 768); u.nt = seg == 1 ? 8 : 4; u.zero = seg == 2; return true; }
    __device__ __forceinline__ void a_ready(const Unit&) const {}
    __device__ __forceinline__ void done(const Unit&) const {}
};

__device__ __forceinline__ unsigned cvt_pk_bf16(float lo, float hi) { unsigned r; asm volatile("v_cvt_pk_bf16_f32 %0, %1, %2" : "=v"(r) : "v"(lo), "v"(hi)); return r; }
__device__ __forceinline__ float bflo(unsigned w) { return __uint_as_float(w << 16); }
__device__ __forceinline__ float bfhi(unsigned w) { return __uint_as_float(w & 0xffff0000u); }
__device__ __forceinline__ float sigmoidf_(float x) { return __builtin_amdgcn_rcpf(1.0f + __builtin_amdgcn_exp2f(-1.4426950408889634f * x)); }


struct EpiZG {
    static constexpr bool PERM = true, AFTER_DRAIN = false, MIDHOOK = false;
    bf16_t* Z; unsigned char* G8; const float* gbias;
    const float* qg; const float* kg; const float* ropec; const float* ropes;
    __device__ __forceinline__ void operator()(const f32x4 (&acc)[2][2][4][2], const Unit& u, int wr, int wc, int fr, int fq) const {
        asm volatile("" : "+v"(fr), "+v"(fq));
        const int row0 = u.pm * BM + wr * 64 + fr;
        if (u.pn >= 1 && u.pn <= 4) {
            const int vec = (u.pn - 1) * 4 + wc; const bool isq = vec < 8;
            const float* gsrc = isq ? qg : kg; const float sc = isq ? 0.125f * 1.4426950408889634f : 1.0f;
            f32x4 gv[2][2];
#pragma unroll
            for (int bj = 0; bj < 2; ++bj)
#pragma unroll
                for (int n = 0; n < 2; ++n) gv[bj][n] = *(const f32x4*)(gsrc + 32 * bj + 8 * fq + 4 * n) * sc;
#pragma unroll
            for (int ai = 0; ai < 2; ++ai)
#pragma unroll
                for (int m = 0; m < 4; ++m) { const size_t row = (size_t)(row0 + ai * HALF + m * 16);
                    float ss = 0.f;
#pragma unroll
                    for (int bj = 0; bj < 2; ++bj)
#pragma unroll
                        for (int n = 0; n < 2; ++n) { const f32x4 x = acc[ai][bj][m][n]; ss += (x[0] * x[0] + x[1] * x[1]) + (x[2] * x[2] + x[3] * x[3]); }
                    { auto rr = __builtin_amdgcn_permlane16_swap(__float_as_uint(ss), __float_as_uint(ss), false, false); ss = __uint_as_float(rr[0]) + __uint_as_float(rr[1]); }
                    { auto rr = __builtin_amdgcn_permlane32_swap(__float_as_uint(ss), __float_as_uint(ss), false, false); ss = __uint_as_float(rr[0]) + __uint_as_float(rr[1]); }
                    const float rs = __builtin_amdgcn_rsqf(ss * (1.0f / 64.0f) + 1e-6f);
                    f32x4 o[2][2];
#pragma unroll
                    for (int n = 0; n < 2; ++n) { const f32x4 c = *(const f32x4*)(ropec + row * 32 + 8 * fq + 4 * n), s = *(const f32x4*)(ropes + row * 32 + 8 * fq + 4 * n);
                        const f32x4 y0 = acc[ai][0][m][n] * rs * gv[0][n], y1 = acc[ai][1][m][n] * rs * gv[1][n];
                        o[0][n] = y0 * c - y1 * s; o[1][n] = y1 * c + y0 * s; }
                    bf16_t* rowp = Z + row * 2048 + 256 + vec * 64 + 8 * fq;
#pragma unroll
                    for (int bj = 0; bj < 2; ++bj) { u32x4 w; w.x = cvt_pk_bf16(o[bj][0][0], o[bj][0][1]); w.y = cvt_pk_bf16(o[bj][0][2], o[bj][0][3]); w.z = cvt_pk_bf16(o[bj][1][0], o[bj][1][1]); w.w = cvt_pk_bf16(o[bj][1][2], o[bj][1][3]);
                        *(u32x4*)(rowp + 32 * bj) = w; }
                    if (m == 3) asm volatile("" ::: "memory"); }
            return;
        }
        if (u.pn >= 8) {
            const int col0 = (u.pn - 8) * BM + wc * 64 + 16 * fq;
            f32x4 bc[2][2];
#pragma unroll
            for (int bj = 0; bj < 2; ++bj)
#pragma unroll
                for (int n = 0; n < 2; ++n) bc[bj][n] = *(const f32x4*)(gbias + col0 + 8 * bj + 4 * n) * (-1.4426950408889634f) - 7.994353436858858f;
#pragma unroll
            for (int ai = 0; ai < 2; ++ai)
#pragma unroll
                for (int m = 0; m < 4; ++m) { u32x4 w;
#pragma unroll
                    for (int bj = 0; bj < 2; ++bj)
#pragma unroll
                        for (int n = 0; n < 2; ++n) { const f32x4 v = acc[ai][bj][m][n] * (-1.4426950408889634f) + bc[bj][n]; unsigned pw = 0u;
#pragma unroll
                            for (int j = 0; j < 4; ++j) pw = __builtin_amdgcn_cvt_pk_u8_f32(fmaxf(__builtin_rintf(__builtin_amdgcn_rcpf(__builtin_amdgcn_exp2f(v[j]) + (1.0f / 255.0f))), 1.0f), j, pw);
                            w[bj * 2 + n] = pw; }
                    *(u32x4*)(G8 + (size_t)(row0 + ai * HALF + m * 16) * 3072 + col0) = w; }
            return;
        }
        const int colt = u.pn * BM;
        const int col0 = colt + wc * 64 + 8 * fq;
#pragma unroll
        for (int ai = 0; ai < 2; ++ai)
#pragma unroll
            for (int m = 0; m < 4; ++m) { bf16_t* rowp = Z + (size_t)(row0 + ai * HALF + m * 16) * 2048 + col0;
#pragma unroll
                for (int bj = 0; bj < 2; ++bj) { const f32x4 v0 = acc[ai][bj][m][0], v1 = acc[ai][bj][m][1];
                    u32x4 w; w.x = cvt_pk_bf16(v0[0], v0[1]); w.y = cvt_pk_bf16(v0[2], v0[3]); w.z = cvt_pk_bf16(v1[0], v1[1]); w.w = cvt_pk_bf16(v1[2], v1[3]);
                    *(u32x4*)(rowp + bj * 32) = w; } }
    }
};
struct EpiMix {
    static constexpr bool PERM = true, AFTER_DRAIN = false, MIDHOOK = false;
    bf16_t* O; const bf16_t* Gt; int gcol0; bool first;
    __device__ __forceinline__ void operator()(const f32x4 (&acc)[2][2][4][2], const Unit& u, int wr, int wc, int fr, int fq) const {
        asm volatile("" : "+v"(fr), "+v"(fq));
        const int row0 = u.pm * BM + wr * 64 + fr, col0 = u.pn * BM + wc * 32 + 8 * fq;
#pragma unroll
        for (int ai = 0; ai < 2; ++ai)
#pragma unroll
            for (int m = 0; m < 4; ++m) { const size_t row = (size_t)(row0 + ai * HALF + m * 16);
#pragma unroll
                for (int bj = 0; bj < 2; ++bj) {
                    const u32x4 gw = *(const u32x4*)(Gt + row * 3072 + gcol0 + col0 + bj * HALF);
                    bf16_t* op = O + row * 1024 + col0 + bj * HALF;
                    f32x4 v0 = acc[ai][bj][m][0], v1 = acc[ai][bj][m][1];
                    v0[0] *= bflo(gw.x); v0[1] *= bfhi(gw.x); v0[2] *= bflo(gw.y); v0[3] *= bfhi(gw.y);
                    v1[0] *= bflo(gw.z); v1[1] *= bfhi(gw.z); v1[2] *= bflo(gw.w); v1[3] *= bfhi(gw.w);
                    if (!first) { const u32x4 pw = *(const u32x4*)op;
                        v0[0] += bflo(pw.x); v0[1] += bfhi(pw.x); v0[2] += bflo(pw.y); v0[3] += bfhi(pw.y);
                        v1[0] += bflo(pw.z); v1[1] += bfhi(pw.z); v1[2] += bflo(pw.w); v1[3] += bfhi(pw.w); }
                    u32x4 w; w.x = cvt_pk_bf16(v0[0], v0[1]); w.y = cvt_pk_bf16(v0[2], v0[3]); w.z = cvt_pk_bf16(v1[0], v1[1]); w.w = cvt_pk_bf16(v1[2], v1[3]);
                    *(u32x4*)op = w; }
                asm volatile("" ::: "memory"); }
    }
};
struct EpiMixFused {
    static constexpr bool PERM = true, AFTER_DRAIN = false, MIDHOOK = false;
    bf16_t* O; const unsigned char* G8;
    __device__ __forceinline__ static void gld(const unsigned char* p, float (&g)[2][2][4]) { const u32x4 w = *(const u32x4*)p;
#pragma unroll
        for (int q = 0; q < 4; ++q) { const unsigned d = w[q]; g[q >> 1][q & 1][0] = (float)(d & 0xffu); g[q >> 1][q & 1][1] = (float)((d >> 8) & 0xffu); g[q >> 1][q & 1][2] = (float)((d >> 16) & 0xffu); g[q >> 1][q & 1][3] = (float)(d >> 24); } }
    __device__ __forceinline__ void operator()(f32x4 (&acc)[2][2][4][2], const Unit& u, int wr, int wc, int fr, int fq) const {
        asm volatile("" : "+v"(fr), "+v"(fq));
        const int row0 = u.pm * BM + wr * 64 + fr, col0 = u.pn * BM + wc * 64 + 16 * fq;
        if (u.seg < 2) {
#pragma unroll
            for (int ai = 0; ai < 2; ++ai)
#pragma unroll
                for (int m = 0; m < 4; ++m) { const unsigned char* gp = G8 + (size_t)(row0 + ai * HALF + m * 16) * 3072 + u.seg * 1024 + col0;
                    float gn[2][2][4], gd[2][2][4]; gld(gp, gn); gld(gp + 1024, gd);
#pragma unroll
                    for (int bj = 0; bj < 2; ++bj)
#pragma unroll
                        for (int n = 0; n < 2; ++n)
#pragma unroll
                            for (int j = 0; j < 4; ++j) acc[ai][bj][m][n][j] *= gn[bj][n][j] * __builtin_amdgcn_rcpf(gd[bj][n][j]);
                    if (m == 3) asm volatile("" ::: "memory"); }
        } else {
#pragma unroll
            for (int ai = 0; ai < 2; ++ai)
#pragma unroll
                for (int m = 0; m < 4; ++m) { const size_t row = (size_t)(row0 + ai * HALF + m * 16);
                    float g[2][2][4]; gld(G8 + row * 3072 + 2048 + col0, g);
#pragma unroll
                    for (int bj = 0; bj < 2; ++bj) { const f32x4 v0 = acc[ai][bj][m][0] * (1.0f / 255.0f), v1 = acc[ai][bj][m][1] * (1.0f / 255.0f);
                        u32x4 w; w.x = cvt_pk_bf16(v0[0] * g[bj][0][0], v0[1] * g[bj][0][1]); w.y = cvt_pk_bf16(v0[2] * g[bj][0][2], v0[3] * g[bj][0][3]);
                        w.z = cvt_pk_bf16(v1[0] * g[bj][1][0], v1[1] * g[bj][1][1]); w.w = cvt_pk_bf16(v1[2] * g[bj][1][2], v1[3] * g[bj][1][3]);
                        *(u32x4*)(O + row * 1024 + col0 + 8 * bj) = w; }
                    if (m == 3) asm volatile("" ::: "memory"); }
        }
    }
};
template <bool FIRST>
struct EpiResid {
    static constexpr bool PERM = true, AFTER_DRAIN = false, MIDHOOK = false;
    const float* Xf; const bf16_t* X; const float* g1; bf16_t* Xo;
    __device__ __forceinline__ void operator()(const f32x4 (&acc)[2][2][4][2], const Unit& u, int wr, int wc, int fr, int fq) const {
        asm volatile("" : "+v"(fr), "+v"(fq));
        const int row0 = u.pm * BM + wr * 64 + fr, col0 = u.pn * BM + wc * 32 + 8 * fq;
        const float* gp = g1 + (size_t)((u.pm * BM) >> 12) * 6144 + col0;
        f32x4 gv[2][2];
#pragma unroll
        for (int bj = 0; bj < 2; ++bj)
#pragma unroll
            for (int n = 0; n < 2; ++n) gv[bj][n] = *(const f32x4*)(gp + bj * HALF + n * 4);
#pragma unroll
        for (int ai = 0; ai < 2; ++ai)
#pragma unroll
            for (int m = 0; m < 4; ++m) { const size_t ro = (size_t)(row0 + ai * HALF + m * 16) * 1024 + col0;
#pragma unroll
                for (int bj = 0; bj < 2; ++bj) { f32x4 x0, x1;
                    if (FIRST) { x0 = *(const f32x4*)(Xf + ro + bj * HALF); x1 = *(const f32x4*)(Xf + ro + bj * HALF + 4); }
                    else { const u32x4 xb = *(const u32x4*)(X + ro + bj * HALF); x0 = (f32x4){bflo(xb.x), bfhi(xb.x), bflo(xb.y), bfhi(xb.y)}; x1 = (f32x4){bflo(xb.z), bfhi(xb.z), bflo(xb.w), bfhi(xb.w)}; }
                    const f32x4 r0 = x0 + gv[bj][0] * acc[ai][bj][m][0], r1 = x1 + gv[bj][1] * acc[ai][bj][m][1];
                    u32x4 w; w.x = cvt_pk_bf16(r0[0], r0[1]); w.y = cvt_pk_bf16(r0[2], r0[3]); w.z = cvt_pk_bf16(r1[0], r1[1]); w.w = cvt_pk_bf16(r1[2], r1[3]);
                    *(u32x4*)(Xo + ro + bj * HALF) = w; } }
    }
};
struct EpiSwiGLU {
    static constexpr bool PERM = true, AFTER_DRAIN = false, MIDHOOK = false;
    bf16_t* O;
    __device__ __forceinline__ void operator()(const f32x4 (&acc)[2][2][4][2], const Unit& u, int wr, int wc, int fr, int fq) const {
        asm volatile("" : "+v"(fr), "+v"(fq));
        const int row0 = u.pm * BM + wr * 64 + fr, col0 = u.pn * HALF + wc * 32 + 8 * fq;
#pragma unroll
        for (int ai = 0; ai < 2; ++ai)
#pragma unroll
            for (int m = 0; m < 4; ++m) { bf16_t* op = O + (size_t)(row0 + ai * HALF + m * 16) * 512 + col0;
                float r[8];
#pragma unroll
                for (int n = 0; n < 2; ++n)
#pragma unroll
                    for (int j = 0; j < 4; ++j) { const float a = acc[ai][0][m][n][j], b = acc[ai][1][m][n][j]; r[n * 4 + j] = a * sigmoidf_(a) * b; }
                u32x4 w; w.x = cvt_pk_bf16(r[0], r[1]); w.y = cvt_pk_bf16(r[2], r[3]); w.z = cvt_pk_bf16(r[4], r[5]); w.w = cvt_pk_bf16(r[6], r[7]);
                *(u32x4*)op = w; }
    }
};
struct EpiY {
    static constexpr bool PERM = true, AFTER_DRAIN = false, MIDHOOK = false;
    bf16_t* O;
    __device__ __forceinline__ void operator()(const f32x4 (&acc)[2][2][4][2], const Unit& u, int wr, int wc, int fr, int fq) const {
        asm volatile("" : "+v"(fr), "+v"(fq));
        const int row0 = u.pm * BM + wr * 64 + fr, col0 = u.pn * BM + wc * 32 + 8 * fq;
#pragma unroll
        for (int ai = 0; ai < 2; ++ai)
#pragma unroll
            for (int m = 0; m < 4; ++m) { bf16_t* rowp = O + (size_t)(row0 + ai * HALF + m * 16) * 1024 + col0;
#pragma unroll
                for (int bj = 0; bj < 2; ++bj) { const f32x4 v0 = acc[ai][bj][m][0], v1 = acc[ai][bj][m][1];
                    u32x4 w; w.x = cvt_pk_bf16(v0[0], v0[1]); w.y = cvt_pk_bf16(v0[2], v0[3]); w.z = cvt_pk_bf16(v1[0], v1[1]); w.w = cvt_pk_bf16(v1[2], v1[3]);
                    *(u32x4*)(rowp + bj * HALF) = w; } }
    }
};

template <class Epi, class Sched, bool ALIGN_EPI = false, bool SP2 = false>
__device__ __forceinline__ void gemm_phase(PG8_LAS unsigned char* lds, const Gemm g, const Sched& S, const Epi& E) {
    const int tid = opqv((int)threadIdx.x), wid = __builtin_amdgcn_readfirstlane(tid >> 6), lane = tid & 63, wr = wid >> 2, wc = wid & 3, fr = lane & 15, fq = lane >> 4;
    const int K = g.K, nt = K / BK, lda = g.lda, ldb = g.ldb;
    unsigned voffA[2], voffB[2];
#pragma unroll
    for (int i = 0; i < 2; ++i) { int R, C; stage_rc(tid * 16 + i * 8192, R, C); const int Rb = Epi::PERM ? ((R & ~31) + perm32(R & 31)) : R;
        voffA[i] = (unsigned)(R * lda + C) * 2u; voffB[i] = (unsigned)(Rb * ldb + C) * 2u; }
    const size_t kstep = (size_t)(BK * 2);
    const size_t hstepA = (size_t)HALF * lda * 2, hstepB = (size_t)HALF * ldb * 2;
    const size_t tstepA = 2 * hstepA, tstepB = 2 * hstepB;
    const unsigned ldsw = (unsigned)wid * 1024u;
    const int aoff = lds_byte(wr * 64 + fr, fq * 8), boff = lds_byte(wc * 32 + fr, fq * 8);
#define PG8_SA(b, h) (((b) * 2 + (h)) * HTB)
#define PG8_SB(b, h) ((4 + (b) * 2 + (h)) * HTB)
#define PG8_STAGE(bufoff, gbase, voff) do { _Pragma("unroll") for (int _i = 0; _i < 2; ++_i) \
        __builtin_amdgcn_global_load_lds((const unsigned*)((const char*)(gbase) + (voff)[_i]), (PG8_LAS unsigned*)(lds + (bufoff) + ldsw + _i * 8192), 16, 0, 0); } while (0)
#define PG8_LDA(dst, b, h) do { _Pragma("unroll") for (int m = 0; m < 4; ++m) _Pragma("unroll") for (int k = 0; k < 2; ++k) dst[m][k] = *(const PG8_LAS bf16x8*)(lds + PG8_SA(b, h) + aoff + m * 2048 + k * 1024); } while (0)
#define PG8_LDB(dst, b, h) do { _Pragma("unroll") for (int n = 0; n < 2; ++n) _Pragma("unroll") for (int k = 0; k < 2; ++k) dst[n][k] = *(const PG8_LAS bf16x8*)(lds + PG8_SB(b, h) + boff + n * 2048 + k * 1024); } while (0)
#define PG8_MMA(ai, bj, At, Bt) do { __builtin_amdgcn_s_setprio(1); _Pragma("unroll") for (int m = 0; m < 4; ++m) _Pragma("unroll") for (int n = 0; n < 2; ++n) _Pragma("unroll") for (int k = 0; k < 2; ++k) \
        acc[ai][bj][m][n] = __builtin_amdgcn_mfma_f32_16x16x32_bf16(Bt[n][k], At[m][k], acc[ai][bj][m][n], 0, 0, 0); __builtin_amdgcn_s_setprio(0); } while (0)
#define PG8_WAIT_V(n) asm volatile("s_waitcnt vmcnt(" #n ")" ::: "memory")
#define PG8_WAIT_L(n) asm volatile("s_waitcnt lgkmcnt(" #n ")" ::: "memory")
#define PG8_BAR __builtin_amdgcn_s_barrier()
#define PG8_SCHED __builtin_amdgcn_sched_barrier(0)
    Unit cur, nxt; int ui = 0;
    if (!S.next(0, cur)) return;
    unsigned gC[2][2], gN[2][2];
#define PG8_GOFF(dst, U) do { if constexpr (Sched::GATHER) { _Pragma("unroll") for (int _h = 0; _h < 2; ++_h) _Pragma("unroll") for (int _i = 0; _i < 2; ++_i) { int _R, _C; stage_rc(tid * 16 + _i * 8192, _R, _C); \
        dst[_h][_i] = (unsigned)S.rowmap[(U).pm * 256 + _h * 128 + _R] * (unsigned)(lda * 2) + (unsigned)_C * 2u; } } } while (0)
#define PG8_STAGEA(bufoff, ptr, gptr, goff) do { if constexpr (Sched::GATHER) PG8_STAGE(bufoff, gptr, goff); else PG8_STAGE(bufoff, ptr, voffA); } while (0)
#define PG8_STAGEA_SEL(bufoff, ptr, gptr, h) do { if constexpr (Sched::GATHER) { if (last) PG8_STAGE(bufoff, gptr, gN[h]); else PG8_STAGE(bufoff, gptr, gC[h]); } else PG8_STAGE(bufoff, ptr, voffA); } while (0)
    PG8_GOFF(gC, cur);
    f32x4 acc[2][2][4][2];
#pragma unroll
    for (int a = 0; a < 2; ++a)
#pragma unroll
        for (int b = 0; b < 2; ++b)
#pragma unroll
            for (int m = 0; m < 4; ++m)
#pragma unroll
                for (int n = 0; n < 2; ++n) acc[a][b][m][n] = (f32x4){0.f, 0.f, 0.f, 0.f};
    bf16x8 At[4][2], B0[2][2], B1[2][2];
    const char* cA = (const char*)g.A + (size_t)cur.pm * tstepA + (Sched::VARK ? (size_t)cur.koff * 2 : 0); const char* cB = (const char*)g.Bt + (size_t)cur.pb * tstepB + (Sched::VARK ? (size_t)cur.koff * 2 : 0);
    S.a_ready(cur);
    if constexpr (SP2) {
        PG8_STAGE(PG8_SB(0, 0), cB, voffB); PG8_STAGE(PG8_SB(0, 1), cB + hstepB, voffB); PG8_STAGEA(PG8_SA(0, 0), cA, (const char*)g.A, gC[0]); PG8_STAGEA(PG8_SA(0, 1), cA + hstepA, (const char*)g.A, gC[1]);
        if (wr == 1) PG8_BAR;
        PG8_WAIT_V(2); PG8_BAR;
        PG8_STAGE(PG8_SB(1, 0), cB + kstep, voffB); PG8_STAGEA(PG8_SA(1, 0), cA + kstep, (const char*)g.A + kstep, gC[0]); PG8_STAGE(PG8_SB(1, 1), cB + hstepB + kstep, voffB);
        PG8_WAIT_V(6); PG8_BAR;
    } else {
        PG8_STAGE(PG8_SB(0, 0), cB, voffB); PG8_STAGE(PG8_SA(0, 0), cA, voffA); PG8_STAGE(PG8_SB(0, 1), cB + hstepB, voffB); PG8_STAGE(PG8_SA(0, 1), cA + hstepA, voffA);
        if (wr == 1) PG8_BAR;
        PG8_WAIT_V(4); PG8_BAR;
        PG8_STAGE(PG8_SB(1, 0), cB + kstep, voffB); PG8_STAGE(PG8_SA(1, 0), cA + kstep, voffA); PG8_STAGE(PG8_SB(1, 1), cB + hstepB + kstep, voffB);
        PG8_WAIT_V(6); PG8_BAR;
    }
    for (;;) {
        const bool has_next = S.next(ui + 1, nxt);
        const char* nA = has_next ? (const char*)g.A + (size_t)nxt.pm * tstepA + (Sched::VARK ? (size_t)nxt.koff * 2 : 0) : cA; const char* nB = has_next ? (const char*)g.Bt + (size_t)nxt.pb * tstepB + (Sched::VARK ? (size_t)nxt.koff * 2 : 0) : cB;
        const int ntc = Sched::VARK ? cur.nt : nt;
        if constexpr (Sched::GATHER) { if (has_next) PG8_GOFF(gN, nxt); else { gN[0][0] = gC[0][0]; gN[0][1] = gC[0][1]; gN[1][0] = gC[1][0]; gN[1][1] = gC[1][1]; } }
#pragma unroll 1
        for (int t = 0; t < ntc; t += 2) {
            const bool last = (t == ntc - 2);
            const char* a1 = cA + (size_t)(t + 1) * kstep;
            const char* a2 = last ? nA : cA + (size_t)(t + 2) * kstep; const char* b2 = last ? nB : cB + (size_t)(t + 2) * kstep;
            const char* a3 = a2 + kstep; const char* b3 = b2 + kstep;
            if (last && has_next) S.a_ready(nxt);
            const char* gk1 = (const char*)g.A + (size_t)(t + 1) * kstep; const char* gk2 = (const char*)g.A + (size_t)(last ? 0 : t + 2) * kstep; const char* gk3 = gk2 + kstep;
            if constexpr (SP2) {
            PG8_LDB(B0, 0, 0); PG8_LDB(B1, 0, 1); PG8_SCHED; PG8_LDA(At, 0, 0); PG8_STAGEA(PG8_SA(1, 1), a1 + hstepA, gk1, gC[1]);
            PG8_WAIT_V(8); PG8_WAIT_L(0); PG8_BAR; PG8_MMA(0, 0, At, B0); PG8_MMA(0, 1, At, B1); PG8_BAR; PG8_SCHED;
            PG8_LDA(At, 0, 1); PG8_STAGE(PG8_SB(0, 0), b2, voffB); PG8_STAGE(PG8_SB(0, 1), b2 + hstepB, voffB); PG8_STAGEA_SEL(PG8_SA(0, 0), a2, gk2, 0);
            PG8_WAIT_V(8); PG8_WAIT_L(0); PG8_BAR; PG8_MMA(1, 0, At, B0); PG8_MMA(1, 1, At, B1); PG8_BAR; PG8_SCHED;
            PG8_LDB(B0, 1, 0); PG8_LDB(B1, 1, 1); PG8_SCHED; PG8_LDA(At, 1, 0); PG8_STAGEA_SEL(PG8_SA(0, 1), a2 + hstepA, gk2, 1);
            PG8_WAIT_V(8); PG8_WAIT_L(0); PG8_BAR; PG8_MMA(0, 0, At, B0); PG8_MMA(0, 1, At, B1); PG8_BAR; PG8_SCHED;
            PG8_LDA(At, 1, 1); PG8_STAGE(PG8_SB(1, 0), b3, voffB); PG8_STAGE(PG8_SB(1, 1), b3 + hstepB, voffB); PG8_STAGEA_SEL(PG8_SA(1, 0), a3, gk3, 0);
            PG8_WAIT_V(8); PG8_WAIT_L(0); PG8_BAR; PG8_MMA(1, 0, At, B0); PG8_MMA(1, 1, At, B1); PG8_BAR; PG8_SCHED;
            } else {
            PG8_LDB(B0, 0, 0); PG8_SCHED; PG8_LDA(At, 0, 0); PG8_STAGE(PG8_SA(1, 1), a1 + hstepA, voffA);
            PG8_WAIT_L(8); PG8_BAR; PG8_WAIT_L(0); PG8_MMA(0, 0, At, B0); PG8_BAR; PG8_SCHED;
            PG8_LDB(B1, 0, 1); PG8_STAGE(PG8_SB(0, 0), b2, voffB);
            PG8_BAR; PG8_WAIT_L(0); PG8_MMA(0, 1, At, B1); PG8_BAR;
            PG8_LDA(At, 0, 1); PG8_STAGE(PG8_SA(0, 0), a2, voffA);
            PG8_BAR; PG8_WAIT_L(0); PG8_MMA(1, 0, At, B0); PG8_BAR; PG8_SCHED;
            PG8_STAGE(PG8_SB(0, 1), b2 + hstepB, voffB);
            PG8_WAIT_V(6); PG8_BAR; PG8_MMA(1, 1, At, B1); PG8_BAR;
            PG8_LDB(B0, 1, 0); PG8_SCHED; PG8_LDA(At, 1, 0); PG8_STAGE(PG8_SA(0, 1), a2 + hstepA, voffA);
            PG8_WAIT_L(8); PG8_BAR; PG8_WAIT_L(0); PG8_MMA(0, 0, At, B0); PG8_BAR; PG8_SCHED;
            PG8_LDB(B1, 1, 1); PG8_STAGE(PG8_SB(1, 0), b3, voffB);
            PG8_BAR; PG8_WAIT_L(0); PG8_MMA(0, 1, At, B1); PG8_BAR;
            PG8_LDA(At, 1, 1); PG8_STAGE(PG8_SA(1, 0), a3, voffA);
            PG8_BAR; PG8_WAIT_L(0); PG8_MMA(1, 0, At, B0); PG8_BAR; PG8_SCHED;
            PG8_STAGE(PG8_SB(1, 1), b3 + hstepB, voffB);
            PG8_WAIT_V(6); PG8_BAR; PG8_MMA(1, 1, At, B1); PG8_BAR;
            }
        }
        if constexpr (ALIGN_EPI) { if (wr == 0) PG8_BAR; }
        if constexpr (!Epi::AFTER_DRAIN) { E(acc, cur, wr, wc, fr, fq); S.done(cur); }
        if (!has_next) break;
        if (!Sched::VARK || cur.zero) {
#pragma unroll
        for (int a = 0; a < 2; ++a)
#pragma unroll
            for (int b = 0; b < 2; ++b)
#pragma unroll
                for (int m = 0; m < 4; ++m)
#pragma unroll
                    for (int n = 0; n < 2; ++n) acc[a][b][m][n] = (f32x4){0.f, 0.f, 0.f, 0.f};
        }
        cur = nxt; cA = nA; cB = nB; ++ui;
        if constexpr (Sched::GATHER) { gC[0][0] = gN[0][0]; gC[0][1] = gN[0][1]; gC[1][0] = gN[1][0]; gC[1][1] = gN[1][1]; }
        if constexpr (ALIGN_EPI) { if (wr == 1) PG8_BAR; }
    }
    PG8_WAIT_V(0);
    if constexpr (!ALIGN_EPI) { if (wr == 0) PG8_BAR; }
    PG8_BAR;
    if constexpr (Epi::AFTER_DRAIN) { E.fused(acc, cur, wr, wc, fr, fq, lds, wid, lane); S.done(cur); }
#undef PG8_GOFF
#undef PG8_STAGEA
#undef PG8_STAGEA_SEL
#undef PG8_SA
#undef PG8_SB
#undef PG8_STAGE
#undef PG8_LDA
#undef PG8_LDB
#undef PG8_MMA
#undef PG8_WAIT_V
#undef PG8_WAIT_L
#undef PG8_BAR
#undef PG8_SCHED
}
}

#ifndef ATTN_FAST
#define ATTN_FAST 1
#endif
#include <hip/hip_bf16.h>
#include <cmath>
namespace attn_body {
using bf16=__hip_bfloat16;
using bf16x8=__attribute__((ext_vector_type(8)))short;
using s16x4=__attribute__((ext_vector_type(4)))short;
using f32x16=__attribute__((ext_vector_type(16)))float;
using u32x4=__attribute__((ext_vector_type(4)))unsigned;
constexpr int BATCH=8,SEQ=4096,D=64,DM=2048,DMO=512;
constexpr int NW=8,QBLK=32,QB=QBLK*NW,KVBLK=64,NQB=SEQ/QB;
constexpr int ATTN_PITCH=DM, ATTN_UNIT_ROWS=QB;
__device__ __forceinline__ int crow(int r,int hi){return (r&3)+8*(r>>2)+4*hi;}
#define SBAR() __builtin_amdgcn_sched_barrier(0)
__device__ __forceinline__ void cmask(f32x16&p0,f32x16&p1,int jb,int wid){
  if(jb>(wid>>1)){ const float NEG=-INFINITY;
    #pragma unroll
    for(int r=0;r<16;++r){p0[r]=NEG;p1[r]=NEG;} }
}

constexpr int NSLOT=3, SLOTB=8192;
constexpr int LDS_K=0, LDS_V=NSLOT*SLOTB, LDS_WS=2*NSLOT*SLOTB, LDS_OST=LDS_WS+NW*64*4, LDS_BYTES=LDS_OST+NW*4096;
constexpr float C2=0.125f*1.4426950408889634f;
__device__ __forceinline__ void glds16(const void*gsrc,unsigned lds_dst){unsigned keep;
  asm volatile("s_mov_b32 %0, m0\n\ts_mov_b32 m0, %2\n\ts_nop 0\n\tglobal_load_lds_dwordx4 %1, off\n\ts_mov_b32 m0, %0":"=&s"(keep):"v"(gsrc),"s"(lds_dst):"memory");}
__device__ __forceinline__ float max3f(float a,float b,float c){float r;asm("v_max3_f32 %0, %1, %2, %3":"=v"(r):"v"(a),"v"(b),"v"(c));return r;}
__device__ __forceinline__ float max2f(float a,float b){float r;asm("v_max_f32_e32 %0, %1, %2":"=v"(r):"v"(a),"v"(b));return r;}
__device__ __forceinline__ float fadd_s(float a,float b){float r;asm("v_add_f32_e32 %0, %1, %2":"=v"(r):"v"(a),"v"(b));return r;}
__device__ __forceinline__ float fsub_s(float a,float b){float r;asm("v_sub_f32_e32 %0, %1, %2":"=v"(r):"v"(a),"v"(b));return r;}
typedef float f32x2_t __attribute__((ext_vector_type(2))); typedef __bf16 bf16x2_t __attribute__((ext_vector_type(2)));
__device__ __forceinline__ unsigned cvtpk_s(float lo,float hi){f32x2_t v={lo,hi};bf16x2_t b=__builtin_convertvector(v,bf16x2_t);return __builtin_bit_cast(unsigned,b);}
#define WAIT_BAR(N) asm volatile("s_waitcnt vmcnt(" #N ") lgkmcnt(0)\n\ts_barrier":::"memory")

__device__ __forceinline__ void qkt(f32x16&p0,f32x16&p1,const char*Kslot,const bf16x8*qr,const f32x16&negm,int r32,int hi){
  const char*kb=Kslot+hi*1024+r32*16;
  #pragma unroll
  for(int d0=0;d0<4;++d0){
    const bf16x8 b0=*reinterpret_cast<const bf16x8*>(kb+d0*2048);
    const bf16x8 b1=*reinterpret_cast<const bf16x8*>(kb+d0*2048+512);
    if(d0==0){p0=__builtin_amdgcn_mfma_f32_32x32x16_bf16(b0,qr[0],negm,0,0,0);p1=__builtin_amdgcn_mfma_f32_32x32x16_bf16(b1,qr[0],negm,0,0,0);}
    else{p0=__builtin_amdgcn_mfma_f32_32x32x16_bf16(b0,qr[d0],p0,0,0,0);p1=__builtin_amdgcn_mfma_f32_32x32x16_bf16(b1,qr[d0],p1,0,0,0);}}
}
typedef __attribute__((address_space(3))) const char* lds_cptr;
typedef short v4i16_t __attribute__((ext_vector_type(4)));
__device__ __forceinline__ void kload8(bf16x8*kf,lds_cptr kp){
  kf[0]=*(const __attribute__((address_space(3))) bf16x8*)(kp);      kf[1]=*(const __attribute__((address_space(3))) bf16x8*)(kp+512);
  kf[2]=*(const __attribute__((address_space(3))) bf16x8*)(kp+2048); kf[3]=*(const __attribute__((address_space(3))) bf16x8*)(kp+2560);
  kf[4]=*(const __attribute__((address_space(3))) bf16x8*)(kp+4096); kf[5]=*(const __attribute__((address_space(3))) bf16x8*)(kp+4608);
  kf[6]=*(const __attribute__((address_space(3))) bf16x8*)(kp+6144); kf[7]=*(const __attribute__((address_space(3))) bf16x8*)(kp+6656);
}
__device__ __forceinline__ void kload2(bf16x8*kf,lds_cptr kp,int j){ kf[2*j]=*(const __attribute__((address_space(3))) bf16x8*)(kp+j*2048); kf[2*j+1]=*(const __attribute__((address_space(3))) bf16x8*)(kp+j*2048+512); }
__device__ __forceinline__ s16x4 vtr(lds_cptr p){ return __builtin_bit_cast(s16x4,__builtin_amdgcn_ds_read_tr16_b64_v4i16((__attribute__((address_space(3))) v4i16_t*)p)); }
__device__ __forceinline__ float rowmax(const f32x16&p0,const f32x16&p1){
  float a=max3f(p0[0],p0[1],p1[0]),b=max3f(p0[2],p0[3],p1[1]);a=max3f(a,p1[2],p1[3]);
  #pragma unroll
  for(int r=4;r<16;r+=4){a=max3f(a,p0[r],p0[r+1]);b=max3f(b,p0[r+2],p0[r+3]);a=max3f(a,p1[r],p1[r+1]);b=max3f(b,p1[r+2],p1[r+3]);}
  const float m=max2f(a,b);
  auto rr=__builtin_amdgcn_permlane32_swap(__float_as_uint(m),__float_as_uint(m),false,false);
  return max2f(__uint_as_float(rr[0]),__uint_as_float(rr[1]));
}
__device__ __forceinline__ void pv(f32x16*o,int vb,bf16x8 pa0,bf16x8 pa1,bf16x8 pa2,bf16x8 pa3){
  #pragma unroll
  for(int d0=0;d0<2;++d0){s16x4 lo[4],hi[4];
    #pragma unroll
    for(int ks=0;ks<4;++ks){
      asm volatile("ds_read_b64_tr_b16 %0,%1 offset:%c2":"=&v"(lo[ks]):"v"(vb),"i"(d0*4096+ks*1024):"memory");
      asm volatile("ds_read_b64_tr_b16 %0,%1 offset:%c2":"=&v"(hi[ks]):"v"(vb),"i"(d0*4096+ks*1024+512):"memory");}
    asm volatile("s_waitcnt lgkmcnt(0)":::"memory");SBAR();
    #define PK(k) (bf16x8){lo[k][0],lo[k][1],lo[k][2],lo[k][3],hi[k][0],hi[k][1],hi[k][2],hi[k][3]}
    o[d0]=__builtin_amdgcn_mfma_f32_32x32x16_bf16(pa0,PK(0),o[d0],0,0,0);
    o[d0]=__builtin_amdgcn_mfma_f32_32x32x16_bf16(pa1,PK(1),o[d0],0,0,0);
    o[d0]=__builtin_amdgcn_mfma_f32_32x32x16_bf16(pa2,PK(2),o[d0],0,0,0);
    o[d0]=__builtin_amdgcn_mfma_f32_32x32x16_bf16(pa3,PK(3),o[d0],0,0,0);
    #undef PK
  }
}

#ifndef ATTN_STORE16
#define ATTN_STORE16(p,v) (*(u32x4*)(p)=(v))
#endif
template<int THRL> __device__ __forceinline__ void attn_unit(int b,int qb,const bf16*Q,const bf16*__restrict__ K,const bf16*__restrict__ V,bf16*O,char*shm){
  const int tid=opqv((int)threadIdx.x),lane=tid&63,r32=lane&31,hi=lane>>5; const int wid=__builtin_amdgcn_readfirstlane(tid>>6);
  const long rowbase=(long)b*SEQ; const int q0=qb*QB;
  const bf16*Qw=Q+(rowbase+q0+wid*QBLK)*DM;
  const bf16*Kh=K+rowbase*DM,*Vh=V+rowbase*DM;
  const unsigned lds0=(unsigned)(uintptr_t)shm;
  float*wsf=(float*)(shm+LDS_WS)+wid*64;
  const bf16*ksrc=Kh+(long)lane*DM+wid*8;
  const bf16*vsrc=Vh+(long)(16*(wid&3)+(lane>>2))*DM+(wid>>2)*32+(lane&3)*8;
  const unsigned kdst=lds0+LDS_K+wid*1024, vdst=lds0+LDS_V+wid*1024;
  #define DMA_K(t,slot) glds16(ksrc+(long)(t)*KVBLK*DM,(unsigned)__builtin_amdgcn_readfirstlane(kdst+(slot)))
  #define DMA_V(t,slot) glds16(vsrc+(long)(t)*KVBLK*DM,(unsigned)__builtin_amdgcn_readfirstlane(vdst+(slot)))
  const int vb0=(int)(lds0+LDS_V)+((lane>>4)&1)*32+(lane&3)*8+(4*hi+((lane&15)>>2))*64;
  const char*Kbase=shm+LDS_K; bf16x8 kf[8];
  const lds_cptr shm3=(lds_cptr)shm; const lds_cptr kp0=shm3+LDS_K+hi*1024+r32*16; const lds_cptr vp0=shm3+LDS_V+((lane>>4)&1)*32+(lane&3)*8+(4*hi+((lane&15)>>2))*64;
  const int NT=(q0+QB)/KVBLK;
  DMA_K(0,0);DMA_V(0,0);DMA_K(1,SLOTB);
  bf16x8 qr[4];
  #pragma unroll
  for(int d0=0;d0<4;++d0)qr[d0]=*reinterpret_cast<const bf16x8*>(&Qw[(long)r32*DM+d0*16+hi*8]);
  float mhat=0.f,l_reg=0.f;f32x16 o[2];o[0]=f32x16{};o[1]=f32x16{};f32x16 negm=f32x16{};asm volatile("":"+v"(negm));
  #define CMASK(P0,P1,t) do{int jb_=(t)-(NT-4); if(jb_>=0)cmask(P0,P1,jb_,wid);}while(0)
  bool resc=false;
  #define START(P0,P1) do{ const float rm=rowmax(P0,P1); resc=false; \
    { const float dl=rm; mhat=fadd_s(mhat,dl); \
      _Pragma("unroll") for(int r=0;r<16;++r){P0[r]=fsub_s(P0[r],dl);P1[r]=fsub_s(P1[r],dl);} \
      _Pragma("unroll") for(int r=0;r<16;++r)negm[r]=-mhat; asm volatile("":"+v"(negm)); } \
    _Pragma("unroll") for(int r=0;r<16;++r)P0[r]=__builtin_amdgcn_exp2f(P0[r]); }while(0)
  #define RESC() do{ if(resc){ asm volatile("s_waitcnt lgkmcnt(0)":::"memory"); \
      _Pragma("unroll") for(int d_=0;d_<2;++d_) _Pragma("unroll") for(int r=0;r<16;++r)o[d_][r]*=wsf[crow(r,hi)]; } }while(0)
  f32x16 pA0,pA1,pB0,pB1;
  int sl_prev=0,sl_cur=0,sl_next=SLOTB;
  #define ROT() do{sl_prev=sl_cur;sl_cur=sl_next;sl_next=(sl_next==(NSLOT-1)*SLOTB)?0:sl_next+SLOTB;}while(0)
  DMA_K(2,2*SLOTB);
  WAIT_BAR(3);
  qkt(pA0,pA1,Kbase,qr,negm,r32,hi);asm volatile("s_nop 15\n\ts_nop 7":"+v"(pA0),"+v"(pA1));CMASK(pA0,pA1,0);
  START(pA0,pA1);
  _Pragma("unroll") for(int r=0;r<16;++r)pA1[r]=__builtin_amdgcn_exp2f(pA1[r]);
  WAIT_BAR(0);
  DMA_K(3,0);DMA_V(1,SLOTB);
  ROT();
  kload8(kf,kp0+sl_cur);
  WAIT_BAR(2);
  s16x4 vlo[8],vhi[8]; u32x4 pw0,pw1,pw2,pw3;
  #define PKW(P,B) cvtpk_s(P[B],P[B+1])
  #define PAF(k) __builtin_bit_cast(bf16x8,pw##k)
  #define VFR(i) (bf16x8){vlo[i][0],vlo[i][1],vlo[i][2],vlo[i][3],vhi[i][0],vhi[i][1],vhi[i][2],vhi[i][3]}
  #define PIN(x) asm volatile("":"+v"(x))
  #define MX3(a,b,c) __builtin_fmaxf(__builtin_fmaxf((a),(b)),(c))
  #define GAPA(MF,A0,A1,A2,A3,W0,W1,PW) do{ MF; sacc+=A0; sacc+=A1; sacc+=A2; sacc+=A3; PIN(sacc); W0; W1; PIN(PW); SBAR(); }while(0)
  #define EX(v) __builtin_amdgcn_exp2f(v)
  #define GAPB(MF,X,B) do{ MF; X[B]=EX(X[B]); X[B+1]=EX(X[B+1]); X[B+2]=EX(X[B+2]); X[B+3]=EX(X[B+3]); PIN(X); SBAR(); }while(0)
  #define VRD(i) do{ vlo[i]=vtr(vp_+(((i)>>2)*4096+((i)&3)*1024)); vhi[i]=vtr(vp_+(((i)>>2)*4096+((i)&3)*1024+512)); }while(0)
  #define KRD(G,j) do{ if(G){ kload2(kf,kp0+sl_next,j); SBAR(); } }while(0)
  #define STEP(C0,C1,P0,P1,t,GK,GV,GL) do{ SBAR(); \
    const lds_cptr vp_=vp0+sl_prev; \
    VRD(0); SBAR(); float sacc=(P0[0]+P0[1]); \
    GAPA(C0=__builtin_amdgcn_mfma_f32_32x32x16_bf16(kf[0],qr[0],negm,0,0,0), P0[2],P0[3],P0[4],P0[5],     pw0[0]=PKW(P0,0), pw0[1]=PKW(P0,2), pw0); \
    VRD(4); SBAR(); GAPA(C1=__builtin_amdgcn_mfma_f32_32x32x16_bf16(kf[1],qr[0],negm,0,0,0), P0[6],P0[7],P0[8],P0[9],     pw0[2]=PKW(P0,4), pw0[3]=PKW(P0,6), pw0); \
    VRD(1); SBAR(); GAPA(C0=__builtin_amdgcn_mfma_f32_32x32x16_bf16(kf[2],qr[1],C0,0,0,0),   P0[10],P0[11],P0[12],P0[13], pw1[0]=PKW(P0,8), pw1[1]=PKW(P0,10), pw1); \
    VRD(5); SBAR(); GAPA(C1=__builtin_amdgcn_mfma_f32_32x32x16_bf16(kf[3],qr[1],C1,0,0,0),   P0[14],P0[15],P1[0],P1[1],   pw1[2]=PKW(P0,12),pw1[3]=PKW(P0,14), pw1); \
    VRD(2); SBAR(); GAPA(C0=__builtin_amdgcn_mfma_f32_32x32x16_bf16(kf[4],qr[2],C0,0,0,0),   P1[2],P1[3],P1[4],P1[5],     pw2[0]=PKW(P1,0), pw2[1]=PKW(P1,2), pw2); \
    VRD(6); SBAR(); GAPA(C1=__builtin_amdgcn_mfma_f32_32x32x16_bf16(kf[5],qr[2],C1,0,0,0),   P1[6],P1[7],P1[8],P1[9],     pw2[2]=PKW(P1,4), pw2[3]=PKW(P1,6), pw2); \
    VRD(3); SBAR(); GAPA(C0=__builtin_amdgcn_mfma_f32_32x32x16_bf16(kf[6],qr[3],C0,0,0,0),   P1[10],P1[11],P1[12],P1[13], pw3[0]=PKW(P1,8), pw3[1]=PKW(P1,10), pw3); \
    VRD(7); SBAR(); GAPA(C1=__builtin_amdgcn_mfma_f32_32x32x16_bf16(kf[7],qr[3],C1,0,0,0),   P1[14],P1[15],0.f,0.f,       pw3[2]=PKW(P1,12),pw3[3]=PKW(P1,14), pw3); \
    l_reg+=sacc; \
    if(GK){DMA_K((t)+3,sl_cur);} if(GV){DMA_V((t)+1,sl_next);} \
    CMASK(C0,C1,t); \
    { float a=MX3(C0[0],C0[1],C1[0]),b=MX3(C0[2],C0[3],C1[1]); a=MX3(a,C1[2],C1[3]); \
      _Pragma("unroll") for(int r=4;r<16;r+=4){a=MX3(a,C0[r],C0[r+1]);b=MX3(b,C0[r+2],C0[r+3]);a=MX3(a,C1[r],C1[r+1]);b=MX3(b,C1[r+2],C1[r+3]);} \
      float rm=__builtin_fmaxf(a,b); { auto rr=__builtin_amdgcn_permlane32_swap(__float_as_uint(rm),__float_as_uint(rm),false,false); rm=__builtin_fmaxf(__uint_as_float(rr[0]),__uint_as_float(rr[1])); } \
      resc=false; \
      if(__builtin_expect(__any(rm>(float)THRL),0)){ const float dl=__builtin_fmaxf(rm,0.f); mhat+=dl; \
        _Pragma("unroll") for(int r=0;r<16;++r){C0[r]-=dl;C1[r]-=dl;} \
        _Pragma("unroll") for(int r=0;r<16;++r)negm[r]=-mhat; asm volatile("":"+v"(negm)); \
        const float f=__builtin_amdgcn_exp2f(-dl); l_reg*=f; if(hi==0)wsf[r32]=f; resc=true; } } \
    SBAR(); \
    GAPB(o[0]=__builtin_amdgcn_mfma_f32_32x32x16_bf16(PAF(0),VFR(0),o[0],0,0,0), C0,0); \
    GAPB(o[1]=__builtin_amdgcn_mfma_f32_32x32x16_bf16(PAF(0),VFR(4),o[1],0,0,0), C0,4); \
    KRD(GL,0); GAPB(o[0]=__builtin_amdgcn_mfma_f32_32x32x16_bf16(PAF(1),VFR(1),o[0],0,0,0), C0,8); \
    KRD(GL,1); GAPB(o[1]=__builtin_amdgcn_mfma_f32_32x32x16_bf16(PAF(1),VFR(5),o[1],0,0,0), C0,12); \
    KRD(GL,2); GAPB(o[0]=__builtin_amdgcn_mfma_f32_32x32x16_bf16(PAF(2),VFR(2),o[0],0,0,0), C1,0); \
    KRD(GL,3); GAPB(o[1]=__builtin_amdgcn_mfma_f32_32x32x16_bf16(PAF(2),VFR(6),o[1],0,0,0), C1,4); \
    GAPB(o[0]=__builtin_amdgcn_mfma_f32_32x32x16_bf16(PAF(3),VFR(3),o[0],0,0,0), C1,8); \
    GAPB(o[1]=__builtin_amdgcn_mfma_f32_32x32x16_bf16(PAF(3),VFR(7),o[1],0,0,0), C1,12); \
    }while(0)
  int t=1;
  #undef CMASK
  #define CMASK(P0,P1,t) do{}while(0)
  for(;t+5<NT;t+=2){
    STEP(pB0,pB1,pA0,pA1,t,true,true,true);     WAIT_BAR(2); RESC(); ROT();
    STEP(pA0,pA1,pB0,pB1,t+1,true,true,true);   WAIT_BAR(2); RESC(); ROT();
  }
  #undef CMASK
  #define CMASK(P0,P1,t) do{int jb_=(t)-(NT-4); if(jb_>=0)cmask(P0,P1,jb_,wid);}while(0)
  #define ENDW(tt) do{ if((tt)+3<NT){WAIT_BAR(2);} else if((tt)+2<NT){WAIT_BAR(1);} else {WAIT_BAR(0);} }while(0)
  for(;t+1<NT;t+=2){
    STEP(pB0,pB1,pA0,pA1,t,(t+3<NT),(t+1<NT),(t+1<NT));       ENDW(t);   RESC(); ROT();
    STEP(pA0,pA1,pB0,pB1,t+1,(t+4<NT),(t+2<NT),(t+2<NT));     ENDW(t+1); RESC(); ROT();
  }
  STEP(pB0,pB1,pA0,pA1,NT-1,false,false,false); RESC();
  { float sacc=pB0[0]+pB0[1]; _Pragma("unroll") for(int r=2;r<16;++r)sacc+=pB0[r]; _Pragma("unroll") for(int r=0;r<16;++r)sacc+=pB1[r]; l_reg+=sacc;
    pw0=(u32x4){PKW(pB0,0),PKW(pB0,2),PKW(pB0,4),PKW(pB0,6)};pw1=(u32x4){PKW(pB0,8),PKW(pB0,10),PKW(pB0,12),PKW(pB0,14)};pw2=(u32x4){PKW(pB1,0),PKW(pB1,2),PKW(pB1,4),PKW(pB1,6)};pw3=(u32x4){PKW(pB1,8),PKW(pB1,10),PKW(pB1,12),PKW(pB1,14)};
    SBAR(); pv(o,vb0+sl_cur,PAF(0),PAF(1),PAF(2),PAF(3)); }
  #undef PKW
  #undef PAF
  #undef VFR
  #undef PIN
  #undef MX3
  #undef GAPA
  #undef GAPB
  #undef EX
  #undef VRD
  #undef KRD
  #undef STEP
  #undef ENDW
  {auto rr=__builtin_amdgcn_permlane32_swap(__float_as_uint(l_reg),__float_as_uint(l_reg),false,false);l_reg=__uint_as_float(rr[0])+__uint_as_float(rr[1]);}
  if(hi==0)wsf[32+r32]=l_reg;asm volatile("s_waitcnt lgkmcnt(0)":::"memory");
  float rli[16];
  #pragma unroll
  for(int r=0;r<16;++r)rli[r]=__builtin_amdgcn_rcpf(wsf[32+crow(r,hi)]);
  bf16*Ow=O+(rowbase+q0+wid*QBLK)*DMO;
  { bf16*stg=(bf16*)(shm+LDS_OST)+wid*2048;
    #pragma unroll
    for(int r=0;r<16;++r){const int orow=crow(r,hi);
      #pragma unroll
      for(int d0=0;d0<2;++d0)stg[orow*64+d0*32+r32]=__float2bfloat16(o[d0][r]*rli[r]);}
    asm volatile("s_waitcnt lgkmcnt(0)":::"memory");
    #pragma unroll
    for(int i=0;i<4;++i){const int row=i*8+(lane>>3),ch=lane&7; const u32x4 v=*(const u32x4*)(stg+row*64+ch*8); ATTN_STORE16(Ow+(long)row*DMO+ch*8,v);} }
  asm volatile("s_waitcnt lgkmcnt(0)\n\ts_barrier":::"memory");
  #undef DMA_K
  #undef DMA_V
  #undef CMASK
  #undef START
  #undef RESC
  #undef ROT
}
constexpr int ATTN_LDS_BYTES=LDS_BYTES;
#undef SBAR
#undef WAIT_BAR
}
#ifndef ATTN_V128
#define ATTN_V128 1
#endif
namespace attn128 {
using bf16=__hip_bfloat16;
using bf16x8=__attribute__((ext_vector_type(8)))short;
using s16x4=__attribute__((ext_vector_type(4)))short;
using f32x16=__attribute__((ext_vector_type(16)))float;
using u32x4=__attribute__((ext_vector_type(4)))unsigned;
constexpr int BATCH=8,SEQ=4096,D=64,DM=2048,DMO=512;
constexpr int NW=8,QBLK=32,QB=QBLK*NW,KVBLK=64,NQB=SEQ/QB;
constexpr int ATTN_PITCH=DM, ATTN_UNIT_ROWS=QB;
__device__ __forceinline__ int crow(int r,int hi){return (r&3)+8*(r>>2)+4*hi;}
#define SBAR() __builtin_amdgcn_sched_barrier(0)
__device__ __forceinline__ void cmask(f32x16&p0,f32x16&p1,int jb,int wid){
  if(jb>(wid>>1)){ const float NEG=-INFINITY;
    #pragma unroll
    for(int r=0;r<16;++r){p0[r]=NEG;p1[r]=NEG;} }
}

constexpr int NSLOT=3, SLOTB=8192;
constexpr int VSLOTB=2*SLOTB;
constexpr int LDS_K=0, LDS_V=NSLOT*SLOTB, LDS_WS=LDS_V+NSLOT*VSLOTB, LDS_OST=LDS_WS+NW*64*4, LDS_BYTES=LDS_OST+NW*8192;
constexpr float C2=0.125f*1.4426950408889634f;
__device__ __forceinline__ void glds16(const void*gsrc,unsigned lds_dst){unsigned keep;
  asm volatile("s_mov_b32 %0, m0\n\ts_mov_b32 m0, %2\n\ts_nop 0\n\tglobal_load_lds_dwordx4 %1, off\n\ts_mov_b32 m0, %0":"=&s"(keep):"v"(gsrc),"s"(lds_dst):"memory");}
__device__ __forceinline__ float max3f(float a,float b,float c){float r;asm("v_max3_f32 %0, %1, %2, %3":"=v"(r):"v"(a),"v"(b),"v"(c));return r;}
__device__ __forceinline__ float max2f(float a,float b){float r;asm("v_max_f32_e32 %0, %1, %2":"=v"(r):"v"(a),"v"(b));return r;}
__device__ __forceinline__ float fadd_s(float a,float b){float r;asm("v_add_f32_e32 %0, %1, %2":"=v"(r):"v"(a),"v"(b));return r;}
__device__ __forceinline__ float fsub_s(float a,float b){float r;asm("v_sub_f32_e32 %0, %1, %2":"=v"(r):"v"(a),"v"(b));return r;}
typedef float f32x2_t __attribute__((ext_vector_type(2))); typedef __bf16 bf16x2_t __attribute__((ext_vector_type(2)));
__device__ __forceinline__ unsigned cvtpk_s(float lo,float hi){f32x2_t v={lo,hi};bf16x2_t b=__builtin_convertvector(v,bf16x2_t);return __builtin_bit_cast(unsigned,b);}
#define WAIT_BAR(N) asm volatile("s_waitcnt vmcnt(" #N ") lgkmcnt(0)\n\ts_barrier":::"memory")

__device__ __forceinline__ void qkt(f32x16&p0,f32x16&p1,const char*Kslot,const bf16x8*qr,int r32,int hi){
  const char*kb=Kslot+hi*1024+r32*16;
  #pragma unroll
  for(int d0=0;d0<4;++d0){
    const bf16x8 b0=*reinterpret_cast<const bf16x8*>(kb+d0*2048);
    const bf16x8 b1=*reinterpret_cast<const bf16x8*>(kb+d0*2048+512);
    if(d0==0){p0=__builtin_amdgcn_mfma_f32_32x32x16_bf16(b0,qr[0],f32x16{},0,0,0);p1=__builtin_amdgcn_mfma_f32_32x32x16_bf16(b1,qr[0],f32x16{},0,0,0);}
    else{p0=__builtin_amdgcn_mfma_f32_32x32x16_bf16(b0,qr[d0],p0,0,0,0);p1=__builtin_amdgcn_mfma_f32_32x32x16_bf16(b1,qr[d0],p1,0,0,0);}}
}
typedef __attribute__((address_space(3))) const char* lds_cptr;
typedef short v4i16_t __attribute__((ext_vector_type(4)));
__device__ __forceinline__ void kload8(bf16x8*kf,lds_cptr kp){
  kf[0]=*(const __attribute__((address_space(3))) bf16x8*)(kp);      kf[1]=*(const __attribute__((address_space(3))) bf16x8*)(kp+512);
  kf[2]=*(const __attribute__((address_space(3))) bf16x8*)(kp+2048); kf[3]=*(const __attribute__((address_space(3))) bf16x8*)(kp+2560);
  kf[4]=*(const __attribute__((address_space(3))) bf16x8*)(kp+4096); kf[5]=*(const __attribute__((address_space(3))) bf16x8*)(kp+4608);
  kf[6]=*(const __attribute__((address_space(3))) bf16x8*)(kp+6144); kf[7]=*(const __attribute__((address_space(3))) bf16x8*)(kp+6656);
}
__device__ __forceinline__ void kload2(bf16x8*kf,lds_cptr kp,int j){ kf[2*j]=*(const __attribute__((address_space(3))) bf16x8*)(kp+j*2048); kf[2*j+1]=*(const __attribute__((address_space(3))) bf16x8*)(kp+j*2048+512); }
__device__ __forceinline__ s16x4 vtr(lds_cptr p){ return __builtin_bit_cast(s16x4,__builtin_amdgcn_ds_read_tr16_b64_v4i16((__attribute__((address_space(3))) v4i16_t*)p)); }
__device__ __forceinline__ float rowmax(const f32x16&p0,const f32x16&p1){
  float a=max3f(p0[0],p0[1],p1[0]),b=max3f(p0[2],p0[3],p1[1]);a=max3f(a,p1[2],p1[3]);
  #pragma unroll
  for(int r=4;r<16;r+=4){a=max3f(a,p0[r],p0[r+1]);b=max3f(b,p0[r+2],p0[r+3]);a=max3f(a,p1[r],p1[r+1]);b=max3f(b,p1[r+2],p1[r+3]);}
  const float m=max2f(a,b);
  auto rr=__builtin_amdgcn_permlane32_swap(__float_as_uint(m),__float_as_uint(m),false,false);
  return max2f(__uint_as_float(rr[0]),__uint_as_float(rr[1]));
}
__device__ __forceinline__ void pv(f32x16*o,int vb,bf16x8 pa0,bf16x8 pa1,bf16x8 pa2,bf16x8 pa3){
  #pragma unroll
  for(int d0=0;d0<4;++d0){s16x4 lo[4],hi[4];
    #pragma unroll
    for(int ks=0;ks<4;++ks){
      asm volatile("ds_read_b64_tr_b16 %0,%1 offset:%c2":"=&v"(lo[ks]):"v"(vb),"i"(d0*4096+ks*1024):"memory");
      asm volatile("ds_read_b64_tr_b16 %0,%1 offset:%c2":"=&v"(hi[ks]):"v"(vb),"i"(d0*4096+ks*1024+512):"memory");}
    asm volatile("s_waitcnt lgkmcnt(0)":::"memory");SBAR();
    #define PK(k) (bf16x8){lo[k][0],lo[k][1],lo[k][2],lo[k][3],hi[k][0],hi[k][1],hi[k][2],hi[k][3]}
    o[d0]=__builtin_amdgcn_mfma_f32_32x32x16_bf16(pa0,PK(0),o[d0],0,0,0);
    o[d0]=__builtin_amdgcn_mfma_f32_32x32x16_bf16(pa1,PK(1),o[d0],0,0,0);
    o[d0]=__builtin_amdgcn_mfma_f32_32x32x16_bf16(pa2,PK(2),o[d0],0,0,0);
    o[d0]=__builtin_amdgcn_mfma_f32_32x32x16_bf16(pa3,PK(3),o[d0],0,0,0);
    #undef PK
  }
}

#ifndef ATTN_STORE16
#define ATTN_STORE16(p,v) (*(u32x4*)(p)=(v))
#endif
template<int THRL> __device__ __forceinline__ void attn_unit(int b,int qb,const bf16*Q,const bf16*__restrict__ K,const bf16*__restrict__ V,bf16*O,char*shm){
  const int tid=opqv((int)threadIdx.x),lane=tid&63,r32=lane&31,hi=lane>>5; const int wid=__builtin_amdgcn_readfirstlane(tid>>6);
  const long rowbase=(long)b*SEQ; const int q0=qb*QB;
  const bf16*Qw=Q+(rowbase+q0+wid*QBLK)*DM;
  const bf16*Kh=K+rowbase*DM,*Vh=V+rowbase*DM;
  const unsigned lds0=(unsigned)(uintptr_t)shm;
  float*wsf=(float*)(shm+LDS_WS)+wid*64;
  const bf16*ksrc=Kh+(long)lane*DM+wid*8;
  const bf16*vsrc=Vh+(long)(16*(wid&3)+(lane>>2))*DM+(wid>>2)*32+(lane&3)*8;
  const unsigned kdst=lds0+LDS_K+wid*1024, vdst=lds0+LDS_V+wid*1024;
  #define DMA_K(t,slot) glds16(ksrc+(long)(t)*KVBLK*DM,(unsigned)__builtin_amdgcn_readfirstlane(kdst+(slot)))
  #define DMA_V(t,slot) do{ glds16(vsrc+(long)(t)*KVBLK*DM,(unsigned)__builtin_amdgcn_readfirstlane(vdst+2*(slot))); glds16(vsrc+(long)(t)*KVBLK*DM+64,(unsigned)__builtin_amdgcn_readfirstlane(vdst+2*(slot)+8192)); }while(0)
  const int vb0=(int)(lds0+LDS_V)+((lane>>4)&1)*32+(lane&3)*8+(4*hi+((lane&15)>>2))*64;
  const char*Kbase=shm+LDS_K; bf16x8 kf[8];
  const lds_cptr shm3=(lds_cptr)shm; const lds_cptr kp0=shm3+LDS_K+hi*1024+r32*16; const lds_cptr vp0=shm3+LDS_V+((lane>>4)&1)*32+(lane&3)*8+(4*hi+((lane&15)>>2))*64;
  const int NT=(q0+QB)/KVBLK;
  DMA_K(0,0);DMA_V(0,0);DMA_K(1,SLOTB);
  bf16x8 qr[4];
  #pragma unroll
  for(int d0=0;d0<4;++d0)qr[d0]=*reinterpret_cast<const bf16x8*>(&Qw[(long)r32*DM+d0*16+hi*8]);
  float mhat=0.f,l_reg=0.f;f32x16 o[4];o[0]=f32x16{};o[1]=f32x16{};o[2]=f32x16{};o[3]=f32x16{};
  #define CMASK(P0,P1,t) do{int jb_=(t)-(NT-4); if(jb_>=0)cmask(P0,P1,jb_,wid);}while(0)
  bool resc=false;
  #define START(P0,P1) do{ mhat=rowmax(P0,P1); resc=false; \
    _Pragma("unroll") for(int r=0;r<16;++r)P0[r]=__builtin_amdgcn_exp2f(P0[r]-mhat); }while(0)
  #define RESC() do{ if(resc){ asm volatile("s_waitcnt lgkmcnt(0)":::"memory"); \
      _Pragma("unroll") for(int d_=0;d_<4;++d_) _Pragma("unroll") for(int r=0;r<16;++r)o[d_][r]*=wsf[crow(r,hi)]; } }while(0)
  f32x16 pA0,pA1,pB0,pB1;
  int sl_prev=0,sl_cur=0,sl_next=SLOTB;
  #define ROT() do{sl_prev=sl_cur;sl_cur=sl_next;sl_next=(sl_next==(NSLOT-1)*SLOTB)?0:sl_next+SLOTB;}while(0)
  DMA_K(2,2*SLOTB);
  WAIT_BAR(4);
  qkt(pA0,pA1,Kbase,qr,r32,hi);asm volatile("s_nop 15\n\ts_nop 7":"+v"(pA0),"+v"(pA1));CMASK(pA0,pA1,0);
  START(pA0,pA1);
  _Pragma("unroll") for(int r=0;r<16;++r)pA1[r]=__builtin_amdgcn_exp2f(pA1[r]-mhat);
  WAIT_BAR(0);
  DMA_K(3,0);DMA_V(1,SLOTB);
  ROT();
  kload8(kf,kp0+sl_cur);
  WAIT_BAR(3);
  s16x4 vlo[8],vhi[8]; u32x4 pw0,pw1,pw2,pw3;
  #define PKW(P,B) cvtpk_s(P[B],P[B+1])
  #define PAF(k) __builtin_bit_cast(bf16x8,pw##k)
  #define VFR(i) (bf16x8){vlo[i][0],vlo[i][1],vlo[i][2],vlo[i][3],vhi[i][0],vhi[i][1],vhi[i][2],vhi[i][3]}
  #define PIN(x) asm volatile("":"+v"(x))
  #define MX3(a,b,c) __builtin_fmaxf(__builtin_fmaxf((a),(b)),(c))
  #define GAPA(MF,A0,A1,A2,A3,W0,W1,PW) do{ MF; sacc+=A0; sacc+=A1; sacc+=A2; sacc+=A3; PIN(sacc); W0; W1; PIN(PW); SBAR(); }while(0)
  #define EX(v) __builtin_amdgcn_exp2f((v)-mhat)
  #define GAPB(MF,X,B) do{ MF; X[B]=EX(X[B]); X[B+1]=EX(X[B+1]); X[B+2]=EX(X[B+2]); X[B+3]=EX(X[B+3]); PIN(X); SBAR(); }while(0)
  #define VRD(i) do{ vlo[i]=vtr(vp_+(((i)>>2)*4096+((i)&3)*1024)); vhi[i]=vtr(vp_+(((i)>>2)*4096+((i)&3)*1024+512)); }while(0)
  #define VRD2(i) do{ vlo[i]=vtr(vp_+((((i)>>2)+2)*4096+((i)&3)*1024)); vhi[i]=vtr(vp_+((((i)>>2)+2)*4096+((i)&3)*1024+512)); SBAR(); }while(0)
  #define GAPC(MF) do{ MF; SBAR(); }while(0)
  #define KRD(G,j) do{ if(G){ kload2(kf,kp0+sl_next,j); SBAR(); } }while(0)
  #define STEP(C0,C1,P0,P1,t,GK,GV,GL) do{ SBAR(); \
    const lds_cptr vp_=vp0+2*sl_prev; \
    VRD(0); SBAR(); float sacc=(P0[0]+P0[1]); \
    GAPA(C0=__builtin_amdgcn_mfma_f32_32x32x16_bf16(kf[0],qr[0],f32x16{},0,0,0), P0[2],P0[3],P0[4],P0[5],     pw0[0]=PKW(P0,0), pw0[1]=PKW(P0,2), pw0); \
    VRD(4); SBAR(); GAPA(C1=__builtin_amdgcn_mfma_f32_32x32x16_bf16(kf[1],qr[0],f32x16{},0,0,0), P0[6],P0[7],P0[8],P0[9],     pw0[2]=PKW(P0,4), pw0[3]=PKW(P0,6), pw0); \
    VRD(1); SBAR(); GAPA(C0=__builtin_amdgcn_mfma_f32_32x32x16_bf16(kf[2],qr[1],C0,0,0,0),   P0[10],P0[11],P0[12],P0[13], pw1[0]=PKW(P0,8), pw1[1]=PKW(P0,10), pw1); \
    VRD(5); SBAR(); GAPA(C1=__builtin_amdgcn_mfma_f32_32x32x16_bf16(kf[3],qr[1],C1,0,0,0),   P0[14],P0[15],P1[0],P1[1],   pw1[2]=PKW(P0,12),pw1[3]=PKW(P0,14), pw1); \
    VRD(2); SBAR(); GAPA(C0=__builtin_amdgcn_mfma_f32_32x32x16_bf16(kf[4],qr[2],C0,0,0,0),   P1[2],P1[3],P1[4],P1[5],     pw2[0]=PKW(P1,0), pw2[1]=PKW(P1,2), pw2); \
    VRD(6); SBAR(); GAPA(C1=__builtin_amdgcn_mfma_f32_32x32x16_bf16(kf[5],qr[2],C1,0,0,0),   P1[6],P1[7],P1[8],P1[9],     pw2[2]=PKW(P1,4), pw2[3]=PKW(P1,6), pw2); \
    VRD(3); SBAR(); GAPA(C0=__builtin_amdgcn_mfma_f32_32x32x16_bf16(kf[6],qr[3],C0,0,0,0),   P1[10],P1[11],P1[12],P1[13], pw3[0]=PKW(P1,8), pw3[1]=PKW(P1,10), pw3); \
    VRD(7); SBAR(); GAPA(C1=__builtin_amdgcn_mfma_f32_32x32x16_bf16(kf[7],qr[3],C1,0,0,0),   P1[14],P1[15],0.f,0.f,       pw3[2]=PKW(P1,12),pw3[3]=PKW(P1,14), pw3); \
    l_reg+=sacc; \
    if(GK){DMA_K((t)+3,sl_cur);} if(GV){DMA_V((t)+1,sl_next);} \
    CMASK(C0,C1,t); \
    { float a=MX3(C0[0],C0[1],C1[0]),b=MX3(C0[2],C0[3],C1[1]); a=MX3(a,C1[2],C1[3]); \
      _Pragma("unroll") for(int r=4;r<16;r+=4){a=MX3(a,C0[r],C0[r+1]);b=MX3(b,C0[r+2],C0[r+3]);a=MX3(a,C1[r],C1[r+1]);b=MX3(b,C1[r+2],C1[r+3]);} \
      float rm=__builtin_fmaxf(a,b); { auto rr=__builtin_amdgcn_permlane32_swap(__float_as_uint(rm),__float_as_uint(rm),false,false); rm=__builtin_fmaxf(__uint_as_float(rr[0]),__uint_as_float(rr[1])); } \
      resc=false; rm-=mhat;                                                            \
      if(__builtin_expect(__any(rm>(float)THRL),0)){ const float dl=__builtin_fmaxf(rm,0.f); mhat+=dl; \
        const float f=__builtin_amdgcn_exp2f(-dl); l_reg*=f; if(hi==0)wsf[r32]=f; resc=true; } } \
    SBAR(); \
    GAPB(o[0]=__builtin_amdgcn_mfma_f32_32x32x16_bf16(PAF(0),VFR(0),o[0],0,0,0), C0,0);  VRD2(0); \
    GAPB(o[1]=__builtin_amdgcn_mfma_f32_32x32x16_bf16(PAF(0),VFR(4),o[1],0,0,0), C0,4);  VRD2(4); \
    GAPB(o[0]=__builtin_amdgcn_mfma_f32_32x32x16_bf16(PAF(1),VFR(1),o[0],0,0,0), C0,8);  VRD2(1); \
    GAPB(o[1]=__builtin_amdgcn_mfma_f32_32x32x16_bf16(PAF(1),VFR(5),o[1],0,0,0), C0,12); VRD2(5); \
    GAPB(o[0]=__builtin_amdgcn_mfma_f32_32x32x16_bf16(PAF(2),VFR(2),o[0],0,0,0), C1,0);  VRD2(2); \
    GAPB(o[1]=__builtin_amdgcn_mfma_f32_32x32x16_bf16(PAF(2),VFR(6),o[1],0,0,0), C1,4);  VRD2(6); \
    GAPB(o[0]=__builtin_amdgcn_mfma_f32_32x32x16_bf16(PAF(3),VFR(3),o[0],0,0,0), C1,8);  VRD2(3); \
    GAPB(o[1]=__builtin_amdgcn_mfma_f32_32x32x16_bf16(PAF(3),VFR(7),o[1],0,0,0), C1,12); VRD2(7); \
      \
    GAPC(o[2]=__builtin_amdgcn_mfma_f32_32x32x16_bf16(PAF(0),VFR(0),o[2],0,0,0)); \
    GAPC(o[3]=__builtin_amdgcn_mfma_f32_32x32x16_bf16(PAF(0),VFR(4),o[3],0,0,0)); \
    KRD(GL,0); GAPC(o[2]=__builtin_amdgcn_mfma_f32_32x32x16_bf16(PAF(1),VFR(1),o[2],0,0,0)); \
    KRD(GL,1); GAPC(o[3]=__builtin_amdgcn_mfma_f32_32x32x16_bf16(PAF(1),VFR(5),o[3],0,0,0)); \
    KRD(GL,2); GAPC(o[2]=__builtin_amdgcn_mfma_f32_32x32x16_bf16(PAF(2),VFR(2),o[2],0,0,0)); \
    KRD(GL,3); GAPC(o[3]=__builtin_amdgcn_mfma_f32_32x32x16_bf16(PAF(2),VFR(6),o[3],0,0,0)); \
    GAPC(o[2]=__builtin_amdgcn_mfma_f32_32x32x16_bf16(PAF(3),VFR(3),o[2],0,0,0)); \
    GAPC(o[3]=__builtin_amdgcn_mfma_f32_32x32x16_bf16(PAF(3),VFR(7),o[3],0,0,0)); \
    }while(0)
  int t=1;
  #undef CMASK
  #define CMASK(P0,P1,t) do{}while(0)
  for(;t+5<NT;t+=2){
    STEP(pB0,pB1,pA0,pA1,t,true,true,true);     WAIT_BAR(3); RESC(); ROT();
    STEP(pA0,pA1,pB0,pB1,t+1,true,true,true);   WAIT_BAR(3); RESC(); ROT();
  }
  #undef CMASK
  #define CMASK(P0,P1,t) do{int jb_=(t)-(NT-4); if(jb_>=0)cmask(P0,P1,jb_,wid);}while(0)
  #define ENDW(tt) do{ if((tt)+3<NT){WAIT_BAR(3);} else if((tt)+2<NT){WAIT_BAR(2);} else {WAIT_BAR(0);} }while(0)
  for(;t+1<NT;t+=2){
    STEP(pB0,pB1,pA0,pA1,t,(t+3<NT),(t+1<NT),(t+1<NT));       ENDW(t);   RESC(); ROT();
    STEP(pA0,pA1,pB0,pB1,t+1,(t+4<NT),(t+2<NT),(t+2<NT));     ENDW(t+1); RESC(); ROT();
  }
  STEP(pB0,pB1,pA0,pA1,NT-1,false,false,false); RESC();
  { float sacc=pB0[0]+pB0[1]; _Pragma("unroll") for(int r=2;r<16;++r)sacc+=pB0[r]; _Pragma("unroll") for(int r=0;r<16;++r)sacc+=pB1[r]; l_reg+=sacc;
    pw0=(u32x4){PKW(pB0,0),PKW(pB0,2),PKW(pB0,4),PKW(pB0,6)};pw1=(u32x4){PKW(pB0,8),PKW(pB0,10),PKW(pB0,12),PKW(pB0,14)};pw2=(u32x4){PKW(pB1,0),PKW(pB1,2),PKW(pB1,4),PKW(pB1,6)};pw3=(u32x4){PKW(pB1,8),PKW(pB1,10),PKW(pB1,12),PKW(pB1,14)};
    SBAR(); pv(o,vb0+2*sl_cur,PAF(0),PAF(1),PAF(2),PAF(3)); }
  #undef PKW
  #undef PAF
  #undef VFR
  #undef PIN
  #undef MX3
  #undef GAPA
  #undef GAPB
  #undef EX
  #undef VRD
  #undef VRD2
  #undef GAPC
  #undef KRD
  #undef STEP
  #undef ENDW
  {auto rr=__builtin_amdgcn_permlane32_swap(__float_as_uint(l_reg),__float_as_uint(l_reg),false,false);l_reg=__uint_as_float(rr[0])+__uint_as_float(rr[1]);}
  if(hi==0)wsf[32+r32]=l_reg;asm volatile("s_waitcnt lgkmcnt(0)":::"memory");
  float rli[16];
  #pragma unroll
  for(int r=0;r<16;++r)rli[r]=__builtin_amdgcn_rcpf(wsf[32+crow(r,hi)]);
  bf16*Ow=O+(rowbase+q0+wid*QBLK)*DMO;
  { bf16*stg=(bf16*)(shm+LDS_OST)+wid*4096;
    #pragma unroll
    for(int r=0;r<16;++r){const int orow=crow(r,hi);
      #pragma unroll
      for(int d0=0;d0<4;++d0)stg[orow*128+d0*32+r32]=__float2bfloat16(o[d0][r]*rli[r]);}
    asm volatile("s_waitcnt lgkmcnt(0)":::"memory");
    #pragma unroll
    for(int i=0;i<8;++i){const int row=i*4+(lane>>4),ch=lane&15; const u32x4 v=*(const u32x4*)(stg+row*128+ch*8); ATTN_STORE16(Ow+(long)row*DMO+ch*8,v);} }
  asm volatile("s_waitcnt lgkmcnt(0)\n\ts_barrier":::"memory");
  #undef DMA_K
  #undef DMA_V
  #undef CMASK
  #undef START
  #undef RESC
  #undef ROT
}
constexpr int ATTN_LDS_BYTES=LDS_BYTES;
#undef SBAR
#undef WAIT_BAR
}


constexpr int NB = 8, SEQ = 4096, T = NB * SEQ, D = 1024, DEPTH = 4;
constexpr int ZW = 2048, GWD = 3072, NCAT = ZW + GWD;
constexpr int ZQ = 256, ZK = 768, ZV = 1280, ZC = 1792;
constexpr int NEXP = 32, FF = 512, MAXSLOT = 2 * T + NEXP * 256;
constexpr float NORM_EPS = 1e-6f;
constexpr int NWAVES = 8;
constexpr int PH_PER_LAYER = 11, N_PHASES = 1 + DEPTH * PH_PER_LAYER + 1;

constexpr size_t MiB = 1u << 20;
constexpr size_t WS_CTL = 0, CTL_ZERO_BYTES = 1 * MiB;
constexpr size_t WS_MOD = 1 * MiB;
constexpr size_t WS_LAM = WS_MOD + (size_t)DEPTH * NB * 6144 * 4;
constexpr size_t WS_ROPE_C = 2 * MiB, WS_ROPE_S = 6 * MiB;
constexpr size_t WS_SSM = 10 * MiB;
constexpr size_t SSM_L_BYTES = 8192 + 8192 + 65536;
constexpr size_t WS_RWT = 11 * MiB;
constexpr size_t WS_TOKE = 12 * MiB, WS_TOKW = WS_TOKE + 256 * 1024, WS_TOKL = WS_TOKW + 256 * 1024, WS_TOKS = WS_TOKL + 256 * 1024;
constexpr size_t WS_WGBASE = 13 * MiB, WS_TILEE = WS_WGBASE + 64 * 1024;
constexpr size_t WS_ROWMAP = WS_WGBASE + 128 * 1024;
constexpr size_t WS_E = 14 * MiB, WS_CIN = 18 * MiB;
constexpr size_t WS_WCAT = 24 * MiB;
constexpr size_t WS_WMIX = 64 * MiB;
constexpr size_t WS_WO = 72 * MiB;
constexpr size_t WS_WGLU = 80 * MiB;
constexpr size_t WS_W13 = 82 * MiB;
constexpr size_t WS_W2 = 146 * MiB;
constexpr size_t WS_H = 178 * MiB;
constexpr size_t WS_Z = 242 * MiB;
constexpr size_t WS_G = 370 * MiB;
constexpr size_t WS_O0 = 562 * MiB, WS_O1 = 626 * MiB;
constexpr size_t WS_AMIX = 690 * MiB;
constexpr size_t WS_MIXED = 754 * MiB;
constexpr size_t WS_AG = 242 * MiB;
constexpr size_t WS_ACT = 386 * MiB;
constexpr size_t WS_Y = 458 * MiB;
constexpr size_t WS_XB = 818 * MiB;
constexpr size_t WS_END = 882 * MiB;
static_assert(WS_AG + (size_t)MAXSLOT * 1024 * 2 <= WS_ACT && WS_ACT + (size_t)MAXSLOT * 512 * 2 <= WS_Y && WS_Y + (size_t)MAXSLOT * 1024 * 2 <= WS_AMIX, "moe overlay map");
constexpr int CW_BAR = 4096;
constexpr int CW_CNT = 16384;

constexpr int RING_OFF = 0, RING_BYTES = 159744;
constexpr int LDSCTL_OFF = RING_BYTES, MISC_OFF = LDSCTL_OFF + 320;
constexpr int LDS_BYTES = 163840;

#define GAS __attribute__((address_space(1)))
#define LAS __attribute__((address_space(3)))
typedef unsigned short bf16;
typedef unsigned v4u __attribute__((ext_vector_type(4)));
typedef unsigned v2u __attribute__((ext_vector_type(2)));
typedef float f32x4 __attribute__((ext_vector_type(4)));
typedef float f32x2 __attribute__((ext_vector_type(2)));
typedef short bf16x8 __attribute__((ext_vector_type(8)));
typedef GAS unsigned gu32;
#define RLX_AGENT __ATOMIC_RELAXED, __HIP_MEMORY_SCOPE_AGENT
#define LDS_WAIT() asm volatile("s_waitcnt lgkmcnt(0)" ::: "memory")
#define VM_WAIT() asm volatile("s_waitcnt vmcnt(0)" ::: "memory")
__device__ __forceinline__ unsigned f2bf(float f) { unsigned u = __builtin_bit_cast(unsigned, f); return (u + 0x7fffu + ((u >> 16) & 1u)) >> 16; }
__device__ __forceinline__ unsigned pk2(float lo, float hi) { return f2bf(lo) | (f2bf(hi) << 16); }
__device__ __forceinline__ float bf2f(unsigned short b) { return __uint_as_float(((unsigned)b) << 16); }
__device__ __forceinline__ float bflo(unsigned w) { return __uint_as_float(w << 16); }
__device__ __forceinline__ float bfhi(unsigned w) { return __uint_as_float(w & 0xffff0000u); }

#define XB_TMO      128
#define XB_XCNT(j)  (256  + 64 * (j))
#define XB_XSUB(j)  (1280 + 64 * (j))
#define XB_XGEN(j)  (2304 + 64 * (j))
#define XB_TOP      3328
#define XB_TOPGEN   3392
#define XCD_BAR_WORDS 3456
#define XB_SPIN_CAP (1u << 18)

__device__ __forceinline__ unsigned xb_ld(unsigned* p)              { return __hip_atomic_load(p, __ATOMIC_RELAXED, __HIP_MEMORY_SCOPE_AGENT); }
__device__ __forceinline__ unsigned xb_add(unsigned* p, unsigned v) { return __hip_atomic_fetch_add(p, v, __ATOMIC_RELAXED, __HIP_MEMORY_SCOPE_AGENT); }
__device__ __forceinline__ unsigned xb_xcc_id() { return (unsigned)__builtin_amdgcn_s_getreg((3 << 11) | 20) & 0xFu; }
#define XB_SPIN(cond, bar) do { unsigned _sp = 0; while (cond) { __builtin_amdgcn_s_sleep(1); \
    if ((++_sp & 255u) == 0u) { if (xb_ld(&(bar)[XB_TMO])) break; if (_sp > XB_SPIN_CAP) { atomicAdd(&(bar)[XB_TMO], 1u); break; } } } } while (0)

struct XcdBarrier {
    unsigned* bar; unsigned x;
    volatile LAS unsigned* st;
};

__device__ __forceinline__ XcdBarrier xcd_barrier_post(unsigned* bar, volatile LAS unsigned* st) {
    XcdBarrier b; b.bar = bar; b.x = xb_xcc_id(); b.st = st;
    if (threadIdx.x == 0) (void)xb_add(&bar[XB_XCNT(b.x)], 1u);
    return b;
}
__device__ __forceinline__ void xcd_barrier_complete(unsigned* bar, unsigned x, unsigned& nloc, unsigned& nx) {
    const unsigned G = gridDim.x * gridDim.y * gridDim.z;
    unsigned sum, cnt, mine, sp = 0u;
    for (;;) {
        sum = 0u; cnt = 0u; mine = 0u;
#pragma unroll
        for (unsigned j = 0; j < 16; ++j) { const unsigned c = xb_ld(&bar[XB_XCNT(j)]); sum += c; cnt += (c > 0u) ? 1u : 0u; mine = (j == x) ? c : mine; }
        if (sum == G) break;
        __builtin_amdgcn_s_sleep(1);
        if ((++sp & 255u) == 0u) { if (xb_ld(&bar[XB_TMO])) break; if (sp > XB_SPIN_CAP) { atomicAdd(&bar[XB_TMO], 1u); break; } }
    }
    nloc = mine > 0u ? mine : 1u; nx = cnt > 0u ? cnt : 1u;
}

__device__ __forceinline__ void xcd_barrier(const XcdBarrier& b) {
    asm volatile("s_waitcnt vmcnt(0)" ::: "memory");
    __syncthreads();
    if (threadIdx.x == 0) {
        unsigned* bar = b.bar;
        __builtin_amdgcn_s_waitcnt(0);
        unsigned nloc = b.st[0], nx = b.st[1];
        if (nloc == 0u) { xcd_barrier_complete(bar, b.x, nloc, nx); b.st[0] = nloc; b.st[1] = nx; }
        const unsigned old = xb_add(&bar[XB_XSUB(b.x)], 1u);
        const unsigned gen = old / nloc;
        if (old + 1u == (gen + 1u) * nloc) {
            __builtin_amdgcn_fence(__ATOMIC_RELEASE, "agent");
            asm volatile("s_waitcnt vmcnt(0)" ::: "memory");
            const unsigned og = xb_add(&bar[XB_TOP], 1u);
            const unsigned tg = og / nx;
            if (og + 1u == (tg + 1u) * nx) xb_add(&bar[XB_TOPGEN], 1u);
            else XB_SPIN(xb_ld(&bar[XB_TOPGEN]) == tg, bar);
            __builtin_amdgcn_fence(__ATOMIC_ACQUIRE, "agent");
            xb_add(&bar[XB_XGEN(b.x)], 1u);
            asm volatile("s_waitcnt vmcnt(0)" ::: "memory");
        } else {
            XB_SPIN(xb_ld(&bar[XB_XGEN(b.x)]) == gen, bar);
            __builtin_amdgcn_fence(__ATOMIC_ACQUIRE, "agent");
            asm volatile("s_waitcnt vmcnt(0)" ::: "memory");
        }
    }
    __syncthreads();
}


typedef float f32x2_cv __attribute__((ext_vector_type(2))); typedef __bf16 bf16x2_cv __attribute__((ext_vector_type(2)));
__device__ __forceinline__ unsigned cvtpk(float lo, float hi) { f32x2_cv v = {lo, hi}; bf16x2_cv b = __builtin_convertvector(v, bf16x2_cv); return __builtin_bit_cast(unsigned, b); }
#define DPPF(v, ctrl) __builtin_bit_cast(float, __builtin_amdgcn_update_dpp(0, __builtin_bit_cast(int, (v)), (ctrl), 0xF, 0xF, false))
__device__ __forceinline__ float wave_sum(float v) {
    v += DPPF(v, 0xB1);
    v += DPPF(v, 0x4E);
    v += DPPF(v, 0x141);
    v += DPPF(v, 0x140);
    { auto rr = __builtin_amdgcn_permlane16_swap(__float_as_uint(v), __float_as_uint(v), false, false); v = __uint_as_float(rr[0]) + __uint_as_float(rr[1]); }
    { auto rr = __builtin_amdgcn_permlane32_swap(__float_as_uint(v), __float_as_uint(v), false, false); v = __uint_as_float(rr[0]) + __uint_as_float(rr[1]); }
    return v;
}
__device__ __forceinline__ void wave_sum4(float& a0, float& a1, float& a2, float& a3, int lane) {
    const bool o1 = (lane & 1) != 0, o2 = (lane & 2) != 0;
    float u = o1 ? a1 : a0; const float us = o1 ? a0 : a1; u += DPPF(us, 0xB1);
    float w = o1 ? a3 : a2; const float wsn = o1 ? a2 : a3; w += DPPF(wsn, 0xB1);
    float p = o2 ? w : u; const float ps = o2 ? u : w; p += DPPF(ps, 0x4E);
    p += DPPF(p, 0x124);
    p += DPPF(p, 0x128);
    { auto rr = __builtin_amdgcn_permlane16_swap(__float_as_uint(p), __float_as_uint(p), false, false); p = __uint_as_float(rr[0]) + __uint_as_float(rr[1]); }
    { auto rr = __builtin_amdgcn_permlane32_swap(__float_as_uint(p), __float_as_uint(p), false, false); p = __uint_as_float(rr[0]) + __uint_as_float(rr[1]); }
    a0 = DPPF(p, 0x00); a1 = DPPF(p, 0x55); a2 = DPPF(p, 0xAA); a3 = DPPF(p, 0xFF);
}
__device__ __forceinline__ float wave_max(float v) {
#pragma unroll
    for (int o = 1; o < 64; o <<= 1) v = fmaxf(v, __shfl_xor(v, o));
    return v;
}
__device__ __forceinline__ float sigmoidf_(float x) { return __builtin_amdgcn_rcpf(1.0f + __builtin_amdgcn_exp2f(-1.4426950408889634f * x)); }
__device__ __forceinline__ float gelu_tanh(float x) { const float u = 0.7978845608028654f * (x + 0.044715f * x * x * x); return x * __builtin_amdgcn_rcpf(1.0f + __builtin_amdgcn_exp2f(-2.8853900817779268f * u)); }

struct TrItem { const float* src; int N; bf16* dst; int ldt, drow0, n0; bool mode16; };
__device__ __forceinline__ TrItem tr_make(const float* W, int N, int k0, int n0, bf16* WT, int ldt, int drow0, int dcol0, bool mode16 = false) {
    TrItem t; t.src = W + (size_t)k0 * N + n0; t.N = N; t.dst = WT + dcol0; t.ldt = ldt; t.drow0 = drow0; t.n0 = n0; t.mode16 = mode16; return t; }
__device__ __forceinline__ void tr_load(const TrItem& t, int lane, f32x4 (&v)[8]) {
#pragma unroll
    for (int i = 0; i < 8; ++i) v[i] = __builtin_nontemporal_load((const f32x4*)(t.src + (size_t)(8 * i + (lane >> 3)) * t.N + 4 * (lane & 7)));
}
__device__ __forceinline__ void tr_store(const TrItem& t, const f32x4 (&v)[8], LAS float* scr, int lane) {
#pragma unroll
    for (int i = 0; i < 8; ++i) { LAS float* d = scr + (8 * i + (lane >> 3)) * 33 + 4 * (lane & 7); d[0] = v[i].x; d[1] = v[i].y; d[2] = v[i].z; d[3] = v[i].w; }
    LDS_WAIT(); asm volatile("" ::: "memory");
    const int c = lane & 7;
#pragma unroll
    for (int j = 0; j < 4; ++j) { const int n = (lane >> 3) + 8 * j; const LAS float* s = scr + (8 * c) * 33 + n;
        v4u o; o.x = pk2(s[0 * 33], s[1 * 33]); o.y = pk2(s[2 * 33], s[3 * 33]); o.z = pk2(s[4 * 33], s[5 * 33]); o.w = pk2(s[6 * 33], s[7 * 33]);
        const int c0 = t.n0 & 255, drow = t.mode16 ? t.drow0 + 128 * (j & 1) + 32 * (c0 >> 6) + 16 * ((c0 >> 5) & 1) + 8 * (j >> 1) + (lane >> 3) : t.drow0 + n;
        *(v4u*)(t.dst + (size_t)drow * t.ldt + 8 * c) = o; }
    LDS_WAIT(); asm volatile("" ::: "memory");
}
template <class Decode>
__device__ __forceinline__ void tr_pipeline(int first, int limit, int stride, const Decode& dec, LAS float* scr, int lane) {
    f32x4 va[8], vb[8]; TrItem ta, tb;
    int it = first;
    if (it < limit) { ta = dec(it); tr_load(ta, lane, va); }
#pragma unroll 1
    while (it < limit) {
        const int i1 = it + stride, i2 = i1 + stride;
        if (i1 < limit) { tb = dec(i1); tr_load(tb, lane, vb); }
        tr_store(ta, va, scr, lane);
        if (i1 >= limit) break;
        if (i2 < limit) { ta = dec(i2); tr_load(ta, lane, va); }
        tr_store(tb, vb, scr, lane);
        it = i2;
    }
}

struct Args { const void* in[40]; float* out; unsigned char* ws; int ph_lo, ph_hi; };

enum { I_X = 0, I_C, I_POS, I_ADAW, I_ADAB, I_N1G, I_WIN, I_POOLW, I_POOLS, I_QNG, I_KNG, I_LQ1, I_LK1, I_LQ2, I_LK2, I_SUBLN,
       I_LAMRE, I_LAMIM, I_LOGDT, I_BRE, I_BIM, I_CRE, I_CIM, I_DSKIP, I_GLUW, I_GLUB, I_PROJA, I_PROJB, I_PROJC, I_GATEW, I_GATEB,
       I_WOUT, I_N2G, I_RGW, I_RGB, I_REW, I_REB, I_W1, I_W3, I_W2 };

__device__ __forceinline__ float lambda_init_of(int l) { return l == 0 ? 0.2f : (l == 1 ? 0.35550906759096926f : (l == 2 ? 0.47071302343358413f : 0.5560582041556841f)); }

__device__ __forceinline__ void prologue_phase(const Args& a, LAS unsigned char* lds) {
    const int z = opq(); (void)z;
    const int tid = opqv((int)threadIdx.x), lane = tid & 63, wave = __builtin_amdgcn_readfirstlane(tid >> 6); const int G = (int)gridDim.x, bx = (int)blockIdx.x;
    const int vcu = (G % 8 == 0) ? (bx % 8) * (G / 8) + bx / 8 : bx; const int gw = vcu * NWAVES + wave, NGW = G * NWAVES, gt = vcu * 512 + tid;
    (void)lane; (void)gw; (void)NGW; (void)gt; (void)bx;
    unsigned char* ws = (a.ws + z);
    const int NGT = G * 512;
    LAS float* scr = (LAS float*)(lds + RING_OFF + wave * 16384);
    {
        constexpr int I_IN = 16 * 64, I_GT = 16 * 96, I_PB = 8 * 32, I_PC = 4 * 32, I_WOI = 16 * 32, I_GL = 4 * 8;
        constexpr int PER_L = I_IN + I_GT + I_PB + I_PC + I_WOI + I_GL;
        struct Dec { const Args& a; unsigned char* ws; int z;
            __device__ __forceinline__ TrItem operator()(int it) const {
                const int l = it / PER_L; int r = it - l * PER_L;
                bf16* wcat = (bf16*)(ws + WS_WCAT) + (size_t)l * NCAT * 1024;
                bf16* wmix = (bf16*)(ws + WS_WMIX) + (size_t)l * 1024 * 1024;
                if (r < I_IN) { const int kb = r / 64, nb = r % 64; int drow = nb * 32;
                    { const int lg = nb & 7, p = 4 * (lg & 1) + (lg >> 1); drow = (nb & ~7) * 32 + 32 * p; }
                    return tr_make((const float*)a.in[z + I_WIN] + (size_t)l * 1024 * ZW, ZW, kb * 64, nb * 32, wcat, 1024, drow, kb * 64); } r -= I_IN;
                if (r < I_GT) { const int kb = r / 96, nb = r % 96;
                    return tr_make((const float*)a.in[z + I_GATEW] + (size_t)l * 1024 * GWD, GWD, kb * 64, nb * 32, wcat, 1024, ZW + (nb & ~7) * 32, kb * 64, true); } r -= I_GT;
                if (r < I_PB) { const int kb = r / 32, nb = r % 32; return tr_make((const float*)a.in[z + I_PROJB] + (size_t)l * 512 * 1024, 1024, kb * 64, nb * 32, wmix, 1024, (nb & ~7) * 32, 256 + kb * 64, true); } r -= I_PB;
                if (r < I_PC) { const int kb = r / 32, nb = r % 32; return tr_make((const float*)a.in[z + I_PROJC] + (size_t)l * 256 * 1024, 1024, kb * 64, nb * 32, wmix, 1024, (nb & ~7) * 32, 768 + kb * 64, true); } r -= I_PC;
                if (r < I_WOI) { const int kb = r / 32, nb = r % 32; return tr_make((const float*)a.in[z + I_WOUT] + (size_t)l * 1024 * 1024, 1024, kb * 64, nb * 32, (bf16*)(ws + WS_WO) + (size_t)l * 1024 * 1024, 1024, nb * 32, kb * 64); } r -= I_WOI;
                { const int kb = r / 8, nb = r % 8; return tr_make((const float*)a.in[z + I_GLUW] + (size_t)l * 256 * 256, 256, kb * 64, nb * 32, (bf16*)(ws + WS_WGLU) + (size_t)l * 256 * 256, 256, nb * 32, kb * 64); }
            } };
        tr_pipeline(gw, DEPTH * PER_L, NGW, Dec{a, ws, z}, scr, lane);
    }
    for (int idx = gt; idx < DEPTH * 256 * 1024; idx += NGT) {
        const int l = idx >> 18, k = (idx >> 10) & 255, n = idx & 1023, g = k >> 6, c = k & 63;
        const float* pw = (const float*)a.in[z + I_POOLW] + ((size_t)(l * 4 + g) * 64 + c) * 64;
        const float* ps = (const float*)a.in[z + I_POOLS] + l * 256 + g * 64;
        const float* pa = (const float*)a.in[z + I_PROJA] + ((size_t)l * 256 + g * 64) * 1024 + n;
        float s = 0.f;
        for (int d = 0; d < 64; ++d) s += pw[d] * ps[d] * pa[(size_t)d * 1024];
        const int cc = n & 255, prow = (n & ~255) + 128 * ((cc >> 3) & 1) + 32 * (cc >> 6) + 8 * ((cc >> 4) & 3) + (cc & 7);
        ((bf16*)(ws + WS_WMIX))[((size_t)l * 1024 + prow) * 1024 + k] = (bf16)f2bf(s);
    }
    for (int idx = gt; idx < T * 32; idx += NGT) {
        const int t = idx >> 5, i = idx & 31;
        const float inv = powf(10000.0f, -(float)(2 * i) / 64.0f);
        const float ang = (float)((const int*)a.in[z + I_POS])[t] * inv;
        ((float*)(ws + WS_ROPE_C))[idx] = cosf(ang); ((float*)(ws + WS_ROPE_S))[idx] = sinf(ang);
    }
    for (int idx = gt; idx < DEPTH * 16 * 64; idx += NGT) {
        const int l = idx >> 10, g = (idx >> 6) & 15, p = idx & 63;
        const float lr = ((const float*)a.in[z + I_LAMRE])[idx], li = ((const float*)a.in[z + I_LAMIM])[idx];
        const float dt = expf(((const float*)a.in[z + I_LOGDT])[l * 16 + g]);
        const float mag = expf(lr * dt), ar = mag * cosf(li * dt), ai = mag * sinf(li * dt);
        const float nr = ar - 1.0f, ni = ai, den = lr * lr + li * li;
        const float kr = (nr * lr + ni * li) / den, ki = (ni * lr - nr * li) / den;
        unsigned char* base = ws + WS_SSM + (size_t)l * SSM_L_BYTES;
        ((f32x2*)base)[g * 64 + p] = (f32x2){ar, ai};
        float pr = ar, pi = ai;
#pragma unroll
        for (int q = 0; q < 6; ++q) { const float tr = pr * pr - pi * pi, ti = 2.0f * pr * pi; pr = tr; pi = ti; }
        ((f32x2*)(base + 8192))[g * 64 + p] = (f32x2){pr, pi};
        const float* br = (const float*)a.in[z + I_BRE] + (size_t)idx * 16; const float* bi = (const float*)a.in[z + I_BIM] + (size_t)idx * 16;
        bf16* bbh = (bf16*)(base + 16384) + (size_t)g * 128 * 16;
        for (int ch = 0; ch < 16; ++ch) { bbh[p * 16 + ch] = (bf16)f2bf(kr * br[ch] - ki * bi[ch]); bbh[(64 + p) * 16 + ch] = (bf16)f2bf(kr * bi[ch] + ki * br[ch]); }
    }
    if (gt < DEPTH) {
        const int l = gt; float s1 = 0.f, s2 = 0.f;
        for (int d = 0; d < 64; ++d) { s1 += ((const float*)a.in[z + I_LQ1])[l * 64 + d] * ((const float*)a.in[z + I_LK1])[l * 64 + d]; s2 += ((const float*)a.in[z + I_LQ2])[l * 64 + d] * ((const float*)a.in[z + I_LK2])[l * 64 + d]; }
        ((float*)(ws + WS_LAM))[l] = expf(s1) - expf(s2) + lambda_init_of(l);
    }
    for (int idx = gt; idx < DEPTH * 36 * 1024; idx += NGT) {
        const int l = idx / (36 * 1024), r = idx - l * 36 * 1024, j = r >> 10, k = r & 1023;
        ((float*)(ws + WS_RWT))[idx] = j < 4 ? ((const float*)a.in[z + I_RGW])[((size_t)l * 1024 + k) * 4 + j] : ((const float*)a.in[z + I_REW])[((size_t)l * 1024 + k) * 32 + (j - 4)];
    }
    {
        LAS float* cact = (LAS float*)(lds + RING_OFF);
        __syncthreads();
        for (int i = tid; i < NB * 1024; i += 512) { const float cv = ((const float*)a.in[z + I_C])[i]; cact[i] = cv * sigmoidf_(cv); }
        __syncthreads();
        const int c4 = tid & 15, kp = tid >> 4;
        for (int u = vcu; u < DEPTH * 96; u += G) {
            const int l = u / 96, cg = u % 96;
            const float* w = (const float*)a.in[z + I_ADAW] + (size_t)l * 1024 * 6144 + cg * 64 + 4 * c4;
            f32x4 acc[NB];
#pragma unroll
            for (int b = 0; b < NB; ++b) acc[b] = (f32x4){0.f, 0.f, 0.f, 0.f};
#pragma unroll 4
            for (int k = kp * 32; k < kp * 32 + 32; ++k) { const f32x4 wv = __builtin_nontemporal_load((const f32x4*)(w + (size_t)k * 6144));
#pragma unroll
                for (int b = 0; b < NB; ++b) acc[b] = acc[b] + wv * cact[b * 1024 + k]; }
            LAS float* red = (LAS float*)(lds + RING_OFF + 32768);
#pragma unroll
            for (int b = 0; b < NB; ++b) *(LAS f32x4*)(red + (kp * NB + b) * 64 + 4 * c4) = acc[b];
            __syncthreads();
            { const int b = tid >> 6, col = tid & 63; float s = 0.f;
#pragma unroll
              for (int q = 0; q < 32; ++q) s += red[(q * NB + b) * 64 + col];
              ((float*)(ws + WS_MOD))[((size_t)l * NB + b) * 6144 + cg * 64 + col] = s + ((const float*)a.in[z + I_ADAB])[l * 6144 + cg * 64 + col]; }
            __syncthreads();
        }
    }
}

__device__ __forceinline__ void moe_weights_phase(const Args& a, int l, LAS unsigned char* lds) {
    const int z = opq(); (void)z;
    const int tid = opqv((int)threadIdx.x), lane = tid & 63, wave = __builtin_amdgcn_readfirstlane(tid >> 6); const int G = (int)gridDim.x, bx = (int)blockIdx.x;
    const int vcu = (G % 8 == 0) ? (bx % 8) * (G / 8) + bx / 8 : bx; const int gw = vcu * NWAVES + wave, NGW = G * NWAVES, gt = vcu * 512 + tid;
    (void)lane; (void)gw; (void)NGW; (void)gt; (void)bx;
    LAS float* scr = (LAS float*)(lds + RING_OFF + wave * 16384);
    bf16* w13 = (bf16*)((a.ws + z) + WS_W13); bf16* w2t = (bf16*)((a.ws + z) + WS_W2);
    struct Dec { const Args& a; int z, l; bf16* w13; bf16* w2t;
        __device__ __forceinline__ TrItem operator()(int it) const {
            const int e = it / 768; int r = it - e * 768;
            if (r < 512) { const int which = r >> 8; r &= 255; const int kb = r >> 4, nb = r & 15, n0 = nb * 32;
                const float* W = (const float*)a.in[z + (which ? I_W3 : I_W1)] + ((size_t)l * NEXP + e) * 1024 * 512;
                return tr_make(W, 512, kb * 64, n0, w13, 1024, e * 1024 + (n0 >> 7) * 256 + which * 128 + (n0 & 127), kb * 64); }
            else { r -= 512; const int kb = r >> 5, nb = r & 31;
                const float* W = (const float*)a.in[z + I_W2] + ((size_t)l * NEXP + e) * 512 * 1024;
                return tr_make(W, 1024, kb * 64, nb * 32, w2t, 512, e * 1024 + nb * 32, kb * 64); }
        } };
    tr_pipeline(gw, NEXP * 768, NGW, Dec{a, z, l, w13, w2t}, scr, lane);
}

__device__ __forceinline__ void norm1_phase(const Args& a, int l, bool first, bool do_norm) {
    const int z = opq(); (void)z;
    const int tid = opqv((int)threadIdx.x), lane = tid & 63, wave = __builtin_amdgcn_readfirstlane(tid >> 6); const int G = (int)gridDim.x, bx = (int)blockIdx.x;
    const int vcu = (G % 8 == 0) ? (bx % 8) * (G / 8) + bx / 8 : bx; const int gw = vcu * NWAVES + wave, NGW = G * NWAVES;
    unsigned char* ws = (a.ws + z);
    const float* mod = (const float*)(ws + WS_MOD);
    const bf16* Y = (const bf16*)(ws + WS_Y);
    const int* tok_slot = (const int*)(ws + WS_TOKS); const float* tok_w = (const float*)(ws + WS_TOKW);
    bf16* H = (bf16*)(ws + WS_H);
    const float* xin = (const float*)a.in[z + I_X]; bf16* XB = (bf16*)(ws + WS_XB);
#pragma unroll 1
    for (int blk = gw; blk < T / 16; blk += NGW) {
        const int mB = blk * 16, b = mB >> 12;
        f32x4 g2v[4], gnv[4], shv[4], scv[4];
        if (!first) { const float* g2 = mod + ((size_t)(l - 1) * NB + b) * 6144 + 5 * 1024;
#pragma unroll
            for (int q = 0; q < 4; ++q) g2v[q] = *(const f32x4*)(g2 + 512 * (q >> 1) + 8 * lane + 4 * (q & 1)); }
        if (do_norm) { const float* mrow = mod + ((size_t)l * NB + b) * 6144; const float* gn = (const float*)a.in[z + I_N1G] + l * D;
#pragma unroll
            for (int q = 0; q < 4; ++q) { const int co = 512 * (q >> 1) + 8 * lane + 4 * (q & 1); gnv[q] = *(const f32x4*)(gn + co); shv[q] = *(const f32x4*)(mrow + co); scv[q] = *(const f32x4*)(mrow + 1024 + co) + 1.0f; } }
#pragma unroll 1
        for (int r2 = 0; r2 < 16; r2 += 2) {
            f32x4 v[2][4]; v4u yp[2][2], yq[2][2]; float w0[2], w1[2];
            if (first) {
#pragma unroll
            for (int r = 0; r < 2; ++r) { const float* xr = xin + (size_t)(mB + r2 + r) * D;
#pragma unroll
                for (int q = 0; q < 4; ++q) v[r][q] = __builtin_nontemporal_load((const f32x4*)(xr + 512 * (q >> 1) + 8 * lane + 4 * (q & 1))); }
            } else {
#pragma unroll
            for (int r = 0; r < 2; ++r)
#pragma unroll
                for (int hq = 0; hq < 2; ++hq) { const v4u xw = __builtin_nontemporal_load((const v4u*)(XB + (size_t)(mB + r2 + r) * D + 512 * hq + 8 * lane));
                    v[r][2 * hq] = (f32x4){bflo(xw.x), bfhi(xw.x), bflo(xw.y), bfhi(xw.y)}; v[r][2 * hq + 1] = (f32x4){bflo(xw.z), bfhi(xw.z), bflo(xw.w), bfhi(xw.w)}; }
            }
            if (!first) {
#pragma unroll
                for (int r = 0; r < 2; ++r) { const int m = mB + r2 + r; const int s0 = tok_slot[2 * m], s1 = tok_slot[2 * m + 1]; w0[r] = tok_w[2 * m]; w1[r] = tok_w[2 * m + 1];
#pragma unroll
                    for (int hq = 0; hq < 2; ++hq) { yp[r][hq] = __builtin_nontemporal_load((const v4u*)(Y + (size_t)s0 * D + 512 * hq + 8 * lane)); yq[r][hq] = __builtin_nontemporal_load((const v4u*)(Y + (size_t)s1 * D + 512 * hq + 8 * lane)); } }
#pragma unroll
                for (int r = 0; r < 2; ++r)
#pragma unroll
                    for (int hq = 0; hq < 2; ++hq) { const v4u p = yp[r][hq], q = yq[r][hq]; f32x4& va = v[r][2 * hq]; f32x4& vb = v[r][2 * hq + 1]; const f32x4 ga = g2v[2 * hq], gb = g2v[2 * hq + 1];
                        va.x += ga.x * (w0[r] * bflo(p.x) + w1[r] * bflo(q.x)); va.y += ga.y * (w0[r] * bfhi(p.x) + w1[r] * bfhi(q.x));
                        va.z += ga.z * (w0[r] * bflo(p.y) + w1[r] * bflo(q.y)); va.w += ga.w * (w0[r] * bfhi(p.y) + w1[r] * bfhi(q.y));
                        vb.x += gb.x * (w0[r] * bflo(p.z) + w1[r] * bflo(q.z)); vb.y += gb.y * (w0[r] * bfhi(p.z) + w1[r] * bfhi(q.z));
                        vb.z += gb.z * (w0[r] * bflo(p.w) + w1[r] * bflo(q.w)); vb.w += gb.w * (w0[r] * bfhi(p.w) + w1[r] * bfhi(q.w)); }
            }
            if (!first && do_norm) {
#pragma unroll
            for (int r = 0; r < 2; ++r)
#pragma unroll
                for (int hq = 0; hq < 2; ++hq) { const f32x4 xa = v[r][2 * hq], xb = v[r][2 * hq + 1];
                    v4u o; o.x = pk2(xa.x, xa.y); o.y = pk2(xa.z, xa.w); o.z = pk2(xb.x, xb.y); o.w = pk2(xb.z, xb.w);
                    *(v4u*)(XB + (size_t)(mB + r2 + r) * D + 512 * hq + 8 * lane) = o; } }
            if (!do_norm) {
#pragma unroll
            for (int r = 0; r < 2; ++r) { float* xo = (a.out + z) + (size_t)(mB + r2 + r) * D;
#pragma unroll
                for (int q = 0; q < 4; ++q) __builtin_nontemporal_store(v[r][q], (f32x4*)(xo + 512 * (q >> 1) + 8 * lane + 4 * (q & 1))); } }
            if (do_norm) {
#pragma unroll
                for (int r = 0; r < 2; ++r) {
                    float ss = 0.f;
#pragma unroll
                    for (int q = 0; q < 4; ++q) ss += (v[r][q].x * v[r][q].x + v[r][q].y * v[r][q].y) + (v[r][q].z * v[r][q].z + v[r][q].w * v[r][q].w);
                    const float rr = rsqrtf(wave_sum(ss) * (1.0f / D) + NORM_EPS);
#pragma unroll
                    for (int hq = 0; hq < 2; ++hq) { const f32x4 ha = (v[r][2 * hq] * rr * gnv[2 * hq]) * scv[2 * hq] + shv[2 * hq], hb = (v[r][2 * hq + 1] * rr * gnv[2 * hq + 1]) * scv[2 * hq + 1] + shv[2 * hq + 1];
                        v4u o; o.x = pk2(ha.x, ha.y); o.y = pk2(ha.z, ha.w); o.z = pk2(hb.x, hb.y); o.w = pk2(hb.z, hb.w);
                        *(v4u*)(H + (size_t)(mB + r2 + r) * D + 512 * hq + 8 * lane) = o; }
                }
            }
        }
    }
}

__device__ __forceinline__ void qkprep_phase(const Args& a, int l) {
    const int z = opq(); (void)z;
    const int tid = opqv((int)threadIdx.x), lane = tid & 63, wave = __builtin_amdgcn_readfirstlane(tid >> 6); const int G = (int)gridDim.x, bx = (int)blockIdx.x;
    const int vcu = (G % 8 == 0) ? (bx % 8) * (G / 8) + bx / 8 : bx; const int gw = vcu * NWAVES + wave, NGW = G * NWAVES;
    unsigned char* ws = (a.ws + z); bf16* Z = (bf16*)(ws + WS_Z);
    const int sq = lane & 3; const bool isq = lane < 32, lowhalf = sq < 2;
    float gn[16];
    { const float* gp = (const float*)a.in[z + (isq ? I_QNG : I_KNG)] + l * 64 + 16 * sq;
#pragma unroll
      for (int i = 0; i < 16; ++i) gn[i] = gp[i] * (isq ? (ATTN_FAST ? 0.125f * 1.4426950408889634f : 0.125f) : 1.0f); }
    const float* RC = (const float*)(ws + WS_ROPE_C) + 16 * (sq & 1); const float* RS = (const float*)(ws + WS_ROPE_S) + 16 * (sq & 1);
#pragma unroll 1
    for (int m2 = gw; m2 < T / 2; m2 += NGW) {
        v4u w[2][2]; f32x4 cs[2][4], sn[2][4];
#pragma unroll
        for (int r = 0; r < 2; ++r) { const int m = m2 * 2 + r; const v4u* zp = (const v4u*)(Z + (size_t)m * ZW + ZQ) + 2 * lane; w[r][0] = zp[0]; w[r][1] = zp[1];
#pragma unroll
            for (int q = 0; q < 4; ++q) { cs[r][q] = *((const f32x4*)(RC + (size_t)m * 32) + q); sn[r][q] = *((const f32x4*)(RS + (size_t)m * 32) + q); } }
#pragma unroll
        for (int r = 0; r < 2; ++r) { const int m = m2 * 2 + r;
            float x[16];
#pragma unroll
            for (int q = 0; q < 2; ++q) { x[8 * q + 0] = bflo(w[r][q].x); x[8 * q + 1] = bfhi(w[r][q].x); x[8 * q + 2] = bflo(w[r][q].y); x[8 * q + 3] = bfhi(w[r][q].y);
                x[8 * q + 4] = bflo(w[r][q].z); x[8 * q + 5] = bfhi(w[r][q].z); x[8 * q + 6] = bflo(w[r][q].w); x[8 * q + 7] = bfhi(w[r][q].w); }
            float ss = 0.f;
#pragma unroll
            for (int i = 0; i < 16; ++i) ss += x[i] * x[i];
            ss += DPPF(ss, 0xB1); ss += DPPF(ss, 0x4E);
            const float rr = rsqrtf(ss * (1.0f / 64.0f) + NORM_EPS);
            unsigned ow[8];
#pragma unroll
            for (int i = 0; i < 16; i += 2) {
                const float y0 = x[i] * rr * gn[i], y1 = x[i + 1] * rr * gn[i + 1];
                const float p0 = DPPF(y0, 0x4E), p1 = DPPF(y1, 0x4E);
                const float c0 = cs[r][i >> 2][i & 3], c1 = cs[r][i >> 2][(i & 3) + 1], s0 = sn[r][i >> 2][i & 3], s1 = sn[r][i >> 2][(i & 3) + 1];
                const float o0 = lowhalf ? y0 * c0 - p0 * s0 : y0 * c0 + p0 * s0, o1 = lowhalf ? y1 * c1 - p1 * s1 : y1 * c1 + p1 * s1;
                ow[i >> 1] = pk2(o0, o1); }
            v4u* zo = (v4u*)(Z + (size_t)m * ZW + ZQ) + 2 * lane;
            zo[0] = (v4u){ow[0], ow[1], ow[2], ow[3]}; zo[1] = (v4u){ow[4], ow[5], ow[6], ow[7]}; }
    }
}

__device__ __forceinline__ void pool_phase(const Args& a, LAS unsigned char* lds) {
    const int z = opq(); (void)z;
    const int tid = opqv((int)threadIdx.x), lane = tid & 63, wave = __builtin_amdgcn_readfirstlane(tid >> 6); const int G = (int)gridDim.x, bx = (int)blockIdx.x;
    const int vcu = (G % 8 == 0) ? (bx % 8) * (G / 8) + bx / 8 : bx; const int gw = vcu * NWAVES + wave, NGW = G * NWAVES, gt = vcu * 512 + tid;
    (void)lane; (void)gw; (void)NGW; (void)gt; (void)bx;
    const bf16* Z = (const bf16*)((a.ws + z) + WS_Z); bf16* AM = (bf16*)((a.ws + z) + WS_AMIX);
    LAS float* U = (LAS float*)(lds + RING_OFF);
    for (int tl = vcu; tl < T / 64; tl += G) {
        const int m0 = tl * 64, s0 = m0 & (SEQ - 1);
        __syncthreads();
        for (int idx = tid; idx < 80 * 32; idx += 512) { const int r = idx >> 5, c8 = (idx & 31) * 8; const int sp = s0 - 16 + r;
            v4u w = (v4u){0u, 0u, 0u, 0u};
            if (sp >= 0) w = *(const v4u*)(Z + (size_t)(m0 - 16 + r) * ZW + c8);
            LAS float* u = U + r * 256 + c8;
            u[0] = bflo(w.x); u[1] = bfhi(w.x); u[2] = bflo(w.y); u[3] = bfhi(w.y); u[4] = bflo(w.z); u[5] = bfhi(w.z); u[6] = bflo(w.w); u[7] = bfhi(w.w); }
        __syncthreads();
        const int cc = tid & 31, tg = tid >> 5, g = cc >> 3, w = 2 << g;
        const LAS f32x4* U4 = (const LAS f32x4*)U + cc * 2;
        f32x4 sa = (f32x4){0.f, 0.f, 0.f, 0.f}, sb = sa; const int t0 = tg * 4;
        for (int q = 0; q < w; ++q) { sa = sa + U4[(16 + t0 - q) * 64]; sb = sb + U4[(16 + t0 - q) * 64 + 1]; }
#pragma unroll
        for (int i = 0; i < 4; ++i) { const int t = t0 + i;
            if (i > 0) { sa = sa + U4[(16 + t) * 64] - U4[(16 + t - w) * 64]; sb = sb + U4[(16 + t) * 64 + 1] - U4[(16 + t - w) * 64 + 1]; }
            const int cnt = (s0 + t + 1) < w ? (s0 + t + 1) : w; const float rc = 1.0f / (float)cnt;
            const f32x4 ua = U4[(16 + t) * 64], ub = U4[(16 + t) * 64 + 1], oa = sa * rc - ua, ob = sb * rc - ub;
            v4u o; o.x = pk2(oa.x, oa.y); o.y = pk2(oa.z, oa.w); o.z = pk2(ob.x, ob.y); o.w = pk2(ob.z, ob.w);
            *(v4u*)(AM + (size_t)(m0 + t) * D + cc * 8) = o; }
    }
}

__device__ __forceinline__ void load_u16(const bf16* up, float (&u)[16]) {
    const v4u w0 = *(const v4u*)up, w1 = *(const v4u*)(up + 8);
    u[0] = bflo(w0.x); u[1] = bfhi(w0.x); u[2] = bflo(w0.y); u[3] = bfhi(w0.y); u[4] = bflo(w0.z); u[5] = bfhi(w0.z); u[6] = bflo(w0.w); u[7] = bfhi(w0.w);
    u[8] = bflo(w1.x); u[9] = bfhi(w1.x); u[10] = bflo(w1.y); u[11] = bfhi(w1.y); u[12] = bflo(w1.z); u[13] = bfhi(w1.z); u[14] = bflo(w1.w); u[15] = bfhi(w1.w);
}
constexpr int BUP = 68;
typedef short bf16x4_t __attribute__((ext_vector_type(4)));
struct BqT { bf16x4_t v[8]; };
__device__ __forceinline__ bf16x4_t ssm_ld_a(const bf16* zrow0  , int fr, int fq) { return *(const bf16x4_t*)(zrow0 + (size_t)fr * ZW + fq * 4); }
__device__ __forceinline__ void ssm_bu16(const bf16x4_t Af, const bf16x4_t (&Bq)[8], LAS unsigned* BU, int fr, int fq) {
#pragma unroll
    for (int cb = 0; cb < 4; ++cb) { const pg8::f32x4 are = __builtin_amdgcn_mfma_f32_16x16x16bf16_1k(Af, Bq[cb], (pg8::f32x4){0.f, 0.f, 0.f, 0.f}, 0, 0, 0);
        const pg8::f32x4 aim = __builtin_amdgcn_mfma_f32_16x16x16bf16_1k(Af, Bq[cb + 4], (pg8::f32x4){0.f, 0.f, 0.f, 0.f}, 0, 0, 0);
#pragma unroll
        for (int j = 0; j < 4; ++j) BU[(fq * 4 + j) * BUP + cb * 16 + fr] = cvtpk(are[j], aim[j]); }
}
__device__ __forceinline__ void ssm_load_bq(const unsigned char* sb, int g, bf16x4_t (&Bq)[8], int fr, int fq) {
    const bf16* bbh = (const bf16*)(sb + 16384) + (size_t)g * 128 * 16;
#pragma unroll
    for (int cb = 0; cb < 8; ++cb) Bq[cb] = *(const bf16x4_t*)(bbh + (cb * 16 + fr) * 16 + fq * 4);
}
__device__ __forceinline__ void ssm_local_phase(const Args& a, int l, LAS unsigned char* lds) {
    const int z = opq(); (void)z;
    const int tid = opqv((int)threadIdx.x), lane = tid & 63, wave = __builtin_amdgcn_readfirstlane(tid >> 6); const int G = (int)gridDim.x, bx = (int)blockIdx.x;
    const int vcu = (G % 8 == 0) ? (bx % 8) * (G / 8) + bx / 8 : bx; const int gw = vcu * NWAVES + wave, NGW = G * NWAVES;
    unsigned char* ws = (a.ws + z); const bf16* Z = (const bf16*)(ws + WS_Z);
    const unsigned char* sb = ws + WS_SSM + (size_t)l * SSM_L_BYTES;
    f32x2* SL = (f32x2*)(ws + WS_E);
    f32x2* EB = (f32x2*)(ws + WS_CIN);
    LAS unsigned* BU = (LAS unsigned*)(lds + RING_OFF) + wave * (16 * BUP);
    const int fr = lane & 15, fq = lane >> 4;
    __syncthreads();
    for (int w = gw; w < NB * 16 * 16; w += NGW) {
        const int g = w & 15, blk = (w >> 4) & 15, b = w >> 8;
        const f32x2 av = ((const f32x2*)sb)[g * 64 + lane];
        bf16x4_t Bq[8]; ssm_load_bq(sb, g, Bq, fr, fq);
        float xr = 0.f, xi = 0.f;
#pragma unroll 1
        for (int j = 0; j < 4; ++j) { const int c = blk * 4 + j;
            SL[((size_t)(b * 64 + c) * 16 + g) * 64 + lane] = (f32x2){xr, xi};
            const bf16* up = Z + (size_t)(b * SEQ + c * 64) * ZW + ZC + g * 16;
            bf16x4_t Af4[4];
#pragma unroll
            for (int tb = 0; tb < 4; ++tb) Af4[tb] = ssm_ld_a(up + (size_t)(tb * 16) * ZW, fr, fq);
#pragma unroll
            for (int tb = 0; tb < 4; ++tb) {
                ssm_bu16(Af4[tb], Bq, BU, fr, fq);
                LDS_WAIT(); asm volatile("" ::: "memory");
#pragma unroll
                for (int tt = 0; tt < 16; ++tt) { const unsigned bw = BU[tt * BUP + lane];
                    const float nr = av.x * xr - av.y * xi + bflo(bw), ni = av.x * xi + av.y * xr + bfhi(bw); xr = nr; xi = ni; }
                LDS_WAIT(); asm volatile("" ::: "memory");
            } }
        EB[((size_t)(b * 16 + blk) * 16 + g) * 64 + lane] = (f32x2){xr, xi};
    }
}
__device__ __forceinline__ void ssm_carry_phase(const Args& a, int l) {
    const int z = opq(); (void)z;
    const int tid = opqv((int)threadIdx.x), lane = tid & 63, wave = __builtin_amdgcn_readfirstlane(tid >> 6); const int G = (int)gridDim.x, bx = (int)blockIdx.x;
    const int vcu = (G % 8 == 0) ? (bx % 8) * (G / 8) + bx / 8 : bx; const int gw = vcu * NWAVES + wave, NGW = G * NWAVES, gt = vcu * 512 + tid;
    (void)lane; (void)gw; (void)NGW; (void)gt; (void)bx;
    if (gt >= NB * 16 * 64) return;
    unsigned char* ws = (a.ws + z); const unsigned char* sb = ws + WS_SSM + (size_t)l * SSM_L_BYTES;
    const int p = gt & 63, g = (gt >> 6) & 15, b = gt >> 10;
    const f32x2 a64 = ((const f32x2*)(sb + 8192))[g * 64 + p];
    const f32x2* E = (const f32x2*)(ws + WS_E); f32x2* CI = (f32x2*)(ws + WS_CIN);
    float sr = 0.f, si = 0.f;
    for (int c = 0; c < 64; ++c) { const size_t o = ((size_t)((b * 64 + c) * 16 + g)) * 64 + p;
        CI[o] = (f32x2){sr, si}; const f32x2 e = E[o];
        const float nr = a64.x * sr - a64.y * si + e.x, ni = a64.x * si + a64.y * sr + e.y; sr = nr; si = ni; }
}

__device__ __forceinline__ void ssm_final_phase(const Args& a, int l, LAS unsigned char* lds) {
    const int z = opq(); (void)z;
    const int tid = opqv((int)threadIdx.x), lane = tid & 63, wave = __builtin_amdgcn_readfirstlane(tid >> 6); const int G = (int)gridDim.x, bx = (int)blockIdx.x;
    const int vcu = (G % 8 == 0) ? (bx % 8) * (G / 8) + bx / 8 : bx; const int gw = vcu * NWAVES + wave, NGW = G * NWAVES, gt = vcu * 512 + tid;
    (void)lane; (void)gw; (void)NGW; (void)gt; (void)bx;
    unsigned char* ws = (a.ws + z); const bf16* Z = (const bf16*)(ws + WS_Z); bf16* AM = (bf16*)(ws + WS_AMIX);
    const unsigned char* sb = ws + WS_SSM + (size_t)l * SSM_L_BYTES;
    constexpr int YP = 264, XP = 136;
    LAS bf16* Ypre = (LAS bf16*)(lds + RING_OFF);
    LAS bf16* Xb = (LAS bf16*)(lds + RING_OFF + 34816) + wave * (16 * XP);
    LAS unsigned* BU = (LAS unsigned*)(lds + RING_OFF + 69632) + wave * (16 * BUP);
    constexpr int UP = 264; LAS bf16* Ut = (LAS bf16*)(lds + RING_OFF + 104448);
    const int fr = lane & 15, fq = lane >> 4;
    f32x2 av[2], a64[2]; float dsk[2]; bf16x4_t Bq[2][8]; bf16x8 Bf[2][4];
#pragma unroll
    for (int gi = 0; gi < 2; ++gi) { const int g = wave * 2 + gi;
        av[gi] = ((const f32x2*)sb)[g * 64 + lane]; a64[gi] = ((const f32x2*)(sb + 8192))[g * 64 + lane]; dsk[gi] = ((const float*)a.in[z + I_DSKIP])[l * 256 + g * 16 + fr];
        ssm_load_bq(sb, g, Bq[gi], fr, fq);
        const float* cre = (const float*)a.in[z + I_CRE] + ((size_t)(l * 16 + g) * 16 + fr) * 64 + fq * 4; const float* cim = (const float*)a.in[z + I_CIM] + ((size_t)(l * 16 + g) * 16 + fr) * 64 + fq * 4;
#pragma unroll
        for (int ks = 0; ks < 4; ++ks) { const f32x4 cr = *(const f32x4*)(cre + ks * 16), ci = *(const f32x4*)(cim + ks * 16);
#pragma unroll
            for (int q = 0; q < 4; ++q) { Bf[gi][ks][2 * q] = (short)f2bf(cr[q]); Bf[gi][ks][2 * q + 1] = (short)f2bf(-ci[q]); } } }
#pragma unroll 1
    for (int uu = vcu; uu < NB * 64; uu += G) {
        const int b = uu >> 6, c = (uu & 256) ? 63 - (uu & 63) : (uu & 63); const size_t m0 = (size_t)b * SEQ + c * 64;
        { const int row = tid >> 3, sg = tid & 7; const v4u* gp = (const v4u*)(Z + (m0 + row) * ZW + ZC + sg * 32); LAS v4u* lp = (LAS v4u*)(Ut + row * UP + sg * 32);
#pragma unroll
          for (int q = 0; q < 4; ++q) lp[q] = gp[q]; }
        float xr[2] = {0.f, 0.f}, xi[2] = {0.f, 0.f};
        for (int rp_ = 0; rp_ < REPN(15); ++rp_) { xr[0] = xr[1] = xi[0] = xi[1] = 0.f; const int blk = c >> 2, jc = c & 3;
          const f32x2* EBp = (const f32x2*)(ws + WS_CIN) + ((size_t)(b * 16) * 16 + wave * 2) * 64 + lane;
          f32x2 a256[2];
#pragma unroll
          for (int gi = 0; gi < 2; ++gi) { float pr = a64[gi].x, pi = a64[gi].y;
#pragma unroll
              for (int q = 0; q < 2; ++q) { const float tr = pr * pr - pi * pi, ti = 2.0f * pr * pi; pr = tr; pi = ti; }
              a256[gi] = (f32x2){pr, pi}; }
#pragma unroll 4
          for (int q = 0; q < blk; ++q) {
#pragma unroll
              for (int gi = 0; gi < 2; ++gi) { const f32x2 ev = EBp[(size_t)q * 1024 + gi * 64]; const float nr = a256[gi].x * xr[gi] - a256[gi].y * xi[gi] + ev.x, ni = a256[gi].x * xi[gi] + a256[gi].y * xr[gi] + ev.y; xr[gi] = nr; xi[gi] = ni; } }
#pragma unroll
          for (int gi = 0; gi < 2; ++gi) {
              for (int q = 0; q < jc; ++q) { const float nr = a64[gi].x * xr[gi] - a64[gi].y * xi[gi], ni = a64[gi].x * xi[gi] + a64[gi].y * xr[gi]; xr[gi] = nr; xi[gi] = ni; }
              const f32x2 sl = ((const f32x2*)(ws + WS_E))[((size_t)(b * 64 + c) * 16 + wave * 2 + gi) * 64 + lane]; xr[gi] += sl.x; xi[gi] += sl.y; } }
        __syncthreads();
        const float xr0s = xr[0], xi0s = xi[0], xr1s = xr[1], xi1s = xi[1];
#pragma unroll 1
        for (int rq_ = 0; rq_ < REPN(16); ++rq_) { xr[0] = xr0s; xi[0] = xi0s; xr[1] = xr1s; xi[1] = xi1s;
#pragma unroll
        for (int gi = 0; gi < 2; ++gi) {
            const int g = wave * 2 + gi;
#pragma unroll 1
            for (int tb = 0; tb < 4; ++tb) {
                ssm_bu16(*(const LAS bf16x4_t*)(Ut + (tb * 16 + fr) * UP + g * 16 + fq * 4), Bq[gi], BU, fr, fq);
                LDS_WAIT(); asm volatile("" ::: "memory");
                unsigned bw[16];
#pragma unroll
                for (int tt = 0; tt < 16; ++tt) bw[tt] = BU[tt * BUP + lane];
#pragma unroll
                for (int tt = 0; tt < 16; ++tt) {
                    const float nr = av[gi].x * xr[gi] - av[gi].y * xi[gi] + bflo(bw[tt]), ni = av[gi].x * xi[gi] + av[gi].y * xr[gi] + bfhi(bw[tt]); xr[gi] = nr; xi[gi] = ni;
                    ((LAS unsigned*)Xb)[tt * (XP / 2) + lane] = cvtpk(nr, ni); }
                LDS_WAIT(); asm volatile("" ::: "memory");
                pg8::f32x4 acc = {0.f, 0.f, 0.f, 0.f};
#pragma unroll
                for (int ks = 0; ks < 4; ++ks) { const bf16x8 Af = *(const LAS bf16x8*)(Xb + fr * XP + ks * 32 + fq * 8);
                    acc = __builtin_amdgcn_mfma_f32_16x16x32_bf16(Af, Bf[gi][ks], acc, 0, 0, 0); }
#pragma unroll
                for (int j = 0; j < 4; ++j) { const int t = tb * 16 + fq * 4 + j;
                    const float uu2 = bf2f(Ut[t * UP + g * 16 + fr]);
                    Ypre[t * YP + g * 16 + fr] = (bf16)f2bf(gelu_tanh(acc[j] + dsk[gi] * uu2)); }
                LDS_WAIT(); asm volatile("" ::: "memory");
            }
        }
        }
        __syncthreads();
#pragma unroll 1
        for (int rg_ = 0; rg_ < REPN(17); ++rg_)
        { pg8::f32x4 acc[4][2];
#pragma unroll
          for (int rb = 0; rb < 4; ++rb)
#pragma unroll
              for (int nb = 0; nb < 2; ++nb) acc[rb][nb] = (pg8::f32x4){0.f, 0.f, 0.f, 0.f};
          const bf16* wg = (const bf16*)(ws + WS_WGLU) + (size_t)l * 256 * 256;
#pragma unroll 2
          for (int ks = 0; ks < 8; ++ks) {
              bf16x8 Bw[2], Aw[4];
#pragma unroll
              for (int nb = 0; nb < 2; ++nb) Bw[nb] = *(const bf16x8*)(wg + (size_t)(wave * 32 + nb * 16 + fr) * 256 + ks * 32 + fq * 8);
#pragma unroll
              for (int rb = 0; rb < 4; ++rb) Aw[rb] = *(const LAS bf16x8*)(Ypre + (rb * 16 + fr) * YP + ks * 32 + fq * 8);
#pragma unroll
              for (int rb = 0; rb < 4; ++rb)
#pragma unroll
                  for (int nb = 0; nb < 2; ++nb) acc[rb][nb] = __builtin_amdgcn_mfma_f32_16x16x32_bf16(Aw[rb], Bw[nb], acc[rb][nb], 0, 0, 0);
          }
          LAS bf16* Yout = (LAS bf16*)(lds + RING_OFF + 69632);
#pragma unroll
          for (int nb = 0; nb < 2; ++nb) { const int n = wave * 32 + nb * 16 + fr; const float gb = ((const float*)a.in[z + I_GLUB])[l * 256 + n];
#pragma unroll
              for (int rb = 0; rb < 4; ++rb)
#pragma unroll
                  for (int j = 0; j < 4; ++j) { const int t = rb * 16 + fq * 4 + j;
                      const float yv = bf2f(Ypre[t * YP + n]);
                      Yout[t * YP + n] = (bf16)f2bf(yv * sigmoidf_(acc[rb][nb][j] + gb)); } }
          __syncthreads();
          { const int row = tid >> 3, seg = tid & 7; const LAS v4u* sp = (const LAS v4u*)(Yout + row * YP + seg * 32); v4u* dp = (v4u*)(AM + (m0 + row) * D + 768 + seg * 32);
#pragma unroll
            for (int q = 0; q < 4; ++q) dp[q] = sp[q]; }
        }
    }
}

__device__ __forceinline__ void attn_naive_unit(const Args& a, int b, int h, int mp, int cc, LAS unsigned char* lds, int tid, int lane, int wave) {
    const int z = opq();
    const bf16* Z = (const bf16*)((a.ws + z) + WS_Z);
    float* O = (float*)((a.ws + z) + (mp ? WS_O1 : WS_O0));
    const size_t m0 = (size_t)b * SEQ + cc * 64;
    const int qcol = ZQ + h * 128 + mp * 64, kcol = ZK + h * 128 + mp * 64, vcol = ZV + h * 128;
    LAS float* Qs = (LAS float*)(lds + RING_OFF);
    LAS unsigned* Vs = (LAS unsigned*)(lds + RING_OFF + 16384);
    LAS float* Ps = (LAS float*)(lds + RING_OFF + 32768) + wave * 512;
    __syncthreads();
    { const int r = tid >> 3, c8 = (tid & 7) * 8; const v4u w = *(const v4u*)(Z + (m0 + r) * ZW + qcol + c8); LAS float* q = Qs + r * 64 + c8;
      q[0] = bflo(w.x); q[1] = bfhi(w.x); q[2] = bflo(w.y); q[3] = bfhi(w.y); q[4] = bflo(w.z); q[5] = bfhi(w.z); q[6] = bflo(w.w); q[7] = bfhi(w.w); }
    float mrun[8], lrun[8], o0[8], o1[8];
#pragma unroll
    for (int i = 0; i < 8; ++i) { mrun[i] = -1e30f; lrun[i] = 0.f; o0[i] = 0.f; o1[i] = 0.f; }
    const size_t kb0 = (size_t)b * SEQ;
#pragma unroll 1
    for (int kt = 0; kt <= cc; ++kt) {
        __syncthreads();
        { const int key = tid >> 3, part = tid & 7; const bf16* vp = Z + (kb0 + kt * 64 + key) * ZW + vcol + part * 16;
          const v4u w0 = *(const v4u*)vp, w1 = *(const v4u*)(vp + 8); LAS v4u* d = (LAS v4u*)(Vs + key * 64 + part * 8); d[0] = w0; d[1] = w1; }
        float kf[64];
        { const bf16* kp = Z + (kb0 + kt * 64 + lane) * ZW + kcol;
#pragma unroll
          for (int q = 0; q < 8; ++q) { const v4u w = *(const v4u*)(kp + q * 8);
              kf[q * 8 + 0] = bflo(w.x); kf[q * 8 + 1] = bfhi(w.x); kf[q * 8 + 2] = bflo(w.y); kf[q * 8 + 3] = bfhi(w.y);
              kf[q * 8 + 4] = bflo(w.z); kf[q * 8 + 5] = bfhi(w.z); kf[q * 8 + 6] = bflo(w.w); kf[q * 8 + 7] = bfhi(w.w); } }
        __syncthreads();
#pragma unroll
        for (int i = 0; i < 8; ++i) {
            const LAS f32x4* qr = (const LAS f32x4*)(Qs + (wave * 8 + i) * 64);
            float s = 0.f;
#pragma unroll
            for (int d4 = 0; d4 < 16; ++d4) { const f32x4 q4 = qr[d4]; s += q4.x * kf[d4 * 4] + q4.y * kf[d4 * 4 + 1] + q4.z * kf[d4 * 4 + 2] + q4.w * kf[d4 * 4 + 3]; }
            const float mt = wave_max(s), mn = fmaxf(mrun[i], mt), al = __expf(mrun[i] - mn), p = __expf(s - mn);
            lrun[i] = lrun[i] * al + wave_sum(p); o0[i] *= al; o1[i] *= al; mrun[i] = mn;
            Ps[i * 64 + lane] = p;
        }
        LDS_WAIT(); asm volatile("" ::: "memory");
#pragma unroll 4
        for (int j4 = 0; j4 < 16; ++j4) {
            unsigned vw[4];
#pragma unroll
            for (int jj = 0; jj < 4; ++jj) vw[jj] = Vs[(j4 * 4 + jj) * 64 + lane];
#pragma unroll
            for (int i = 0; i < 8; ++i) { const f32x4 p4 = *(const LAS f32x4*)(Ps + i * 64 + j4 * 4);
                o0[i] += p4.x * bflo(vw[0]) + p4.y * bflo(vw[1]) + p4.z * bflo(vw[2]) + p4.w * bflo(vw[3]);
                o1[i] += p4.x * bfhi(vw[0]) + p4.y * bfhi(vw[1]) + p4.z * bfhi(vw[2]) + p4.w * bfhi(vw[3]); }
        }
    }
#pragma unroll
    for (int i = 0; i < 8; ++i) { const float rl = 1.0f / lrun[i];
        *(f32x2*)(O + (m0 + wave * 8 + i) * 512 + h * 128 + lane * 2) = (f32x2){o0[i] * rl, o1[i] * rl}; }
}
__device__ __forceinline__ void attn_naive_phase(const Args& a, LAS unsigned char* lds) {
    const int z = opq(); (void)z;
    const int tid = opqv((int)threadIdx.x), lane = tid & 63, wave = __builtin_amdgcn_readfirstlane(tid >> 6); const int G = (int)gridDim.x, bx = (int)blockIdx.x;
    const int vcu = (G % 8 == 0) ? (bx % 8) * (G / 8) + bx / 8 : bx; const int gw = vcu * NWAVES + wave, NGW = G * NWAVES, gt = vcu * 512 + tid;
    (void)lane; (void)gw; (void)NGW; (void)gt; (void)bx;
    for (int u = vcu; u < 2048; u += G) {
        const int bhm = u >> 5, j = u & 31, b = bhm >> 3, h = (bhm >> 1) & 3, mp = bhm & 1;
        attn_naive_unit(a, b, h, mp, j, lds, tid, lane, wave);
        attn_naive_unit(a, b, h, mp, 63 - j, lds, tid, lane, wave);
    }
}

__device__ __forceinline__ void attn_fast_phase(const Args& a, char* lds_generic) {
    const int z = opq();
    const int G = (int)gridDim.x, bx = (int)blockIdx.x; const int vcu = (G % 8 == 0) ? (bx % 8) * (G / 8) + bx / 8 : bx;
    const attn_body::bf16* Z = (const attn_body::bf16*)((a.ws + z) + WS_Z);
#pragma unroll 1
    for (int p = vcu; p < 1024; p += G) {
        const int stream = (p >> 8) * 32 + ((p & 255) >> 3), j = p & 7;
        const int b = stream >> 4, vh = stream & 15, h = vh >> 2, mp = (vh >> 1) & 1, vhalf = vh & 1;
        const attn_body::bf16* Q = Z + ZQ + h * 128 + mp * 64; const attn_body::bf16* K = Z + ZK + h * 128 + mp * 64; const attn_body::bf16* V = Z + ZV + h * 128 + vhalf * 64;
        attn_body::bf16* O = (attn_body::bf16*)((a.ws + z) + (mp ? WS_O1 : WS_O0)) + h * 128 + vhalf * 64;
#pragma unroll 1
        for (int k2 = 0; k2 < 2; ++k2) attn_body::attn_unit<8>(b, k2 ? 15 - j : j, Q, K, V, O, lds_generic);
    }
}

__device__ __forceinline__ void attn_v128_phase(const Args& a, char* lds_generic) {
    const int z = opq();
    const int G = (int)gridDim.x, bx = (int)blockIdx.x; const int vcu = (G % 8 == 0) ? (bx % 8) * (G / 8) + bx / 8 : bx;
    const attn128::bf16* Z = (const attn128::bf16*)((a.ws + z) + WS_Z);
#pragma unroll 1
    for (int p = vcu; p < 512; p += G) {
        const int stream = (p >> 8) * 32 + ((p & 255) >> 3), j = p & 7;
        const int b = stream >> 3, h = (stream >> 1) & 3, mp = stream & 1;
        const attn128::bf16* Q = Z + ZQ + h * 128 + mp * 64; const attn128::bf16* K = Z + ZK + h * 128 + mp * 64; const attn128::bf16* V = Z + ZV + h * 128;
        attn128::bf16* O = (attn128::bf16*)((a.ws + z) + (mp ? WS_O1 : WS_O0)) + h * 128;
#pragma unroll 1
        for (int k2 = 0; k2 < 2; ++k2) attn128::attn_unit<8>(b, k2 ? 15 - j : j, Q, K, V, O, lds_generic);
    }
}

__device__ __forceinline__ void attn_combine_phase(const Args& a, int l) {
    const int z = opq(); (void)z;
    const int tid = opqv((int)threadIdx.x), lane = tid & 63, wave = __builtin_amdgcn_readfirstlane(tid >> 6); const int G = (int)gridDim.x, bx = (int)blockIdx.x;
    const int vcu = (G % 8 == 0) ? (bx % 8) * (G / 8) + bx / 8 : bx; const int gw = vcu * NWAVES + wave, NGW = G * NWAVES;
    unsigned char* ws = (a.ws + z); const bf16* O0 = (const bf16*)(ws + WS_O0); const bf16* O1 = (const bf16*)(ws + WS_O1); bf16* AM = (bf16*)(ws + WS_AMIX);
    const float lam = ((const float*)(ws + WS_LAM))[l], post = 1.0f - lambda_init_of(l);
    float sg[8];
    { const float* sp = (const float*)a.in[z + I_SUBLN] + l * 128 + 8 * (lane & 15);
#pragma unroll
      for (int i = 0; i < 8; ++i) sg[i] = sp[i] * post; }
#pragma unroll 1
    for (int m4 = gw; m4 < T / 4; m4 += NGW) {
        v4u pw[4], qw[4];
#pragma unroll
        for (int r = 0; r < 4; ++r) { const size_t m = (size_t)m4 * 4 + r; pw[r] = __builtin_nontemporal_load((const v4u*)(O0 + m * 512) + lane); qw[r] = __builtin_nontemporal_load((const v4u*)(O1 + m * 512) + lane); }
#pragma unroll
        for (int r = 0; r < 4; ++r) { const size_t m = (size_t)m4 * 4 + r;
            float d[8];
            d[0] = bflo(pw[r].x) - lam * bflo(qw[r].x); d[1] = bfhi(pw[r].x) - lam * bfhi(qw[r].x); d[2] = bflo(pw[r].y) - lam * bflo(qw[r].y); d[3] = bfhi(pw[r].y) - lam * bfhi(qw[r].y);
            d[4] = bflo(pw[r].z) - lam * bflo(qw[r].z); d[5] = bfhi(pw[r].z) - lam * bfhi(qw[r].z); d[6] = bflo(pw[r].w) - lam * bflo(qw[r].w); d[7] = bfhi(pw[r].w) - lam * bfhi(qw[r].w);
            float ss = 0.f;
#pragma unroll
            for (int i = 0; i < 8; ++i) ss += d[i] * d[i];
            ss += DPPF(ss, 0xB1); ss += DPPF(ss, 0x4E); ss += DPPF(ss, 0x141); ss += DPPF(ss, 0x140);
            const float rr = rsqrtf(ss * (1.0f / 128.0f) + NORM_EPS);
            v4u o; o.x = pk2(d[0] * rr * sg[0], d[1] * rr * sg[1]); o.y = pk2(d[2] * rr * sg[2], d[3] * rr * sg[3]); o.z = pk2(d[4] * rr * sg[4], d[5] * rr * sg[5]); o.w = pk2(d[6] * rr * sg[6], d[7] * rr * sg[7]);
            *((v4u*)(AM + m * D + 256) + lane) = o; }
    }
}

__device__ __forceinline__ void norm2_router_phase(const Args& a, int l, LAS unsigned char* lds, bool do_cnt) {
    const int z = opq(); (void)z;
    const int tid = opqv((int)threadIdx.x), lane = tid & 63, wave = __builtin_amdgcn_readfirstlane(tid >> 6); const int G = (int)gridDim.x, bx = (int)blockIdx.x;
    const int vcu = (G % 8 == 0) ? (bx % 8) * (G / 8) + bx / 8 : bx; const int gw = vcu * NWAVES + wave, NGW = G * NWAVES;
    unsigned char* ws = (a.ws + z);
    const float* mod = (const float*)(ws + WS_MOD); bf16* H = (bf16*)(ws + WS_H);
    int* tok_e = (int*)(ws + WS_TOKE); float* tok_w = (float*)(ws + WS_TOKW); int* tok_l = (int*)(ws + WS_TOKL);
    LAS f32x4* RW4 = (LAS f32x4*)(lds + RING_OFF);
    LAS int* lcnt = (LAS int*)(lds + RING_OFF + 147456);
    LAS float* rbias = (LAS float*)(lds + RING_OFF + 147456 + 128);
    const bf16* XBp = (const bf16*)(ws + WS_XB);
    v4u nx[4][2];
#define P8_PREFETCH(row0) do { _Pragma("unroll") for (int r = 0; r < 4; ++r) { const v4u* xr_ = (const v4u*)(XBp + (size_t)((row0) + r) * D) + lane; nx[r][0] = __builtin_nontemporal_load(xr_); nx[r][1] = __builtin_nontemporal_load(xr_ + 64); } } while (0)
    int blk = gw;
    if (blk < T / 16) P8_PREFETCH(blk * 16);
    __syncthreads();
    { const f32x4* rwt = (const f32x4*)((const float*)(ws + WS_RWT) + (size_t)l * 36 * 1024);
#pragma unroll
      for (int hb = 0; hb < 2; ++hb) { f32x4 t_[9];
#pragma unroll
          for (int k = 0; k < 9; ++k) { const int i = tid + 512 * (hb * 9 + k), q = (i >> 6) & 3; t_[k] = rwt[(i & ~255) + 128 * (q >> 1) + 2 * (i & 63) + (q & 1)]; }
#pragma unroll
          for (int k = 0; k < 9; ++k) RW4[tid + 512 * (hb * 9 + k)] = t_[k]; }
      if (tid < 32) lcnt[tid] = 0;
      if (tid < 36) rbias[tid] = tid < 4 ? ((const float*)a.in[z + I_RGB])[l * 4 + tid] : ((const float*)a.in[z + I_REB])[l * 32 + tid - 4]; }
    __syncthreads();
#pragma unroll 1
    for (; blk < T / 16; blk += NGW) {
      const float* mrow = mod + ((size_t)l * NB + ((blk * 16) >> 12)) * 6144;
      f32x4 gs_[4], shv_[4];
#pragma unroll
      for (int j = 0; j < 4; ++j) { const int c4 = 128 * (j >> 1) + 2 * lane + (j & 1);
          gs_[j] = *((const f32x4*)((const float*)a.in[z + I_N2G] + l * D) + c4) * (*((const f32x4*)(mrow + 4 * 1024) + c4) + 1.0f); shv_[j] = *((const f32x4*)(mrow + 3 * 1024) + c4); }
#pragma unroll 1
      for (int i4 = 0; i4 < 4; ++i4) {
        const int mb = blk * 16 + i4 * 4;
        f32x4 hv[4][4];
#pragma unroll
        for (int r = 0; r < 4; ++r)
#pragma unroll
            for (int hq = 0; hq < 2; ++hq) { const v4u xw = nx[r][hq];
                hv[r][2 * hq] = (f32x4){bflo(xw.x), bfhi(xw.x), bflo(xw.y), bfhi(xw.y)}; hv[r][2 * hq + 1] = (f32x4){bflo(xw.z), bfhi(xw.z), bflo(xw.w), bfhi(xw.w)}; }
        { const int nrow = i4 < 3 ? mb + 4 : (blk + NGW) * 16;
          if (nrow < T) P8_PREFETCH(nrow); }
        { float ss[4];
#pragma unroll
          for (int r = 0; r < 4; ++r) { f32x2 s2 = {0.f, 0.f};
#pragma unroll
              for (int j = 0; j < 4; ++j) { s2 = hv[r][j].xy * hv[r][j].xy + s2; s2 = hv[r][j].zw * hv[r][j].zw + s2; }
              ss[r] = s2.x + s2.y; }
          wave_sum4(ss[0], ss[1], ss[2], ss[3], lane);
#pragma unroll
          for (int r = 0; r < 4; ++r) {
            const float rr = rsqrtf(ss[r] * (1.0f / D) + NORM_EPS);
            v4u* ho = (v4u*)(H + (size_t)(mb + r) * D) + lane;
#pragma unroll
            for (int j = 0; j < 4; ++j) hv[r][j] = (hv[r][j] * rr) * gs_[j] + shv_[j];
#pragma unroll
            for (int hq = 0; hq < 2; ++hq) { const f32x4 ha = hv[r][2 * hq], hb = hv[r][2 * hq + 1];
                v4u o; o.x = pk2(ha.x, ha.y); o.y = pk2(ha.z, ha.w); o.z = pk2(hb.x, hb.y); o.w = pk2(hb.z, hb.w); ho[64 * hq] = o; }
          } }
        float gl[4][4];
        { f32x2 s2[4][4];
#pragma unroll
          for (int r = 0; r < 4; ++r)
#pragma unroll
              for (int j = 0; j < 4; ++j) s2[r][j] = (f32x2){0.f, 0.f};
#pragma unroll
          for (int j = 0; j < 4; ++j)
#pragma unroll
              for (int q = 0; q < 4; ++q) { const f32x4 w = RW4[j * 256 + 64 * q + lane];
#pragma unroll
                  for (int r = 0; r < 4; ++r) { s2[r][j] = hv[r][q].xy * w.xy + s2[r][j]; s2[r][j] = hv[r][q].zw * w.zw + s2[r][j]; } }
#pragma unroll
          for (int r = 0; r < 4; ++r) {
#pragma unroll
              for (int j = 0; j < 4; ++j) gl[r][j] = s2[r][j].x + s2[r][j].y;
              wave_sum4(gl[r][0], gl[r][1], gl[r][2], gl[r][3], lane); } }
#pragma unroll
        for (int r = 0; r < 4; ++r) {
#pragma unroll
            for (int j = 0; j < 4; ++j) gl[r][j] += rbias[j];
            int gi = 0; float gm = gl[r][0];
#pragma unroll
            for (int j = 1; j < 4; ++j) if (gl[r][j] > gm) { gm = gl[r][j]; gi = j; }
            float gs = 0.f;
#pragma unroll
            for (int j = 0; j < 4; ++j) gs += __expf(gl[r][j] - gm);
            const float pg = __builtin_amdgcn_rcpf(gs);
            gi = __builtin_amdgcn_readfirstlane(gi);
            float el[8];
            { f32x2 s2[8];
#pragma unroll
              for (int j = 0; j < 8; ++j) { s2[j] = (f32x2){0.f, 0.f}; const LAS f32x4* wrow = RW4 + (4 + gi * 8 + j) * 256 + lane;
#pragma unroll
                  for (int q = 0; q < 4; ++q) { const f32x4 w = wrow[64 * q]; s2[j] = hv[r][q].xy * w.xy + s2[j]; s2[j] = hv[r][q].zw * w.zw + s2[j]; }
                  el[j] = s2[j].x + s2[j].y; }
              wave_sum4(el[0], el[1], el[2], el[3], lane); wave_sum4(el[4], el[5], el[6], el[7], lane); }
#pragma unroll
            for (int j = 0; j < 8; ++j) el[j] += rbias[4 + gi * 8 + j];
            int e0 = 0; float m0v = el[0];
#pragma unroll
            for (int j = 1; j < 8; ++j) if (el[j] > m0v) { m0v = el[j]; e0 = j; }
            int e1 = -1; float m1v = -3.0e38f;
#pragma unroll
            for (int j = 0; j < 8; ++j) if (j != e0 && el[j] > m1v) { m1v = el[j]; e1 = j; }
            if (e1 < 0) { e1 = (e0 + 1) & 7; m1v = el[0]; }
            const float x1 = __expf(m1v - m0v), w0 = pg * __builtin_amdgcn_rcpf(1.0f + x1), w1 = w0 * x1;
            if (lane == 0) {
                const int m = mb + r, ea = gi * 8 + e0, eb = gi * 8 + e1;
                typedef int i32x2 __attribute__((ext_vector_type(2)));
                const int l0 = __hip_atomic_fetch_add(&lcnt[ea], 1, __ATOMIC_RELAXED, __HIP_MEMORY_SCOPE_WORKGROUP), l1 = __hip_atomic_fetch_add(&lcnt[eb], 1, __ATOMIC_RELAXED, __HIP_MEMORY_SCOPE_WORKGROUP);
                *(i32x2*)(tok_e + 2 * m) = (i32x2){ea, eb}; *(f32x2*)(tok_w + 2 * m) = (f32x2){w0, w1}; *(i32x2*)(tok_l + 2 * m) = (i32x2){l0, l1};
            }
        }
      }
    }
#undef P8_PREFETCH
    __syncthreads();
    if (tid < 32 && do_cnt) { const int c = lcnt[tid];
        const unsigned old = __hip_atomic_fetch_add((unsigned*)(ws + WS_CTL) + CW_CNT + l * 64 + tid, (unsigned)c, RLX_AGENT);
        ((int*)(ws + WS_WGBASE))[bx * 32 + tid] = (int)old; }
}

__device__ __forceinline__ void moe_scatter_phase(const Args& a, int l, LAS unsigned char* lds) {
    const int z = opq(); (void)z;
    const int tid = opqv((int)threadIdx.x), lane = tid & 63, wave = __builtin_amdgcn_readfirstlane(tid >> 6); const int G = (int)gridDim.x, bx = (int)blockIdx.x;
    const int vcu = (G % 8 == 0) ? (bx % 8) * (G / 8) + bx / 8 : bx; const int gw = vcu * NWAVES + wave, NGW = G * NWAVES;
    unsigned char* ws = (a.ws + z);
    LAS int* pst = (LAS int*)(lds + RING_OFF);
    LAS int* pend = pst + 32;
    int* rowmap = (int*)(ws + WS_ROWMAP);
    __syncthreads();
    if (tid == 0) {
        int run = 0; int* tile_e = (int*)(ws + WS_TILEE);
        for (int e = 0; e < NEXP; ++e) { const int c = (int)__hip_atomic_load((unsigned*)(ws + WS_CTL) + CW_CNT + l * 64 + e, RLX_AGENT); const int pad = (c + 255) & ~255;
            pst[e] = run + ((const int*)(ws + WS_WGBASE))[bx * 32 + e]; pend[e] = run + c; pend[32 + e] = run + pad;
            if (bx == 0) for (int q = 0; q < (pad >> 8); ++q) tile_e[(run >> 8) + q] = e;
            run += pad; }
        if (bx == 0) tile_e[511] = run >> 8;
    }
    __syncthreads();
    { const int e = bx & 31; for (int s = pend[e] + tid; s < pend[32 + e]; s += 512) rowmap[s] = 0; }
    const int* tok_e = (const int*)(ws + WS_TOKE); const int* tok_l = (const int*)(ws + WS_TOKL); int* tok_s = (int*)(ws + WS_TOKS);
    for (int m4b = gw * 4; m4b < T / 4; m4b += NGW * 4) {
        if (lane < 32) { const int m = m4b * 4 + (lane >> 1), k = lane & 1;
            const int s = pst[tok_e[2 * m + k]] + tok_l[2 * m + k]; tok_s[2 * m + k] = s; rowmap[s] = m; }
    }
}

__device__ __forceinline__ void stagger_delay(int steps, int ticks_per_step) {
    const unsigned long long t0 = __builtin_amdgcn_s_memrealtime(), want = (unsigned long long)(steps * ticks_per_step);
    while (__builtin_amdgcn_s_memrealtime() - t0 < want) __builtin_amdgcn_s_sleep(8);
}
__global__ void __launch_bounds__(NWAVES * 64, 2) fwd(Args args) {
    extern __shared__ __attribute__((aligned(16))) unsigned char lds_raw[];
    LAS unsigned char* lds = (LAS unsigned char*)lds_raw;
    for (int u = threadIdx.x; u < (LDS_BYTES - LDSCTL_OFF) / 4; u += NWAVES * 64) ((LAS unsigned*)(lds + LDSCTL_OFF))[u] = 0u;
    __syncthreads();
#if MK_MULTI
#define GRID_BAR() do { } while (0)
#else
    XcdBarrier bar = xcd_barrier_post((unsigned*)(args.ws + WS_CTL) + CW_BAR, (volatile LAS unsigned*)(lds + MISC_OFF) + 8);
#define GRID_BAR() xcd_barrier(bar)
#endif
    const int lo = args.ph_lo, hi = args.ph_hi;
#ifndef PHMASK
#define PHMASK 0xFFFF
#endif
#define EN(p) (((PHMASK) >> (p)) & 1)
#ifndef REPMASK
#define REPMASK 0
#endif
#define REPEAT(b) _Pragma("unroll 1") for (int rep_ = 0; rep_ < ((((REPMASK) >> (b)) & 1) ? 2 : 1); ++rep_)
#define IN(k) (lo <= (k) && (k) < hi)
#define SEAM(k) do { if (IN(k) && IN((k) + 1)) { GRID_BAR(); if (((REPMASK) >> 14) & 1) GRID_BAR(); } } while (0)

    if (EN(11) && IN(0)) { REPEAT(11) prologue_phase(args, lds); SEAM(0); }

#pragma unroll 1
    for (int l = 0; l < DEPTH; ++l) {
        const int pb = 1 + l * PH_PER_LAYER;
        if (EN(0) && IN(pb + 0)) { norm1_phase(args, l, l == 0, true); REPEAT(0) moe_weights_phase(args, l, lds); SEAM(pb + 0); }
        if (EN(1) && IN(pb + 1)) { unsigned char* ws = args.ws + opq(); const int G = (int)gridDim.x, bx = (int)blockIdx.x;
            pg8::Gemm g{(const pg8::bf16_t*)(ws + WS_H), (const pg8::bf16_t*)(ws + WS_WCAT) + (size_t)l * NCAT * 1024, 1024, 1024, 1024}; pg8::StaticOrder S; S.init(T, NCAT, G, bx);
            pg8::EpiZG E{(pg8::bf16_t*)(ws + WS_Z), (unsigned char*)(ws + WS_G), (const float*)args.in[opq() + I_GATEB] + l * GWD,
                         (const float*)args.in[opq() + I_QNG] + l * 64, (const float*)args.in[opq() + I_KNG] + l * 64, (const float*)(ws + WS_ROPE_C), (const float*)(ws + WS_ROPE_S)};
#ifdef STAGGER_P2
            stagger_delay((int)(blockIdx.x >> 3) & 7, STAGGER_P2);
#endif
            REPEAT(1) pg8::gemm_phase<pg8::EpiZG, pg8::StaticOrder, true, true>(lds + RING_OFF, g, S, E);
            SEAM(pb + 1);
        }
        if (EN(3) && IN(pb + 3)) {
            REPEAT(2) { pool_phase(args, lds); ssm_local_phase(args, l, lds); }
            __syncthreads();
#if ATTN_FAST
#if ATTN_V128
            REPEAT(3) attn_v128_phase(args, (char*)lds_raw + RING_OFF);
#else
            REPEAT(3) attn_fast_phase(args, (char*)lds_raw + RING_OFF);
#endif
#else
            attn_naive_phase(args, lds);
#endif
            SEAM(pb + 3); }
        if (EN(4) && IN(pb + 4)) { REPEAT(12) attn_combine_phase(args, l); REPEAT(4) ssm_final_phase(args, l, lds); SEAM(pb + 4); }
        if (EN(5) && IN(pb + 5)) { unsigned char* ws = args.ws + opq(); const int G = (int)gridDim.x, bx = (int)blockIdx.x;
            const pg8::bf16_t* am = (const pg8::bf16_t*)(ws + WS_AMIX); pg8::bf16_t* mx = (pg8::bf16_t*)(ws + WS_MIXED); const unsigned char* gt_ = (const unsigned char*)(ws + WS_G);
            const pg8::bf16_t* wmix = (const pg8::bf16_t*)(ws + WS_WMIX) + (size_t)l * 1024 * 1024;
            pg8::StaticOrder S; S.init(T, D, G, bx);
            { pg8::Gemm g{am, wmix, 1024, 1024, 1024}; pg8::EpiMixFused E{mx, gt_}; pg8::MixOrder MS{S};
              REPEAT(5) pg8::gemm_phase<pg8::EpiMixFused, pg8::MixOrder, true, true>(lds + RING_OFF, g, MS, E); }
            SEAM(pb + 5);
        }
        if (EN(6) && IN(pb + 6)) { unsigned char* ws = args.ws + opq(); const int G = (int)gridDim.x, bx = (int)blockIdx.x;
            pg8::Gemm g{(const pg8::bf16_t*)(ws + WS_MIXED), (const pg8::bf16_t*)(ws + WS_WO) + (size_t)l * 1024 * 1024, 1024, 1024, 1024}; pg8::StaticOrder S; S.init(T, D, G, bx);
            REPEAT(6) { pg8::bf16_t* xb = (pg8::bf16_t*)(ws + WS_XB); pg8::bf16_t* xo = xb; if (rep_ + 1 < REPN(6)) xo = (pg8::bf16_t*)(ws + WS_O0);
            const float* g1 = (const float*)(ws + WS_MOD) + (size_t)l * NB * 6144 + 2 * 1024;
            if (l == 0) { pg8::EpiResid<true> E{(const float*)args.in[opq() + I_X], xb, g1, xo};
                pg8::gemm_phase<pg8::EpiResid<true>, pg8::StaticOrder, true, true>(lds + RING_OFF, g, S, E); }
            else { pg8::EpiResid<false> E{nullptr, xb, g1, xo};
                pg8::gemm_phase<pg8::EpiResid<false>, pg8::StaticOrder, true, true>(lds + RING_OFF, g, S, E); } }
            SEAM(pb + 6);
        }
        if (EN(7) && IN(pb + 7)) { REPEAT(7) norm2_router_phase(args, l, lds, rep_ == ((((REPMASK) >> 7) & 1) ? 1 : 0)); SEAM(pb + 7); }
        if (EN(8) && IN(pb + 8)) { REPEAT(8) moe_scatter_phase(args, l, lds); SEAM(pb + 8); }
        if (EN(9) && IN(pb + 9)) { unsigned char* ws = args.ws + opq(); const int G = (int)gridDim.x, bx = (int)blockIdx.x; const int vcu = (G % 8 == 0) ? (bx % 8) * (G / 8) + bx / 8 : bx;
            const int* tile_e = (const int*)(ws + WS_TILEE);
            pg8::GatherOrder S{tile_e, (const int*)(ws + WS_ROWMAP), __builtin_amdgcn_readfirstlane(tile_e[511]), G, vcu};
            pg8::Gemm g{(const pg8::bf16_t*)(ws + WS_H), (const pg8::bf16_t*)(ws + WS_W13), 1024, 1024, 1024};
            pg8::EpiSwiGLU E{(pg8::bf16_t*)(ws + WS_ACT)};
            REPEAT(9) pg8::gemm_phase<pg8::EpiSwiGLU, pg8::GatherOrder, true, true>(lds + RING_OFF, g, S, E);
            SEAM(pb + 9);
        }
        if (EN(10) && IN(pb + 10)) { unsigned char* ws = args.ws + opq(); const int G = (int)gridDim.x, bx = (int)blockIdx.x; const int vcu = (G % 8 == 0) ? (bx % 8) * (G / 8) + bx / 8 : bx;
            const int* tile_e = (const int*)(ws + WS_TILEE);
            pg8::GroupedOrder S{tile_e, __builtin_amdgcn_readfirstlane(tile_e[511]), G, vcu};
            pg8::Gemm g{(const pg8::bf16_t*)(ws + WS_ACT), (const pg8::bf16_t*)(ws + WS_W2), 512, 512, 512};
            pg8::EpiY E{(pg8::bf16_t*)(ws + WS_Y)};
            REPEAT(10) pg8::gemm_phase<pg8::EpiY, pg8::GroupedOrder, true, true>(lds + RING_OFF, g, S, E);
            SEAM(pb + 10);
        }
    }
    if (EN(12) && IN(N_PHASES - 1)) norm1_phase(args, DEPTH, false, false);
#undef IN
#undef SEAM
}

extern "C" void kernel_launch(void* const* d_in, const int* in_sizes, int n_in, void* d_out, int out_size, void* d_ws, size_t ws_size, hipStream_t stream) {
    static int grid = 0;
    if (grid == 0) {
        if (n_in != 40 || out_size != T * D || ws_size < WS_END) { fprintf(stderr, "kernel_launch: unexpected shapes (n_in %d out %d ws %zu)\n", n_in, out_size, ws_size); grid = -1; return; }
        int dev = 0, cus = 0, per_cu = 0;
        if (hipGetDevice(&dev) != hipSuccess || hipDeviceGetAttribute(&cus, hipDeviceAttributeMultiprocessorCount, dev) != hipSuccess) { grid = -1; return; }
        if (hipFuncSetAttribute((const void*)fwd, hipFuncAttributeMaxDynamicSharedMemorySize, LDS_BYTES) != hipSuccess) { fprintf(stderr, "kernel_launch: hipFuncSetAttribute failed\n"); grid = -1; return; }
        if (hipOccupancyMaxActiveBlocksPerMultiprocessor(&per_cu, (const void*)fwd, NWAVES * 64, LDS_BYTES) != hipSuccess || per_cu < 1) fprintf(stderr, "kernel_launch: occupancy query says %d\n", per_cu);
        (void)hipGetLastError();
        grid = cus;
    }
    if (grid < 0) return;
    if (hipMemsetAsync((char*)d_ws + WS_CTL, 0, CTL_ZERO_BYTES, stream) != hipSuccess) return;
    Args a{};
    for (int i = 0; i < 40; ++i) a.in[i] = d_in[i];
    a.out = (float*)d_out; a.ws = (unsigned char*)d_ws;
#if MK_MULTI
    for (int p = 0; p < N_PHASES; ++p) { a.ph_lo = p; a.ph_hi = p + 1; hipLaunchKernelGGL(fwd, dim3(grid), dim3(NWAVES * 64), LDS_BYTES, stream, a); }
#else
    a.ph_lo = 0; a.ph_hi = N_PHASES;
    hipLaunchKernelGGL(fwd, dim3(grid), dim3(NWAVES * 64), LDS_BYTES, stream, a);
#endif
}
```
